# Optimizing an MI355X kernel written in HIP

```python
import jax
import jax.numpy as jnp
from jax import lax
import numpy as np

D_MODEL = 1024
BATCH = 4
SEQ = 4096
DEPTH = 2

HEAD_DIM = 64
BLOCK = 128
SWA_HEADS = D_MODEL // (2 * HEAD_DIM)
SWA_KV_HEADS = SWA_HEADS // 4
SWA_GROUP = SWA_HEADS // SWA_KV_HEADS
WINDOW = 128
RWKV_HEADS = D_MODEL // (2 * HEAD_DIM)
RWKV_DIM = RWKV_HEADS * HEAD_DIM
DECAY_LORA = 64
ICLR_LORA = 64
GATE_LORA = 128
FOX_HEADS = D_MODEL // HEAD_DIM
FOX_DIM = FOX_HEADS * HEAD_DIM
D_FF = 2816
PLE_DIM = 256
N_EVEN = (DEPTH + 1) // 2
N_ODD = DEPTH // 2
NORM_EPS = 1e-6
GN_EPS = 64e-5
L2_EPS = 1e-12

SWA_Q = SWA_HEADS * HEAD_DIM
SWA_KV = SWA_KV_HEADS * HEAD_DIM
SWA_COLS = SWA_Q + 2 * SWA_KV
RWKV_COLS = 3 * RWKV_DIM + DECAY_LORA + ICLR_LORA + GATE_LORA
RWKV_SPLITS = [RWKV_DIM, 2 * RWKV_DIM, 3 * RWKV_DIM,
               3 * RWKV_DIM + DECAY_LORA, 3 * RWKV_DIM + DECAY_LORA + ICLR_LORA]
EVEN_IN = SWA_COLS + RWKV_COLS
EVEN_OUT = SWA_Q + RWKV_DIM
FOX_IN = 3 * FOX_DIM + FOX_HEADS

kernel_name = "hybrid_swa_rwkv7_fox_macaron"


def rms_norm(x, g):
    xf = x.astype(jnp.float32)
    y = xf * lax.rsqrt(jnp.mean(xf * xf, axis=-1, keepdims=True) + NORM_EPS)
    return (y * g.astype(jnp.float32)).astype(x.dtype)


def swiglu(h, w_gu, w_down):
    g, u = jnp.split(h @ w_gu, 2, axis=-1)
    return (jax.nn.silu(g) * u) @ w_down


def alibi_slopes(n):
    return 2.0 ** (-8.0 * jnp.arange(1, n + 1, dtype=jnp.float32) / n)


def sliding_window_attention(q, k, v, sinks):
    b, s = q.shape[:2]
    nb = s // BLOCK
    scale = HEAD_DIM ** -0.5
    qb = q.reshape(b, nb, BLOCK, SWA_KV_HEADS, SWA_GROUP, HEAD_DIM)
    pad = ((0, 0), (BLOCK, 0), (0, 0), (0, 0))
    kp = jnp.pad(k, pad).reshape(b, nb + 1, BLOCK, SWA_KV_HEADS, HEAD_DIM)
    vp = jnp.pad(v, pad).reshape(b, nb + 1, BLOCK, SWA_KV_HEADS, HEAD_DIM)
    kb = jnp.concatenate([kp[:, :-1], kp[:, 1:]], axis=2)
    vb = jnp.concatenate([vp[:, :-1], vp[:, 1:]], axis=2)
    logits = jnp.einsum('bnqhgd,bnkhd->bnhgqk', qb, kb).astype(jnp.float32) * scale
    qi = jnp.arange(BLOCK)[:, None]
    ki = jnp.arange(2 * BLOCK)[None, :]
    dist = qi + BLOCK - ki
    blk = jnp.arange(nb)[:, None, None]
    valid = (dist >= 0) & (dist < WINDOW) & (blk * BLOCK - BLOCK + ki >= 0)
    slopes = alibi_slopes(SWA_HEADS).reshape(SWA_KV_HEADS, SWA_GROUP)
    logits = logits - slopes[:, :, None, None] * dist.astype(jnp.float32)
    logits = jnp.where(valid[None, :, None, None], logits, -jnp.inf)
    sink = sinks.astype(jnp.float32).reshape(SWA_KV_HEADS, SWA_GROUP)[:, :, None]
    m = jnp.maximum(logits.max(axis=-1), sink)
    pr = jnp.exp(logits - m[..., None])
    denom = pr.sum(axis=-1) + jnp.exp(sink - m)
    pr = pr / denom[..., None]
    out = jnp.einsum('bnhgqk,bnkhd->bnqhgd', pr.astype(v.dtype), vb)
    return out.reshape(b, s, SWA_Q)


def rwkv7_time_mix(h, mu, w0, w2, a0, a2, g2, k_k, k_a, r_k, ln_w, ln_b):
    b, s, _ = h.shape
    f32 = jnp.float32
    shifted = jnp.pad(h[:, :-1], ((0, 0), (1, 0), (0, 0)))
    h = h + (shifted - h) * mu
    r, k, v, xw, xa, xg = jnp.split(h, RWKV_SPLITS, axis=-1)
    wlog = -jax.nn.softplus(-(w0 + jnp.tanh(xw) @ w2)) - 0.5
    a = jax.nn.sigmoid(a0 + xa @ a2)
    g = jax.nn.sigmoid(xg) @ g2
    hd = lambda t: t.astype(f32).reshape(b, s, RWKV_HEADS, HEAD_DIM)
    r, k, v, wlog, a = hd(r), hd(k), hd(v), hd(wlog), hd(a)
    kk = k * k_k.astype(f32).reshape(RWKV_HEADS, HEAD_DIM)
    kk = kk / jnp.maximum(jnp.sqrt(jnp.sum(kk * kk, axis=-1, keepdims=True)), L2_EPS)
    k = k * (1.0 + (a - 1.0) * k_a.astype(f32).reshape(RWKV_HEADS, HEAD_DIM))
    decay = jnp.exp(-jnp.exp(wlog))

    def step(state, inp):
        r_t, w_t, k_t, v_t, kk_t, a_t = inp
        s_kk = jnp.einsum('bhij,bhj->bhi', state, kk_t)
        state = (state * w_t[:, :, None, :]
                 - s_kk[..., None] * (kk_t * a_t)[:, :, None, :]
                 + v_t[..., None] * k_t[:, :, None, :])
        return state, jnp.einsum('bhij,bhj->bhi', state, r_t)

    xs = tuple(jnp.moveaxis(t, 1, 0) for t in (r, decay, k, v, kk, a))
    state0 = jnp.zeros((b, RWKV_HEADS, HEAD_DIM, HEAD_DIM), f32)
    _, y = lax.scan(step, state0, xs)
    y = jnp.moveaxis(y, 0, 1)
    mean = jnp.mean(y, axis=-1, keepdims=True)
    var = jnp.mean(jnp.square(y - mean), axis=-1, keepdims=True)
    y = ((y - mean) * lax.rsqrt(var + GN_EPS) * ln_w.astype(f32).reshape(RWKV_HEADS, HEAD_DIM)
         + ln_b.astype(f32).reshape(RWKV_HEADS, HEAD_DIM))
    y = y + jnp.sum(r * k * r_k.astype(f32), axis=-1, keepdims=True) * v
    return (y.reshape(b, s, RWKV_DIM) * g.astype(f32)).astype(h.dtype)


def forgetting_attention(q, k, v, log_f):
    b, s = q.shape[:2]
    nb = s // BLOCK
    scale = HEAD_DIM ** -0.5
    c = jnp.moveaxis(jnp.cumsum(log_f, axis=1), 1, 2)
    key_pos = jnp.arange(s)

    def one_block(n):
        start = n * BLOCK
        qb = lax.dynamic_slice_in_dim(q, start, BLOCK, axis=1)
        cq = lax.dynamic_slice_in_dim(c, start, BLOCK, axis=2)
        logits = (jnp.einsum('bqhd,bkhd->bhqk', qb, k).astype(jnp.float32) * scale
                  + cq[..., None] - c[:, :, None, :])
        qpos = start + jnp.arange(BLOCK)
        logits = jnp.where(key_pos[None, :] <= qpos[:, None], logits, -jnp.inf)
        pr = jax.nn.softmax(logits, axis=-1)
        return jnp.einsum('bhqk,bkhd->bqhd', pr.astype(v.dtype), v)

    out = lax.map(one_block, jnp.arange(nb))
    return jnp.moveaxis(out, 0, 1).reshape(b, s, FOX_DIM)


def setup_inputs(seed: int = 0) -> dict:
    key = jax.random.key(seed)
    k = jax.random.split(key, 30)
    f32 = jnp.float32
    nrm = lambda kk, shape, scale: jax.random.normal(kk, shape, f32) * scale
    gain = lambda kk, shape: 1.0 + 0.05 * jax.random.normal(kk, shape, f32)
    unif = lambda kk, shape, lo, hi: jax.random.uniform(kk, shape, f32, lo, hi)
    return {
        'x': nrm(k[0], (BATCH, SEQ, D_MODEL), 1.0),
        'p': nrm(k[1], (DEPTH, BATCH, SEQ, PLE_DIM), 1.0),
        'ffn1_norm': gain(k[2], (DEPTH, D_MODEL)),
        'ffn1_w_gu': nrm(k[3], (DEPTH, D_MODEL, 2 * D_FF), D_MODEL ** -0.5),
        'ffn1_w_down': nrm(k[4], (DEPTH, D_FF, D_MODEL), D_FF ** -0.5),
        'mix_norm': gain(k[5], (DEPTH, D_MODEL)),
        'ffn2_norm': gain(k[6], (DEPTH, D_MODEL)),
        'ffn2_w_gu': nrm(k[7], (DEPTH, D_MODEL, 2 * D_FF), D_MODEL ** -0.5),
        'ffn2_w_down': nrm(k[8], (DEPTH, D_FF, D_MODEL), D_FF ** -0.5),
        'ple_norm': gain(k[9], (DEPTH, D_MODEL)),
        'ple_w_gate': nrm(k[10], (DEPTH, D_MODEL, D_MODEL), D_MODEL ** -0.5),
        'ple_w_proj': nrm(k[11], (DEPTH, PLE_DIM, D_MODEL), 0.5 * PLE_DIM ** -0.5),
        'even_w_in': nrm(k[12], (N_EVEN, D_MODEL, EVEN_IN), D_MODEL ** -0.5),
        'even_w_out': nrm(k[13], (N_EVEN, EVEN_OUT, D_MODEL), EVEN_OUT ** -0.5),
        'swa_sinks': nrm(k[14], (N_EVEN, SWA_HEADS), 0.5),
        'rwkv_mu': unif(k[15], (N_EVEN, RWKV_COLS), 0.0, 1.0),
        'rwkv_w0': unif(k[16], (N_EVEN, RWKV_DIM), -5.0, -0.5),
        'rwkv_w2': nrm(k[17], (N_EVEN, DECAY_LORA, RWKV_DIM), 0.5 * DECAY_LORA ** -0.5),
        'rwkv_a0': nrm(k[18], (N_EVEN, RWKV_DIM), 0.1),
        'rwkv_a2': nrm(k[19], (N_EVEN, ICLR_LORA, RWKV_DIM), 0.5 * ICLR_LORA ** -0.5),
        'rwkv_g2': nrm(k[20], (N_EVEN, GATE_LORA, RWKV_DIM), GATE_LORA ** -0.5),
        'rwkv_k_k': 0.85 + nrm(k[21], (N_EVEN, RWKV_DIM), 0.05),
        'rwkv_k_a': 1.0 + nrm(k[22], (N_EVEN, RWKV_DIM), 0.05),
        'rwkv_r_k': nrm(k[23], (N_EVEN, RWKV_HEADS, HEAD_DIM), 0.1),
        'rwkv_ln_w': gain(k[24], (N_EVEN, RWKV_DIM)),
        'rwkv_ln_b': nrm(k[25], (N_EVEN, RWKV_DIM), 0.01),
        'fox_w_in': nrm(k[26], (N_ODD, D_MODEL, FOX_IN), D_MODEL ** -0.5),
        'fox_b_f': unif(k[27], (N_ODD, FOX_HEADS), 1.0, 6.0),
        'fox_w_out': nrm(k[28], (N_ODD, FOX_DIM, D_MODEL), FOX_DIM ** -0.5),
        'final_norm': gain(k[29], (D_MODEL,)),
    }


def reference(x, p, ffn1_norm, ffn1_w_gu, ffn1_w_down, mix_norm, ffn2_norm, ffn2_w_gu,
              ffn2_w_down, ple_norm, ple_w_gate, ple_w_proj, even_w_in, even_w_out,
              swa_sinks, rwkv_mu, rwkv_w0, rwkv_w2, rwkv_a0, rwkv_a2, rwkv_g2, rwkv_k_k,
              rwkv_k_a, rwkv_r_k, rwkv_ln_w, rwkv_ln_b, fox_w_in, fox_b_f, fox_w_out,
              final_norm):
    b, s, _ = x.shape
    for i in range(DEPTH):
        j = i // 2
        x = x + 0.5 * swiglu(rms_norm(x, ffn1_norm[i]), ffn1_w_gu[i], ffn1_w_down[i])
        hn = rms_norm(x, mix_norm[i])
        if i % 2 == 0:
            proj = hn @ even_w_in[j]
            qa, ka, va, hb = jnp.split(proj, [SWA_Q, SWA_Q + SWA_KV, SWA_COLS], axis=-1)
            ya = sliding_window_attention(
                qa.reshape(b, s, SWA_HEADS, HEAD_DIM),
                ka.reshape(b, s, SWA_KV_HEADS, HEAD_DIM),
                va.reshape(b, s, SWA_KV_HEADS, HEAD_DIM),
                swa_sinks[j])
            yb = rwkv7_time_mix(hb, rwkv_mu[j], rwkv_w0[j], rwkv_w2[j], rwkv_a0[j], rwkv_a2[j],
                                rwkv_g2[j], rwkv_k_k[j], rwkv_k_a[j], rwkv_r_k[j],
                                rwkv_ln_w[j], rwkv_ln_b[j])
            mixed = jnp.concatenate([ya, yb], axis=-1) @ even_w_out[j]
        else:
            proj = hn @ fox_w_in[j]
            qc, kc, vc, fz = jnp.split(proj, [FOX_DIM, 2 * FOX_DIM, 3 * FOX_DIM], axis=-1)
            log_f = jax.nn.log_sigmoid(fz.astype(jnp.float32) + fox_b_f[j].astype(jnp.float32))
            yc = forgetting_attention(
                qc.reshape(b, s, FOX_HEADS, HEAD_DIM),
                kc.reshape(b, s, FOX_HEADS, HEAD_DIM),
                vc.reshape(b, s, FOX_HEADS, HEAD_DIM),
                log_f)
            mixed = yc @ fox_w_out[j]
        x = x + mixed
        x = x + 0.5 * swiglu(rms_norm(x, ffn2_norm[i]), ffn2_w_gu[i], ffn2_w_down[i])
        gate = jax.nn.sigmoid(rms_norm(x, ple_norm[i]) @ ple_w_gate[i])
        x = x + gate * (p[i] @ ple_w_proj[i])
    return rms_norm(x, final_norm)
```

```cpp
#include <hip/hip_runtime.h>
#include <hip/hip_cooperative_groups.h>
#include <hip/hip_bf16.h>
#include <cstdio>
#include <cstdint>
#include <cmath>
namespace cg = cooperative_groups;
#ifndef PHM
#define PHM 255
#endif
namespace pg8 {
#define PG8_LAS __attribute__((address_space(3)))
typedef unsigned short bf16_t;
typedef short bf16x8 __attribute__((ext_vector_type(8)));
typedef float f32x4 __attribute__((ext_vector_type(4)));
typedef unsigned u32x4 __attribute__((ext_vector_type(4)));
constexpr int BM = 256, BK = 64, HALF = 128, HTB = HALF * BK * 2  , STAGE_BYTES = 8 * HTB, NXCD = 8, WGM = 8;

__host__ __device__ __forceinline__ int lds_byte(int r, int c) { const int st = (r >> 4) * 2 + (c >> 5), rr = r & 15, cc = c & 31, ob = rr * 64 + cc * 2; return st * 1024 + (ob ^ (((ob >> 9) & 1) << 5)); }
__host__ __device__ __forceinline__ void stage_rc(int b, int& R, int& C) { const int st = b / 1024, sb = b % 1024, swz = sb ^ (((sb >> 9) & 1) << 5); R = (st >> 1) * 16 + swz / 64; C = (st & 1) * 32 + (swz % 64) / 2; }
__host__ __device__ __forceinline__ int perm32(int rho) { const int n = rho >> 4, i = rho & 15; return 8 * (i >> 2) + 4 * n + (i & 3); }

struct Unit { int pm, pn; };
struct Gemm { const bf16_t* A; const bf16_t* Bt; int M, N, K; };

struct StaticOrder {
    int nM, nN, nwg, G, c;
    __host__ __device__ void init(int M, int N, int G_, int c_) { nM = M / BM; nN = N / BM; nwg = nM * nN; G = G_; c = c_; }
    __host__ __device__ bool next(int i, Unit& u) const {
        const long L = (long)i * G + c; if (L >= nwg) return false;
        int wgid = (int)L; { const int q = nwg / NXCD, r = nwg % NXCD, xcd = wgid % NXCD, off = wgid / NXCD; wgid = (xcd < r ? xcd * (q + 1) : r * (q + 1) + (xcd - r) * q) + off; }
        const int nig = WGM * nN, gid = wgid / nig, fm = gid * WGM, gsz = (nM - fm) < WGM ? (nM - fm) : WGM;
        u.pm = fm + ((wgid % nig) % gsz); u.pn = (wgid % nig) / gsz; return true;
    }
    __device__ __forceinline__ void a_ready(const Unit&) const {}
    __device__ __forceinline__ void done(const Unit&) const {}
};

typedef float f32x2_c __attribute__((ext_vector_type(2))); typedef __bf16 bf16x2_c __attribute__((ext_vector_type(2)));
__device__ __forceinline__ unsigned cvt_pk_bf16(float lo, float hi) { f32x2_c v = {lo, hi}; bf16x2_c b = __builtin_convertvector(v, bf16x2_c); return __builtin_bit_cast(unsigned, b); }
typedef float f32x2 __attribute__((ext_vector_type(2)));
constexpr float NORM_EPS = 1e-6f;
__device__ __forceinline__ float ssq_sum(const float* ssq, int row) { const f32x4* p = (const f32x4*)(ssq + (size_t)row * 16); const f32x4 a = p[0], b = p[1], c = p[2], d = p[3];
    return ((a[0] + a[1]) + (a[2] + a[3])) + ((b[0] + b[1]) + (b[2] + b[3])) + (((c[0] + c[1]) + (c[2] + c[3])) + ((d[0] + d[1]) + (d[2] + d[3]))); }
__device__ __forceinline__ float rstd_of(const float* ssq, int row) { return rsqrtf(ssq_sum(ssq, row) * (1.0f / 1024.0f) + NORM_EPS); }
__device__ __forceinline__ float sigm(float x) { return __builtin_amdgcn_rcpf(1.0f + __expf(-x)); }
struct EpiGU { static constexpr bool PERM = true, AFTER_DRAIN = false;
    bf16_t* H; const float* ssq;
    __device__ __forceinline__ void operator()(const f32x4 (&acc)[2][2][4][2], const Unit& u, int wr, int wc, int fr, int fq) const {
        int row0 = u.pm * BM + wr * 64 + fr; asm volatile("" : "+v"(row0)); const int col0 = u.pn * 128 + wc * 32 + 8 * fq;
#pragma unroll
        for (int ai = 0; ai < 2; ++ai)
#pragma unroll
            for (int m = 0; m < 4; ++m) { const int row = row0 + ai * HALF + m * 16; const float rs = rstd_of(ssq, row);
                const f32x4 g0 = acc[ai][0][m][0] * rs, g1 = acc[ai][0][m][1] * rs, u0 = acc[ai][1][m][0] * rs, u1 = acc[ai][1][m][1] * rs;
                u32x4 w;
                w.x = cvt_pk_bf16(g0[0] * sigm(g0[0]) * u0[0], g0[1] * sigm(g0[1]) * u0[1]); w.y = cvt_pk_bf16(g0[2] * sigm(g0[2]) * u0[2], g0[3] * sigm(g0[3]) * u0[3]);
                w.z = cvt_pk_bf16(g1[0] * sigm(g1[0]) * u1[0], g1[1] * sigm(g1[1]) * u1[1]); w.w = cvt_pk_bf16(g1[2] * sigm(g1[2]) * u1[2], g1[3] * sigm(g1[3]) * u1[3]);
                *(u32x4*)(H + (size_t)row * 2816 + col0) = w; }
    }
};
struct EpiRes { static constexpr bool PERM = true, AFTER_DRAIN = false;
    const float* base; float* X; bf16_t* XB; float* ssq_out; float alpha;
    __device__ __forceinline__ void operator()(const f32x4 (&acc)[2][2][4][2], const Unit& u, int wr, int wc, int fr, int fq) const {
        int row0 = u.pm * BM + wr * 64 + fr; asm volatile("" : "+v"(row0)); const int col0 = u.pn * BM + wc * 32 + 8 * fq;
#pragma unroll
        for (int ai = 0; ai < 2; ++ai)
#pragma unroll
            for (int m = 0; m < 4; ++m) { const int row = row0 + ai * HALF + m * 16; float part = 0.f;
#pragma unroll
                for (int bj = 0; bj < 2; ++bj) { const size_t off = (size_t)row * 1024 + col0 + bj * HALF;
                    const f32x4 b0 = *(const f32x4*)(base + off), b1 = *(const f32x4*)(base + off + 4);
                    const f32x4 v0 = b0 + acc[ai][bj][m][0] * alpha, v1 = b1 + acc[ai][bj][m][1] * alpha;
                    *(f32x4*)(X + off) = v0; *(f32x4*)(X + off + 4) = v1;
                    u32x4 w; w.x = cvt_pk_bf16(v0[0], v0[1]); w.y = cvt_pk_bf16(v0[2], v0[3]); w.z = cvt_pk_bf16(v1[0], v1[1]); w.w = cvt_pk_bf16(v1[2], v1[3]);
                    *(u32x4*)(XB + off) = w;
                    part += (v0[0] * v0[0] + v0[1] * v0[1]) + (v0[2] * v0[2] + v0[3] * v0[3]) + (v1[0] * v1[0] + v1[1] * v1[1]) + (v1[2] * v1[2] + v1[3] * v1[3]); }
                part += __shfl_xor(part, 16); part += __shfl_xor(part, 32);
                if (fq == 0) ssq_out[(size_t)row * 16 + u.pn * 4 + wc] = part; }
    }
};
struct EpiPle { static constexpr bool PERM = true, AFTER_DRAIN = false;
    int mode; float* X; bf16_t* XB; bf16_t* PP; const float* ssq_in; float* ssq_out;
    __device__ __forceinline__ void operator()(const f32x4 (&acc)[2][2][4][2], const Unit& u, int wr, int wc, int fr, int fq) const {
        int row0 = u.pm * BM + wr * 64 + fr; asm volatile("" : "+v"(row0)); const int col0 = u.pn * BM + wc * 32 + 8 * fq;
#pragma unroll
        for (int ai = 0; ai < 2; ++ai)
#pragma unroll
            for (int m = 0; m < 4; ++m) { const int row = row0 + ai * HALF + m * 16; float part = 0.f; const float rs = mode ? rstd_of(ssq_in, row) : 1.f;
#pragma unroll
                for (int bj = 0; bj < 2; ++bj) { const size_t off = (size_t)row * 1024 + col0 + bj * HALF;
                    if (mode == 0) { const f32x4 v0 = acc[ai][bj][m][0], v1 = acc[ai][bj][m][1];
                        u32x4 w; w.x = cvt_pk_bf16(v0[0], v0[1]); w.y = cvt_pk_bf16(v0[2], v0[3]); w.z = cvt_pk_bf16(v1[0], v1[1]); w.w = cvt_pk_bf16(v1[2], v1[3]);
                        *(u32x4*)(PP + off) = w;
                    } else {
                        const u32x4 pw = *(const u32x4*)(PP + off);
                        const f32x4 p0 = {__uint_as_float(pw.x << 16), __uint_as_float(pw.x & 0xffff0000u), __uint_as_float(pw.y << 16), __uint_as_float(pw.y & 0xffff0000u)};
                        const f32x4 p1 = {__uint_as_float(pw.z << 16), __uint_as_float(pw.z & 0xffff0000u), __uint_as_float(pw.w << 16), __uint_as_float(pw.w & 0xffff0000u)};
                        const f32x4 b0 = *(const f32x4*)(X + off), b1 = *(const f32x4*)(X + off + 4);
                        const f32x4 a0 = acc[ai][bj][m][0] * rs, a1 = acc[ai][bj][m][1] * rs;
                        f32x4 v0, v1;
#pragma unroll
                        for (int j = 0; j < 4; ++j) { v0[j] = b0[j] + sigm(a0[j]) * p0[j]; v1[j] = b1[j] + sigm(a1[j]) * p1[j]; }
                        *(f32x4*)(X + off) = v0; *(f32x4*)(X + off + 4) = v1;
                        u32x4 w; w.x = cvt_pk_bf16(v0[0], v0[1]); w.y = cvt_pk_bf16(v0[2], v0[3]); w.z = cvt_pk_bf16(v1[0], v1[1]); w.w = cvt_pk_bf16(v1[2], v1[3]);
                        *(u32x4*)(XB + off) = w;
                        part += (v0[0] * v0[0] + v0[1] * v0[1]) + (v0[2] * v0[2] + v0[3] * v0[3]) + (v1[0] * v1[0] + v1[1] * v1[1]) + (v1[2] * v1[2] + v1[3] * v1[3]); } }
                if (mode) { part += __shfl_xor(part, 16); part += __shfl_xor(part, 32); if (fq == 0) ssq_out[(size_t)row * 16 + u.pn * 4 + wc] = part; } }
    }
};
struct EpiStore { static constexpr bool PERM = true, AFTER_DRAIN = false;
    bf16_t* O; int ldc; const float* ssq; float scale0; int scale_tiles; int split_tiles; size_t split_stride; int lf_tile; float* LF; const float* bfv;
    __device__ __forceinline__ void operator()(const f32x4 (&acc)[2][2][4][2], const Unit& u, int wr, int wc, int fr, int fq) const {
        int row0 = u.pm * BM + wr * 64 + fr; asm volatile("" : "+v"(row0));
        if (u.pn == lf_tile) {
            if (wc == 0 && fq < 2) {
#pragma unroll
                for (int ai = 0; ai < 2; ++ai)
#pragma unroll
                    for (int m = 0; m < 4; ++m) { const int row = row0 + ai * HALF + m * 16; const float rs = rstd_of(ssq, row);
#pragma unroll
                        for (int n = 0; n < 2; ++n) { f32x4 o;
#pragma unroll
                            for (int j = 0; j < 4; ++j) { const float z = fmaxf(acc[ai][0][m][n][j] * rs + bfv[8 * fq + 4 * n + j], -80.f), e = __expf(-z);
                                o[j] = (e < 0.01f) ? -(e - 0.5f * e * e + e * e * e * (1.f / 3.f)) : -__logf(1.f + e); }
                            *(f32x4*)(LF + (size_t)row * 16 + 8 * fq + 4 * n) = o; } }
            }
            return;
        }
        const int t = u.pn / split_tiles, ct = u.pn - t * split_tiles;
        bf16_t* base = O + (size_t)t * split_stride; const float sc = (u.pn < scale_tiles) ? scale0 : 1.f;
        const int col0 = ct * BM + wc * 32 + 8 * fq;
#pragma unroll
        for (int ai = 0; ai < 2; ++ai)
#pragma unroll
            for (int m = 0; m < 4; ++m) { const int row = row0 + ai * HALF + m * 16; const float rs = rstd_of(ssq, row) * sc;
#pragma unroll
                for (int bj = 0; bj < 2; ++bj) { const f32x4 v0 = acc[ai][bj][m][0] * rs, v1 = acc[ai][bj][m][1] * rs;
                    u32x4 w; w.x = cvt_pk_bf16(v0[0], v0[1]); w.y = cvt_pk_bf16(v0[2], v0[3]); w.z = cvt_pk_bf16(v1[0], v1[1]); w.w = cvt_pk_bf16(v1[2], v1[3]);
                    *(u32x4*)(base + (size_t)row * ldc + col0 + bj * HALF) = w; } }
    }
};

template <class Epi, class Sched, bool ALIGN_EPI = false, bool SP2 = false>
__device__ __forceinline__ void gemm_phase(PG8_LAS unsigned char* lds, const Gemm g, const Sched& S, const Epi& E, const int tid) {
    const int wid = __builtin_amdgcn_readfirstlane(tid >> 6), lane = tid & 63, wr = wid >> 2, wc = wid & 3, fr = lane & 15, fq = lane >> 4;
    const int K = g.K, nt = K / BK;
    unsigned voffA[2], voffB[2];
#pragma unroll
    for (int i = 0; i < 2; ++i) { int R, C; stage_rc(tid * 16 + i * 8192, R, C); const int Rb = Epi::PERM ? ((R & ~31) + perm32(R & 31)) : R;
        voffA[i] = (unsigned)(R * K + C) * 2u; voffB[i] = (unsigned)(Rb * K + C) * 2u; }
    const size_t kstep = (size_t)(BK * 2);
    const size_t hstep = (size_t)HALF * K * 2;
    const size_t tstep = 2 * hstep;
    const unsigned ldsw = (unsigned)wid * 1024u;
    const int aoff = lds_byte(wr * 64 + fr, fq * 8), boff = lds_byte(wc * 32 + fr, fq * 8);
#define PG8_SA(b, h) (((b) * 2 + (h)) * HTB)
#define PG8_SB(b, h) ((4 + (b) * 2 + (h)) * HTB)
#define PG8_STAGE(bufoff, gbase, voff) do { _Pragma("unroll") for (int _i = 0; _i < 2; ++_i) \
        __builtin_amdgcn_global_load_lds((const unsigned*)((const char*)(gbase) + (voff)[_i]), (PG8_LAS unsigned*)(lds + (bufoff) + ldsw + _i * 8192), 16, 0, 0); } while (0)
#define PG8_LDA(dst, b, h) do { _Pragma("unroll") for (int m = 0; m < 4; ++m) _Pragma("unroll") for (int k = 0; k < 2; ++k) dst[m][k] = *(const PG8_LAS bf16x8*)(lds + PG8_SA(b, h) + aoff + m * 2048 + k * 1024); } while (0)
#define PG8_LDB(dst, b, h) do { _Pragma("unroll") for (int n = 0; n < 2; ++n) _Pragma("unroll") for (int k = 0; k < 2; ++k) dst[n][k] = *(const PG8_LAS bf16x8*)(lds + PG8_SB(b, h) + boff + n * 2048 + k * 1024); } while (0)
#define PG8_MMA(ai, bj, At, Bt) do { __builtin_amdgcn_s_setprio(1); _Pragma("unroll") for (int m = 0; m < 4; ++m) _Pragma("unroll") for (int n = 0; n < 2; ++n) _Pragma("unroll") for (int k = 0; k < 2; ++k) \
        acc[ai][bj][m][n] = __builtin_amdgcn_mfma_f32_16x16x32_bf16(Bt[n][k], At[m][k], acc[ai][bj][m][n], 0, 0, 0); __builtin_amdgcn_s_setprio(0); } while (0)
#define PG8_WAIT_V(n) asm volatile("s_waitcnt vmcnt(" #n ")" ::: "memory")
#define PG8_WAIT_L(n) asm volatile("s_waitcnt lgkmcnt(" #n ")" ::: "memory")
#define PG8_BAR __builtin_amdgcn_s_barrier()
#define PG8_SCHED __builtin_amdgcn_sched_barrier(0)
    Unit cur, nxt; int ui = 0;
    if (!S.next(0, cur)) return;
    f32x4 acc[2][2][4][2];
#pragma unroll
    for (int a = 0; a < 2; ++a)
#pragma unroll
        for (int b = 0; b < 2; ++b)
#pragma unroll
            for (int m = 0; m < 4; ++m)
#pragma unroll
                for (int n = 0; n < 2; ++n) acc[a][b][m][n] = (f32x4){0.f, 0.f, 0.f, 0.f};
    bf16x8 At[4][2], B0[2][2], B1[2][2];
    const char* cA = (const char*)g.A + (size_t)cur.pm * tstep; const char* cB = (const char*)g.Bt + (size_t)cur.pn * tstep;
    S.a_ready(cur);
    if constexpr (SP2) {
        PG8_STAGE(PG8_SB(0, 0), cB, voffB); PG8_STAGE(PG8_SB(0, 1), cB + hstep, voffB); PG8_STAGE(PG8_SA(0, 0), cA, voffA); PG8_STAGE(PG8_SA(0, 1), cA + hstep, voffA);
        if (wr == 1) PG8_BAR;
        PG8_WAIT_V(2); PG8_BAR;
        PG8_STAGE(PG8_SB(1, 0), cB + kstep, voffB); PG8_STAGE(PG8_SA(1, 0), cA + kstep, voffA); PG8_STAGE(PG8_SB(1, 1), cB + hstep + kstep, voffB);
        PG8_WAIT_V(6); PG8_BAR;
    } else {
        PG8_STAGE(PG8_SB(0, 0), cB, voffB); PG8_STAGE(PG8_SA(0, 0), cA, voffA); PG8_STAGE(PG8_SB(0, 1), cB + hstep, voffB); PG8_STAGE(PG8_SA(0, 1), cA + hstep, voffA);
        if (wr == 1) PG8_BAR;
        PG8_WAIT_V(4); PG8_BAR;
        PG8_STAGE(PG8_SB(1, 0), cB + kstep, voffB); PG8_STAGE(PG8_SA(1, 0), cA + kstep, voffA); PG8_STAGE(PG8_SB(1, 1), cB + hstep + kstep, voffB);
        PG8_WAIT_V(6); PG8_BAR;
    }
    for (;;) {
        const bool has_next = S.next(ui + 1, nxt);
        const char* nA = has_next ? (const char*)g.A + (size_t)nxt.pm * tstep : cA; const char* nB = has_next ? (const char*)g.Bt + (size_t)nxt.pn * tstep : cB;
        for (int t = 0; t < nt; t += 2) {
            const bool last = (t == nt - 2);
            const char* a1 = cA + (size_t)(t + 1) * kstep;
            const char* a2 = last ? nA : cA + (size_t)(t + 2) * kstep; const char* b2 = last ? nB : cB + (size_t)(t + 2) * kstep;
            const char* a3 = a2 + kstep; const char* b3 = b2 + kstep;
            if (last && has_next) S.a_ready(nxt);
            if constexpr (SP2) {
            PG8_LDB(B0, 0, 0); PG8_LDB(B1, 0, 1); PG8_SCHED; PG8_LDA(At, 0, 0); PG8_STAGE(PG8_SA(1, 1), a1 + hstep, voffA);
            PG8_WAIT_V(8); PG8_WAIT_L(0); PG8_BAR; PG8_MMA(0, 0, At, B0); PG8_MMA(0, 1, At, B1); PG8_BAR; PG8_SCHED;
            PG8_LDA(At, 0, 1); PG8_STAGE(PG8_SB(0, 0), b2, voffB); PG8_STAGE(PG8_SB(0, 1), b2 + hstep, voffB); PG8_STAGE(PG8_SA(0, 0), a2, voffA);
            PG8_WAIT_V(8); PG8_WAIT_L(0); PG8_BAR; PG8_MMA(1, 0, At, B0); PG8_MMA(1, 1, At, B1); PG8_BAR; PG8_SCHED;
            PG8_LDB(B0, 1, 0); PG8_LDB(B1, 1, 1); PG8_SCHED; PG8_LDA(At, 1, 0); PG8_STAGE(PG8_SA(0, 1), a2 + hstep, voffA);
            PG8_WAIT_V(8); PG8_WAIT_L(0); PG8_BAR; PG8_MMA(0, 0, At, B0); PG8_MMA(0, 1, At, B1); PG8_BAR; PG8_SCHED;
            PG8_LDA(At, 1, 1); PG8_STAGE(PG8_SB(1, 0), b3, voffB); PG8_STAGE(PG8_SB(1, 1), b3 + hstep, voffB); PG8_STAGE(PG8_SA(1, 0), a3, voffA);
            PG8_WAIT_V(8); PG8_WAIT_L(0); PG8_BAR; PG8_MMA(1, 0, At, B0); PG8_MMA(1, 1, At, B1); PG8_BAR; PG8_SCHED;
            } else {
            PG8_LDB(B0, 0, 0); PG8_SCHED; PG8_LDA(At, 0, 0); PG8_STAGE(PG8_SA(1, 1), a1 + hstep, voffA);
            PG8_WAIT_L(8); PG8_BAR; PG8_WAIT_L(0); PG8_MMA(0, 0, At, B0); PG8_BAR; PG8_SCHED;
            PG8_LDB(B1, 0, 1); PG8_STAGE(PG8_SB(0, 0), b2, voffB);
            PG8_BAR; PG8_WAIT_L(0); PG8_MMA(0, 1, At, B1); PG8_BAR;
            PG8_LDA(At, 0, 1); PG8_STAGE(PG8_SA(0, 0), a2, voffA);
            PG8_BAR; PG8_WAIT_L(0); PG8_MMA(1, 0, At, B0); PG8_BAR; PG8_SCHED;
            PG8_STAGE(PG8_SB(0, 1), b2 + hstep, voffB);
            PG8_WAIT_V(6); PG8_BAR; PG8_MMA(1, 1, At, B1); PG8_BAR;
            PG8_LDB(B0, 1, 0); PG8_SCHED; PG8_LDA(At, 1, 0); PG8_STAGE(PG8_SA(0, 1), a2 + hstep, voffA);
            PG8_WAIT_L(8); PG8_BAR; PG8_WAIT_L(0); PG8_MMA(0, 0, At, B0); PG8_BAR; PG8_SCHED;
            PG8_LDB(B1, 1, 1); PG8_STAGE(PG8_SB(1, 0), b3, voffB);
            PG8_BAR; PG8_WAIT_L(0); PG8_MMA(0, 1, At, B1); PG8_BAR;
            PG8_LDA(At, 1, 1); PG8_STAGE(PG8_SA(1, 0), a3, voffA);
            PG8_BAR; PG8_WAIT_L(0); PG8_MMA(1, 0, At, B0); PG8_BAR; PG8_SCHED;
            PG8_STAGE(PG8_SB(1, 1), b3 + hstep, voffB);
            PG8_WAIT_V(6); PG8_BAR; PG8_MMA(1, 1, At, B1); PG8_BAR;
            }
        }
        if constexpr (ALIGN_EPI) { if (wr == 0) PG8_BAR; }
        if constexpr (!Epi::AFTER_DRAIN) { E(acc, cur, wr, wc, fr, fq); S.done(cur); }
        if (!has_next) break;
#pragma unroll
        for (int a = 0; a < 2; ++a)
#pragma unroll
            for (int b = 0; b < 2; ++b)
#pragma unroll
                for (int m = 0; m < 4; ++m)
#pragma unroll
                    for (int n = 0; n < 2; ++n) acc[a][b][m][n] = (f32x4){0.f, 0.f, 0.f, 0.f};
        cur = nxt; cA = nA; cB = nB; ++ui;
        if constexpr (ALIGN_EPI) { if (wr == 1) PG8_BAR; }
    }
    PG8_WAIT_V(0);
    if constexpr (!ALIGN_EPI) { if (wr == 0) PG8_BAR; }
    PG8_BAR;
    if constexpr (Epi::AFTER_DRAIN) { E.fused(acc, cur, wr, wc, fr, fq, lds, wid, lane); S.done(cur); }
#undef PG8_SA
#undef PG8_SB
#undef PG8_STAGE
#undef PG8_LDA
#undef PG8_LDB
#undef PG8_MMA
#undef PG8_WAIT_V
#undef PG8_WAIT_L
#undef PG8_BAR
#undef PG8_SCHED
}
}
#include <hip/hip_bf16.h>
#include <cmath>
namespace attn_body {
using bf16=__hip_bfloat16;
using bf16x8=__attribute__((ext_vector_type(8)))short;
using s16x4=__attribute__((ext_vector_type(4)))short;
using f32x16=__attribute__((ext_vector_type(16)))float;
using u32x4=__attribute__((ext_vector_type(4)))unsigned;
constexpr int BATCH=4,NHEAD=16,SEQ=4096,D=64,DM=NHEAD*D;
constexpr int NW=8,QBLK=32,QB=QBLK*NW,KVBLK=64,NQB=SEQ/QB;
constexpr int ATTN_PITCH=DM, ATTN_UNIT_ROWS=QB;
__device__ __forceinline__ int crow(int r,int hi){return (r&3)+8*(r>>2)+4*hi;}
#define SBAR() __builtin_amdgcn_sched_barrier(0)
__device__ __forceinline__ void cmask(f32x16&p0,f32x16&p1,int jb,int qrel,int hi){
  const float NEG=-INFINITY; int kb=64*jb+4*hi;
  #pragma unroll
  for(int r=0;r<16;++r){int kv=kb+(r&3)+8*(r>>2); if(kv>qrel)p0[r]=NEG; if(kv+32>qrel)p1[r]=NEG;}
}

constexpr int NSLOT=3, SLOTB=8192;
constexpr int LDS_K=0, LDS_V=NSLOT*SLOTB, LDS_WS=2*NSLOT*SLOTB, LDS_OST=LDS_WS+NW*64*4, LDS_BYTES=LDS_OST+NW*4096;
constexpr float C2=0.125f*1.4426950408889634f;
__device__ __forceinline__ void glds16(const void*gsrc,unsigned lds_dst){unsigned keep;
  asm volatile("s_mov_b32 %0, m0\n\ts_mov_b32 m0, %2\n\ts_nop 0\n\tglobal_load_lds_dwordx4 %1, off\n\ts_mov_b32 m0, %0":"=&s"(keep):"v"(gsrc),"s"(lds_dst):"memory");}
__device__ __forceinline__ float max3f(float a,float b,float c){float r;asm("v_max3_f32 %0, %1, %2, %3":"=v"(r):"v"(a),"v"(b),"v"(c));return r;}
__device__ __forceinline__ float max2f(float a,float b){float r;asm("v_max_f32_e32 %0, %1, %2":"=v"(r):"v"(a),"v"(b));return r;}
__device__ __forceinline__ float fadd_s(float a,float b){float r;asm("v_add_f32_e32 %0, %1, %2":"=v"(r):"v"(a),"v"(b));return r;}
__device__ __forceinline__ float fsub_s(float a,float b){float r;asm("v_sub_f32_e32 %0, %1, %2":"=v"(r):"v"(a),"v"(b));return r;}
typedef float f32x2_t __attribute__((ext_vector_type(2))); typedef __bf16 bf16x2_t __attribute__((ext_vector_type(2)));
__device__ __forceinline__ unsigned cvtpk_s(float lo,float hi){f32x2_t v={lo,hi};bf16x2_t b=__builtin_convertvector(v,bf16x2_t);return __builtin_bit_cast(unsigned,b);}
#define WAIT_BAR(N) asm volatile("s_waitcnt vmcnt(" #N ") lgkmcnt(0)\n\ts_barrier":::"memory")

__device__ __forceinline__ void qkt(f32x16&p0,f32x16&p1,const char*Kslot,const bf16x8*qr,int r32,int hi){
  const char*kb=Kslot+hi*1024+r32*16;
  #pragma unroll
  for(int d0=0;d0<4;++d0){
    const bf16x8 b0=*reinterpret_cast<const bf16x8*>(kb+d0*2048);
    const bf16x8 b1=*reinterpret_cast<const bf16x8*>(kb+d0*2048+512);
    {p0=__builtin_amdgcn_mfma_f32_32x32x16_bf16(b0,qr[d0],p0,0,0,0);p1=__builtin_amdgcn_mfma_f32_32x32x16_bf16(b1,qr[d0],p1,0,0,0);}}
}
typedef __attribute__((address_space(3))) const char* lds_cptr;
typedef short v4i16_t __attribute__((ext_vector_type(4)));
__device__ __forceinline__ void kload8(bf16x8*kf,lds_cptr kp){
  kf[0]=*(const __attribute__((address_space(3))) bf16x8*)(kp);      kf[1]=*(const __attribute__((address_space(3))) bf16x8*)(kp+512);
  kf[2]=*(const __attribute__((address_space(3))) bf16x8*)(kp+2048); kf[3]=*(const __attribute__((address_space(3))) bf16x8*)(kp+2560);
  kf[4]=*(const __attribute__((address_space(3))) bf16x8*)(kp+4096); kf[5]=*(const __attribute__((address_space(3))) bf16x8*)(kp+4608);
  kf[6]=*(const __attribute__((address_space(3))) bf16x8*)(kp+6144); kf[7]=*(const __attribute__((address_space(3))) bf16x8*)(kp+6656);
}
__device__ __forceinline__ void kload2(bf16x8*kf,lds_cptr kp,int j){ kf[2*j]=*(const __attribute__((address_space(3))) bf16x8*)(kp+j*2048); kf[2*j+1]=*(const __attribute__((address_space(3))) bf16x8*)(kp+j*2048+512); }
__device__ __forceinline__ s16x4 vtr(lds_cptr p){ return __builtin_bit_cast(s16x4,__builtin_amdgcn_ds_read_tr16_b64_v4i16((__attribute__((address_space(3))) v4i16_t*)p)); }
__device__ __forceinline__ float rowmax(const f32x16&p0,const f32x16&p1){
  float a=max3f(p0[0],p0[1],p1[0]),b=max3f(p0[2],p0[3],p1[1]);a=max3f(a,p1[2],p1[3]);
  #pragma unroll
  for(int r=4;r<16;r+=4){a=max3f(a,p0[r],p0[r+1]);b=max3f(b,p0[r+2],p0[r+3]);a=max3f(a,p1[r],p1[r+1]);b=max3f(b,p1[r+2],p1[r+3]);}
  const float m=max2f(a,b);
  auto rr=__builtin_amdgcn_permlane32_swap(__float_as_uint(m),__float_as_uint(m),false,false);
  return max2f(__uint_as_float(rr[0]),__uint_as_float(rr[1]));
}
__device__ __forceinline__ void pv(f32x16*o,int vb,bf16x8 pa0,bf16x8 pa1,bf16x8 pa2,bf16x8 pa3){
  #pragma unroll
  for(int d0=0;d0<2;++d0){s16x4 lo[4],hi[4];
    #pragma unroll
    for(int ks=0;ks<4;++ks){
      asm volatile("ds_read_b64_tr_b16 %0,%1 offset:%c2":"=&v"(lo[ks]):"v"(vb),"i"(d0*4096+ks*1024):"memory");
      asm volatile("ds_read_b64_tr_b16 %0,%1 offset:%c2":"=&v"(hi[ks]):"v"(vb),"i"(d0*4096+ks*1024+512):"memory");}
    asm volatile("s_waitcnt lgkmcnt(0)":::"memory");SBAR();
    #define PK(k) (bf16x8){lo[k][0],lo[k][1],lo[k][2],lo[k][3],hi[k][0],hi[k][1],hi[k][2],hi[k][3]}
    o[d0]=__builtin_amdgcn_mfma_f32_32x32x16_bf16(pa0,PK(0),o[d0],0,0,0);
    o[d0]=__builtin_amdgcn_mfma_f32_32x32x16_bf16(pa1,PK(1),o[d0],0,0,0);
    o[d0]=__builtin_amdgcn_mfma_f32_32x32x16_bf16(pa2,PK(2),o[d0],0,0,0);
    o[d0]=__builtin_amdgcn_mfma_f32_32x32x16_bf16(pa3,PK(3),o[d0],0,0,0);
    #undef PK
  }
}

#ifndef ATTN_STORE16
#define ATTN_STORE16(p,v) (*(u32x4*)(p)=(v))
#endif
typedef float f32x4b __attribute__((ext_vector_type(4)));
typedef __attribute__((address_space(3))) const float* lds_fptr;
typedef __attribute__((address_space(3))) const f32x4b* lds_f4ptr;
template<int THRL> __device__ __forceinline__ void attn_unit(int b,int h,int qb,const bf16*Q,const bf16*__restrict__ K,const bf16*__restrict__ V,bf16*O,char*shm,lds_fptr cs,const int tid){
  const int lane=tid&63,r32=lane&31,hi=lane>>5; const int wid=__builtin_amdgcn_readfirstlane(tid>>6);
  const long rowbase=(long)b*SEQ; const int q0=qb*QB;
  const bf16*Qw=Q+(rowbase+q0+wid*QBLK)*DM+h*D;
  const bf16*Kh=K+rowbase*DM+h*D,*Vh=V+rowbase*DM+h*D;
  const unsigned lds0=(unsigned)(uintptr_t)shm;
  float*wsf=(float*)(shm+LDS_WS)+wid*64;
  const bf16*ksrc=Kh+(long)lane*DM+wid*8;
  const bf16*vsrc=Vh+(long)(16*(wid&3)+(lane>>2))*DM+(wid>>2)*32+(lane&3)*8;
  const unsigned kdst=lds0+LDS_K+wid*1024, vdst=lds0+LDS_V+wid*1024;
  #define DMA_K(t,slot) glds16(ksrc+(long)(t)*KVBLK*DM,(unsigned)__builtin_amdgcn_readfirstlane(kdst+(slot)))
  #define DMA_V(t,slot) glds16(vsrc+(long)(t)*KVBLK*DM,(unsigned)__builtin_amdgcn_readfirstlane(vdst+(slot)))
  const int vb0=(int)(lds0+LDS_V)+((lane>>4)&1)*32+(lane&3)*8+(4*hi+((lane&15)>>2))*64;
  const char*Kbase=shm+LDS_K; bf16x8 kf[8];
  const lds_cptr shm3=(lds_cptr)shm; const lds_cptr kp0=shm3+LDS_K+hi*1024+r32*16; const lds_cptr vp0=shm3+LDS_V+((lane>>4)&1)*32+(lane&3)*8+(4*hi+((lane&15)>>2))*64;
  const int NT=(q0+QB)/KVBLK;
  DMA_K(0,0);DMA_V(0,0);DMA_K(1,SLOTB);
  bf16x8 qr[4];
  #pragma unroll
  for(int d0=0;d0<4;++d0)qr[d0]=*reinterpret_cast<const bf16x8*>(&Qw[(long)r32*DM+d0*16+hi*8]);
  const int qrel=wid*QBLK+r32;
  const float ci2=cs[q0+qrel];
  float mhat=0.f,l_reg=0.f;f32x16 o[2];o[0]=f32x16{};o[1]=f32x16{};float nm=ci2;
  #define CINIT(P0,P1,t) do{ const lds_f4ptr cb_=(lds_f4ptr)(cs+64*(t)+4*hi); \
    _Pragma("unroll") for(int g_=0;g_<4;++g_){ const f32x4b n0_=cb_[2*g_], n1_=cb_[8+2*g_]; \
      P0[4*g_]=nm-n0_[0];P0[4*g_+1]=nm-n0_[1];P0[4*g_+2]=nm-n0_[2];P0[4*g_+3]=nm-n0_[3]; \
      P1[4*g_]=nm-n1_[0];P1[4*g_+1]=nm-n1_[1];P1[4*g_+2]=nm-n1_[2];P1[4*g_+3]=nm-n1_[3]; } }while(0)
  #define CMASK(P0,P1,t) do{int jb_=(t)-(NT-4); if(jb_>=0)cmask(P0,P1,jb_,qrel,hi);}while(0)
  bool resc=false;
  #define START(P0,P1) do{ const float rm=rowmax(P0,P1); resc=false; \
    { const float dl=rm; mhat=fadd_s(mhat,dl); \
      _Pragma("unroll") for(int r=0;r<16;++r){P0[r]=fsub_s(P0[r],dl);P1[r]=fsub_s(P1[r],dl);} \
      nm=ci2-mhat; } \
    _Pragma("unroll") for(int r=0;r<16;++r)P0[r]=__builtin_amdgcn_exp2f(P0[r]); }while(0)
  #define RESC() do{ if(resc){ asm volatile("s_waitcnt lgkmcnt(0)":::"memory"); \
      _Pragma("unroll") for(int d_=0;d_<2;++d_) _Pragma("unroll") for(int r=0;r<16;++r)o[d_][r]*=wsf[crow(r,hi)]; } }while(0)
  f32x16 pA0,pA1,pB0,pB1;
  int sl_prev=0,sl_cur=0,sl_next=SLOTB;
  #define ROT() do{sl_prev=sl_cur;sl_cur=sl_next;sl_next=(sl_next==(NSLOT-1)*SLOTB)?0:sl_next+SLOTB;}while(0)
  DMA_K(2,2*SLOTB);
  WAIT_BAR(3);
  CINIT(pA0,pA1,0);qkt(pA0,pA1,Kbase,qr,r32,hi);asm volatile("s_nop 15\n\ts_nop 7":"+v"(pA0),"+v"(pA1));CMASK(pA0,pA1,0);
  START(pA0,pA1);
  _Pragma("unroll") for(int r=0;r<16;++r)pA1[r]=__builtin_amdgcn_exp2f(pA1[r]);
  WAIT_BAR(0);
  DMA_K(3,0);DMA_V(1,SLOTB);
  ROT();
  kload8(kf,kp0+sl_cur);
  WAIT_BAR(2);
  s16x4 vlo[8],vhi[8]; u32x4 pw0,pw1,pw2,pw3;
  #define PKW(P,B) cvtpk_s(P[B],P[B+1])
  #define PAF(k) __builtin_bit_cast(bf16x8,pw##k)
  #define VFR(i) (bf16x8){vlo[i][0],vlo[i][1],vlo[i][2],vlo[i][3],vhi[i][0],vhi[i][1],vhi[i][2],vhi[i][3]}
  #define PIN(x) asm volatile("":"+v"(x))
  #define MX3(a,b,c) __builtin_fmaxf(__builtin_fmaxf((a),(b)),(c))
  #define GAPA(MF,A0,A1,A2,A3,W0,W1,PW) do{ MF; sacc+=A0; sacc+=A1; sacc+=A2; sacc+=A3; PIN(sacc); W0; W1; PIN(PW); SBAR(); }while(0)
  #define EX(v) __builtin_amdgcn_exp2f(v)
  #define GAPB(MF,X,B) do{ MF; X[B]=EX(X[B]); X[B+1]=EX(X[B+1]); X[B+2]=EX(X[B+2]); X[B+3]=EX(X[B+3]); PIN(X); SBAR(); }while(0)
  #define VRD(i) do{ vlo[i]=vtr(vp_+(((i)>>2)*4096+((i)&3)*1024)); vhi[i]=vtr(vp_+(((i)>>2)*4096+((i)&3)*1024+512)); }while(0)
  #define KRD(G,j) do{ if(G){ kload2(kf,kp0+sl_next,j); SBAR(); } }while(0)
  #define STEP(C0,C1,P0,P1,t,GK,GV,GL) do{ SBAR(); \
    const lds_cptr vp_=vp0+sl_prev; CINIT(C0,C1,t); SBAR(); \
    VRD(0); SBAR(); float sacc=(P0[0]+P0[1]); \
    GAPA(C0=__builtin_amdgcn_mfma_f32_32x32x16_bf16(kf[0],qr[0],C0,0,0,0), P0[2],P0[3],P0[4],P0[5],     pw0[0]=PKW(P0,0), pw0[1]=PKW(P0,2), pw0); \
    VRD(4); SBAR(); GAPA(C1=__builtin_amdgcn_mfma_f32_32x32x16_bf16(kf[1],qr[0],C1,0,0,0), P0[6],P0[7],P0[8],P0[9],     pw0[2]=PKW(P0,4), pw0[3]=PKW(P0,6), pw0); \
    VRD(1); SBAR(); GAPA(C0=__builtin_amdgcn_mfma_f32_32x32x16_bf16(kf[2],qr[1],C0,0,0,0),   P0[10],P0[11],P0[12],P0[13], pw1[0]=PKW(P0,8), pw1[1]=PKW(P0,10), pw1); \
    VRD(5); SBAR(); GAPA(C1=__builtin_amdgcn_mfma_f32_32x32x16_bf16(kf[3],qr[1],C1,0,0,0),   P0[14],P0[15],P1[0],P1[1],   pw1[2]=PKW(P0,12),pw1[3]=PKW(P0,14), pw1); \
    VRD(2); SBAR(); GAPA(C0=__builtin_amdgcn_mfma_f32_32x32x16_bf16(kf[4],qr[2],C0,0,0,0),   P1[2],P1[3],P1[4],P1[5],     pw2[0]=PKW(P1,0), pw2[1]=PKW(P1,2), pw2); \
    VRD(6); SBAR(); GAPA(C1=__builtin_amdgcn_mfma_f32_32x32x16_bf16(kf[5],qr[2],C1,0,0,0),   P1[6],P1[7],P1[8],P1[9],     pw2[2]=PKW(P1,4), pw2[3]=PKW(P1,6), pw2); \
    VRD(3); SBAR(); GAPA(C0=__builtin_amdgcn_mfma_f32_32x32x16_bf16(kf[6],qr[3],C0,0,0,0),   P1[10],P1[11],P1[12],P1[13], pw3[0]=PKW(P1,8), pw3[1]=PKW(P1,10), pw3); \
    VRD(7); SBAR(); GAPA(C1=__builtin_amdgcn_mfma_f32_32x32x16_bf16(kf[7],qr[3],C1,0,0,0),   P1[14],P1[15],0.f,0.f,       pw3[2]=PKW(P1,12),pw3[3]=PKW(P1,14), pw3); \
    l_reg+=sacc; \
    if(GK){DMA_K((t)+3,sl_cur);} if(GV){DMA_V((t)+1,sl_next);} \
    CMASK(C0,C1,t); \
    { float a=MX3(C0[0],C0[1],C1[0]),b=MX3(C0[2],C0[3],C1[1]); a=MX3(a,C1[2],C1[3]); \
      _Pragma("unroll") for(int r=4;r<16;r+=4){a=MX3(a,C0[r],C0[r+1]);b=MX3(b,C0[r+2],C0[r+3]);a=MX3(a,C1[r],C1[r+1]);b=MX3(b,C1[r+2],C1[r+3]);} \
      float rm=__builtin_fmaxf(a,b); { auto rr=__builtin_amdgcn_permlane32_swap(__float_as_uint(rm),__float_as_uint(rm),false,false); rm=__builtin_fmaxf(__uint_as_float(rr[0]),__uint_as_float(rr[1])); } \
      resc=false; \
      if(__builtin_expect(__any(rm>(float)THRL),0)){ const float dl=__builtin_fmaxf(rm,0.f); mhat+=dl; \
        _Pragma("unroll") for(int r=0;r<16;++r){C0[r]-=dl;C1[r]-=dl;} \
        nm=ci2-mhat; \
        const float f=__builtin_amdgcn_exp2f(-dl); l_reg*=f; if(hi==0)wsf[r32]=f; resc=true; } } \
    SBAR(); \
    GAPB(o[0]=__builtin_amdgcn_mfma_f32_32x32x16_bf16(PAF(0),VFR(0),o[0],0,0,0), C0,0); \
    GAPB(o[1]=__builtin_amdgcn_mfma_f32_32x32x16_bf16(PAF(0),VFR(4),o[1],0,0,0), C0,4); \
    KRD(GL,0); GAPB(o[0]=__builtin_amdgcn_mfma_f32_32x32x16_bf16(PAF(1),VFR(1),o[0],0,0,0), C0,8); \
    KRD(GL,1); GAPB(o[1]=__builtin_amdgcn_mfma_f32_32x32x16_bf16(PAF(1),VFR(5),o[1],0,0,0), C0,12); \
    KRD(GL,2); GAPB(o[0]=__builtin_amdgcn_mfma_f32_32x32x16_bf16(PAF(2),VFR(2),o[0],0,0,0), C1,0); \
    KRD(GL,3); GAPB(o[1]=__builtin_amdgcn_mfma_f32_32x32x16_bf16(PAF(2),VFR(6),o[1],0,0,0), C1,4); \
    GAPB(o[0]=__builtin_amdgcn_mfma_f32_32x32x16_bf16(PAF(3),VFR(3),o[0],0,0,0), C1,8); \
    GAPB(o[1]=__builtin_amdgcn_mfma_f32_32x32x16_bf16(PAF(3),VFR(7),o[1],0,0,0), C1,12); \
    }while(0)
  int t=1;
  #undef CMASK
  #define CMASK(P0,P1,t) do{}while(0)
  for(;t+5<NT;t+=2){
    STEP(pB0,pB1,pA0,pA1,t,true,true,true);     WAIT_BAR(2); RESC(); ROT();
    STEP(pA0,pA1,pB0,pB1,t+1,true,true,true);   WAIT_BAR(2); RESC(); ROT();
  }
  #undef CMASK
  #define CMASK(P0,P1,t) do{int jb_=(t)-(NT-4); if(jb_>=0)cmask(P0,P1,jb_,qrel,hi);}while(0)
  #define ENDW(tt) do{ if((tt)+3<NT){WAIT_BAR(2);} else if((tt)+2<NT){WAIT_BAR(1);} else {WAIT_BAR(0);} }while(0)
  for(;t+1<NT;t+=2){
    STEP(pB0,pB1,pA0,pA1,t,(t+3<NT),(t+1<NT),(t+1<NT));       ENDW(t);   RESC(); ROT();
    STEP(pA0,pA1,pB0,pB1,t+1,(t+4<NT),(t+2<NT),(t+2<NT));     ENDW(t+1); RESC(); ROT();
  }
  STEP(pB0,pB1,pA0,pA1,NT-1,false,false,false); RESC();
  { float sacc=pB0[0]+pB0[1]; _Pragma("unroll") for(int r=2;r<16;++r)sacc+=pB0[r]; _Pragma("unroll") for(int r=0;r<16;++r)sacc+=pB1[r]; l_reg+=sacc;
    pw0=(u32x4){PKW(pB0,0),PKW(pB0,2),PKW(pB0,4),PKW(pB0,6)};pw1=(u32x4){PKW(pB0,8),PKW(pB0,10),PKW(pB0,12),PKW(pB0,14)};pw2=(u32x4){PKW(pB1,0),PKW(pB1,2),PKW(pB1,4),PKW(pB1,6)};pw3=(u32x4){PKW(pB1,8),PKW(pB1,10),PKW(pB1,12),PKW(pB1,14)};
    SBAR(); pv(o,vb0+sl_cur,PAF(0),PAF(1),PAF(2),PAF(3)); }
  #undef PKW
  #undef PAF
  #undef VFR
  #undef PIN
  #undef MX3
  #undef GAPA
  #undef GAPB
  #undef EX
  #undef VRD
  #undef KRD
  #undef STEP
  #undef ENDW
  {auto rr=__builtin_amdgcn_permlane32_swap(__float_as_uint(l_reg),__float_as_uint(l_reg),false,false);l_reg=__uint_as_float(rr[0])+__uint_as_float(rr[1]);}
  if(hi==0)wsf[32+r32]=l_reg;asm volatile("s_waitcnt lgkmcnt(0)":::"memory");
  float rli[16];
  #pragma unroll
  for(int r=0;r<16;++r)rli[r]=__builtin_amdgcn_rcpf(wsf[32+crow(r,hi)]);
  bf16*Ow=O+(rowbase+q0+wid*QBLK)*DM+h*D;
  { bf16*stg=(bf16*)(shm+LDS_OST)+wid*2048;
    #pragma unroll
    for(int r=0;r<16;++r){const int orow=crow(r,hi);
      #pragma unroll
      for(int d0=0;d0<2;++d0)stg[orow*64+d0*32+r32]=__float2bfloat16(o[d0][r]*rli[r]);}
    asm volatile("s_waitcnt lgkmcnt(0)":::"memory");
    #pragma unroll
    for(int i=0;i<4;++i){const int row=i*8+(lane>>3),ch=lane&7; const u32x4 v=*(const u32x4*)(stg+row*64+ch*8); ATTN_STORE16(Ow+(long)row*DM+ch*8,v);} }
  asm volatile("s_waitcnt lgkmcnt(0)\n\ts_barrier":::"memory");
  #undef DMA_K
  #undef DMA_V
  #undef CINIT
  #undef CMASK
  #undef START
  #undef RESC
  #undef ROT
}
constexpr int ATTN_LDS_BYTES=LDS_BYTES;
struct AttnTensors { const bf16* Q; const bf16* K; const bf16* V; bf16* O; };
struct AttnUnit { int bh; int qb; };
struct StaticOrder {
  int vcu;
  __device__ __forceinline__ explicit StaticOrder(int grid,int block):vcu((block%8)*(grid/8)+block/8){}
  __device__ __forceinline__ bool next(int i,AttnUnit&u)const{ if(i>=4)return false; const int s=vcu&3; u.bh=vcu>>2; u.qb=(i==0)?s:(i==1)?7-s:(i==2)?8+s:15-s; return true; }
  __device__ __forceinline__ void a_ready(const AttnUnit&)const{}
  __device__ __forceinline__ void done(const AttnUnit&)const{}
};
#undef SBAR
#undef WAIT_BAR
}
#define LAS __attribute__((address_space(3)))
typedef unsigned short bf16;
typedef unsigned v4u __attribute__((ext_vector_type(4)));
typedef unsigned v2u __attribute__((ext_vector_type(2)));
typedef float f32x4 __attribute__((ext_vector_type(4)));
typedef float f32x16 __attribute__((ext_vector_type(16)));
typedef short bf16x8 __attribute__((ext_vector_type(8)));
typedef float f32x2s __attribute__((ext_vector_type(2)));

constexpr int NBATCH = 4, SEQ = 4096, M = NBATCH * SEQ, D = 1024, DFF = 2816, PLE = 256;
constexpr int EVEN_IN = 2560, FOX_IN = 3088, FOX_INP = 3328;
constexpr float LOG2E = 1.4426950408889634f;
constexpr float QSCALE = 0.125f * LOG2E;
constexpr float GN_EPS = 64e-5f;
constexpr size_t MiB = 1u << 20;
constexpr size_t WS_SSQ = 0;
constexpr size_t WS_C3 = 1 * MiB;
constexpr size_t WS_LF = 2 * MiB;
constexpr size_t WS_G2F = 3 * MiB;
constexpr size_t WS_WGU = 4 * MiB;
constexpr size_t WS_WD = 48 * MiB;
constexpr size_t WS_WG = 70 * MiB;
constexpr size_t WS_WP = 74 * MiB;
constexpr size_t WS_WIN0 = 75 * MiB, WS_WOUT0 = 80 * MiB, WS_WIN1 = 82 * MiB, WS_WOUT1 = 89 * MiB;
constexpr size_t WS_XB = 91 * MiB;
constexpr size_t WS_Y = 123 * MiB;
constexpr size_t WS_BIG = 155 * MiB;
constexpr size_t WS_PB = 243 * MiB;
constexpr size_t WS_SSQP = 251 * MiB;
constexpr size_t WS_END = 253 * MiB;
constexpr size_t WS_BAR = 0;
constexpr int LDS_BYTES = 147456, MISC_OFF = 147456 - 64;

#define LDS_WAIT() asm volatile("s_waitcnt lgkmcnt(0)" ::: "memory")
__device__ __forceinline__ unsigned pk2(float lo, float hi) { return pg8::cvt_pk_bf16(lo, hi); }
__device__ __forceinline__ float bflo(unsigned w) { return __uint_as_float(w << 16); }
__device__ __forceinline__ float bfhi(unsigned w) { return __uint_as_float(w & 0xffff0000u); }
__device__ __forceinline__ float bf2f(bf16 h) { return __uint_as_float((unsigned)h << 16); }
__device__ __forceinline__ float wave_sum(float v) {
#pragma unroll
    for (int o = 1; o < 64; o <<= 1) v += __shfl_xor(v, o);
    return v;
}
__device__ __forceinline__ int crow(int r, int hi) { return (r & 3) + 8 * (r >> 2) + 4 * hi; }
template <int CTRL> __device__ __forceinline__ float dpp_f(float x) { return __int_as_float(__builtin_amdgcn_update_dpp(0, __float_as_int(x), CTRL, 0xf, 0xf, true)); }
__device__ __forceinline__ float red16(float x) { x += dpp_f<0xB1>(x); x += dpp_f<0x4E>(x); x += dpp_f<0x141>(x); x += dpp_f<0x140>(x); return x; }
__device__ __forceinline__ float red8(float x) { x += dpp_f<0xB1>(x); x += dpp_f<0x4E>(x); x += dpp_f<0x141>(x); return x; }
__device__ __forceinline__ void unpack8(const v4u w, float (&f)[8]) { f[0] = bflo(w.x); f[1] = bfhi(w.x); f[2] = bflo(w.y); f[3] = bfhi(w.y); f[4] = bflo(w.z); f[5] = bfhi(w.z); f[6] = bflo(w.w); f[7] = bfhi(w.w); }
__device__ __forceinline__ bf16x8 pack8(const float (&f)[8]) { v4u w; w.x = pk2(f[0], f[1]); w.y = pk2(f[2], f[3]); w.z = pk2(f[4], f[5]); w.w = pk2(f[6], f[7]); return __builtin_bit_cast(bf16x8, w); }

__device__ __forceinline__ void conv_item(const float* W, int K, int N, int NP, bf16* WT, const float* gain, int mode, LAS float* scr, int item, int lane) {
    const int nblk = NP / 32, kb = item / nblk, nb = item - kb * nblk, k0 = 64 * kb, n0 = 32 * nb;
    int orow0 = n0;
    if (mode == 1) orow0 = (n0 < DFF) ? (n0 / 128) * 256 + (n0 % 128) : ((n0 - DFF) / 128) * 256 + 128 + ((n0 - DFF) % 128);
    const int nq = 4 * (lane & 7); const bool inb = (n0 + nq) < N;
#pragma unroll
    for (int i = 0; i < 8; ++i) { const int kk = 8 * i + (lane >> 3); f32x4 v = {0.f, 0.f, 0.f, 0.f}; if (inb) v = *(const f32x4*)(W + (size_t)(k0 + kk) * N + n0 + nq);
        if (gain) v = v * gain[k0 + kk];
        LAS float* d = scr + kk * 33 + nq; d[0] = v[0]; d[1] = v[1]; d[2] = v[2]; d[3] = v[3]; }
    LDS_WAIT(); asm volatile("" ::: "memory");
    const int c = lane & 7;
#pragma unroll
    for (int j = 0; j < 4; ++j) { const int nn = (lane >> 3) + 8 * j; const LAS float* s = scr + (8 * c) * 33 + nn;
        v4u o; o.x = pk2(s[0 * 33], s[1 * 33]); o.y = pk2(s[2 * 33], s[3 * 33]); o.z = pk2(s[4 * 33], s[5 * 33]); o.w = pk2(s[6 * 33], s[7 * 33]);
        *(v4u*)(WT + (size_t)(orow0 + nn) * K + k0 + 8 * c) = o; }
    LDS_WAIT(); asm volatile("" ::: "memory");
}

constexpr int VTP = 264;
__device__ __forceinline__ void swa_unit(int unit, const bf16* PROJ, bf16* Y, const float* sinks, LAS unsigned char* lds, int tid, int lane, int wid) {
    const int b = unit >> 6, kvh = (unit >> 5) & 1, qblk = unit & 31, q0 = qblk * 128; const size_t rb = (size_t)b * SEQ;
    asm volatile("" : "+s"(PROJ), "+s"(Y));
    LAS bf16* VT = (LAS bf16*)lds;
    for (int c = tid; c < 2048; c += 512) { const int kvl = c >> 3, ch = c & 7, tok = q0 - 128 + kvl; v4u v = {0u, 0u, 0u, 0u};
        if (tok >= 0) v = *(const v4u*)(PROJ + (rb + tok) * EVEN_IN + 640 + kvh * 64 + ch * 8);
        LAS bf16* d = VT + (ch * 8) * VTP + kvl;
        d[0 * VTP] = (bf16)(v.x & 0xffffu); d[1 * VTP] = (bf16)(v.x >> 16); d[2 * VTP] = (bf16)(v.y & 0xffffu); d[3 * VTP] = (bf16)(v.y >> 16);
        d[4 * VTP] = (bf16)(v.z & 0xffffu); d[5 * VTP] = (bf16)(v.z >> 16); d[6 * VTP] = (bf16)(v.w & 0xffffu); d[7 * VTP] = (bf16)(v.w >> 16); }
    __syncthreads();
    const int g = wid >> 1, qh = wid & 1, hq = kvh * 4 + g;
    const float slope2 = exp2f(-(float)(hq + 1)) * LOG2E, sink2 = sinks[hq] * LOG2E;
#pragma unroll 1
    for (int sb = 0; sb < 2; ++sb) {
        int r32 = lane & 31, hi = lane >> 5; asm volatile("" : "+v"(r32), "+v"(hi));
        const int qs = q0 + 64 * qh + 32 * sb;
        bf16x8 qf[4];
#pragma unroll
        for (int ks = 0; ks < 4; ++ks) qf[ks] = *(const bf16x8*)(PROJ + (rb + qs + r32) * EVEN_IN + hq * 64 + 16 * ks + 8 * hi);
        f32x16 sc[5];
#pragma unroll
        for (int kt = 0; kt < 5; ++kt) { int tk = qs - 128 + 32 * kt + r32; tk = tk < 0 ? 0 : tk; sc[kt] = f32x16{};
#pragma unroll
            for (int ks = 0; ks < 4; ++ks) { const bf16x8 kf = *(const bf16x8*)(PROJ + (rb + tk) * EVEN_IN + 512 + kvh * 64 + 16 * ks + 8 * hi);
                sc[kt] = __builtin_amdgcn_mfma_f32_32x32x16_bf16(kf, qf[ks], sc[kt], 0, 0, 0); }
            asm volatile("" ::: "memory"); }
        const int db = r32 + 128 - 4 * hi, kmin = 128 - qs - 4 * hi; const float ab = -slope2 * (float)db;
        float mx = sink2;
#pragma unroll
        for (int kt = 0; kt < 5; ++kt)
#pragma unroll
            for (int r = 0; r < 16; ++r) { const int kc = 32 * kt + (r & 3) + 8 * (r >> 2), dist = db - kc; const bool ok = ((unsigned)dist < 128u) && (kmin <= kc);
                const float s = ok ? fmaf(slope2, (float)kc, sc[kt][r] + ab) : -INFINITY; sc[kt][r] = s; mx = fmaxf(mx, s); }
        mx = fmaxf(mx, __shfl_xor(mx, 32));
        float l = 0.f;
#pragma unroll
        for (int kt = 0; kt < 5; ++kt)
#pragma unroll
            for (int r = 0; r < 16; ++r) { const float p = exp2f(sc[kt][r] - mx); sc[kt][r] = p; l += p; }
        l += __shfl_xor(l, 32); l += exp2f(sink2 - mx);
        const float rl = 1.0f / l;
        f32x16 o[2]; o[0] = f32x16{}; o[1] = f32x16{};
        const int kvl0 = 64 * qh + 32 * sb;
#pragma unroll
        for (int kt = 0; kt < 5; ++kt)
#pragma unroll
            for (int s2 = 0; s2 < 2; ++s2) { v4u pw; pw.x = pk2(sc[kt][8 * s2 + 0], sc[kt][8 * s2 + 1]); pw.y = pk2(sc[kt][8 * s2 + 2], sc[kt][8 * s2 + 3]); pw.z = pk2(sc[kt][8 * s2 + 4], sc[kt][8 * s2 + 5]); pw.w = pk2(sc[kt][8 * s2 + 6], sc[kt][8 * s2 + 7]);
                const bf16x8 pa = __builtin_bit_cast(bf16x8, pw);
#pragma unroll
                for (int db = 0; db < 2; ++db) { const LAS bf16* vp = VT + (32 * db + r32) * VTP + kvl0 + 32 * kt + 16 * s2 + 4 * hi;
                    const v2u lo = *(const LAS v2u*)vp, hh = *(const LAS v2u*)(vp + 8); v4u vw; vw.x = lo.x; vw.y = lo.y; vw.z = hh.x; vw.w = hh.y;
                    o[db] = __builtin_amdgcn_mfma_f32_32x32x16_bf16(pa, __builtin_bit_cast(bf16x8, vw), o[db], 0, 0, 0); } }
#pragma unroll
        for (int r = 0; r < 16; ++r) { const int qq = crow(r, hi); const float sc1 = __shfl(rl, qq);
            bf16* yp = Y + (rb + qs + qq) * 1024 + hq * 64 + r32;
            yp[0] = (bf16)(pk2(o[0][r] * sc1, 0.f) & 0xffffu); yp[32] = (bf16)(pk2(o[1][r] * sc1, 0.f) & 0xffffu); }
    }
    __syncthreads();
}
typedef unsigned v4u_unused_;
#define XB_TMO      128
#define XB_XCNT(j)  (256  + 64 * (j))
#define XB_XSUB(j)  (1280 + 64 * (j))
#define XB_XGEN(j)  (2304 + 64 * (j))
#define XB_TOP      3328
#define XB_TOPGEN   3392
#define XCD_BAR_WORDS 3456
#define XB_SPIN_CAP (1u << 18)

__device__ __forceinline__ unsigned xb_ld(unsigned* p)              { return __hip_atomic_load(p, __ATOMIC_RELAXED, __HIP_MEMORY_SCOPE_AGENT); }
__device__ __forceinline__ unsigned xb_add(unsigned* p, unsigned v) { return __hip_atomic_fetch_add(p, v, __ATOMIC_RELAXED, __HIP_MEMORY_SCOPE_AGENT); }
__device__ __forceinline__ unsigned xb_xcc_id() { return (unsigned)__builtin_amdgcn_s_getreg((3 << 11) | 20) & 0xFu; }
#define XB_SPIN(cond, bar) do { unsigned _sp = 0; while (cond) { __builtin_amdgcn_s_sleep(1); \
    if ((++_sp & 255u) == 0u) { if (xb_ld(&(bar)[XB_TMO])) break; if (_sp > XB_SPIN_CAP) { atomicAdd(&(bar)[XB_TMO], 1u); break; } } } } while (0)

struct XcdBarrier {
    unsigned* bar; unsigned x;
    volatile LAS unsigned* st;
};

__device__ __forceinline__ XcdBarrier xcd_barrier_post(unsigned* bar, volatile LAS unsigned* st) {
    XcdBarrier b; b.bar = bar; b.x = xb_xcc_id(); b.st = st;
    if (threadIdx.x == 0) (void)xb_add(&bar[XB_XCNT(b.x)], 1u);
    return b;
}
__device__ __forceinline__ void xcd_barrier_complete(unsigned* bar, unsigned x, unsigned& nloc, unsigned& nx) {
    const unsigned G = gridDim.x * gridDim.y * gridDim.z;
    unsigned sum, cnt, mine, sp = 0u;
    for (;;) {
        sum = 0u; cnt = 0u; mine = 0u;
#pragma unroll
        for (unsigned j = 0; j < 16; ++j) { const unsigned c = xb_ld(&bar[XB_XCNT(j)]); sum += c; cnt += (c > 0u) ? 1u : 0u; mine = (j == x) ? c : mine; }
        if (sum == G) break;
        __builtin_amdgcn_s_sleep(1);
        if ((++sp & 255u) == 0u) { if (xb_ld(&bar[XB_TMO])) break; if (sp > XB_SPIN_CAP) { atomicAdd(&bar[XB_TMO], 1u); break; } }
    }
    nloc = mine > 0u ? mine : 1u; nx = cnt > 0u ? cnt : 1u;
}

__device__ __forceinline__ void xcd_barrier(const XcdBarrier& b) {
    asm volatile("s_waitcnt vmcnt(0)" ::: "memory");
    __syncthreads();
    if (threadIdx.x == 0) {
        unsigned* bar = b.bar;
        __builtin_amdgcn_s_waitcnt(0);
        unsigned nloc = b.st[0], nx = b.st[1];
        if (nloc == 0u) { xcd_barrier_complete(bar, b.x, nloc, nx); b.st[0] = nloc; b.st[1] = nx; }
        const unsigned old = xb_add(&bar[XB_XSUB(b.x)], 1u);
        const unsigned gen = old / nloc;
        if (old + 1u == (gen + 1u) * nloc) {
            __builtin_amdgcn_fence(__ATOMIC_RELEASE, "agent");
            asm volatile("s_waitcnt vmcnt(0)" ::: "memory");
            const unsigned og = xb_add(&bar[XB_TOP], 1u);
            const unsigned tg = og / nx;
            if (og + 1u == (tg + 1u) * nx) xb_add(&bar[XB_TOPGEN], 1u);
            else XB_SPIN(xb_ld(&bar[XB_TOPGEN]) == tg, bar);
            __builtin_amdgcn_fence(__ATOMIC_ACQUIRE, "agent");
            xb_add(&bar[XB_XGEN(b.x)], 1u);
            asm volatile("s_waitcnt vmcnt(0)" ::: "memory");
        } else {
            XB_SPIN(xb_ld(&bar[XB_XGEN(b.x)]) == gen, bar);
            __builtin_amdgcn_fence(__ATOMIC_ACQUIRE, "agent");
            asm volatile("s_waitcnt vmcnt(0)" ::: "memory");
        }
    }
    __syncthreads();
}
constexpr int TC = 32, SBS = 340, LBS = 68;
constexpr int SBS_UNUSED_ = 336;
constexpr int RW_SBUF = 0, RW_SBUF_BYTES = TC * SBS * 4, RW_LW = 2 * RW_SBUF_BYTES, RW_LA = RW_LW + 2 * TC * LBS * 4, RW_EC = RW_LA + 2 * TC * LBS * 4, RW_BF = RW_EC + 2560;
__device__ __forceinline__ void rwkv_scan_unit(int unit, const bf16* PROJ, float* YRAW, float* C3, const float* mu, const float* w0, const float* w2, const float* a0, const float* a2,
                                               const float* k_k, const float* k_a, const float* r_k, LAS unsigned char* lds, const int lane, int wid) {
    const int role = (wid < 2) ? 0 : ((wid == 4 || wid == 5) ? 2 : 1), lw = wid - 4, ew = (wid < 4) ? wid - 2 : wid - 4;
    const int b = unit >> 6, h = (unit >> 3) & 7, rg = unit & 7; const size_t rb = (size_t)b * SEQ;
    const int r32 = lane & 31, hi = lane >> 5;
    constexpr int NCH = SEQ / TC;
    if (role == 2) {
        const int colx = 768 + ((lw == 0) ? 1536 : 1600); const float* Wl = (lw == 0) ? w2 : a2;
#pragma unroll
        for (int nb = 0; nb < 2; ++nb)
#pragma unroll
            for (int ks = 0; ks < 4; ++ks) { float f[8];
#pragma unroll
                for (int i = 0; i < 8; ++i) f[i] = Wl[(size_t)(16 * ks + 8 * hi + i) * 512 + h * 64 + 32 * nb + r32];
                *(LAS bf16x8*)(lds + RW_BF + (((lw * 2 + nb) * 4 + ks) * 64 + lane) * 16) = pack8(f); }
        ((LAS float*)(lds + RW_EC))[512 + lw * 64 + lane] = mu[colx - 768 + lane];
        v4u lcw[4], lpw[4];
#define LORA_LOAD(itn) do { const int tl_ = (itn) * TC + r32; const bf16* p_ = PROJ + (rb + tl_) * EVEN_IN + colx + 8 * hi; _Pragma("unroll") for (int ks = 0; ks < 4; ++ks) { lcw[ks] = *(const v4u*)(p_ + 16 * ks); \
            lpw[ks] = (v4u){0u, 0u, 0u, 0u}; if (tl_ > 0) lpw[ks] = *(const v4u*)(p_ - EVEN_IN + 16 * ks); } } while (0)
        LORA_LOAD(0);
#pragma unroll 1
        for (int it = 0; it < NCH + 2; ++it) {
            if (it < NCH) { bf16x8 afr[4];
#pragma unroll
                for (int ks = 0; ks < 4; ++ks) { float c[8], p[8]; unpack8(lcw[ks], c); unpack8(lpw[ks], p);
                    const LAS float* mq = (const LAS float*)(lds + RW_EC) + 512 + lw * 64 + 16 * ks + 8 * hi; const f32x4 m0 = *(const LAS f32x4*)mq, m1 = *(const LAS f32x4*)(mq + 4);
#pragma unroll
                    for (int i = 0; i < 8; ++i) { float x = c[i] + (p[i] - c[i]) * (i < 4 ? m0[i] : m1[i - 4]); if (lw == 0) x = 1.f - 2.f * __builtin_amdgcn_rcpf(1.f + __expf(2.f * x)); c[i] = x; }
                    afr[ks] = pack8(c); }
                if (it + 1 < NCH) LORA_LOAD(it + 1);
                LAS float* LB = (LAS float*)(lds + ((lw == 0) ? RW_LW : RW_LA)) + (it & 1) * (TC * LBS);
#pragma unroll
                for (int nb = 0; nb < 2; ++nb) { f32x16 acc = f32x16{};
#pragma unroll
                    for (int ks = 0; ks < 4; ++ks) acc = __builtin_amdgcn_mfma_f32_32x32x16_bf16(afr[ks], *(const LAS bf16x8*)(lds + RW_BF + (((lw * 2 + nb) * 4 + ks) * 64 + lane) * 16), acc, 0, 0, 0);
#pragma unroll
                    for (int r = 0; r < 16; ++r) LB[crow(r, hi) * LBS + 32 * nb + r32] = acc[r]; } }
            asm volatile("s_waitcnt lgkmcnt(0)\n\ts_barrier" ::: "memory");
        }
#undef LORA_LOAD
    } else if (role == 1) {
        const int el = ew * 64 + lane, s = el >> 3, g = el & 7;
        float ecc[8][8];
        { const int chn = h * 64 + 8 * g;
#pragma unroll
          for (int i = 0; i < 8; ++i) { ecc[0][i] = mu[chn + i]; ecc[1][i] = mu[512 + chn + i]; ecc[2][i] = mu[1024 + chn + i]; ecc[3][i] = w0[chn + i]; ecc[4][i] = a0[chn + i]; ecc[5][i] = k_k[chn + i]; ecc[6][i] = k_a[chn + i]; ecc[7][i] = r_k[chn + i]; } }
        v4u ecr, eck, ecv, epr, epk, epv;
#define ELEM_LOAD(cn) do { const int tl_ = (cn) * TC + s; const bf16* p_ = PROJ + (rb + tl_) * EVEN_IN + 768 + h * 64 + 8 * g; \
            ecr = *(const v4u*)p_; eck = *(const v4u*)(p_ + 512); ecv = *(const v4u*)(p_ + 1024); epr = (v4u){0u, 0u, 0u, 0u}; epk = epr; epv = epr; \
            if (tl_ > 0) { epr = *(const v4u*)(p_ - EVEN_IN); epk = *(const v4u*)(p_ - EVEN_IN + 512); epv = *(const v4u*)(p_ - EVEN_IN + 1024); } } while (0)
        ELEM_LOAD(0);
#pragma unroll 1
        for (int it = 0; it < NCH + 2; ++it) {
            const int c = it - 1;
            if (c >= 0 && c < NCH) { const size_t row = rb + c * TC + s;
                const LAS float* LW = (const LAS float*)(lds + RW_LW) + (c & 1) * (TC * LBS) + s * LBS + 8 * g; const LAS float* LA = (const LAS float*)(lds + RW_LA) + (c & 1) * (TC * LBS) + s * LBS + 8 * g;
                LAS float* sp = (LAS float*)(lds + RW_SBUF + (c & 1) * RW_SBUF_BYTES) + s * SBS;
                float ec[8];
#define LDEC(arr) do { _Pragma("unroll") for (int i_ = 0; i_ < 8; ++i_) ec[i_] = ecc[arr][i_]; } while (0)
                float r[8], k[8], v[8], t[8];
                unpack8(ecr, r); unpack8(epr, t); LDEC(0);
#pragma unroll
                for (int i = 0; i < 8; ++i) r[i] += (t[i] - r[i]) * ec[i];
                unpack8(eck, k); unpack8(epk, t); LDEC(1);
#pragma unroll
                for (int i = 0; i < 8; ++i) k[i] += (t[i] - k[i]) * ec[i];
                unpack8(ecv, v); unpack8(epv, t); LDEC(2);
#pragma unroll
                for (int i = 0; i < 8; ++i) v[i] += (t[i] - v[i]) * ec[i];
                if (c + 1 < NCH) ELEM_LOAD(c + 1);
                const f32x4 dw0 = *(const LAS f32x4*)LW, dw1 = *(const LAS f32x4*)(LW + 4), da0 = *(const LAS f32x4*)LA, da1 = *(const LAS f32x4*)(LA + 4);
                float w[8], a[8], kk[8], kp[8]; float n2 = 0.f;
#pragma unroll
                for (int i = 0; i < 8; ++i) w[i] = i < 4 ? dw0[i] : dw1[i - 4];
                LDEC(3);
#pragma unroll
                for (int i = 0; i < 8; ++i) w[i] = __expf(-0.60653065971f * pg8::sigm(ec[i] + w[i]));
                LDEC(4);
#pragma unroll
                for (int i = 0; i < 8; ++i) a[i] = pg8::sigm(ec[i] + (i < 4 ? da0[i] : da1[i - 4]));
                LDEC(5);
#pragma unroll
                for (int i = 0; i < 8; ++i) { kk[i] = k[i] * ec[i]; n2 += kk[i] * kk[i]; }
                LDEC(6);
#pragma unroll
                for (int i = 0; i < 8; ++i) kp[i] = k[i] * (1.f + (a[i] - 1.f) * ec[i]);
                LDEC(7);
                n2 = red8(n2); const float inv = __builtin_amdgcn_rsqf(fmaxf(n2, 1e-24f));
                float c1 = 0.f, c2 = 0.f, c3 = 0.f;
#pragma unroll
                for (int i = 0; i < 8; ++i) { kk[i] *= inv; t[i] = kk[i] * a[i]; c1 += t[i] * r[i]; c2 += kp[i] * r[i]; c3 += r[i] * kp[i] * ec[i]; }
#undef LDEC
                c1 = red8(c1); c2 = red8(c2); c3 = red8(c3);
                *(LAS f32x4*)(sp + 8 * g) = (f32x4){kk[0], kk[1], kk[2], kk[3]}; *(LAS f32x4*)(sp + 8 * g + 4) = (f32x4){kk[4], kk[5], kk[6], kk[7]};
                *(LAS f32x4*)(sp + 64 + 8 * g) = (f32x4){w[0] * r[0], w[1] * r[1], w[2] * r[2], w[3] * r[3]}; *(LAS f32x4*)(sp + 64 + 8 * g + 4) = (f32x4){w[4] * r[4], w[5] * r[5], w[6] * r[6], w[7] * r[7]};
                *(LAS f32x4*)(sp + 128 + 8 * g) = (f32x4){w[0], w[1], w[2], w[3]}; *(LAS f32x4*)(sp + 128 + 8 * g + 4) = (f32x4){w[4], w[5], w[6], w[7]};
                *(LAS f32x4*)(sp + 192 + 8 * g) = (f32x4){t[0], t[1], t[2], t[3]}; *(LAS f32x4*)(sp + 192 + 8 * g + 4) = (f32x4){t[4], t[5], t[6], t[7]};
                *(LAS f32x4*)(sp + 256 + 8 * g) = (f32x4){kp[0], kp[1], kp[2], kp[3]}; *(LAS f32x4*)(sp + 256 + 8 * g + 4) = (f32x4){kp[4], kp[5], kp[6], kp[7]};
                if (g == rg) { *(LAS f32x4*)(sp + 320) = (f32x4){v[0], v[1], v[2], v[3]}; *(LAS f32x4*)(sp + 324) = (f32x4){v[4], v[5], v[6], v[7]}; }
                if (g == 0) { sp[328] = c1; sp[329] = c2; if (rg == 0) C3[row * 8 + h] = c3; } }
            asm volatile("s_waitcnt lgkmcnt(0)\n\ts_barrier" ::: "memory");
        }
#undef ELEM_LOAD
    } else {
        const int rowl = 4 * (wid & 1) + (lane >> 4), cgp = lane & 15;
        f32x2s S01 = {0.f, 0.f}, S23 = {0.f, 0.f};
#pragma unroll 1
        for (int it = 0; it < NCH + 2; ++it) {
            const int c = it - 2;
            if (c >= 0) { const LAS float* SBF = (const LAS float*)(lds + RW_SBUF + (c & 1) * RW_SBUF_BYTES);
                float* yp = YRAW + (rb + (size_t)c * TC) * 512 + h * 64 + 8 * rg + rowl;
                __builtin_amdgcn_s_setprio(3);
                f32x4 kkA, wrA, wA, kaA, kpA, kkB, wrB, wB, kaB, kpB; float viA, viB; float pkeep = 0.f, qkeep = 0.f;
#define LDREC(X, s_) do { const LAS float* sp_ = SBF + (s_) * SBS; kk##X = *(const LAS f32x4*)(sp_ + 4 * cgp); wr##X = *(const LAS f32x4*)(sp_ + 64 + 4 * cgp); w##X = *(const LAS f32x4*)(sp_ + 128 + 4 * cgp); \
                    ka##X = *(const LAS f32x4*)(sp_ + 192 + 4 * cgp); kp##X = *(const LAS f32x4*)(sp_ + 256 + 4 * cgp); vi##X = sp_[320 + rowl]; } while (0)
#define LO2(v) __builtin_shufflevector(v, v, 0, 1)
#define HI2(v) __builtin_shufflevector(v, v, 2, 3)
#define STEPREC(X, s_) do { f32x2s pp = S01 * LO2(kk##X); pp = S23 * HI2(kk##X) + pp; f32x2s qq = S01 * LO2(wr##X); qq = S23 * HI2(wr##X) + qq; float p = pp[0] + pp[1], q = qq[0] + qq[1]; \
                    const f32x2s vv_ = {vi##X, vi##X}; const f32x2s u01_ = S01 * LO2(w##X) + LO2(kp##X) * vv_, u23_ = S23 * HI2(w##X) + HI2(kp##X) * vv_;     \
                    p += dpp_f<0xB1>(p); q += dpp_f<0xB1>(q); p += dpp_f<0x4E>(p); q += dpp_f<0x4E>(q); p += dpp_f<0x141>(p); q += dpp_f<0x141>(q); p += dpp_f<0x140>(p); q += dpp_f<0x140>(q); \
                    const f32x2s pv_ = {p, p}; \
                    S01 = u01_ - LO2(ka##X) * pv_; S23 = u23_ - HI2(ka##X) * pv_; \
                    pkeep = (((s_) & 15) == cgp) ? p : pkeep; qkeep = (((s_) & 15) == cgp) ? q : qkeep;     \
                    if (((s_) & 15) == 15) { const LAS float* sy_ = SBF + ((s_) - 15 + cgp) * SBS; const f32x2s cy_ = *(const LAS f32x2s*)(sy_ + 328); \
                        yp[(size_t)((s_) - 15 + cgp) * 512] = qkeep - pkeep * cy_[0] + sy_[320 + rowl] * cy_[1]; } } while (0)
                LDREC(A, 0);
#pragma unroll
                for (int s = 0; s < TC; s += 2) {
 LDREC(B, s + 1); STEPREC(A, s); LDREC(A, s + 2); STEPREC(B, s + 1); }
#undef LDREC
#undef STEPREC
#undef LO2
#undef HI2
                __builtin_amdgcn_s_setprio(0); }
            asm volatile("s_waitcnt lgkmcnt(0)\n\ts_barrier" ::: "memory");
        }
    }
    __syncthreads();
}

__device__ __forceinline__ void rwkv_post_unit(int tile, const bf16* PROJ, const float* YRAW, const float* C3, bf16* Y, const float* mu, const bf16* g2f, const float* ln_w, const float* ln_b, int lane, int wid) {
    asm volatile("" : "+s"(PROJ), "+s"(mu), "+s"(g2f), "+s"(YRAW));
    const int h = wid, r32 = lane & 31, hi = lane >> 5; const int tok0 = tile * 32; const bool first = (tok0 & (SEQ - 1)) == 0;
    bf16x8 afr[8];
    { const int tk = tok0 + r32; const bool hp = !(first && r32 == 0); v4u cwv[8], pwv[8];
      const __attribute__((address_space(1))) bf16* pg = (const __attribute__((address_space(1))) bf16*)(PROJ + (size_t)tk * EVEN_IN + 768 + 1664 + 8 * hi);
#pragma unroll
        for (int ks = 0; ks < 8; ++ks) { cwv[ks] = *(const __attribute__((address_space(1))) v4u*)(pg + 16 * ks); pwv[ks] = (v4u){0u, 0u, 0u, 0u};
            if (hp) pwv[ks] = *(const __attribute__((address_space(1))) v4u*)(pg - EVEN_IN + 16 * ks); }
#pragma unroll
        for (int ks = 0; ks < 8; ++ks) { float c[8], p[8]; unpack8(cwv[ks], c); unpack8(pwv[ks], p);
            const f32x4 m0 = *(const f32x4*)(mu + 1664 + 16 * ks + 8 * hi), m1 = *(const f32x4*)(mu + 1664 + 16 * ks + 8 * hi + 4);
#pragma unroll
            for (int i = 0; i < 8; ++i) c[i] = pg8::sigm(c[i] + (p[i] - c[i]) * (i < 4 ? m0[i] : m1[i - 4]));
            afr[ks] = pack8(c); } }
    f32x16 gt[2];
#pragma unroll
    for (int nb = 0; nb < 2; ++nb) { gt[nb] = f32x16{};
#pragma unroll
        for (int ks = 0; ks < 8; ++ks) { const bf16x8 bf = *(const bf16x8*)(g2f + ((size_t)((h * 2 + nb) * 8 + ks) * 64 + lane) * 8);
            gt[nb] = __builtin_amdgcn_mfma_f32_32x32x16_bf16(afr[ks], bf, gt[nb], 0, 0, 0); } }
    typedef const __attribute__((address_space(1))) float* gfp; typedef const __attribute__((address_space(1))) unsigned short* gup;
    const int ch0 = h * 64 + r32; const float lw0 = ln_w[ch0], lw1 = ln_w[ch0 + 32], lb0 = ln_b[ch0], lb1 = ln_b[ch0 + 32], mv0 = mu[1024 + ch0], mv1 = mu[1024 + ch0 + 32];
    float y0[16], y1[16], c3v[16]; unsigned vc[16], vp[16];
#pragma unroll
    for (int r = 0; r < 16; ++r) { const int tk = tok0 + crow(r, hi); gfp yp = (gfp)(YRAW + (size_t)tk * 512 + ch0); y0[r] = yp[0]; y1[r] = yp[32]; c3v[r] = ((gfp)C3)[(size_t)tk * 8 + h];
        gup vq = (gup)(PROJ + (size_t)tk * EVEN_IN + 768 + 1024 + ch0); vc[r] = (unsigned)vq[0] | ((unsigned)vq[32] << 16); vp[r] = 0u;
        if ((tk & (SEQ - 1)) != 0) vp[r] = (unsigned)vq[-EVEN_IN] | ((unsigned)vq[32 - EVEN_IN] << 16); }
#pragma unroll
    for (int r = 0; r < 16; ++r) { const int tk = tok0 + crow(r, hi);
        float s = y0[r] + y1[r]; s = red16(s); s += __shfl_xor(s, 16);
        const float mean = s * (1.f / 64.f), d0 = y0[r] - mean, d1 = y1[r] - mean; float q = d0 * d0 + d1 * d1; q = red16(q); q += __shfl_xor(q, 16);
        const float rstd = rsqrtf(q * (1.f / 64.f) + GN_EPS);
        const float cv0 = bflo(vc[r]), cv1 = bfhi(vc[r]), pv0 = bflo(vp[r]), pv1 = bfhi(vp[r]);
        const float v0 = cv0 + (pv0 - cv0) * mv0, v1 = cv1 + (pv1 - cv1) * mv1;
        const float o0 = (d0 * rstd * lw0 + lb0 + c3v[r] * v0) * gt[0][r], o1 = (d1 * rstd * lw1 + lb1 + c3v[r] * v1) * gt[1][r];
        bf16* op = Y + (size_t)tk * 1024 + 512 + ch0; op[0] = (bf16)(pk2(o0, 0.f) & 0xffffu); op[32] = (bf16)(pk2(o1, 0.f) & 0xffffu); }
}

__device__ __forceinline__ void fox_prefix(const float* LFbh, LAS float* cs, LAS float* wtot, int tid, int lane, int wid) {
    const float* lp = LFbh + (size_t)tid * 128;
    float s[8]; s[0] = lp[0]; s[1] = s[0] + lp[16]; s[2] = s[1] + lp[32]; s[3] = s[2] + lp[48]; s[4] = s[3] + lp[64]; s[5] = s[4] + lp[80]; s[6] = s[5] + lp[96]; s[7] = s[6] + lp[112];
    float incl = s[7];
#pragma unroll
    for (int o = 1; o < 64; o <<= 1) { const float t = __shfl_up(incl, o); if (lane >= o) incl += t; }
    if (lane == 63) wtot[wid] = incl;
    __syncthreads();
    float base = incl - s[7];
    for (int w = 0; w < wid; ++w) base += wtot[w];
#pragma unroll
    for (int i = 0; i < 8; ++i) cs[8 * tid + i] = (base + s[i]) * LOG2E;
    __syncthreads();
}
struct Args { const float* in[30]; float* out; unsigned char* ws; int ph_lo, ph_hi; };
#define AS4 __attribute__((address_space(4)))
#ifndef DUP_SWA
#define DUP_SWA 0
#endif
#ifndef DUP_SCAN
#define DUP_SCAN 0
#endif
#ifndef DUP_POST
#define DUP_POST 0
#endif
#ifndef DUP_GU
#define DUP_GU 0
#endif
#ifndef DUP_INPROJ
#define DUP_INPROJ 0
#endif
#ifndef DUP_P0
#define DUP_P0 0
#endif
#ifndef DUP_SYNC
#define DUP_SYNC 0
#endif
#define INP(i) (*(const float* const AS4*)(kp + 8 * (i)))
#define GSYNC() xcd_barrier(xbar)
#define FRESH() const AS4 char* kp = kp0; asm volatile("" : "+s"(kp)); unsigned char* ws = *(unsigned char* const AS4*)(kp + 248); float* X = *(float* const AS4*)(kp + 240); \
    int tid = threadIdx.x; asm volatile("" : "+v"(tid)); const int lane = tid & 63, wid = __builtin_amdgcn_readfirstlane(tid >> 6); \
    const int gw = bx * 8 + wid, NGW = G * 8; \
    float* ssq = (float*)(ws + WS_SSQP); float* C3 = (float*)(ws + WS_C3); float* LF = (float*)(ws + WS_LF); \
    bf16* XB = (bf16*)(ws + WS_XB); float* YRAW = (float*)(ws + WS_XB); bf16* Y = (bf16*)(ws + WS_Y); \
    bf16* H = (bf16*)(ws + WS_BIG); bf16* PROJ = (bf16*)(ws + WS_BIG); bf16* PP = (bf16*)(ws + WS_BIG); bf16* PB = (bf16*)(ws + WS_PB); \
    bf16* Qb = (bf16*)(ws + WS_BIG); bf16* Kb = Qb + (size_t)M * D; bf16* Vb = Kb + (size_t)M * D; \
    (void)X; (void)lane; (void)wid; (void)gw; (void)NGW; (void)ssq; (void)C3; (void)LF; (void)XB; (void)YRAW; (void)Y; (void)H; (void)PROJ; (void)PP; (void)PB; (void)Qb; (void)Kb; (void)Vb
__global__ void __launch_bounds__(512, 2) fwd_megakernel(Args a_unused) {
    extern __shared__ __attribute__((aligned(16))) unsigned char lds_raw[];
    cg::grid_group grid = cg::this_grid();
    LAS unsigned char* lds = (LAS unsigned char*)lds_raw;
    const int G = gridDim.x, bx = blockIdx.x;
    const AS4 char* kp0 = (const AS4 char*)__builtin_amdgcn_kernarg_segment_ptr();
    const int ph_lo = *(const int AS4*)(kp0 + 256), ph_hi = *(const int AS4*)(kp0 + 260);
    XcdBarrier xbar;
    { unsigned* barw = (unsigned*)(*(unsigned char* const AS4*)(kp0 + 248) + WS_BAR);
      if (bx == 0) for (int i = threadIdx.x; i < XCD_BAR_WORDS; i += 512) barw[i] = 0u;
      if (threadIdx.x < 4) ((LAS unsigned*)(lds + MISC_OFF))[threadIdx.x] = 0u;
      asm volatile("s_waitcnt vmcnt(0)" ::: "memory"); __syncthreads();
      grid.sync();
      __builtin_amdgcn_fence(__ATOMIC_ACQUIRE, "agent"); asm volatile("s_waitcnt vmcnt(0)" ::: "memory");
      xbar = xcd_barrier_post(barw, (volatile LAS unsigned*)(lds + MISC_OFF)); }

#ifdef NANFILL
    { FRESH(); v4u q = {0xffffffffu, 0xffffffffu, 0xffffffffu, 0xffffffffu};
      for (size_t i = (size_t)bx * 512 + tid; i < WS_END / 16; i += (size_t)G * 512) ((v4u*)ws)[i] = q;
      for (size_t i = (size_t)bx * 512 + tid; i < (size_t)M * D / 4; i += (size_t)G * 512) ((v4u*)X)[i] = q;
      for (int i = tid; i < LDS_BYTES / 4; i += 512) ((LAS unsigned*)lds)[i] = 0xffffffffu; }
    GSYNC();
#endif
    for (int dup = 0; dup < 1 + DUP_P0; ++dup)
    if (ph_lo == 0) {
        FRESH();
        LAS float* scr = (LAS float*)(lds + wid * 16384);
        constexpr int I_GU = (D / 64) * (2 * DFF / 32), I_D = (DFF / 64) * (D / 32), I_G = (D / 64) * (D / 32), I_P = (PLE / 64) * (D / 32), I_IN0 = (D / 64) * (EVEN_IN / 32), I_IN1 = (D / 64) * (FOX_INP / 32);
        constexpr int NITEMS = 4 * I_GU + 4 * I_D + 2 * I_G + 2 * I_P + I_IN0 + I_IN1 + 2 * I_G;
        for (int it = gw; it < NITEMS; it += NGW) {
            int r = it;
#define MAT(cnt, W_, K_, N_, NP_, WT_, G_, MODE_) if (r < (cnt)) { conv_item((W_), (K_), (N_), (NP_), (bf16*)(WT_), (G_), (MODE_), scr, r, lane); continue; } r -= (cnt);
            MAT(I_GU, INP(3), D, 2 * DFF, 2 * DFF, ws + WS_WGU, INP(2), 1)
            MAT(I_GU, INP(7), D, 2 * DFF, 2 * DFF, ws + WS_WGU + 11 * MiB, INP(6), 1)
            MAT(I_GU, INP(3) + (size_t)D * 2 * DFF, D, 2 * DFF, 2 * DFF, ws + WS_WGU + 22 * MiB, INP(2) + D, 1)
            MAT(I_GU, INP(7) + (size_t)D * 2 * DFF, D, 2 * DFF, 2 * DFF, ws + WS_WGU + 33 * MiB, INP(6) + D, 1)
            MAT(I_D, INP(4), DFF, D, D, ws + WS_WD, nullptr, 0)
            MAT(I_D, INP(8), DFF, D, D, ws + WS_WD + (size_t)D * DFF * 2, nullptr, 0)
            MAT(I_D, INP(4) + (size_t)D * DFF, DFF, D, D, ws + WS_WD + (size_t)D * DFF * 4, nullptr, 0)
            MAT(I_D, INP(8) + (size_t)D * DFF, DFF, D, D, ws + WS_WD + (size_t)D * DFF * 6, nullptr, 0)
            MAT(I_G, INP(10), D, D, D, ws + WS_WG, INP(9), 0)
            MAT(I_G, INP(10) + (size_t)D * D, D, D, D, ws + WS_WG + 2 * MiB, INP(9) + D, 0)
            MAT(I_P, INP(11), PLE, D, D, ws + WS_WP, nullptr, 0)
            MAT(I_P, INP(11) + (size_t)PLE * D, PLE, D, D, ws + WS_WP + (size_t)PLE * D * 2, nullptr, 0)
            MAT(I_IN0, INP(12), D, EVEN_IN, EVEN_IN, ws + WS_WIN0, INP(5), 0)
            MAT(I_IN1, INP(26), D, FOX_IN, FOX_INP, ws + WS_WIN1, INP(5) + D, 0)
            MAT(I_G, INP(13), D, D, D, ws + WS_WOUT0, nullptr, 0)
            MAT(I_G, INP(28), D, D, D, ws + WS_WOUT1, nullptr, 0)
#undef MAT
        }
        const float* x_in = INP(0);
        for (int m = gw; m < M; m += NGW) { const f32x4* xr = (const f32x4*)(x_in + (size_t)m * D) + lane; f32x4 v[4]; float s = 0.f;
#pragma unroll
            for (int j = 0; j < 4; ++j) { v[j] = xr[64 * j]; s += (v[j][0] * v[j][0] + v[j][1] * v[j][1]) + (v[j][2] * v[j][2] + v[j][3] * v[j][3]); }
            s = wave_sum(s); if (lane < 16) ssq[(size_t)m * 16 + lane] = (lane == 0) ? s : 0.f;
            v2u* o = (v2u*)(XB + (size_t)m * D) + lane;
#pragma unroll
            for (int j = 0; j < 4; ++j) { v2u w; w.x = pk2(v[j][0], v[j][1]); w.y = pk2(v[j][2], v[j][3]); o[64 * j] = w; } }
        const float* g2 = INP(20);
        for (int i = bx * 512 + tid; i < 8192; i += G * 512) { const int ln = i & 63, ks = (i >> 6) & 7, nb = (i >> 9) & 1, hh = i >> 10; float f[8];
#pragma unroll
            for (int j = 0; j < 8; ++j) f[j] = g2[(size_t)(16 * ks + 8 * (ln >> 5) + j) * 512 + hh * 64 + 32 * nb + (ln & 31)];
            ((bf16x8*)(ws + WS_G2F))[i] = pack8(f); }
    }
    if (ph_lo == 0 && ph_hi > 1) GSYNC();

#define GEMM(EpiT, Aptr, Bptr, Nn, Kk, Eobj) do { pg8::Gemm g_{(const pg8::bf16_t*)(Aptr), (const pg8::bf16_t*)(Bptr), M, (Nn), (Kk)}; pg8::StaticOrder S_; S_.init(M, (Nn), G, bx); \
        pg8::gemm_phase<EpiT, pg8::StaticOrder, true, true>(lds, g_, S_, (Eobj), tid); } while (0)
#pragma unroll 1
    for (int L = 0; L < 2; ++L) {
#pragma unroll 1
        for (int st = 0; st < 9; ++st) {
            const int ph = 1 + 9 * L + st; if (ph < ph_lo || ph >= ph_hi) continue;
            switch (st) {
            case 0: case 6: {
#if PHM & 1
                FRESH();
                for (int dup = 0; dup < 1 + DUP_GU; ++dup) {
                const int f = (st == 6); pg8::EpiGU E{H, ssq + (size_t)((f ? 2 : 0) & 1) * M * 16};
                GEMM(pg8::EpiGU, (L == 1 && st == 0) ? Y : XB, ws + WS_WGU + (size_t)(L * 2 + f) * 11 * MiB, 2 * DFF, D, E);
                __syncthreads(); }
#endif
            } break;
            case 1: case 5: case 7: {
#if PHM & 2
                FRESH();
                const bf16* A; const bf16* Bt; int K; float alpha; float* so;
                if (st == 5) { A = (L == 0) ? Y : Qb; Bt = (const bf16*)(ws + (L == 0 ? WS_WOUT0 : WS_WOUT1)); K = D; alpha = 1.f; so = ssq; }
                else { const int f = (st == 7); A = H; Bt = (const bf16*)(ws + WS_WD + (size_t)(L * 2 + f) * D * DFF * 2); K = DFF; alpha = 0.5f; so = ssq + (size_t)M * 16; }
                pg8::EpiRes E{(L == 0 && st == 1) ? INP(0) : (const float*)X, X, XB, so, alpha};
                GEMM(pg8::EpiRes, A, Bt, D, K, E);
                if (st == 7) {
                    const f32x4* ps = (const f32x4*)(INP(1) + (size_t)L * M * PLE);
                    for (int i = bx * 512 + tid; i < M * PLE / 8; i += G * 512) { const f32x4 u0 = ps[2 * i], u1 = ps[2 * i + 1]; v4u w; w.x = pk2(u0[0], u0[1]); w.y = pk2(u0[2], u0[3]); w.z = pk2(u1[0], u1[1]); w.w = pk2(u1[2], u1[3]); ((v4u*)PB)[i] = w; }
                }
#endif
            } break;
            case 2: {
#if PHM & 4
                FRESH();
                pg8::EpiStore E{Qb, L ? D : EVEN_IN, ssq + (size_t)M * 16, QSCALE, L ? 4 : 2, L ? 4 : 1000, (size_t)M * D, L ? 12 : -1, LF, INP(27)};
                for (int dup = 0; dup < 1 + DUP_INPROJ; ++dup) { GEMM(pg8::EpiStore, XB, ws + (L ? WS_WIN1 : WS_WIN0), L ? FOX_INP : EVEN_IN, D, E); __syncthreads(); }
#endif
            } break;
            case 3: {
                if (L == 0) {
#if PHM & 8
                    { FRESH();
#pragma unroll 1
                    for (int dup = 0; dup < 1 + DUP_SWA; ++dup)
                    for (int u = bx; u < 256; u += G) swa_unit(u, PROJ, Y, INP(14), lds, tid, lane, wid); }
#endif
#if PHM & 16
                    { FRESH();
#pragma unroll 1
                    for (int dup = 0; dup < 1 + DUP_SCAN; ++dup)
                    for (int u = bx; u < 256; u += G) rwkv_scan_unit(u, PROJ, YRAW, C3, INP(15), INP(16), INP(17), INP(18), INP(19), INP(21), INP(22), INP(23), lds, lane, wid); }
#endif
                } else {
#if PHM & 32
                    FRESH();
                    const int vcu = (G % 8 == 0) ? (bx % 8) * (G / 8) + bx / 8 : bx;
#pragma unroll 1
                    for (int v = vcu; v < 256; v += G)
#pragma unroll 1
                        for (int i = 0; i < 4; ++i) { int tid2 = tid; asm volatile("" : "+v"(tid2)); const int lane2 = tid2 & 63, wid2 = __builtin_amdgcn_readfirstlane(tid2 >> 6); const int s = v & 3, bh = v >> 2, qb = (i == 0) ? s : (i == 1) ? 7 - s : (i == 2) ? 8 + s : 15 - s;
                            if (i == 0) fox_prefix(LF + (size_t)(bh >> 4) * SEQ * 16 + (bh & 15), (LAS float*)(lds + 98304), (LAS float*)(lds + 98304 + 16384), tid2, lane2, wid2);
                            attn_body::attn_unit<60>(bh >> 4, bh & 15, qb, (const attn_body::bf16*)Qb, (const attn_body::bf16*)Kb, (const attn_body::bf16*)Vb, (attn_body::bf16*)Qb, (char*)lds_raw, (attn_body::lds_fptr)(lds + 98304), tid2); }
#endif
                }
            } break;
            case 4: {
#if PHM & 64
                if (L == 0) { FRESH();
#pragma unroll 1
                    for (int dup = 0; dup < 1 + DUP_POST; ++dup)
                    for (int t = bx; t < M / 32; t += G) rwkv_post_unit(t, PROJ, YRAW, C3, Y, INP(15), (const bf16*)(ws + WS_G2F), INP(24), INP(25), lane, wid); }
#endif
            } break;
            case 8: {
#if PHM & 128
                FRESH();
#pragma unroll 1
                for (int mode = 0; mode < 2; ++mode) {
                    pg8::EpiPle E{mode, X, Y, PP, ssq + (size_t)M * 16, ssq};
                    GEMM(pg8::EpiPle, mode ? XB : PB, mode ? ws + WS_WG + (size_t)L * 2 * MiB : ws + WS_WP + (size_t)L * PLE * D * 2, D, mode ? D : PLE, E);
                    __syncthreads();
                }
#endif
            } break;
            }
            if (!(L == 1 && st == 4) && ph + 1 < ph_hi) { GSYNC(); for (int dup = 0; dup < DUP_SYNC; ++dup) GSYNC(); }
        }
    }
#undef GEMM
    if (ph_hi == 20) { FRESH(); const float* fg = INP(29); const float* s8 = ssq;
        for (int m = gw; m < M; m += NGW) { f32x4* xr = (f32x4*)(X + (size_t)m * D) + lane; const float rs = pg8::rstd_of(s8, m);
#pragma unroll
            for (int j = 0; j < 4; ++j) { const f32x4 gv = ((const f32x4*)fg)[lane + 64 * j]; xr[64 * j] = xr[64 * j] * rs * gv; } } }
}

extern "C" void kernel_launch(void* const* d_in, const int* in_sizes, int n_in, void* d_out, int out_size, void* d_ws, size_t ws_size, hipStream_t stream) {
    static int grid = 0;
    if (grid == 0) {
        if (n_in != 30 || out_size != M * D || ws_size < WS_END) { fprintf(stderr, "kernel_launch: unexpected shapes (n_in %d out %d ws %zu)\n", n_in, out_size, ws_size); grid = -1; return; }
        int dev = 0, cus = 0, per_cu = 0;
        if (hipGetDevice(&dev) != hipSuccess || hipDeviceGetAttribute(&cus, hipDeviceAttributeMultiprocessorCount, dev) != hipSuccess) { grid = -1; return; }
        if (hipFuncSetAttribute((const void*)fwd_megakernel, hipFuncAttributeMaxDynamicSharedMemorySize, LDS_BYTES) != hipSuccess) { fprintf(stderr, "kernel_launch: hipFuncSetAttribute failed\n"); grid = -1; return; }
        if (hipOccupancyMaxActiveBlocksPerMultiprocessor(&per_cu, (const void*)fwd_megakernel, 512, LDS_BYTES) != hipSuccess || per_cu < 1) { fprintf(stderr, "kernel_launch: occupancy query failed (%d)\n", per_cu); (void)hipGetLastError(); grid = -1; return; }
        grid = cus * per_cu;
        if (grid > 256) grid = 256;
    }
    if (grid < 0) return;
    Args a{};
    for (int i = 0; i < 30; ++i) a.in[i] = (const float*)d_in[i];
    a.out = (float*)d_out; a.ws = (unsigned char*)d_ws;
#ifndef N_LAUNCH_PER_PHASE
    a.ph_lo = 0; a.ph_hi = 20;
    { void* args[] = {&a};
      hipError_t e = hipLaunchCooperativeKernel((const void*)fwd_megakernel, dim3(grid), dim3(512), args, LDS_BYTES, stream);
      if (e != hipSuccess) fprintf(stderr, "cooperative launch failed: %s (grid %d)\n", hipGetErrorString(e), grid); }
#else
    for (int ph = 0; ph < 20; ++ph) { if (ph == 14) continue; a.ph_lo = ph; a.ph_hi = ph + 1; void* args[] = {&a};
      hipError_t e = hipLaunchCooperativeKernel((const void*)fwd_megakernel, dim3(grid), dim3(512), args, LDS_BYTES, stream);
      if (e != hipSuccess) { fprintf(stderr, "cooperative launch failed: %s (grid %d)\n", hipGetErrorString(e), grid); break; } }
#endif
}
```

```cpp
#include <hip/hip_runtime.h>
#include <hip/hip_cooperative_groups.h>
#include <hip/hip_bf16.h>
#include <cstdio>
#include <cstdint>
#include <cmath>
namespace cg = cooperative_groups;
#ifndef PHM
#define PHM 255
#endif
namespace pg8 {
#define PG8_LAS __attribute__((address_space(3)))
typedef unsigned short bf16_t;
typedef short bf16x8 __attribute__((ext_vector_type(8)));
typedef float f32x4 __attribute__((ext_vector_type(4)));
typedef unsigned u32x4 __attribute__((ext_vector_type(4)));
constexpr int BM = 256, BK = 64, HALF = 128, HTB = HALF * BK * 2  , STAGE_BYTES = 8 * HTB, NXCD = 8, WGM = 8;

__host__ __device__ __forceinline__ int lds_byte(int r, int c) { const int st = (r >> 4) * 2 + (c >> 5), rr = r & 15, cc = c & 31, ob = rr * 64 + cc * 2; return st * 1024 + (ob ^ (((ob >> 9) & 1) << 5)); }
__host__ __device__ __forceinline__ void stage_rc(int b, int& R, int& C) { const int st = b / 1024, sb = b % 1024, swz = sb ^ (((sb >> 9) & 1) << 5); R = (st >> 1) * 16 + swz / 64; C = (st & 1) * 32 + (swz % 64) / 2; }
__host__ __device__ __forceinline__ int perm32(int rho) { const int n = rho >> 4, i = rho & 15; return 8 * (i >> 2) + 4 * n + (i & 3); }

struct Unit { int pm, pn; };
struct Gemm { const bf16_t* A; const bf16_t* Bt; int M, N, K; };

struct StaticOrder {
    int nM, nN, nwg, G, c;
    __host__ __device__ void init(int M, int N, int G_, int c_) { nM = M / BM; nN = N / BM; nwg = nM * nN; G = G_; c = c_; }
    __host__ __device__ bool next(int i, Unit& u) const {
        const long L = (long)i * G + c; if (L >= nwg) return false;
        int wgid = (int)L; { const int q = nwg / NXCD, r = nwg % NXCD, xcd = wgid % NXCD, off = wgid / NXCD; wgid = (xcd < r ? xcd * (q + 1) : r * (q + 1) + (xcd - r) * q) + off; }
        const int nig = WGM * nN, gid = wgid / nig, fm = gid * WGM, gsz = (nM - fm) < WGM ? (nM - fm) : WGM;
        u.pm = fm + ((wgid % nig) % gsz); u.pn = (wgid % nig) / gsz; return true;
    }
    __device__ __forceinline__ void a_ready(const Unit&) const {}
    __device__ __forceinline__ void done(const Unit&) const {}
};

typedef float f32x2_c __attribute__((ext_vector_type(2))); typedef __bf16 bf16x2_c __attribute__((ext_vector_type(2)));
__device__ __forceinline__ unsigned cvt_pk_bf16(float lo, float hi) { f32x2_c v = {lo, hi}; bf16x2_c b = __builtin_convertvector(v, bf16x2_c); return __builtin_bit_cast(unsigned, b); }
typedef float f32x2 __attribute__((ext_vector_type(2)));
constexpr float NORM_EPS = 1e-6f;
__device__ __forceinline__ float ssq_sum(const float* ssq, int row) { const f32x4* p = (const f32x4*)(ssq + (size_t)row * 16); const f32x4 a = p[0], b = p[1], c = p[2], d = p[3];
    return ((a[0] + a[1]) + (a[2] + a[3])) + ((b[0] + b[1]) + (b[2] + b[3])) + (((c[0] + c[1]) + (c[2] + c[3])) + ((d[0] + d[1]) + (d[2] + d[3]))); }
__device__ __forceinline__ float rstd_of(const float* ssq, int row) { return rsqrtf(ssq_sum(ssq, row) * (1.0f / 1024.0f) + NORM_EPS); }
__device__ __forceinline__ float sigm(float x) { return __builtin_amdgcn_rcpf(1.0f + __expf(-x)); }
struct EpiGU { static constexpr bool PERM = true, AFTER_DRAIN = false;
    bf16_t* H; const float* ssq;
    __device__ __forceinline__ void operator()(const f32x4 (&acc)[2][2][4][2], const Unit& u, int wr, int wc, int fr, int fq) const {
        int row0 = u.pm * BM + wr * 64 + fr; asm volatile("" : "+v"(row0)); const int col0 = u.pn * 128 + wc * 32 + 8 * fq;
#pragma unroll
        for (int ai = 0; ai < 2; ++ai)
#pragma unroll
            for (int m = 0; m < 4; ++m) { const int row = row0 + ai * HALF + m * 16; const float rs = rstd_of(ssq, row);
                const f32x4 g0 = acc[ai][0][m][0] * rs, g1 = acc[ai][0][m][1] * rs, u0 = acc[ai][1][m][0] * rs, u1 = acc[ai][1][m][1] * rs;
                u32x4 w;
                w.x = cvt_pk_bf16(g0[0] * sigm(g0[0]) * u0[0], g0[1] * sigm(g0[1]) * u0[1]); w.y = cvt_pk_bf16(g0[2] * sigm(g0[2]) * u0[2], g0[3] * sigm(g0[3]) * u0[3]);
                w.z = cvt_pk_bf16(g1[0] * sigm(g1[0]) * u1[0], g1[1] * sigm(g1[1]) * u1[1]); w.w = cvt_pk_bf16(g1[2] * sigm(g1[2]) * u1[2], g1[3] * sigm(g1[3]) * u1[3]);
                *(u32x4*)(H + (size_t)row * 2816 + col0) = w; }
    }
};
struct EpiRes { static constexpr bool PERM = true, AFTER_DRAIN = false;
    const float* base; float* X; bf16_t* XB; float* ssq_out; float alpha;
    __device__ __forceinline__ void operator()(const f32x4 (&acc)[2][2][4][2], const Unit& u, int wr, int wc, int fr, int fq) const {
        int row0 = u.pm * BM + wr * 64 + fr; asm volatile("" : "+v"(row0)); const int col0 = u.pn * BM + wc * 32 + 8 * fq;
#pragma unroll
        for (int ai = 0; ai < 2; ++ai)
#pragma unroll
            for (int m = 0; m < 4; ++m) { const int row = row0 + ai * HALF + m * 16; float part = 0.f;
#pragma unroll
                for (int bj = 0; bj < 2; ++bj) { const size_t off = (size_t)row * 1024 + col0 + bj * HALF;
                    const f32x4 b0 = *(const f32x4*)(base + off), b1 = *(const f32x4*)(base + off + 4);
                    const f32x4 v0 = b0 + acc[ai][bj][m][0] * alpha, v1 = b1 + acc[ai][bj][m][1] * alpha;
                    *(f32x4*)(X + off) = v0; *(f32x4*)(X + off + 4) = v1;
                    u32x4 w; w.x = cvt_pk_bf16(v0[0], v0[1]); w.y = cvt_pk_bf16(v0[2], v0[3]); w.z = cvt_pk_bf16(v1[0], v1[1]); w.w = cvt_pk_bf16(v1[2], v1[3]);
                    *(u32x4*)(XB + off) = w;
                    part += (v0[0] * v0[0] + v0[1] * v0[1]) + (v0[2] * v0[2] + v0[3] * v0[3]) + (v1[0] * v1[0] + v1[1] * v1[1]) + (v1[2] * v1[2] + v1[3] * v1[3]); }
                part += __shfl_xor(part, 16); part += __shfl_xor(part, 32);
                if (fq == 0) ssq_out[(size_t)row * 16 + u.pn * 4 + wc] = part; }
    }
};
struct EpiPle { static constexpr bool PERM = true, AFTER_DRAIN = false;
    int mode; float* X; bf16_t* XB; bf16_t* PP; const float* ssq_in; float* ssq_out;
    __device__ __forceinline__ void operator()(const f32x4 (&acc)[2][2][4][2], const Unit& u, int wr, int wc, int fr, int fq) const {
        int row0 = u.pm * BM + wr * 64 + fr; asm volatile("" : "+v"(row0)); const int col0 = u.pn * BM + wc * 32 + 8 * fq;
#pragma unroll
        for (int ai = 0; ai < 2; ++ai)
#pragma unroll
            for (int m = 0; m < 4; ++m) { const int row = row0 + ai * HALF + m * 16; float part = 0.f; const float rs = mode ? rstd_of(ssq_in, row) : 1.f;
#pragma unroll
                for (int bj = 0; bj < 2; ++bj) { const size_t off = (size_t)row * 1024 + col0 + bj * HALF;
                    if (mode == 0) { const f32x4 v0 = acc[ai][bj][m][0], v1 = acc[ai][bj][m][1];
                        u32x4 w; w.x = cvt_pk_bf16(v0[0], v0[1]); w.y = cvt_pk_bf16(v0[2], v0[3]); w.z = cvt_pk_bf16(v1[0], v1[1]); w.w = cvt_pk_bf16(v1[2], v1[3]);
                        *(u32x4*)(PP + off) = w;
                    } else {
                        const u32x4 pw = *(const u32x4*)(PP + off);
                        const f32x4 p0 = {__uint_as_float(pw.x << 16), __uint_as_float(pw.x & 0xffff0000u), __uint_as_float(pw.y << 16), __uint_as_float(pw.y & 0xffff0000u)};
                        const f32x4 p1 = {__uint_as_float(pw.z << 16), __uint_as_float(pw.z & 0xffff0000u), __uint_as_float(pw.w << 16), __uint_as_float(pw.w & 0xffff0000u)};
                        const f32x4 b0 = *(const f32x4*)(X + off), b1 = *(const f32x4*)(X + off + 4);
                        const f32x4 a0 = acc[ai][bj][m][0] * rs, a1 = acc[ai][bj][m][1] * rs;
                        f32x4 v0, v1;
#pragma unroll
                        for (int j = 0; j < 4; ++j) { v0[j] = b0[j] + sigm(a0[j]) * p0[j]; v1[j] = b1[j] + sigm(a1[j]) * p1[j]; }
                        *(f32x4*)(X + off) = v0; *(f32x4*)(X + off + 4) = v1;
                        u32x4 w; w.x = cvt_pk_bf16(v0[0], v0[1]); w.y = cvt_pk_bf16(v0[2], v0[3]); w.z = cvt_pk_bf16(v1[0], v1[1]); w.w = cvt_pk_bf16(v1[2], v1[3]);
                        *(u32x4*)(XB + off) = w;
                        part += (v0[0] * v0[0] + v0[1] * v0[1]) + (v0[2] * v0[2] + v0[3] * v0[3]) + (v1[0] * v1[0] + v1[1] * v1[1]) + (v1[2] * v1[2] + v1[3] * v1[3]); } }
                if (mode) { part += __shfl_xor(part, 16); part += __shfl_xor(part, 32); if (fq == 0) ssq_out[(size_t)row * 16 + u.pn * 4 + wc] = part; } }
    }
};
struct EpiStore { static constexpr bool PERM = true, AFTER_DRAIN = false;
    bf16_t* O; int ldc; const float* ssq; float scale0; int scale_tiles; int split_tiles; size_t split_stride; int lf_tile; float* LF; const float* bfv;
    __device__ __forceinline__ void operator()(const f32x4 (&acc)[2][2][4][2], const Unit& u, int wr, int wc, int fr, int fq) const {
        int row0 = u.pm * BM + wr * 64 + fr; asm volatile("" : "+v"(row0));
        if (u.pn == lf_tile) {
            if (wc == 0 && fq < 2) {
#pragma unroll
                for (int ai = 0; ai < 2; ++ai)
#pragma unroll
                    for (int m = 0; m < 4; ++m) { const int row = row0 + ai * HALF + m * 16; const float rs = rstd_of(ssq, row);
#pragma unroll
                        for (int n = 0; n < 2; ++n) { f32x4 o;
#pragma unroll
                            for (int j = 0; j < 4; ++j) { const float z = fmaxf(acc[ai][0][m][n][j] * rs + bfv[8 * fq + 4 * n + j], -80.f), e = __expf(-z);
                                o[j] = (e < 0.01f) ? -(e - 0.5f * e * e + e * e * e * (1.f / 3.f)) : -__logf(1.f + e); }
                            *(f32x4*)(LF + (size_t)row * 16 + 8 * fq + 4 * n) = o; } }
            }
            return;
        }
        const int t = u.pn / split_tiles, ct = u.pn - t * split_tiles;
        bf16_t* base = O + (size_t)t * split_stride; const float sc = (u.pn < scale_tiles) ? scale0 : 1.f;
        const int col0 = ct * BM + wc * 32 + 8 * fq;
#pragma unroll
        for (int ai = 0; ai < 2; ++ai)
#pragma unroll
            for (int m = 0; m < 4; ++m) { const int row = row0 + ai * HALF + m * 16; const float rs = rstd_of(ssq, row) * sc;
#pragma unroll
                for (int bj = 0; bj < 2; ++bj) { const f32x4 v0 = acc[ai][bj][m][0] * rs, v1 = acc[ai][bj][m][1] * rs;
                    u32x4 w; w.x = cvt_pk_bf16(v0[0], v0[1]); w.y = cvt_pk_bf16(v0[2], v0[3]); w.z = cvt_pk_bf16(v1[0], v1[1]); w.w = cvt_pk_bf16(v1[2], v1[3]);
                    *(u32x4*)(base + (size_t)row * ldc + col0 + bj * HALF) = w; } }
    }
};

template <class Epi, class Sched, bool ALIGN_EPI = false, bool SP2 = false>
__device__ __forceinline__ void gemm_phase(PG8_LAS unsigned char* lds, const Gemm g, const Sched& S, const Epi& E, const int tid) {
    const int wid = __builtin_amdgcn_readfirstlane(tid >> 6), lane = tid & 63, wr = wid >> 2, wc = wid & 3, fr = lane & 15, fq = lane >> 4;
    const int K = g.K, nt = K / BK;
    unsigned voffA[2], voffB[2];
#pragma unroll
    for (int i = 0; i < 2; ++i) { int R, C; stage_rc(tid * 16 + i * 8192, R, C); const int Rb = Epi::PERM ? ((R & ~31) + perm32(R & 31)) : R;
        voffA[i] = (unsigned)(R * K + C) * 2u; voffB[i] = (unsigned)(Rb * K + C) * 2u; }
    const size_t kstep = (size_t)(BK * 2);
    const size_t hstep = (size_t)HALF * K * 2;
    const size_t tstep = 2 * hstep;
    const unsigned ldsw = (unsigned)wid * 1024u;
    const int aoff = lds_byte(wr * 64 + fr, fq * 8), boff = lds_byte(wc * 32 + fr, fq * 8);
#define PG8_SA(b, h) (((b) * 2 + (h)) * HTB)
#define PG8_SB(b, h) ((4 + (b) * 2 + (h)) * HTB)
#define PG8_STAGE(bufoff, gbase, voff) do { _Pragma("unroll") for (int _i = 0; _i < 2; ++_i) \
        __builtin_amdgcn_global_load_lds((const unsigned*)((const char*)(gbase) + (voff)[_i]), (PG8_LAS unsigned*)(lds + (bufoff) + ldsw + _i * 8192), 16, 0, 0); } while (0)
#define PG8_LDA(dst, b, h) do { _Pragma("unroll") for (int m = 0; m < 4; ++m) _Pragma("unroll") for (int k = 0; k < 2; ++k) dst[m][k] = *(const PG8_LAS bf16x8*)(lds + PG8_SA(b, h) + aoff + m * 2048 + k * 1024); } while (0)
#define PG8_LDB(dst, b, h) do { _Pragma("unroll") for (int n = 0; n < 2; ++n) _Pragma("unroll") for (int k = 0; k < 2; ++k) dst[n][k] = *(const PG8_LAS bf16x8*)(lds + PG8_SB(b, h) + boff + n * 2048 + k * 1024); } while (0)
#define PG8_MMA(ai, bj, At, Bt) do { __builtin_amdgcn_s_setprio(1); _Pragma("unroll") for (int m = 0; m < 4; ++m) _Pragma("unroll") for (int n = 0; n < 2; ++n) _Pragma("unroll") for (int k = 0; k < 2; ++k) \
        acc[ai][bj][m][n] = __builtin_amdgcn_mfma_f32_16x16x32_bf16(Bt[n][k], At[m][k], acc[ai][bj][m][n], 0, 0, 0); __builtin_amdgcn_s_setprio(0); } while (0)
#define PG8_WAIT_V(n) asm volatile("s_waitcnt vmcnt(" #n ")" ::: "memory")
#define PG8_WAIT_L(n) asm volatile("s_waitcnt lgkmcnt(" #n ")" ::: "memory")
#define PG8_BAR __builtin_amdgcn_s_barrier()
#define PG8_SCHED __builtin_amdgcn_sched_barrier(0)
    Unit cur, nxt; int ui = 0;
    if (!S.next(0, cur)) return;
    f32x4 acc[2][2][4][2];
#pragma unroll
    for (int a = 0; a < 2; ++a)
#pragma unroll
        for (int b = 0; b < 2; ++b)
#pragma unroll
            for (int m = 0; m < 4; ++m)
#pragma unroll
                for (int n = 0; n < 2; ++n) acc[a][b][m][n] = (f32x4){0.f, 0.f, 0.f, 0.f};
    bf16x8 At[4][2], B0[2][2], B1[2][2];
    const char* cA = (const char*)g.A + (size_t)cur.pm * tstep; const char* cB = (const char*)g.Bt + (size_t)cur.pn * tstep;
    S.a_ready(cur);
    if constexpr (SP2) {
        PG8_STAGE(PG8_SB(0, 0), cB, voffB); PG8_STAGE(PG8_SB(0, 1), cB + hstep, voffB); PG8_STAGE(PG8_SA(0, 0), cA, voffA); PG8_STAGE(PG8_SA(0, 1), cA + hstep, voffA);
        if (wr == 1) PG8_BAR;
        PG8_WAIT_V(2); PG8_BAR;
        PG8_STAGE(PG8_SB(1, 0), cB + kstep, voffB); PG8_STAGE(PG8_SA(1, 0), cA + kstep, voffA); PG8_STAGE(PG8_SB(1, 1), cB + hstep + kstep, voffB);
        PG8_WAIT_V(6); PG8_BAR;
    } else {
        PG8_STAGE(PG8_SB(0, 0), cB, voffB); PG8_STAGE(PG8_SA(0, 0), cA, voffA); PG8_STAGE(PG8_SB(0, 1), cB + hstep, voffB); PG8_STAGE(PG8_SA(0, 1), cA + hstep, voffA);
        if (wr == 1) PG8_BAR;
        PG8_WAIT_V(4); PG8_BAR;
        PG8_STAGE(PG8_SB(1, 0), cB + kstep, voffB); PG8_STAGE(PG8_SA(1, 0), cA + kstep, voffA); PG8_STAGE(PG8_SB(1, 1), cB + hstep + kstep, voffB);
        PG8_WAIT_V(6); PG8_BAR;
    }
    for (;;) {
        const bool has_next = S.next(ui + 1, nxt);
        const char* nA = has_next ? (const char*)g.A + (size_t)nxt.pm * tstep : cA; const char* nB = has_next ? (const char*)g.Bt + (size_t)nxt.pn * tstep : cB;
        for (int t = 0; t < nt; t += 2) {
            const bool last = (t == nt - 2);
            const char* a1 = cA + (size_t)(t + 1) * kstep;
            const char* a2 = last ? nA : cA + (size_t)(t + 2) * kstep; const char* b2 = last ? nB : cB + (size_t)(t + 2) * kstep;
            const char* a3 = a2 + kstep; const char* b3 = b2 + kstep;
            if (last && has_next) S.a_ready(nxt);
            if constexpr (SP2) {
            PG8_LDB(B0, 0, 0); PG8_LDB(B1, 0, 1); PG8_SCHED; PG8_LDA(At, 0, 0); PG8_STAGE(PG8_SA(1, 1), a1 + hstep, voffA);
            PG8_WAIT_V(8); PG8_WAIT_L(0); PG8_BAR; PG8_MMA(0, 0, At, B0); PG8_MMA(0, 1, At, B1); PG8_BAR; PG8_SCHED;
            PG8_LDA(At, 0, 1); PG8_STAGE(PG8_SB(0, 0), b2, voffB); PG8_STAGE(PG8_SB(0, 1), b2 + hstep, voffB); PG8_STAGE(PG8_SA(0, 0), a2, voffA);
            PG8_WAIT_V(8); PG8_WAIT_L(0); PG8_BAR; PG8_MMA(1, 0, At, B0); PG8_MMA(1, 1, At, B1); PG8_BAR; PG8_SCHED;
            PG8_LDB(B0, 1, 0); PG8_LDB(B1, 1, 1); PG8_SCHED; PG8_LDA(At, 1, 0); PG8_STAGE(PG8_SA(0, 1), a2 + hstep, voffA);
            PG8_WAIT_V(8); PG8_WAIT_L(0); PG8_BAR; PG8_MMA(0, 0, At, B0); PG8_MMA(0, 1, At, B1); PG8_BAR; PG8_SCHED;
            PG8_LDA(At, 1, 1); PG8_STAGE(PG8_SB(1, 0), b3, voffB); PG8_STAGE(PG8_SB(1, 1), b3 + hstep, voffB); PG8_STAGE(PG8_SA(1, 0), a3, voffA);
            PG8_WAIT_V(8); PG8_WAIT_L(0); PG8_BAR; PG8_MMA(1, 0, At, B0); PG8_MMA(1, 1, At, B1); PG8_BAR; PG8_SCHED;
            } else {
            PG8_LDB(B0, 0, 0); PG8_SCHED; PG8_LDA(At, 0, 0); PG8_STAGE(PG8_SA(1, 1), a1 + hstep, voffA);
            PG8_WAIT_L(8); PG8_BAR; PG8_WAIT_L(0); PG8_MMA(0, 0, At, B0); PG8_BAR; PG8_SCHED;
            PG8_LDB(B1, 0, 1); PG8_STAGE(PG8_SB(0, 0), b2, voffB);
            PG8_BAR; PG8_WAIT_L(0); PG8_MMA(0, 1, At, B1); PG8_BAR;
            PG8_LDA(At, 0, 1); PG8_STAGE(PG8_SA(0, 0), a2, voffA);
            PG8_BAR; PG8_WAIT_L(0); PG8_MMA(1, 0, At, B0); PG8_BAR; PG8_SCHED;
            PG8_STAGE(PG8_SB(0, 1), b2 + hstep, voffB);
            PG8_WAIT_V(6); PG8_BAR; PG8_MMA(1, 1, At, B1); PG8_BAR;
            PG8_LDB(B0, 1, 0); PG8_SCHED; PG8_LDA(At, 1, 0); PG8_STAGE(PG8_SA(0, 1), a2 + hstep, voffA);
            PG8_WAIT_L(8); PG8_BAR; PG8_WAIT_L(0); PG8_MMA(0, 0, At, B0); PG8_BAR; PG8_SCHED;
            PG8_LDB(B1, 1, 1); PG8_STAGE(PG8_SB(1, 0), b3, voffB);
            PG8_BAR; PG8_WAIT_L(0); PG8_MMA(0, 1, At, B1); PG8_BAR;
            PG8_LDA(At, 1, 1); PG8_STAGE(PG8_SA(1, 0), a3, voffA);
            PG8_BAR; PG8_WAIT_L(0); PG8_MMA(1, 0, At, B0); PG8_BAR; PG8_SCHED;
            PG8_STAGE(PG8_SB(1, 1), b3 + hstep, voffB);
            PG8_WAIT_V(6); PG8_BAR; PG8_MMA(1, 1, At, B1); PG8_BAR;
            }
        }
        if constexpr (ALIGN_EPI) { if (wr == 0) PG8_BAR; }
        if constexpr (!Epi::AFTER_DRAIN) { E(acc, cur, wr, wc, fr, fq); S.done(cur); }
        if (!has_next) break;
#pragma unroll
        for (int a = 0; a < 2; ++a)
#pragma unroll
            for (int b = 0; b < 2; ++b)
#pragma unroll
                for (int m = 0; m < 4; ++m)
#pragma unroll
                    for (int n = 0; n < 2; ++n) acc[a][b][m][n] = (f32x4){0.f, 0.f, 0.f, 0.f};
        cur = nxt; cA = nA; cB = nB; ++ui;
        if constexpr (ALIGN_EPI) { if (wr == 1) PG8_BAR; }
    }
    PG8_WAIT_V(0);
    if constexpr (!ALIGN_EPI) { if (wr == 0) PG8_BAR; }
    PG8_BAR;
    if constexpr (Epi::AFTER_DRAIN) { E.fused(acc, cur, wr, wc, fr, fq, lds, wid, lane); S.done(cur); }
#undef PG8_SA
#undef PG8_SB
#undef PG8_STAGE
#undef PG8_LDA
#undef PG8_LDB
#undef PG8_MMA
#undef PG8_WAIT_V
#undef PG8_WAIT_L
#undef PG8_BAR
#undef PG8_SCHED
}
}
#include <hip/hip_bf16.h>
#include <cmath>
namespace attn_body {
using bf16=__hip_bfloat16;
using bf16x8=__attribute__((ext_vector_type(8)))short;
using s16x4=__attribute__((ext_vector_type(4)))short;
using f32x16=__attribute__((ext_vector_type(16)))float;
using u32x4=__attribute__((ext_vector_type(4)))unsigned;
constexpr int BATCH=4,NHEAD=16,SEQ=4096,D=64,DM=NHEAD*D;
constexpr int NW=8,QBLK=32,QB=QBLK*NW,KVBLK=64,NQB=SEQ/QB;
constexpr int ATTN_PITCH=DM, ATTN_UNIT_ROWS=QB;
__device__ __forceinline__ int crow(int r,int hi){return (r&3)+8*(r>>2)+4*hi;}
#define SBAR() __builtin_amdgcn_sched_barrier(0)
__device__ __forceinline__ void cmask(f32x16&p0,f32x16&p1,int jb,int qrel,int hi){
  const float NEG=-INFINITY; int kb=64*jb+4*hi;
  #pragma unroll
  for(int r=0;r<16;++r){int kv=kb+(r&3)+8*(r>>2); if(kv>qrel)p0[r]=NEG; if(kv+32>qrel)p1[r]=NEG;}
}

constexpr int NSLOT=3, SLOTB=8192;
constexpr int LDS_K=0, LDS_V=NSLOT*SLOTB, LDS_WS=2*NSLOT*SLOTB, LDS_OST=LDS_WS+NW*64*4, LDS_BYTES=LDS_OST+NW*4096;
constexpr float C2=0.125f*1.4426950408889634f;
__device__ __forceinline__ void glds16(const void*gsrc,unsigned lds_dst){unsigned keep;
  asm volatile("s_mov_b32 %0, m0\n\ts_mov_b32 m0, %2\n\ts_nop 0\n\tglobal_load_lds_dwordx4 %1, off\n\ts_mov_b32 m0, %0":"=&s"(keep):"v"(gsrc),"s"(lds_dst):"memory");}
__device__ __forceinline__ float max3f(float a,float b,float c){float r;asm("v_max3_f32 %0, %1, %2, %3":"=v"(r):"v"(a),"v"(b),"v"(c));return r;}
__device__ __forceinline__ float max2f(float a,float b){float r;asm("v_max_f32_e32 %0, %1, %2":"=v"(r):"v"(a),"v"(b));return r;}
__device__ __forceinline__ float fadd_s(float a,float b){float r;asm("v_add_f32_e32 %0, %1, %2":"=v"(r):"v"(a),"v"(b));return r;}
__device__ __forceinline__ float fsub_s(float a,float b){float r;asm("v_sub_f32_e32 %0, %1, %2":"=v"(r):"v"(a),"v"(b));return r;}
typedef float f32x2_t __attribute__((ext_vector_type(2))); typedef __bf16 bf16x2_t __attribute__((ext_vector_type(2)));
__device__ __forceinline__ unsigned cvtpk_s(float lo,float hi){f32x2_t v={lo,hi};bf16x2_t b=__builtin_convertvector(v,bf16x2_t);return __builtin_bit_cast(unsigned,b);}
#define WAIT_BAR(N) asm volatile("s_waitcnt vmcnt(" #N ") lgkmcnt(0)\n\ts_barrier":::"memory")

__device__ __forceinline__ void qkt(f32x16&p0,f32x16&p1,const char*Kslot,const bf16x8*qr,int r32,int hi){
  const char*kb=Kslot+hi*1024+r32*16;
  #pragma unroll
  for(int d0=0;d0<4;++d0){
    const bf16x8 b0=*reinterpret_cast<const bf16x8*>(kb+d0*2048);
    const bf16x8 b1=*reinterpret_cast<const bf16x8*>(kb+d0*2048+512);
    {p0=__builtin_amdgcn_mfma_f32_32x32x16_bf16(b0,qr[d0],p0,0,0,0);p1=__builtin_amdgcn_mfma_f32_32x32x16_bf16(b1,qr[d0],p1,0,0,0);}}
}
typedef __attribute__((address_space(3))) const char* lds_cptr;
typedef short v4i16_t __attribute__((ext_vector_type(4)));
__device__ __forceinline__ void kload8(bf16x8*kf,lds_cptr kp){
  kf[0]=*(const __attribute__((address_space(3))) bf16x8*)(kp);      kf[1]=*(const __attribute__((address_space(3))) bf16x8*)(kp+512);
  kf[2]=*(const __attribute__((address_space(3))) bf16x8*)(kp+2048); kf[3]=*(const __attribute__((address_space(3))) bf16x8*)(kp+2560);
  kf[4]=*(const __attribute__((address_space(3))) bf16x8*)(kp+4096); kf[5]=*(const __attribute__((address_space(3))) bf16x8*)(kp+4608);
  kf[6]=*(const __attribute__((address_space(3))) bf16x8*)(kp+6144); kf[7]=*(const __attribute__((address_space(3))) bf16x8*)(kp+6656);
}
__device__ __forceinline__ void kload2(bf16x8*kf,lds_cptr kp,int j){ kf[2*j]=*(const __attribute__((address_space(3))) bf16x8*)(kp+j*2048); kf[2*j+1]=*(const __attribute__((address_space(3))) bf16x8*)(kp+j*2048+512); }
__device__ __forceinline__ s16x4 vtr(lds_cptr p){ return __builtin_bit_cast(s16x4,__builtin_amdgcn_ds_read_tr16_b64_v4i16((__attribute__((address_space(3))) v4i16_t*)p)); }
__device__ __forceinline__ float rowmax(const f32x16&p0,const f32x16&p1){
  float a=max3f(p0[0],p0[1],p1[0]),b=max3f(p0[2],p0[3],p1[1]);a=max3f(a,p1[2],p1[3]);
  #pragma unroll
  for(int r=4;r<16;r+=4){a=max3f(a,p0[r],p0[r+1]);b=max3f(b,p0[r+2],p0[r+3]);a=max3f(a,p1[r],p1[r+1]);b=max3f(b,p1[r+2],p1[r+3]);}
  const float m=max2f(a,b);
  auto rr=__builtin_amdgcn_permlane32_swap(__float_as_uint(m),__float_as_uint(m),false,false);
  return max2f(__uint_as_float(rr[0]),__uint_as_float(rr[1]));
}
__device__ __forceinline__ void pv(f32x16*o,int vb,bf16x8 pa0,bf16x8 pa1,bf16x8 pa2,bf16x8 pa3){
  #pragma unroll
  for(int d0=0;d0<2;++d0){s16x4 lo[4],hi[4];
    #pragma unroll
    for(int ks=0;ks<4;++ks){
      asm volatile("ds_read_b64_tr_b16 %0,%1 offset:%c2":"=&v"(lo[ks]):"v"(vb),"i"(d0*4096+ks*1024):"memory");
      asm volatile("ds_read_b64_tr_b16 %0,%1 offset:%c2":"=&v"(hi[ks]):"v"(vb),"i"(d0*4096+ks*1024+512):"memory");}
    asm volatile("s_waitcnt lgkmcnt(0)":::"memory");SBAR();
    #define PK(k) (bf16x8){lo[k][0],lo[k][1],lo[k][2],lo[k][3],hi[k][0],hi[k][1],hi[k][2],hi[k][3]}
    o[d0]=__builtin_amdgcn_mfma_f32_32x32x16_bf16(pa0,PK(0),o[d0],0,0,0);
    o[d0]=__builtin_amdgcn_mfma_f32_32x32x16_bf16(pa1,PK(1),o[d0],0,0,0);
    o[d0]=__builtin_amdgcn_mfma_f32_32x32x16_bf16(pa2,PK(2),o[d0],0,0,0);
    o[d0]=__builtin_amdgcn_mfma_f32_32x32x16_bf16(pa3,PK(3),o[d0],0,0,0);
    #undef PK
  }
}

#ifndef ATTN_STORE16
#define ATTN_STORE16(p,v) (*(u32x4*)(p)=(v))
#endif
typedef float f32x4b __attribute__((ext_vector_type(4)));
typedef __attribute__((address_space(3))) const float* lds_fptr;
typedef __attribute__((address_space(3))) const f32x4b* lds_f4ptr;
template<int THRL> __device__ __forceinline__ void attn_unit(int b,int h,int qb,const bf16*Q,const bf16*__restrict__ K,const bf16*__restrict__ V,bf16*O,char*shm,lds_fptr cs,const int tid){
  const int lane=tid&63,r32=lane&31,hi=lane>>5; const int wid=__builtin_amdgcn_readfirstlane(tid>>6);
  const long rowbase=(long)b*SEQ; const int q0=qb*QB;
  const bf16*Qw=Q+(rowbase+q0+wid*QBLK)*DM+h*D;
  const bf16*Kh=K+rowbase*DM+h*D,*Vh=V+rowbase*DM+h*D;
  const unsigned lds0=(unsigned)(uintptr_t)shm;
  float*wsf=(float*)(shm+LDS_WS)+wid*64;
  const bf16*ksrc=Kh+(long)lane*DM+wid*8;
  const bf16*vsrc=Vh+(long)(16*(wid&3)+(lane>>2))*DM+(wid>>2)*32+(lane&3)*8;
  const unsigned kdst=lds0+LDS_K+wid*1024, vdst=lds0+LDS_V+wid*1024;
  #define DMA_K(t,slot) glds16(ksrc+(long)(t)*KVBLK*DM,(unsigned)__builtin_amdgcn_readfirstlane(kdst+(slot)))
  #define DMA_V(t,slot) glds16(vsrc+(long)(t)*KVBLK*DM,(unsigned)__builtin_amdgcn_readfirstlane(vdst+(slot)))
  const int vb0=(int)(lds0+LDS_V)+((lane>>4)&1)*32+(lane&3)*8+(4*hi+((lane&15)>>2))*64;
  const char*Kbase=shm+LDS_K; bf16x8 kf[8];
  const lds_cptr shm3=(lds_cptr)shm; const lds_cptr kp0=shm3+LDS_K+hi*1024+r32*16; const lds_cptr vp0=shm3+LDS_V+((lane>>4)&1)*32+(lane&3)*8+(4*hi+((lane&15)>>2))*64;
  const int NT=(q0+QB)/KVBLK;
  DMA_K(0,0);DMA_V(0,0);DMA_K(1,SLOTB);
  bf16x8 qr[4];
  #pragma unroll
  for(int d0=0;d0<4;++d0)qr[d0]=*reinterpret_cast<const bf16x8*>(&Qw[(long)r32*DM+d0*16+hi*8]);
  const int qrel=wid*QBLK+r32;
  const float ci2=cs[q0+qrel];
  float mhat=0.f,l_reg=0.f;f32x16 o[2];o[0]=f32x16{};o[1]=f32x16{};float nm=ci2;
  #define CINIT(P0,P1,t) do{ const lds_f4ptr cb_=(lds_f4ptr)(cs+64*(t)+4*hi); \
    _Pragma("unroll") for(int g_=0;g_<4;++g_){ const f32x4b n0_=cb_[2*g_], n1_=cb_[8+2*g_]; \
      P0[4*g_]=nm-n0_[0];P0[4*g_+1]=nm-n0_[1];P0[4*g_+2]=nm-n0_[2];P0[4*g_+3]=nm-n0_[3]; \
      P1[4*g_]=nm-n1_[0];P1[4*g_+1]=nm-n1_[1];P1[4*g_+2]=nm-n1_[2];P1[4*g_+3]=nm-n1_[3]; } }while(0)
  #define CMASK(P0,P1,t) do{int jb_=(t)-(NT-4); if(jb_>=0)cmask(P0,P1,jb_,qrel,hi);}while(0)
  bool resc=false;
  #define START(P0,P1) do{ const float rm=rowmax(P0,P1); resc=false; \
    { const float dl=rm; mhat=fadd_s(mhat,dl); \
      _Pragma("unroll") for(int r=0;r<16;++r){P0[r]=fsub_s(P0[r],dl);P1[r]=fsub_s(P1[r],dl);} \
      nm=ci2-mhat; } \
    _Pragma("unroll") for(int r=0;r<16;++r)P0[r]=__builtin_amdgcn_exp2f(P0[r]); }while(0)
  #define RESC() do{ if(resc){ asm volatile("s_waitcnt lgkmcnt(0)":::"memory"); \
      _Pragma("unroll") for(int d_=0;d_<2;++d_) _Pragma("unroll") for(int r=0;r<16;++r)o[d_][r]*=wsf[crow(r,hi)]; } }while(0)
  f32x16 pA0,pA1,pB0,pB1;
  int sl_prev=0,sl_cur=0,sl_next=SLOTB;
  #define ROT() do{sl_prev=sl_cur;sl_cur=sl_next;sl_next=(sl_next==(NSLOT-1)*SLOTB)?0:sl_next+SLOTB;}while(0)
  DMA_K(2,2*SLOTB);
  WAIT_BAR(3);
  CINIT(pA0,pA1,0);qkt(pA0,pA1,Kbase,qr,r32,hi);asm volatile("s_nop 15\n\ts_nop 7":"+v"(pA0),"+v"(pA1));CMASK(pA0,pA1,0);
  START(pA0,pA1);
  _Pragma("unroll") for(int r=0;r<16;++r)pA1[r]=__builtin_amdgcn_exp2f(pA1[r]);
  WAIT_BAR(0);
  DMA_K(3,0);DMA_V(1,SLOTB);
  ROT();
  kload8(kf,kp0+sl_cur);
  WAIT_BAR(2);
  s16x4 vlo[8],vhi[8]; u32x4 pw0,pw1,pw2,pw3;
  #define PKW(P,B) cvtpk_s(P[B],P[B+1])
  #define PAF(k) __builtin_bit_cast(bf16x8,pw##k)
  #define VFR(i) (bf16x8){vlo[i][0],vlo[i][1],vlo[i][2],vlo[i][3],vhi[i][0],vhi[i][1],vhi[i][2],vhi[i][3]}
  #define PIN(x) asm volatile("":"+v"(x))
  #define MX3(a,b,c) __builtin_fmaxf(__builtin_fmaxf((a),(b)),(c))
  #define GAPA(MF,A0,A1,A2,A3,W0,W1,PW) do{ MF; sacc+=A0; sacc+=A1; sacc+=A2; sacc+=A3; PIN(sacc); W0; W1; PIN(PW); SBAR(); }while(0)
  #define EX(v) __builtin_amdgcn_exp2f(v)
  #define GAPB(MF,X,B) do{ MF; X[B]=EX(X[B]); X[B+1]=EX(X[B+1]); X[B+2]=EX(X[B+2]); X[B+3]=EX(X[B+3]); PIN(X); SBAR(); }while(0)
  #define VRD(i) do{ vlo[i]=vtr(vp_+(((i)>>2)*4096+((i)&3)*1024)); vhi[i]=vtr(vp_+(((i)>>2)*4096+((i)&3)*1024+512)); }while(0)
  #define KRD(G,j) do{ if(G){ kload2(kf,kp0+sl_next,j); SBAR(); } }while(0)
  #define STEP(C0,C1,P0,P1,t,GK,GV,GL) do{ SBAR(); \
    const lds_cptr vp_=vp0+sl_prev; CINIT(C0,C1,t); SBAR(); \
    VRD(0); SBAR(); float sacc=(P0[0]+P0[1]); \
    GAPA(C0=__builtin_amdgcn_mfma_f32_32x32x16_bf16(kf[0],qr[0],C0,0,0,0), P0[2],P0[3],P0[4],P0[5],     pw0[0]=PKW(P0,0), pw0[1]=PKW(P0,2), pw0); \
    VRD(4); SBAR(); GAPA(C1=__builtin_amdgcn_mfma_f32_32x32x16_bf16(kf[1],qr[0],C1,0,0,0), P0[6],P0[7],P0[8],P0[9],     pw0[2]=PKW(P0,4), pw0[3]=PKW(P0,6), pw0); \
    VRD(1); SBAR(); GAPA(C0=__builtin_amdgcn_mfma_f32_32x32x16_bf16(kf[2],qr[1],C0,0,0,0),   P0[10],P0[11],P0[12],P0[13], pw1[0]=PKW(P0,8), pw1[1]=PKW(P0,10), pw1); \
    VRD(5); SBAR(); GAPA(C1=__builtin_amdgcn_mfma_f32_32x32x16_bf16(kf[3],qr[1],C1,0,0,0),   P0[14],P0[15],P1[0],P1[1],   pw1[2]=PKW(P0,12),pw1[3]=PKW(P0,14), pw1); \
    VRD(2); SBAR(); GAPA(C0=__builtin_amdgcn_mfma_f32_32x32x16_bf16(kf[4],qr[2],C0,0,0,0),   P1[2],P1[3],P1[4],P1[5],     pw2[0]=PKW(P1,0), pw2[1]=PKW(P1,2), pw2); \
    VRD(6); SBAR(); GAPA(C1=__builtin_amdgcn_mfma_f32_32x32x16_bf16(kf[5],qr[2],C1,0,0,0),   P1[6],P1[7],P1[8],P1[9],     pw2[2]=PKW(P1,4), pw2[3]=PKW(P1,6), pw2); \
    VRD(3); SBAR(); GAPA(C0=__builtin_amdgcn_mfma_f32_32x32x16_bf16(kf[6],qr[3],C0,0,0,0),   P1[10],P1[11],P1[12],P1[13], pw3[0]=PKW(P1,8), pw3[1]=PKW(P1,10), pw3); \
    VRD(7); SBAR(); GAPA(C1=__builtin_amdgcn_mfma_f32_32x32x16_bf16(kf[7],qr[3],C1,0,0,0),   P1[14],P1[15],0.f,0.f,       pw3[2]=PKW(P1,12),pw3[3]=PKW(P1,14), pw3); \
    l_reg+=sacc; \
    if(GK){DMA_K((t)+3,sl_cur);} if(GV){DMA_V((t)+1,sl_next);} \
    CMASK(C0,C1,t); \
    { float a=MX3(C0[0],C0[1],C1[0]),b=MX3(C0[2],C0[3],C1[1]); a=MX3(a,C1[2],C1[3]); \
      _Pragma("unroll") for(int r=4;r<16;r+=4){a=MX3(a,C0[r],C0[r+1]);b=MX3(b,C0[r+2],C0[r+3]);a=MX3(a,C1[r],C1[r+1]);b=MX3(b,C1[r+2],C1[r+3]);} \
      float rm=__builtin_fmaxf(a,b); { auto rr=__builtin_amdgcn_permlane32_swap(__float_as_uint(rm),__float_as_uint(rm),false,false); rm=__builtin_fmaxf(__uint_as_float(rr[0]),__uint_as_float(rr[1])); } \
      resc=false; \
      if(__builtin_expect(__any(rm>(float)THRL),0)){ const float dl=__builtin_fmaxf(rm,0.f); mhat+=dl; \
        _Pragma("unroll") for(int r=0;r<16;++r){C0[r]-=dl;C1[r]-=dl;} \
        nm=ci2-mhat; \
        const float f=__builtin_amdgcn_exp2f(-dl); l_reg*=f; if(hi==0)wsf[r32]=f; resc=true; } } \
    SBAR(); \
    GAPB(o[0]=__builtin_amdgcn_mfma_f32_32x32x16_bf16(PAF(0),VFR(0),o[0],0,0,0), C0,0); \
    GAPB(o[1]=__builtin_amdgcn_mfma_f32_32x32x16_bf16(PAF(0),VFR(4),o[1],0,0,0), C0,4); \
    KRD(GL,0); GAPB(o[0]=__builtin_amdgcn_mfma_f32_32x32x16_bf16(PAF(1),VFR(1),o[0],0,0,0), C0,8); \
    KRD(GL,1); GAPB(o[1]=__builtin_amdgcn_mfma_f32_32x32x16_bf16(PAF(1),VFR(5),o[1],0,0,0), C0,12); \
    KRD(GL,2); GAPB(o[0]=__builtin_amdgcn_mfma_f32_32x32x16_bf16(PAF(2),VFR(2),o[0],0,0,0), C1,0); \
    KRD(GL,3); GAPB(o[1]=__builtin_amdgcn_mfma_f32_32x32x16_bf16(PAF(2),VFR(6),o[1],0,0,0), C1,4); \
    GAPB(o[0]=__builtin_amdgcn_mfma_f32_32x32x16_bf16(PAF(3),VFR(3),o[0],0,0,0), C1,8); \
    GAPB(o[1]=__builtin_amdgcn_mfma_f32_32x32x16_bf16(PAF(3),VFR(7),o[1],0,0,0), C1,12); \
    }while(0)
  int t=1;
  #undef CMASK
  #define CMASK(P0,P1,t) do{}while(0)
  for(;t+5<NT;t+=2){
    STEP(pB0,pB1,pA0,pA1,t,true,true,true);     WAIT_BAR(2); RESC(); ROT();
    STEP(pA0,pA1,pB0,pB1,t+1,true,true,true);   WAIT_BAR(2); RESC(); ROT();
  }
  #undef CMASK
  #define CMASK(P0,P1,t) do{int jb_=(t)-(NT-4); if(jb_>=0)cmask(P0,P1,jb_,qrel,hi);}while(0)
  #define ENDW(tt) do{ if((tt)+3<NT){WAIT_BAR(2);} else if((tt)+2<NT){WAIT_BAR(1);} else {WAIT_BAR(0);} }while(0)
  for(;t+1<NT;t+=2){
    STEP(pB0,pB1,pA0,pA1,t,(t+3<NT),(t+1<NT),(t+1<NT));       ENDW(t);   RESC(); ROT();
    STEP(pA0,pA1,pB0,pB1,t+1,(t+4<NT),(t+2<NT),(t+2<NT));     ENDW(t+1); RESC(); ROT();
  }
  STEP(pB0,pB1,pA0,pA1,NT-1,false,false,false); RESC();
  { float sacc=pB0[0]+pB0[1]; _Pragma("unroll") for(int r=2;r<16;++r)sacc+=pB0[r]; _Pragma("unroll") for(int r=0;r<16;++r)sacc+=pB1[r]; l_reg+=sacc;
    pw0=(u32x4){PKW(pB0,0),PKW(pB0,2),PKW(pB0,4),PKW(pB0,6)};pw1=(u32x4){PKW(pB0,8),PKW(pB0,10),PKW(pB0,12),PKW(pB0,14)};pw2=(u32x4){PKW(pB1,0),PKW(pB1,2),PKW(pB1,4),PKW(pB1,6)};pw3=(u32x4){PKW(pB1,8),PKW(pB1,10),PKW(pB1,12),PKW(pB1,14)};
    SBAR(); pv(o,vb0+sl_cur,PAF(0),PAF(1),PAF(2),PAF(3)); }
  #undef PKW
  #undef PAF
  #undef VFR
  #undef PIN
  #undef MX3
  #undef GAPA
  #undef GAPB
  #undef EX
  #undef VRD
  #undef KRD
  #undef STEP
  #undef ENDW
  {auto rr=__builtin_amdgcn_permlane32_swap(__float_as_uint(l_reg),__float_as_uint(l_reg),false,false);l_reg=__uint_as_float(rr[0])+__uint_as_float(rr[1]);}
  if(hi==0)wsf[32+r32]=l_reg;asm volatile("s_waitcnt lgkmcnt(0)":::"memory");
  float rli[16];
  #pragma unroll
  for(int r=0;r<16;++r)rli[r]=__builtin_amdgcn_rcpf(wsf[32+crow(r,hi)]);
  bf16*Ow=O+(rowbase+q0+wid*QBLK)*DM+h*D;
  { bf16*stg=(bf16*)(shm+LDS_OST)+wid*2048;
    #pragma unroll
    for(int r=0;r<16;++r){const int orow=crow(r,hi);
      #pragma unroll
      for(int d0=0;d0<2;++d0)stg[orow*64+d0*32+r32]=__float2bfloat16(o[d0][r]*rli[r]);}
    asm volatile("s_waitcnt lgkmcnt(0)":::"memory");
    #pragma unroll
    for(int i=0;i<4;++i){const int row=i*8+(lane>>3),ch=lane&7; const u32x4 v=*(const u32x4*)(stg+row*64+ch*8); ATTN_STORE16(Ow+(long)row*DM+ch*8,v);} }
  asm volatile("s_waitcnt lgkmcnt(0)\n\ts_barrier":::"memory");
  #undef DMA_K
  #undef DMA_V
  #undef CINIT
  #undef CMASK
  #undef START
  #undef RESC
  #undef ROT
}
constexpr int ATTN_LDS_BYTES=LDS_BYTES;
struct AttnTensors { const bf16* Q; const bf16* K; const bf16* V; bf16* O; };
struct AttnUnit { int bh; int qb; };
struct StaticOrder {
  int vcu;
  __device__ __forceinline__ explicit StaticOrder(int grid,int block):vcu((block%8)*(grid/8)+block/8){}
  __device__ __forceinline__ bool next(int i,AttnUnit&u)const{ if(i>=4)return false; const int s=vcu&3; u.bh=vcu>>2; u.qb=(i==0)?s:(i==1)?7-s:(i==2)?8+s:15-s; return true; }
  __device__ __forceinline__ void a_ready(const AttnUnit&)const{}
  __device__ __forceinline__ void done(const AttnUnit&)const{}
};
#undef SBAR
#undef WAIT_BAR
}
#define LAS __attribute__((address_space(3)))
typedef unsigned short bf16;
typedef unsigned v4u __attribute__((ext_vector_type(4)));
typedef unsigned v2u __attribute__((ext_vector_type(2)));
typedef float f32x4 __attribute__((ext_vector_type(4)));
typedef float f32x16 __attribute__((ext_vector_type(16)));
typedef short bf16x8 __attribute__((ext_vector_type(8)));
typedef float f32x2s __attribute__((ext_vector_type(2)));

constexpr int NBATCH = 4, SEQ = 4096, M = NBATCH * SEQ, D = 1024, DFF = 2816, PLE = 256;
constexpr int EVEN_IN = 2560, FOX_IN = 3088, FOX_INP = 3328;
constexpr float LOG2E = 1.4426950408889634f;
constexpr float QSCALE = 0.125f * LOG2E;
constexpr float GN_EPS = 64e-5f;
constexpr size_t MiB = 1u << 20;
constexpr size_t WS_SSQ = 0;
constexpr size_t WS_C3 = 1 * MiB;
constexpr size_t WS_LF = 2 * MiB;
constexpr size_t WS_G2F = 3 * MiB;
constexpr size_t WS_WGU = 4 * MiB;
constexpr size_t WS_WD = 48 * MiB;
constexpr size_t WS_WG = 70 * MiB;
constexpr size_t WS_WP = 74 * MiB;
constexpr size_t WS_WIN0 = 75 * MiB, WS_WOUT0 = 80 * MiB, WS_WIN1 = 82 * MiB, WS_WOUT1 = 89 * MiB;
constexpr size_t WS_XB = 91 * MiB;
constexpr size_t WS_Y = 123 * MiB;
constexpr size_t WS_BIG = 155 * MiB;
constexpr size_t WS_PB = 243 * MiB;
constexpr size_t WS_SSQP = 251 * MiB;
constexpr size_t WS_END = 253 * MiB;
constexpr size_t WS_BAR = 0;
constexpr int LDS_BYTES = 147456, MISC_OFF = 147456 - 64;

#define LDS_WAIT() asm volatile("s_waitcnt lgkmcnt(0)" ::: "memory")
__device__ __forceinline__ unsigned pk2(float lo, float hi) { return pg8::cvt_pk_bf16(lo, hi); }
__device__ __forceinline__ float bflo(unsigned w) { return __uint_as_float(w << 16); }
__device__ __forceinline__ float bfhi(unsigned w) { return __uint_as_float(w & 0xffff0000u); }
__device__ __forceinline__ float bf2f(bf16 h) { return __uint_as_float((unsigned)h << 16); }
__device__ __forceinline__ float wave_sum(float v) {
#pragma unroll
    for (int o = 1; o < 64; o <<= 1) v += __shfl_xor(v, o);
    return v;
}
__device__ __forceinline__ int crow(int r, int hi) { return (r & 3) + 8 * (r >> 2) + 4 * hi; }
template <int CTRL> __device__ __forceinline__ float dpp_f(float x) { return __int_as_float(__builtin_amdgcn_update_dpp(0, __float_as_int(x), CTRL, 0xf, 0xf, true)); }
__device__ __forceinline__ float red16(float x) { x += dpp_f<0xB1>(x); x += dpp_f<0x4E>(x); x += dpp_f<0x141>(x); x += dpp_f<0x140>(x); return x; }
__device__ __forceinline__ float red8(float x) { x += dpp_f<0xB1>(x); x += dpp_f<0x4E>(x); x += dpp_f<0x141>(x); return x; }
__device__ __forceinline__ void unpack8(const v4u w, float (&f)[8]) { f[0] = bflo(w.x); f[1] = bfhi(w.x); f[2] = bflo(w.y); f[3] = bfhi(w.y); f[4] = bflo(w.z); f[5] = bfhi(w.z); f[6] = bflo(w.w); f[7] = bfhi(w.w); }
__device__ __forceinline__ bf16x8 pack8(const float (&f)[8]) { v4u w; w.x = pk2(f[0], f[1]); w.y = pk2(f[2], f[3]); w.z = pk2(f[4], f[5]); w.w = pk2(f[6], f[7]); return __builtin_bit_cast(bf16x8, w); }

__device__ __forceinline__ void conv_item(const float* W, int K, int N, int NP, bf16* WT, const float* gain, int mode, LAS float* scr, int item, int lane) {
    const int nblk = NP / 32, kb = item / nblk, nb = item - kb * nblk, k0 = 64 * kb, n0 = 32 * nb;
    int orow0 = n0;
    if (mode == 1) orow0 = (n0 < DFF) ? (n0 / 128) * 256 + (n0 % 128) : ((n0 - DFF) / 128) * 256 + 128 + ((n0 - DFF) % 128);
    const int nq = 4 * (lane & 7); const bool inb = (n0 + nq) < N;
#pragma unroll
    for (int i = 0; i < 8; ++i) { const int kk = 8 * i + (lane >> 3); f32x4 v = {0.f, 0.f, 0.f, 0.f}; if (inb) v = *(const f32x4*)(W + (size_t)(k0 + kk) * N + n0 + nq);
        if (gain) v = v * gain[k0 + kk];
        LAS float* d = scr + kk * 33 + nq; d[0] = v[0]; d[1] = v[1]; d[2] = v[2]; d[3] = v[3]; }
    LDS_WAIT(); asm volatile("" ::: "memory");
    const int c = lane & 7;
#pragma unroll
    for (int j = 0; j < 4; ++j) { const int nn = (lane >> 3) + 8 * j; const LAS float* s = scr + (8 * c) * 33 + nn;
        v4u o; o.x = pk2(s[0 * 33], s[1 * 33]); o.y = pk2(s[2 * 33], s[3 * 33]); o.z = pk2(s[4 * 33], s[5 * 33]); o.w = pk2(s[6 * 33], s[7 * 33]);
        *(v4u*)(WT + (size_t)(orow0 + nn) * K + k0 + 8 * c) = o; }
    LDS_WAIT(); asm volatile("" ::: "memory");
}

constexpr int VTP = 264;
__device__ __forceinline__ void swa_unit(int unit, const bf16* PROJ, bf16* Y, const float* sinks, LAS unsigned char* lds, int tid, int lane, int wid) {
    const int b = unit >> 6, kvh = (unit >> 5) & 1, qblk = unit & 31, q0 = qblk * 128; const size_t rb = (size_t)b * SEQ;
    asm volatile("" : "+s"(PROJ), "+s"(Y));
    LAS bf16* VT = (LAS bf16*)lds;
    for (int c = tid; c < 2048; c += 512) { const int kvl = c >> 3, ch = c & 7, tok = q0 - 128 + kvl; v4u v = {0u, 0u, 0u, 0u};
        if (tok >= 0) v = *(const v4u*)(PROJ + (rb + tok) * EVEN_IN + 640 + kvh * 64 + ch * 8);
        LAS bf16* d = VT + (ch * 8) * VTP + kvl;
        d[0 * VTP] = (bf16)(v.x & 0xffffu); d[1 * VTP] = (bf16)(v.x >> 16); d[2 * VTP] = (bf16)(v.y & 0xffffu); d[3 * VTP] = (bf16)(v.y >> 16);
        d[4 * VTP] = (bf16)(v.z & 0xffffu); d[5 * VTP] = (bf16)(v.z >> 16); d[6 * VTP] = (bf16)(v.w & 0xffffu); d[7 * VTP] = (bf16)(v.w >> 16); }
    __syncthreads();
    const int g = wid >> 1, qh = wid & 1, hq = kvh * 4 + g;
    const float slope2 = exp2f(-(float)(hq + 1)) * LOG2E, sink2 = sinks[hq] * LOG2E;
#pragma unroll 1
    for (int sb = 0; sb < 2; ++sb) {
        int r32 = lane & 31, hi = lane >> 5; asm volatile("" : "+v"(r32), "+v"(hi));
        const int qs = q0 + 64 * qh + 32 * sb;
        bf16x8 qf[4];
#pragma unroll
        for (int ks = 0; ks < 4; ++ks) qf[ks] = *(const bf16x8*)(PROJ + (rb + qs + r32) * EVEN_IN + hq * 64 + 16 * ks + 8 * hi);
        f32x16 sc[5];
#pragma unroll
        for (int kt = 0; kt < 5; ++kt) { int tk = qs - 128 + 32 * kt + r32; tk = tk < 0 ? 0 : tk; sc[kt] = f32x16{};
#pragma unroll
            for (int ks = 0; ks < 4; ++ks) { const bf16x8 kf = *(const bf16x8*)(PROJ + (rb + tk) * EVEN_IN + 512 + kvh * 64 + 16 * ks + 8 * hi);
                sc[kt] = __builtin_amdgcn_mfma_f32_32x32x16_bf16(kf, qf[ks], sc[kt], 0, 0, 0); }
            asm volatile("" ::: "memory"); }
        const int db = r32 + 128 - 4 * hi, kmin = 128 - qs - 4 * hi; const float ab = -slope2 * (float)db;
        float mx = sink2;
#pragma unroll
        for (int kt = 0; kt < 5; ++kt)
#pragma unroll
            for (int r = 0; r < 16; ++r) { const int kc = 32 * kt + (r & 3) + 8 * (r >> 2), dist = db - kc; const bool ok = ((unsigned)dist < 128u) && (kmin <= kc);
                const float s = ok ? fmaf(slope2, (float)kc, sc[kt][r] + ab) : -INFINITY; sc[kt][r] = s; mx = fmaxf(mx, s); }
        mx = fmaxf(mx, __shfl_xor(mx, 32));
        float l = 0.f;
#pragma unroll
        for (int kt = 0; kt < 5; ++kt)
#pragma unroll
            for (int r = 0; r < 16; ++r) { const float p = exp2f(sc[kt][r] - mx); sc[kt][r] = p; l += p; }
        l += __shfl_xor(l, 32); l += exp2f(sink2 - mx);
        const float rl = 1.0f / l;
        f32x16 o[2]; o[0] = f32x16{}; o[1] = f32x16{};
        const int kvl0 = 64 * qh + 32 * sb;
#pragma unroll
        for (int kt = 0; kt < 5; ++kt)
#pragma unroll
            for (int s2 = 0; s2 < 2; ++s2) { v4u pw; pw.x = pk2(sc[kt][8 * s2 + 0], sc[kt][8 * s2 + 1]); pw.y = pk2(sc[kt][8 * s2 + 2], sc[kt][8 * s2 + 3]); pw.z = pk2(sc[kt][8 * s2 + 4], sc[kt][8 * s2 + 5]); pw.w = pk2(sc[kt][8 * s2 + 6], sc[kt][8 * s2 + 7]);
                const bf16x8 pa = __builtin_bit_cast(bf16x8, pw);
#pragma unroll
                for (int db = 0; db < 2; ++db) { const LAS bf16* vp = VT + (32 * db + r32) * VTP + kvl0 + 32 * kt + 16 * s2 + 4 * hi;
                    const v2u lo = *(const LAS v2u*)vp, hh = *(const LAS v2u*)(vp + 8); v4u vw; vw.x = lo.x; vw.y = lo.y; vw.z = hh.x; vw.w = hh.y;
                    o[db] = __builtin_amdgcn_mfma_f32_32x32x16_bf16(pa, __builtin_bit_cast(bf16x8, vw), o[db], 0, 0, 0); } }
#pragma unroll
        for (int r = 0; r < 16; ++r) { const int qq = crow(r, hi); const float sc1 = __shfl(rl, qq);
            bf16* yp = Y + (rb + qs + qq) * 1024 + hq * 64 + r32;
            yp[0] = (bf16)(pk2(o[0][r] * sc1, 0.f) & 0xffffu); yp[32] = (bf16)(pk2(o[1][r] * sc1, 0.f) & 0xffffu); }
    }
    __syncthreads();
}
typedef unsigned v4u_unused_;
#define XB_TMO      128
#define XB_XCNT(j)  (256  + 64 * (j))
#define XB_XSUB(j)  (1280 + 64 * (j))
#define XB_XGEN(j)  (2304 + 64 * (j))
#define XB_TOP      3328
#define XB_TOPGEN   3392
#define XCD_BAR_WORDS 3456
#define XB_SPIN_CAP (1u << 18)

__device__ __forceinline__ unsigned xb_ld(unsigned* p)              { return __hip_atomic_load(p, __ATOMIC_RELAXED, __HIP_MEMORY_SCOPE_AGENT); }
__device__ __forceinline__ unsigned xb_add(unsigned* p, unsigned v) { return __hip_atomic_fetch_add(p, v, __ATOMIC_RELAXED, __HIP_MEMORY_SCOPE_AGENT); }
__device__ __forceinline__ unsigned xb_xcc_id() { return (unsigned)__builtin_amdgcn_s_getreg((3 << 11) | 20) & 0xFu; }
#define XB_SPIN(cond, bar) do { unsigned _sp = 0; while (cond) { __builtin_amdgcn_s_sleep(1); \
    if ((++_sp & 255u) == 0u) { if (xb_ld(&(bar)[XB_TMO])) break; if (_sp > XB_SPIN_CAP) { atomicAdd(&(bar)[XB_TMO], 1u); break; } } } } while (0)

struct XcdBarrier {
    unsigned* bar; unsigned x;
    volatile LAS unsigned* st;
};

__device__ __forceinline__ XcdBarrier xcd_barrier_post(unsigned* bar, volatile LAS unsigned* st) {
    XcdBarrier b; b.bar = bar; b.x = xb_xcc_id(); b.st = st;
    if (threadIdx.x == 0) (void)xb_add(&bar[XB_XCNT(b.x)], 1u);
    return b;
}
__device__ __forceinline__ void xcd_barrier_complete(unsigned* bar, unsigned x, unsigned& nloc, unsigned& nx) {
    const unsigned G = gridDim.x * gridDim.y * gridDim.z;
    unsigned sum, cnt, mine, sp = 0u;
    for (;;) {
        sum = 0u; cnt = 0u; mine = 0u;
#pragma unroll
        for (unsigned j = 0; j < 16; ++j) { const unsigned c = xb_ld(&bar[XB_XCNT(j)]); sum += c; cnt += (c > 0u) ? 1u : 0u; mine = (j == x) ? c : mine; }
        if (sum == G) break;
        __builtin_amdgcn_s_sleep(1);
        if ((++sp & 255u) == 0u) { if (xb_ld(&bar[XB_TMO])) break; if (sp > XB_SPIN_CAP) { atomicAdd(&bar[XB_TMO], 1u); break; } }
    }
    nloc = mine > 0u ? mine : 1u; nx = cnt > 0u ? cnt : 1u;
}

__device__ __forceinline__ void xcd_barrier(const XcdBarrier& b) {
    asm volatile("s_waitcnt vmcnt(0)" ::: "memory");
    __syncthreads();
    if (threadIdx.x == 0) {
        unsigned* bar = b.bar;
        __builtin_amdgcn_s_waitcnt(0);
        unsigned nloc = b.st[0], nx = b.st[1];
        if (nloc == 0u) { xcd_barrier_complete(bar, b.x, nloc, nx); b.st[0] = nloc; b.st[1] = nx; }
        const unsigned old = xb_add(&bar[XB_XSUB(b.x)], 1u);
        const unsigned gen = old / nloc;
        if (old + 1u == (gen + 1u) * nloc) {
            __builtin_amdgcn_fence(__ATOMIC_RELEASE, "agent");
            asm volatile("s_waitcnt vmcnt(0)" ::: "memory");
            const unsigned og = xb_add(&bar[XB_TOP], 1u);
            const unsigned tg = og / nx;
            if (og + 1u == (tg + 1u) * nx) xb_add(&bar[XB_TOPGEN], 1u);
            else XB_SPIN(xb_ld(&bar[XB_TOPGEN]) == tg, bar);
            __builtin_amdgcn_fence(__ATOMIC_ACQUIRE, "agent");
            xb_add(&bar[XB_XGEN(b.x)], 1u);
            asm volatile("s_waitcnt vmcnt(0)" ::: "memory");
        } else {
            XB_SPIN(xb_ld(&bar[XB_XGEN(b.x)]) == gen, bar);
            __builtin_amdgcn_fence(__ATOMIC_ACQUIRE, "agent");
            asm volatile("s_waitcnt vmcnt(0)" ::: "memory");
        }
    }
    __syncthreads();
}
constexpr int TC = 32, SBS = 340, LBS = 68;
constexpr int SBS_UNUSED_ = 336;
constexpr int RW_SBUF = 0, RW_SBUF_BYTES = TC * SBS * 4, RW_LW = 2 * RW_SBUF_BYTES, RW_LA = RW_LW + 2 * TC * LBS * 4, RW_EC = RW_LA + 2 * TC * LBS * 4, RW_BF = RW_EC + 2560;
__device__ __forceinline__ void rwkv_scan_unit(int unit, const bf16* PROJ, float* YRAW, float* C3, const float* mu, const float* w0, const float* w2, const float* a0, const float* a2,
                                               const float* k_k, const float* k_a, const float* r_k, LAS unsigned char* lds, const int lane, int wid) {
    const int role = (wid < 2) ? 0 : ((wid == 4 || wid == 5) ? 2 : 1), lw = wid - 4, ew = (wid < 4) ? wid - 2 : wid - 4;
    const int b = unit >> 6, h = (unit >> 3) & 7, rg = unit & 7; const size_t rb = (size_t)b * SEQ;
    const int r32 = lane & 31, hi = lane >> 5;
    constexpr int NCH = SEQ / TC;
    if (role == 2) {
        const int colx = 768 + ((lw == 0) ? 1536 : 1600); const float* Wl = (lw == 0) ? w2 : a2;
#pragma unroll
        for (int nb = 0; nb < 2; ++nb)
#pragma unroll
            for (int ks = 0; ks < 4; ++ks) { float f[8];
#pragma unroll
                for (int i = 0; i < 8; ++i) f[i] = Wl[(size_t)(16 * ks + 8 * hi + i) * 512 + h * 64 + 32 * nb + r32];
                *(LAS bf16x8*)(lds + RW_BF + (((lw * 2 + nb) * 4 + ks) * 64 + lane) * 16) = pack8(f); }
        ((LAS float*)(lds + RW_EC))[512 + lw * 64 + lane] = mu[colx - 768 + lane];
        v4u lcw[4], lpw[4];
#define LORA_LOAD(itn) do { const int tl_ = (itn) * TC + r32; const bf16* p_ = PROJ + (rb + tl_) * EVEN_IN + colx + 8 * hi; _Pragma("unroll") for (int ks = 0; ks < 4; ++ks) { lcw[ks] = *(const v4u*)(p_ + 16 * ks); \
            lpw[ks] = (v4u){0u, 0u, 0u, 0u}; if (tl_ > 0) lpw[ks] = *(const v4u*)(p_ - EVEN_IN + 16 * ks); } } while (0)
        LORA_LOAD(0);
#pragma unroll 1
        for (int it = 0; it < NCH + 2; ++it) {
            if (it < NCH) { bf16x8 afr[4];
#pragma unroll
                for (int ks = 0; ks < 4; ++ks) { float c[8], p[8]; unpack8(lcw[ks], c); unpack8(lpw[ks], p);
                    const LAS float* mq = (const LAS float*)(lds + RW_EC) + 512 + lw * 64 + 16 * ks + 8 * hi; const f32x4 m0 = *(const LAS f32x4*)mq, m1 = *(const LAS f32x4*)(mq + 4);
#pragma unroll
                    for (int i = 0; i < 8; ++i) { float x = c[i] + (p[i] - c[i]) * (i < 4 ? m0[i] : m1[i - 4]); if (lw == 0) x = 1.f - 2.f * __builtin_amdgcn_rcpf(1.f + __expf(2.f * x)); c[i] = x; }
                    afr[ks] = pack8(c); }
                if (it + 1 < NCH) LORA_LOAD(it + 1);
                LAS float* LB = (LAS float*)(lds + ((lw == 0) ? RW_LW : RW_LA)) + (it & 1) * (TC * LBS);
#pragma unroll
                for (int nb = 0; nb < 2; ++nb) { f32x16 acc = f32x16{};
#pragma unroll
                    for (int ks = 0; ks < 4; ++ks) acc = __builtin_amdgcn_mfma_f32_32x32x16_bf16(afr[ks], *(const LAS bf16x8*)(lds + RW_BF + (((lw * 2 + nb) * 4 + ks) * 64 + lane) * 16), acc, 0, 0, 0);
#pragma unroll
                    for (int r = 0; r < 16; ++r) LB[crow(r, hi) * LBS + 32 * nb + r32] = acc[r]; } }
            asm volatile("s_waitcnt lgkmcnt(0)\n\ts_barrier" ::: "memory");
        }
#undef LORA_LOAD
    } else if (role == 1) {
        const int el = ew * 64 + lane, s = el >> 3, g = el & 7;
        float ecc[8][8];
        { const int chn = h * 64 + 8 * g;
#pragma unroll
          for (int i = 0; i < 8; ++i) { ecc[0][i] = mu[chn + i]; ecc[1][i] = mu[512 + chn + i]; ecc[2][i] = mu[1024 + chn + i]; ecc[3][i] = w0[chn + i]; ecc[4][i] = a0[chn + i]; ecc[5][i] = k_k[chn + i]; ecc[6][i] = k_a[chn + i]; ecc[7][i] = r_k[chn + i]; } }
        v4u ecr, eck, ecv, epr, epk, epv;
#define ELEM_LOAD(cn) do { const int tl_ = (cn) * TC + s; const bf16* p_ = PROJ + (rb + tl_) * EVEN_IN + 768 + h * 64 + 8 * g; \
            ecr = *(const v4u*)p_; eck = *(const v4u*)(p_ + 512); ecv = *(const v4u*)(p_ + 1024); epr = (v4u){0u, 0u, 0u, 0u}; epk = epr; epv = epr; \
            if (tl_ > 0) { epr = *(const v4u*)(p_ - EVEN_IN); epk = *(const v4u*)(p_ - EVEN_IN + 512); epv = *(const v4u*)(p_ - EVEN_IN + 1024); } } while (0)
        ELEM_LOAD(0);
#pragma unroll 1
        for (int it = 0; it < NCH + 2; ++it) {
            const int c = it - 1;
            if (c >= 0 && c < NCH) { const size_t row = rb + c * TC + s;
                const LAS float* LW = (const LAS float*)(lds + RW_LW) + (c & 1) * (TC * LBS) + s * LBS + 8 * g; const LAS float* LA = (const LAS float*)(lds + RW_LA) + (c & 1) * (TC * LBS) + s * LBS + 8 * g;
                LAS float* sp = (LAS float*)(lds + RW_SBUF + (c & 1) * RW_SBUF_BYTES) + s * SBS;
                float ec[8];
#define LDEC(arr) do { _Pragma("unroll") for (int i_ = 0; i_ < 8; ++i_) ec[i_] = ecc[arr][i_]; } while (0)
                float r[8], k[8], v[8], t[8];
                unpack8(ecr, r); unpack8(epr, t); LDEC(0);
#pragma unroll
                for (int i = 0; i < 8; ++i) r[i] += (t[i] - r[i]) * ec[i];
                unpack8(eck, k); unpack8(epk, t); LDEC(1);
#pragma unroll
                for (int i = 0; i < 8; ++i) k[i] += (t[i] - k[i]) * ec[i];
                unpack8(ecv, v); unpack8(epv, t); LDEC(2);
#pragma unroll
                for (int i = 0; i < 8; ++i) v[i] += (t[i] - v[i]) * ec[i];
                if (c + 1 < NCH) ELEM_LOAD(c + 1);
                const f32x4 dw0 = *(const LAS f32x4*)LW, dw1 = *(const LAS f32x4*)(LW + 4), da0 = *(const LAS f32x4*)LA, da1 = *(const LAS f32x4*)(LA + 4);
                float w[8], a[8], kk[8], kp[8]; float n2 = 0.f;
#pragma unroll
                for (int i = 0; i < 8; ++i) w[i] = i < 4 ? dw0[i] : dw1[i - 4];
                LDEC(3);
#pragma unroll
                for (int i = 0; i < 8; ++i) w[i] = __expf(-0.60653065971f * pg8::sigm(ec[i] + w[i]));
                LDEC(4);
#pragma unroll
                for (int i = 0; i < 8; ++i) a[i] = pg8::sigm(ec[i] + (i < 4 ? da0[i] : da1[i - 4]));
                LDEC(5);
#pragma unroll
                for (int i = 0; i < 8; ++i) { kk[i] = k[i] * ec[i]; n2 += kk[i] * kk[i]; }
                LDEC(6);
#pragma unroll
                for (int i = 0; i < 8; ++i) kp[i] = k[i] * (1.f + (a[i] - 1.f) * ec[i]);
                LDEC(7);
                n2 = red8(n2); const float inv = __builtin_amdgcn_rsqf(fmaxf(n2, 1e-24f));
                float c1 = 0.f, c2 = 0.f, c3 = 0.f;
#pragma unroll
                for (int i = 0; i < 8; ++i) { kk[i] *= inv; t[i] = kk[i] * a[i]; c1 += t[i] * r[i]; c2 += kp[i] * r[i]; c3 += r[i] * kp[i] * ec[i]; }
#undef LDEC
                c1 = red8(c1); c2 = red8(c2); c3 = red8(c3);
                *(LAS f32x4*)(sp + 8 * g) = (f32x4){kk[0], kk[1], kk[2], kk[3]}; *(LAS f32x4*)(sp + 8 * g + 4) = (f32x4){kk[4], kk[5], kk[6], kk[7]};
                *(LAS f32x4*)(sp + 64 + 8 * g) = (f32x4){w[0] * r[0], w[1] * r[1], w[2] * r[2], w[3] * r[3]}; *(LAS f32x4*)(sp + 64 + 8 * g + 4) = (f32x4){w[4] * r[4], w[5] * r[5], w[6] * r[6], w[7] * r[7]};
                *(LAS f32x4*)(sp + 128 + 8 * g) = (f32x4){w[0], w[1], w[2], w[3]}; *(LAS f32x4*)(sp + 128 + 8 * g + 4) = (f32x4){w[4], w[5], w[6], w[7]};
                *(LAS f32x4*)(sp + 192 + 8 * g) = (f32x4){t[0], t[1], t[2], t[3]}; *(LAS f32x4*)(sp + 192 + 8 * g + 4) = (f32x4){t[4], t[5], t[6], t[7]};
                *(LAS f32x4*)(sp + 256 + 8 * g) = (f32x4){kp[0], kp[1], kp[2], kp[3]}; *(LAS f32x4*)(sp + 256 + 8 * g + 4) = (f32x4){kp[4], kp[5], kp[6], kp[7]};
                if (g == rg) { *(LAS f32x4*)(sp + 320) = (f32x4){v[0], v[1], v[2], v[3]}; *(LAS f32x4*)(sp + 324) = (f32x4){v[4], v[5], v[6], v[7]}; }
                if (g == 0) { sp[328] = c1; sp[329] = c2; if (rg == 0) C3[row * 8 + h] = c3; } }
            asm volatile("s_waitcnt lgkmcnt(0)\n\ts_barrier" ::: "memory");
        }
#undef ELEM_LOAD
    } else {
        const int rowl = 4 * (wid & 1) + (lane >> 4), cgp = lane & 15;
        f32x2s S01 = {0.f, 0.f}, S23 = {0.f, 0.f};
#pragma unroll 1
        for (int it = 0; it < NCH + 2; ++it) {
            const int c = it - 2;
            if (c >= 0) { const LAS float* SBF = (const LAS float*)(lds + RW_SBUF + (c & 1) * RW_SBUF_BYTES);
                float* yp = YRAW + (rb + (size_t)c * TC) * 512 + h * 64 + 8 * rg + rowl;
                __builtin_amdgcn_s_setprio(3);
                f32x4 kkA, wrA, wA, kaA, kpA, kkB, wrB, wB, kaB, kpB; float viA, viB; float pkeep = 0.f, qkeep = 0.f;
#define LDREC(X, s_) do { const LAS float* sp_ = SBF + (s_) * SBS; kk##X = *(const LAS f32x4*)(sp_ + 4 * cgp); wr##X = *(const LAS f32x4*)(sp_ + 64 + 4 * cgp); w##X = *(const LAS f32x4*)(sp_ + 128 + 4 * cgp); \
                    ka##X = *(const LAS f32x4*)(sp_ + 192 + 4 * cgp); kp##X = *(const LAS f32x4*)(sp_ + 256 + 4 * cgp); vi##X = sp_[320 + rowl]; } while (0)
#define LO2(v) __builtin_shufflevector(v, v, 0, 1)
#define HI2(v) __builtin_shufflevector(v, v, 2, 3)
#define STEPREC(X, s_) do { f32x2s pp = S01 * LO2(kk##X); pp = S23 * HI2(kk##X) + pp; f32x2s qq = S01 * LO2(wr##X); qq = S23 * HI2(wr##X) + qq; float p = pp[0] + pp[1], q = qq[0] + qq[1]; \
                    const f32x2s vv_ = {vi##X, vi##X}; const f32x2s u01_ = S01 * LO2(w##X) + LO2(kp##X) * vv_, u23_ = S23 * HI2(w##X) + HI2(kp##X) * vv_;     \
                    p += dpp_f<0xB1>(p); q += dpp_f<0xB1>(q); p += dpp_f<0x4E>(p); q += dpp_f<0x4E>(q); p += dpp_f<0x141>(p); q += dpp_f<0x141>(q); p += dpp_f<0x140>(p); q += dpp_f<0x140>(q); \
                    const f32x2s pv_ = {p, p}; \
                    S01 = u01_ - LO2(ka##X) * pv_; S23 = u23_ - HI2(ka##X) * pv_; \
                    pkeep = (((s_) & 15) == cgp) ? p : pkeep; qkeep = (((s_) & 15) == cgp) ? q : qkeep;     \
                    if (((s_) & 15) == 15) { const LAS float* sy_ = SBF + ((s_) - 15 + cgp) * SBS; const f32x2s cy_ = *(const LAS f32x2s*)(sy_ + 328); \
                        yp[(size_t)((s_) - 15 + cgp) * 512] = qkeep - pkeep * cy_[0] + sy_[320 + rowl] * cy_[1]; } } while (0)
                LDREC(A, 0);
#pragma unroll
                for (int s = 0; s < TC; s += 2) {
 LDREC(B, s + 1); STEPREC(A, s); LDREC(A, s + 2); STEPREC(B, s + 1); }
#undef LDREC
#undef STEPREC
#undef LO2
#undef HI2
                __builtin_amdgcn_s_setprio(0); }
            asm volatile("s_waitcnt lgkmcnt(0)\n\ts_barrier" ::: "memory");
        }
    }
    __syncthreads();
}

__device__ __forceinline__ void rwkv_post_unit(int tile, const bf16* PROJ, const float* YRAW, const float* C3, bf16* Y, const float* mu, const bf16* g2f, const float* ln_w, const float* ln_b, int lane, int wid) {
    asm volatile("" : "+s"(PROJ), "+s"(mu), "+s"(g2f), "+s"(YRAW));
    const int h = wid, r32 = lane & 31, hi = lane >> 5; const int tok0 = tile * 32; const bool first = (tok0 & (SEQ - 1)) == 0;
    bf16x8 afr[8];
    { const int tk = tok0 + r32; const bool hp = !(first && r32 == 0); v4u cwv[8], pwv[8];
      const __attribute__((address_space(1))) bf16* pg = (const __attribute__((address_space(1))) bf16*)(PROJ + (size_t)tk * EVEN_IN + 768 + 1664 + 8 * hi);
#pragma unroll
        for (int ks = 0; ks < 8; ++ks) { cwv[ks] = *(const __attribute__((address_space(1))) v4u*)(pg + 16 * ks); pwv[ks] = (v4u){0u, 0u, 0u, 0u};
            if (hp) pwv[ks] = *(const __attribute__((address_space(1))) v4u*)(pg - EVEN_IN + 16 * ks); }
#pragma unroll
        for (int ks = 0; ks < 8; ++ks) { float c[8], p[8]; unpack8(cwv[ks], c); unpack8(pwv[ks], p);
            const f32x4 m0 = *(const f32x4*)(mu + 1664 + 16 * ks + 8 * hi), m1 = *(const f32x4*)(mu + 1664 + 16 * ks + 8 * hi + 4);
#pragma unroll
            for (int i = 0; i < 8; ++i) c[i] = pg8::sigm(c[i] + (p[i] - c[i]) * (i < 4 ? m0[i] : m1[i - 4]));
            afr[ks] = pack8(c); } }
    f32x16 gt[2];
#pragma unroll
    for (int nb = 0; nb < 2; ++nb) { gt[nb] = f32x16{};
#pragma unroll
        for (int ks = 0; ks < 8; ++ks) { const bf16x8 bf = *(const bf16x8*)(g2f + ((size_t)((h * 2 + nb) * 8 + ks) * 64 + lane) * 8);
            gt[nb] = __builtin_amdgcn_mfma_f32_32x32x16_bf16(afr[ks], bf, gt[nb], 0, 0, 0); } }
    typedef const __attribute__((address_space(1))) float* gfp; typedef const __attribute__((address_space(1))) unsigned short* gup;
    const int ch0 = h * 64 + r32; const float lw0 = ln_w[ch0], lw1 = ln_w[ch0 + 32], lb0 = ln_b[ch0], lb1 = ln_b[ch0 + 32], mv0 = mu[1024 + ch0], mv1 = mu[1024 + ch0 + 32];
    float y0[16], y1[16], c3v[16]; unsigned vc[16], vp[16];
#pragma unroll
    for (int r = 0; r < 16; ++r) { const int tk = tok0 + crow(r, hi); gfp yp = (gfp)(YRAW + (size_t)tk * 512 + ch0); y0[r] = yp[0]; y1[r] = yp[32]; c3v[r] = ((gfp)C3)[(size_t)tk * 8 + h];
        gup vq = (gup)(PROJ + (size_t)tk * EVEN_IN + 768 + 1024 + ch0); vc[r] = (unsigned)vq[0] | ((unsigned)vq[32] << 16); vp[r] = 0u;
        if ((tk & (SEQ - 1)) != 0) vp[r] = (unsigned)vq[-EVEN_IN] | ((unsigned)vq[32 - EVEN_IN] << 16); }
#pragma unroll
    for (int r = 0; r < 16; ++r) { const int tk = tok0 + crow(r, hi);
        float s = y0[r] + y1[r]; s = red16(s); s += __shfl_xor(s, 16);
        const float mean = s * (1.f / 64.f), d0 = y0[r] - mean, d1 = y1[r] - mean; float q = d0 * d0 + d1 * d1; q = red16(q); q += __shfl_xor(q, 16);
        const float rstd = rsqrtf(q * (1.f / 64.f) + GN_EPS);
        const float cv0 = bflo(vc[r]), cv1 = bfhi(vc[r]), pv0 = bflo(vp[r]), pv1 = bfhi(vp[r]);
        const float v0 = cv0 + (pv0 - cv0) * mv0, v1 = cv1 + (pv1 - cv1) * mv1;
        const float o0 = (d0 * rstd * lw0 + lb0 + c3v[r] * v0) * gt[0][r], o1 = (d1 * rstd * lw1 + lb1 + c3v[r] * v1) * gt[1][r];
        bf16* op = Y + (size_t)tk * 1024 + 512 + ch0; op[0] = (bf16)(pk2(o0, 0.f) & 0xffffu); op[32] = (bf16)(pk2(o1, 0.f) & 0xffffu); }
}

__device__ __forceinline__ void fox_gate_pass(const bf16* XB, const bf16* Wf, const float* ssqv, const float* bfv, float* LF, int gw, int NGW, int lane) {
    typedef float f32x4g __attribute__((ext_vector_type(4)));
    const int fr = lane & 15, fq = lane >> 4;
    for (int t = gw; t < M / 16; t += NGW) {
        const bf16* ap = XB + (size_t)(t * 16 + fr) * D + 8 * fq; const bf16* bp = Wf + (size_t)fr * D + 8 * fq;
        f32x4g acc = {0.f, 0.f, 0.f, 0.f};
#pragma unroll 8
        for (int ks = 0; ks < D / 32; ++ks) acc = __builtin_amdgcn_mfma_f32_16x16x32_bf16(*(const bf16x8*)(ap + 32 * ks), *(const bf16x8*)(bp + 32 * ks), acc, 0, 0, 0);
        const float bn = bfv[fr];
#pragma unroll
        for (int j = 0; j < 4; ++j) { const int row = t * 16 + 4 * fq + j; const float z = fmaxf(acc[j] * pg8::rstd_of(ssqv, row) + bn, -80.f), e = __expf(-z);
            LF[(size_t)row * 16 + fr] = (e < 0.01f) ? -(e - 0.5f * e * e + e * e * e * (1.f / 3.f)) : -__logf(1.f + e); }
    }
}

__device__ __forceinline__ void fox_prefix(const float* LFbh, LAS float* cs, LAS float* wtot, int tid, int lane, int wid) {
    const float* lp = LFbh + (size_t)tid * 128;
    float s[8]; s[0] = lp[0]; s[1] = s[0] + lp[16]; s[2] = s[1] + lp[32]; s[3] = s[2] + lp[48]; s[4] = s[3] + lp[64]; s[5] = s[4] + lp[80]; s[6] = s[5] + lp[96]; s[7] = s[6] + lp[112];
    float incl = s[7];
#pragma unroll
    for (int o = 1; o < 64; o <<= 1) { const float t = __shfl_up(incl, o); if (lane >= o) incl += t; }
    if (lane == 63) wtot[wid] = incl;
    __syncthreads();
    float base = incl - s[7];
    for (int w = 0; w < wid; ++w) base += wtot[w];
#pragma unroll
    for (int i = 0; i < 8; ++i) cs[8 * tid + i] = (base + s[i]) * LOG2E;
    __syncthreads();
}
struct Args { const float* in[30]; float* out; unsigned char* ws; int ph_lo, ph_hi; };
#define AS4 __attribute__((address_space(4)))
#ifndef DUP_SWA
#define DUP_SWA 0
#endif
#ifndef DUP_SCAN
#define DUP_SCAN 0
#endif
#ifndef DUP_POST
#define DUP_POST 0
#endif
#ifndef DUP_GU
#define DUP_GU 0
#endif
#ifndef DUP_INPROJ
#define DUP_INPROJ 0
#endif
#ifndef DUP_P0
#define DUP_P0 0
#endif
#ifndef DUP_SYNC
#define DUP_SYNC 0
#endif
#define INP(i) (*(const float* const AS4*)(kp + 8 * (i)))
#define GSYNC() xcd_barrier(xbar)
#define FRESH() const AS4 char* kp = kp0; asm volatile("" : "+s"(kp)); unsigned char* ws = *(unsigned char* const AS4*)(kp + 248); float* X = *(float* const AS4*)(kp + 240); \
    int tid = threadIdx.x; asm volatile("" : "+v"(tid)); const int lane = tid & 63, wid = __builtin_amdgcn_readfirstlane(tid >> 6); \
    const int gw = bx * 8 + wid, NGW = G * 8; \
    float* ssq = (float*)(ws + WS_SSQP); float* C3 = (float*)(ws + WS_C3); float* LF = (float*)(ws + WS_LF); \
    bf16* XB = (bf16*)(ws + WS_XB); float* YRAW = (float*)(ws + WS_XB); bf16* Y = (bf16*)(ws + WS_Y); \
    bf16* H = (bf16*)(ws + WS_BIG); bf16* PROJ = (bf16*)(ws + WS_BIG); bf16* PP = (bf16*)(ws + WS_BIG); bf16* PB = (bf16*)(ws + WS_PB); \
    bf16* Qb = (bf16*)(ws + WS_BIG); bf16* Kb = Qb + (size_t)M * D; bf16* Vb = Kb + (size_t)M * D; \
    (void)X; (void)lane; (void)wid; (void)gw; (void)NGW; (void)ssq; (void)C3; (void)LF; (void)XB; (void)YRAW; (void)Y; (void)H; (void)PROJ; (void)PP; (void)PB; (void)Qb; (void)Kb; (void)Vb
__global__ void __launch_bounds__(512, 2) fwd_megakernel(Args a_unused) {
    extern __shared__ __attribute__((aligned(16))) unsigned char lds_raw[];
    cg::grid_group grid = cg::this_grid();
    LAS unsigned char* lds = (LAS unsigned char*)lds_raw;
    const int G = gridDim.x, bx = blockIdx.x;
    const AS4 char* kp0 = (const AS4 char*)__builtin_amdgcn_kernarg_segment_ptr();
    const int ph_lo = *(const int AS4*)(kp0 + 256), ph_hi = *(const int AS4*)(kp0 + 260);
    XcdBarrier xbar;
    { unsigned* barw = (unsigned*)(*(unsigned char* const AS4*)(kp0 + 248) + WS_BAR);
      if (bx == 0) for (int i = threadIdx.x; i < XCD_BAR_WORDS; i += 512) barw[i] = 0u;
      if (threadIdx.x < 4) ((LAS unsigned*)(lds + MISC_OFF))[threadIdx.x] = 0u;
      asm volatile("s_waitcnt vmcnt(0)" ::: "memory"); __syncthreads();
      grid.sync();
      __builtin_amdgcn_fence(__ATOMIC_ACQUIRE, "agent"); asm volatile("s_waitcnt vmcnt(0)" ::: "memory");
      xbar = xcd_barrier_post(barw, (volatile LAS unsigned*)(lds + MISC_OFF)); }

#ifdef NANFILL
    { FRESH(); v4u q = {0xffffffffu, 0xffffffffu, 0xffffffffu, 0xffffffffu};
      for (size_t i = (size_t)bx * 512 + tid; i < WS_END / 16; i += (size_t)G * 512) ((v4u*)ws)[i] = q;
      for (size_t i = (size_t)bx * 512 + tid; i < (size_t)M * D / 4; i += (size_t)G * 512) ((v4u*)X)[i] = q;
      for (int i = tid; i < LDS_BYTES / 4; i += 512) ((LAS unsigned*)lds)[i] = 0xffffffffu; }
    GSYNC();
#endif
    for (int dup = 0; dup < 1 + DUP_P0; ++dup)
    if (ph_lo == 0) {
        FRESH();
        LAS float* scr = (LAS float*)(lds + wid * 16384);
        constexpr int I_GU = (D / 64) * (2 * DFF / 32), I_D = (DFF / 64) * (D / 32), I_G = (D / 64) * (D / 32), I_P = (PLE / 64) * (D / 32), I_IN0 = (D / 64) * (EVEN_IN / 32), I_IN1 = (D / 64) * (FOX_INP / 32);
        constexpr int NITEMS = 4 * I_GU + 4 * I_D + 2 * I_G + 2 * I_P + I_IN0 + I_IN1 + 2 * I_G;
        for (int it = gw; it < NITEMS; it += NGW) {
            int r = it;
#define MAT(cnt, W_, K_, N_, NP_, WT_, G_, MODE_) if (r < (cnt)) { conv_item((W_), (K_), (N_), (NP_), (bf16*)(WT_), (G_), (MODE_), scr, r, lane); continue; } r -= (cnt);
            MAT(I_GU, INP(3), D, 2 * DFF, 2 * DFF, ws + WS_WGU, INP(2), 1)
            MAT(I_GU, INP(7), D, 2 * DFF, 2 * DFF, ws + WS_WGU + 11 * MiB, INP(6), 1)
            MAT(I_GU, INP(3) + (size_t)D * 2 * DFF, D, 2 * DFF, 2 * DFF, ws + WS_WGU + 22 * MiB, INP(2) + D, 1)
            MAT(I_GU, INP(7) + (size_t)D * 2 * DFF, D, 2 * DFF, 2 * DFF, ws + WS_WGU + 33 * MiB, INP(6) + D, 1)
            MAT(I_D, INP(4), DFF, D, D, ws + WS_WD, nullptr, 0)
            MAT(I_D, INP(8), DFF, D, D, ws + WS_WD + (size_t)D * DFF * 2, nullptr, 0)
            MAT(I_D, INP(4) + (size_t)D * DFF, DFF, D, D, ws + WS_WD + (size_t)D * DFF * 4, nullptr, 0)
            MAT(I_D, INP(8) + (size_t)D * DFF, DFF, D, D, ws + WS_WD + (size_t)D * DFF * 6, nullptr, 0)
            MAT(I_G, INP(10), D, D, D, ws + WS_WG, INP(9), 0)
            MAT(I_G, INP(10) + (size_t)D * D, D, D, D, ws + WS_WG + 2 * MiB, INP(9) + D, 0)
            MAT(I_P, INP(11), PLE, D, D, ws + WS_WP, nullptr, 0)
            MAT(I_P, INP(11) + (size_t)PLE * D, PLE, D, D, ws + WS_WP + (size_t)PLE * D * 2, nullptr, 0)
            MAT(I_IN0, INP(12), D, EVEN_IN, EVEN_IN, ws + WS_WIN0, INP(5), 0)
            MAT(I_IN1, INP(26), D, FOX_IN, FOX_INP, ws + WS_WIN1, INP(5) + D, 0)
            MAT(I_G, INP(13), D, D, D, ws + WS_WOUT0, nullptr, 0)
            MAT(I_G, INP(28), D, D, D, ws + WS_WOUT1, nullptr, 0)
#undef MAT
        }
        const float* x_in = INP(0);
        for (int m = gw; m < M; m += NGW) { const f32x4* xr = (const f32x4*)(x_in + (size_t)m * D) + lane; f32x4 v[4]; float s = 0.f;
#pragma unroll
            for (int j = 0; j < 4; ++j) { v[j] = xr[64 * j]; s += (v[j][0] * v[j][0] + v[j][1] * v[j][1]) + (v[j][2] * v[j][2] + v[j][3] * v[j][3]); }
            s = wave_sum(s); if (lane < 16) ssq[(size_t)m * 16 + lane] = (lane == 0) ? s : 0.f;
            v2u* o = (v2u*)(XB + (size_t)m * D) + lane;
#pragma unroll
            for (int j = 0; j < 4; ++j) { v2u w; w.x = pk2(v[j][0], v[j][1]); w.y = pk2(v[j][2], v[j][3]); o[64 * j] = w; } }
        const float* g2 = INP(20);
        for (int i = bx * 512 + tid; i < 8192; i += G * 512) { const int ln = i & 63, ks = (i >> 6) & 7, nb = (i >> 9) & 1, hh = i >> 10; float f[8];
#pragma unroll
            for (int j = 0; j < 8; ++j) f[j] = g2[(size_t)(16 * ks + 8 * (ln >> 5) + j) * 512 + hh * 64 + 32 * nb + (ln & 31)];
            ((bf16x8*)(ws + WS_G2F))[i] = pack8(f); }
    }
    if (ph_lo == 0 && ph_hi > 1) GSYNC();

#define GEMM(EpiT, Aptr, Bptr, Nn, Kk, Eobj) do { pg8::Gemm g_{(const pg8::bf16_t*)(Aptr), (const pg8::bf16_t*)(Bptr), M, (Nn), (Kk)}; pg8::StaticOrder S_; S_.init(M, (Nn), G, bx); \
        pg8::gemm_phase<EpiT, pg8::StaticOrder, true, true>(lds, g_, S_, (Eobj), tid); } while (0)
#pragma unroll 1
    for (int L = 0; L < 2; ++L) {
#pragma unroll 1
        for (int st = 0; st < 9; ++st) {
            const int ph = 1 + 9 * L + st; if (ph < ph_lo || ph >= ph_hi) continue;
            switch (st) {
            case 0: case 6: {
#if PHM & 1
                FRESH();
                for (int dup = 0; dup < 1 + DUP_GU; ++dup) {
                const int f = (st == 6); pg8::EpiGU E{H, ssq + (size_t)((f ? 2 : 0) & 1) * M * 16};
                GEMM(pg8::EpiGU, (L == 1 && st == 0) ? Y : XB, ws + WS_WGU + (size_t)(L * 2 + f) * 11 * MiB, 2 * DFF, D, E);
                __syncthreads(); }
#endif
            } break;
            case 1: case 5: case 7: {
#if PHM & 2
                FRESH();
                const bf16* A; const bf16* Bt; int K; float alpha; float* so;
                if (st == 5) { A = (L == 0) ? Y : Qb; Bt = (const bf16*)(ws + (L == 0 ? WS_WOUT0 : WS_WOUT1)); K = D; alpha = 1.f; so = ssq; }
                else { const int f = (st == 7); A = H; Bt = (const bf16*)(ws + WS_WD + (size_t)(L * 2 + f) * D * DFF * 2); K = DFF; alpha = 0.5f; so = ssq + (size_t)M * 16; }
                pg8::EpiRes E{(L == 0 && st == 1) ? INP(0) : (const float*)X, X, XB, so, alpha};
                GEMM(pg8::EpiRes, A, Bt, D, K, E);
                if (st == 7) {
                    const f32x4* ps = (const f32x4*)(INP(1) + (size_t)L * M * PLE);
                    for (int i = bx * 512 + tid; i < M * PLE / 8; i += G * 512) { const f32x4 u0 = ps[2 * i], u1 = ps[2 * i + 1]; v4u w; w.x = pk2(u0[0], u0[1]); w.y = pk2(u0[2], u0[3]); w.z = pk2(u1[0], u1[1]); w.w = pk2(u1[2], u1[3]); ((v4u*)PB)[i] = w; }
                }
#endif
            } break;
            case 2: {
#if PHM & 4
                FRESH();
                pg8::EpiStore E{Qb, L ? D : EVEN_IN, ssq + (size_t)M * 16, QSCALE, L ? 4 : 2, L ? 4 : 1000, (size_t)M * D, -1, LF, INP(27)};
                for (int dup = 0; dup < 1 + DUP_INPROJ; ++dup) { GEMM(pg8::EpiStore, XB, ws + (L ? WS_WIN1 : WS_WIN0), L ? 3 * D : EVEN_IN, D, E); __syncthreads(); }
                if (L == 1) fox_gate_pass(XB, (const bf16*)(ws + WS_WIN1) + (size_t)3 * D * D, ssq + (size_t)M * 16, INP(27), LF, gw, NGW, lane);
#endif
            } break;
            case 3: {
                if (L == 0) {
#if PHM & 8
                    { FRESH();
#pragma unroll 1
                    for (int dup = 0; dup < 1 + DUP_SWA; ++dup)
                    for (int u = bx; u < 256; u += G) swa_unit(u, PROJ, Y, INP(14), lds, tid, lane, wid); }
#endif
#if PHM & 16
                    { FRESH();
#pragma unroll 1
                    for (int dup = 0; dup < 1 + DUP_SCAN; ++dup)
                    for (int u = bx; u < 256; u += G) rwkv_scan_unit(u, PROJ, YRAW, C3, INP(15), INP(16), INP(17), INP(18), INP(19), INP(21), INP(22), INP(23), lds, lane, wid); }
#endif
                } else {
#if PHM & 32
                    FRESH();
                    const int vcu = (G % 8 == 0) ? (bx % 8) * (G / 8) + bx / 8 : bx;
#pragma unroll 1
                    for (int v = vcu; v < 256; v += G)
#pragma unroll 1
                        for (int i = 0; i < 4; ++i) { int tid2 = tid; asm volatile("" : "+v"(tid2)); const int lane2 = tid2 & 63, wid2 = __builtin_amdgcn_readfirstlane(tid2 >> 6); const int s = v & 3, bh = v >> 2, qb = (i == 0) ? s : (i == 1) ? 7 - s : (i == 2) ? 8 + s : 15 - s;
                            if (i == 0) fox_prefix(LF + (size_t)(bh >> 4) * SEQ * 16 + (bh & 15), (LAS float*)(lds + 98304), (LAS float*)(lds + 98304 + 16384), tid2, lane2, wid2);
                            attn_body::attn_unit<60>(bh >> 4, bh & 15, qb, (const attn_body::bf16*)Qb, (const attn_body::bf16*)Kb, (const attn_body::bf16*)Vb, (attn_body::bf16*)Qb, (char*)lds_raw, (attn_body::lds_fptr)(lds + 98304), tid2); }
#endif
                }
            } break;
            case 4: {
#if PHM & 64
                if (L == 0) { FRESH();
#pragma unroll 1
                    for (int dup = 0; dup < 1 + DUP_POST; ++dup)
                    for (int t = bx; t < M / 32; t += G) rwkv_post_unit(t, PROJ, YRAW, C3, Y, INP(15), (const bf16*)(ws + WS_G2F), INP(24), INP(25), lane, wid); }
#endif
            } break;
            case 8: {
#if PHM & 128
                FRESH();
#pragma unroll 1
                for (int mode = 0; mode < 2; ++mode) {
                    pg8::EpiPle E{mode, X, Y, PP, ssq + (size_t)M * 16, ssq};
                    GEMM(pg8::EpiPle, mode ? XB : PB, mode ? ws + WS_WG + (size_t)L * 2 * MiB : ws + WS_WP + (size_t)L * PLE * D * 2, D, mode ? D : PLE, E);
                    __syncthreads();
                }
#endif
            } break;
            }
            if (!(L == 1 && st == 4) && ph + 1 < ph_hi) { GSYNC(); for (int dup = 0; dup < DUP_SYNC; ++dup) GSYNC(); }
        }
    }
#undef GEMM
    if (ph_hi == 20) { FRESH(); const float* fg = INP(29); const float* s8 = ssq;
        for (int m = gw; m < M; m += NGW) { f32x4* xr = (f32x4*)(X + (size_t)m * D) + lane; const float rs = pg8::rstd_of(s8, m);
#pragma unroll
            for (int j = 0; j < 4; ++j) { const f32x4 gv = ((const f32x4*)fg)[lane + 64 * j]; xr[64 * j] = xr[64 * j] * rs * gv; } } }
}

extern "C" void kernel_launch(void* const* d_in, const int* in_sizes, int n_in, void* d_out, int out_size, void* d_ws, size_t ws_size, hipStream_t stream) {
    static int grid = 0;
    if (grid == 0) {
        if (n_in != 30 || out_size != M * D || ws_size < WS_END) { fprintf(stderr, "kernel_launch: unexpected shapes (n_in %d out %d ws %zu)\n", n_in, out_size, ws_size); grid = -1; return; }
        int dev = 0, cus = 0, per_cu = 0;
        if (hipGetDevice(&dev) != hipSuccess || hipDeviceGetAttribute(&cus, hipDeviceAttributeMultiprocessorCount, dev) != hipSuccess) { grid = -1; return; }
        if (hipFuncSetAttribute((const void*)fwd_megakernel, hipFuncAttributeMaxDynamicSharedMemorySize, LDS_BYTES) != hipSuccess) { fprintf(stderr, "kernel_launch: hipFuncSetAttribute failed\n"); grid = -1; return; }
        if (hipOccupancyMaxActiveBlocksPerMultiprocessor(&per_cu, (const void*)fwd_megakernel, 512, LDS_BYTES) != hipSuccess || per_cu < 1) { fprintf(stderr, "kernel_launch: occupancy query failed (%d)\n", per_cu); (void)hipGetLastError(); grid = -1; return; }
        grid = cus * per_cu;
        if (grid > 256) grid = 256;
    }
    if (grid < 0) return;
    Args a{};
    for (int i = 0; i < 30; ++i) a.in[i] = (const float*)d_in[i];
    a.out = (float*)d_out; a.ws = (unsigned char*)d_ws;
#ifndef N_LAUNCH_PER_PHASE
    a.ph_lo = 0; a.ph_hi = 20;
    { void* args[] = {&a};
      hipError_t e = hipLaunchCooperativeKernel((const void*)fwd_megakernel, dim3(grid), dim3(512), args, LDS_BYTES, stream);
      if (e != hipSuccess) fprintf(stderr, "cooperative launch failed: %s (grid %d)\n", hipGetErrorString(e), grid); }
#else
    for (int ph = 0; ph < 20; ++ph) { if (ph == 14) continue; a.ph_lo = ph; a.ph_hi = ph + 1; void* args[] = {&a};
      hipError_t e = hipLaunchCooperativeKernel((const void*)fwd_megakernel, dim3(grid), dim3(512), args, LDS_BYTES, stream);
      if (e != hipSuccess) { fprintf(stderr, "cooperative launch failed: %s (grid %d)\n", hipGetErrorString(e), grid); break; } }
#endif
}
```

```cpp
#include <hip/hip_runtime.h>
#include <hip/hip_cooperative_groups.h>
#include <hip/hip_bf16.h>
#include <cstdio>
#include <cstdint>
#include <cmath>
namespace cg = cooperative_groups;
#ifndef PHM
#define PHM 255
#endif
namespace pg8 {
#define PG8_LAS __attribute__((address_space(3)))
typedef unsigned short bf16_t;
typedef short bf16x8 __attribute__((ext_vector_type(8)));
typedef float f32x4 __attribute__((ext_vector_type(4)));
typedef unsigned u32x4 __attribute__((ext_vector_type(4)));
constexpr int BM = 256, BK = 64, HALF = 128, HTB = HALF * BK * 2  , STAGE_BYTES = 8 * HTB, NXCD = 8, WGM = 8;

__host__ __device__ __forceinline__ int lds_byte(int r, int c) { const int st = (r >> 4) * 2 + (c >> 5), rr = r & 15, cc = c & 31, ob = rr * 64 + cc * 2; return st * 1024 + (ob ^ (((ob >> 9) & 1) << 5)); }
__host__ __device__ __forceinline__ void stage_rc(int b, int& R, int& C) { const int st = b / 1024, sb = b % 1024, swz = sb ^ (((sb >> 9) & 1) << 5); R = (st >> 1) * 16 + swz / 64; C = (st & 1) * 32 + (swz % 64) / 2; }
__host__ __device__ __forceinline__ int perm32(int rho) { const int n = rho >> 4, i = rho & 15; return 8 * (i >> 2) + 4 * n + (i & 3); }

struct Unit { int pm, pn; };
struct Gemm { const bf16_t* A; const bf16_t* Bt; int M, N, K; };

struct StaticOrder {
    int nM, nN, nwg, G, c;
    __host__ __device__ void init(int M, int N, int G_, int c_) { nM = M / BM; nN = N / BM; nwg = nM * nN; G = G_; c = c_; }
    __host__ __device__ bool next(int i, Unit& u) const {
        const long L = (long)i * G + c; if (L >= nwg) return false;
        int wgid = (int)L; { const int q = nwg / NXCD, r = nwg % NXCD, xcd = wgid % NXCD, off = wgid / NXCD; wgid = (xcd < r ? xcd * (q + 1) : r * (q + 1) + (xcd - r) * q) + off; }
        const int nig = WGM * nN, gid = wgid / nig, fm = gid * WGM, gsz = (nM - fm) < WGM ? (nM - fm) : WGM;
        u.pm = fm + ((wgid % nig) % gsz); u.pn = (wgid % nig) / gsz; return true;
    }
    __device__ __forceinline__ void a_ready(const Unit&) const {}
    __device__ __forceinline__ void done(const Unit&) const {}
};

typedef float f32x2_c __attribute__((ext_vector_type(2))); typedef __bf16 bf16x2_c __attribute__((ext_vector_type(2)));
__device__ __forceinline__ unsigned cvt_pk_bf16(float lo, float hi) { f32x2_c v = {lo, hi}; bf16x2_c b = __builtin_convertvector(v, bf16x2_c); return __builtin_bit_cast(unsigned, b); }
typedef float f32x2 __attribute__((ext_vector_type(2)));
constexpr float NORM_EPS = 1e-6f;
__device__ __forceinline__ float ssq_sum(const float* ssq, int row) { const f32x4* p = (const f32x4*)(ssq + (size_t)row * 16); const f32x4 a = p[0], b = p[1], c = p[2], d = p[3];
    return ((a[0] + a[1]) + (a[2] + a[3])) + ((b[0] + b[1]) + (b[2] + b[3])) + (((c[0] + c[1]) + (c[2] + c[3])) + ((d[0] + d[1]) + (d[2] + d[3]))); }
__device__ __forceinline__ float rstd_of(const float* ssq, int row) { return rsqrtf(ssq_sum(ssq, row) * (1.0f / 1024.0f) + NORM_EPS); }
__device__ __forceinline__ float sigm(float x) { return __builtin_amdgcn_rcpf(1.0f + __expf(-x)); }
struct EpiGU { static constexpr bool PERM = true, AFTER_DRAIN = false;
    bf16_t* H; const float* ssq;
    __device__ __forceinline__ void operator()(const f32x4 (&acc)[2][2][4][2], const Unit& u, int wr, int wc, int fr, int fq) const {
        int row0 = u.pm * BM + wr * 64 + fr; asm volatile("" : "+v"(row0)); const int col0 = u.pn * 128 + wc * 32 + 8 * fq;
#pragma unroll
        for (int ai = 0; ai < 2; ++ai)
#pragma unroll
            for (int m = 0; m < 4; ++m) { const int row = row0 + ai * HALF + m * 16; const float rs = rstd_of(ssq, row);
                const f32x4 g0 = acc[ai][0][m][0] * rs, g1 = acc[ai][0][m][1] * rs, u0 = acc[ai][1][m][0] * rs, u1 = acc[ai][1][m][1] * rs;
                u32x4 w;
                w.x = cvt_pk_bf16(g0[0] * sigm(g0[0]) * u0[0], g0[1] * sigm(g0[1]) * u0[1]); w.y = cvt_pk_bf16(g0[2] * sigm(g0[2]) * u0[2], g0[3] * sigm(g0[3]) * u0[3]);
                w.z = cvt_pk_bf16(g1[0] * sigm(g1[0]) * u1[0], g1[1] * sigm(g1[1]) * u1[1]); w.w = cvt_pk_bf16(g1[2] * sigm(g1[2]) * u1[2], g1[3] * sigm(g1[3]) * u1[3]);
                *(u32x4*)(H + (size_t)row * 2816 + col0) = w; }
    }
};
struct EpiRes { static constexpr bool PERM = true, AFTER_DRAIN = false;
    const float* base; float* X; bf16_t* XB; float* ssq_out; float alpha;
    __device__ __forceinline__ void operator()(const f32x4 (&acc)[2][2][4][2], const Unit& u, int wr, int wc, int fr, int fq) const {
        int row0 = u.pm * BM + wr * 64 + fr; asm volatile("" : "+v"(row0)); const int col0 = u.pn * BM + wc * 32 + 8 * fq;
#pragma unroll
        for (int ai = 0; ai < 2; ++ai)
#pragma unroll
            for (int m = 0; m < 4; ++m) { const int row = row0 + ai * HALF + m * 16; float part = 0.f;
#pragma unroll
                for (int bj = 0; bj < 2; ++bj) { const size_t off = (size_t)row * 1024 + col0 + bj * HALF;
                    const f32x4 b0 = *(const f32x4*)(base + off), b1 = *(const f32x4*)(base + off + 4);
                    const f32x4 v0 = b0 + acc[ai][bj][m][0] * alpha, v1 = b1 + acc[ai][bj][m][1] * alpha;
                    *(f32x4*)(X + off) = v0; *(f32x4*)(X + off + 4) = v1;
                    u32x4 w; w.x = cvt_pk_bf16(v0[0], v0[1]); w.y = cvt_pk_bf16(v0[2], v0[3]); w.z = cvt_pk_bf16(v1[0], v1[1]); w.w = cvt_pk_bf16(v1[2], v1[3]);
                    *(u32x4*)(XB + off) = w;
                    part += (v0[0] * v0[0] + v0[1] * v0[1]) + (v0[2] * v0[2] + v0[3] * v0[3]) + (v1[0] * v1[0] + v1[1] * v1[1]) + (v1[2] * v1[2] + v1[3] * v1[3]); }
                part += __shfl_xor(part, 16); part += __shfl_xor(part, 32);
                if (fq == 0) ssq_out[(size_t)row * 16 + u.pn * 4 + wc] = part; }
    }
};
struct EpiPle { static constexpr bool PERM = true, AFTER_DRAIN = false;
    int mode; float* X; bf16_t* XB; bf16_t* PP; const float* ssq_in; float* ssq_out;
    __device__ __forceinline__ void operator()(const f32x4 (&acc)[2][2][4][2], const Unit& u, int wr, int wc, int fr, int fq) const {
        int row0 = u.pm * BM + wr * 64 + fr; asm volatile("" : "+v"(row0)); const int col0 = u.pn * BM + wc * 32 + 8 * fq;
#pragma unroll
        for (int ai = 0; ai < 2; ++ai)
#pragma unroll
            for (int m = 0; m < 4; ++m) { const int row = row0 + ai * HALF + m * 16; float part = 0.f; const float rs = mode ? rstd_of(ssq_in, row) : 1.f;
#pragma unroll
                for (int bj = 0; bj < 2; ++bj) { const size_t off = (size_t)row * 1024 + col0 + bj * HALF;
                    if (mode == 0) { const f32x4 v0 = acc[ai][bj][m][0], v1 = acc[ai][bj][m][1];
                        u32x4 w; w.x = cvt_pk_bf16(v0[0], v0[1]); w.y = cvt_pk_bf16(v0[2], v0[3]); w.z = cvt_pk_bf16(v1[0], v1[1]); w.w = cvt_pk_bf16(v1[2], v1[3]);
                        *(u32x4*)(PP + off) = w;
                    } else {
                        const u32x4 pw = *(const u32x4*)(PP + off);
                        const f32x4 p0 = {__uint_as_float(pw.x << 16), __uint_as_float(pw.x & 0xffff0000u), __uint_as_float(pw.y << 16), __uint_as_float(pw.y & 0xffff0000u)};
                        const f32x4 p1 = {__uint_as_float(pw.z << 16), __uint_as_float(pw.z & 0xffff0000u), __uint_as_float(pw.w << 16), __uint_as_float(pw.w & 0xffff0000u)};
                        const f32x4 b0 = *(const f32x4*)(X + off), b1 = *(const f32x4*)(X + off + 4);
                        const f32x4 a0 = acc[ai][bj][m][0] * rs, a1 = acc[ai][bj][m][1] * rs;
                        f32x4 v0, v1;
#pragma unroll
                        for (int j = 0; j < 4; ++j) { v0[j] = b0[j] + sigm(a0[j]) * p0[j]; v1[j] = b1[j] + sigm(a1[j]) * p1[j]; }
                        *(f32x4*)(X + off) = v0; *(f32x4*)(X + off + 4) = v1;
                        u32x4 w; w.x = cvt_pk_bf16(v0[0], v0[1]); w.y = cvt_pk_bf16(v0[2], v0[3]); w.z = cvt_pk_bf16(v1[0], v1[1]); w.w = cvt_pk_bf16(v1[2], v1[3]);
                        *(u32x4*)(XB + off) = w;
                        part += (v0[0] * v0[0] + v0[1] * v0[1]) + (v0[2] * v0[2] + v0[3] * v0[3]) + (v1[0] * v1[0] + v1[1] * v1[1]) + (v1[2] * v1[2] + v1[3] * v1[3]); } }
                if (mode) { part += __shfl_xor(part, 16); part += __shfl_xor(part, 32); if (fq == 0) ssq_out[(size_t)row * 16 + u.pn * 4 + wc] = part; } }
    }
};
struct EpiStore { static constexpr bool PERM = true, AFTER_DRAIN = false;
    bf16_t* O; int ldc; const float* ssq; float scale0; int scale_tiles; int split_tiles; size_t split_stride; int lf_tile; float* LF; const float* bfv;
    __device__ __forceinline__ void operator()(const f32x4 (&acc)[2][2][4][2], const Unit& u, int wr, int wc, int fr, int fq) const {
        int row0 = u.pm * BM + wr * 64 + fr; asm volatile("" : "+v"(row0));
        if (u.pn == lf_tile) {
            if (wc == 0 && fq < 2) {
#pragma unroll
                for (int ai = 0; ai < 2; ++ai)
#pragma unroll
                    for (int m = 0; m < 4; ++m) { const int row = row0 + ai * HALF + m * 16; const float rs = rstd_of(ssq, row);
#pragma unroll
                        for (int n = 0; n < 2; ++n) { f32x4 o;
#pragma unroll
                            for (int j = 0; j < 4; ++j) { const float z = fmaxf(acc[ai][0][m][n][j] * rs + bfv[8 * fq + 4 * n + j], -80.f), e = __expf(-z);
                                o[j] = (e < 0.01f) ? -(e - 0.5f * e * e + e * e * e * (1.f / 3.f)) : -__logf(1.f + e); }
                            *(f32x4*)(LF + (size_t)row * 16 + 8 * fq + 4 * n) = o; } }
            }
            return;
        }
        const int t = u.pn / split_tiles, ct = u.pn - t * split_tiles;
        bf16_t* base = O + (size_t)t * split_stride; const float sc = (u.pn < scale_tiles) ? scale0 : 1.f;
        const int col0 = ct * BM + wc * 32 + 8 * fq;
#pragma unroll
        for (int ai = 0; ai < 2; ++ai)
#pragma unroll
            for (int m = 0; m < 4; ++m) { const int row = row0 + ai * HALF + m * 16; const float rs = rstd_of(ssq, row) * sc;
#pragma unroll
                for (int bj = 0; bj < 2; ++bj) { const f32x4 v0 = acc[ai][bj][m][0] * rs, v1 = acc[ai][bj][m][1] * rs;
                    u32x4 w; w.x = cvt_pk_bf16(v0[0], v0[1]); w.y = cvt_pk_bf16(v0[2], v0[3]); w.z = cvt_pk_bf16(v1[0], v1[1]); w.w = cvt_pk_bf16(v1[2], v1[3]);
                    *(u32x4*)(base + (size_t)row * ldc + col0 + bj * HALF) = w; } }
    }
};

template <class Epi, class Sched, bool ALIGN_EPI = false, bool SP2 = false>
__device__ __forceinline__ void gemm_phase(PG8_LAS unsigned char* lds, const Gemm g, const Sched& S, const Epi& E, const int tid) {
    const int wid = __builtin_amdgcn_readfirstlane(tid >> 6), lane = tid & 63, wr = wid >> 2, wc = wid & 3, fr = lane & 15, fq = lane >> 4;
    const int K = g.K, nt = K / BK;
    unsigned voffA[2], voffB[2];
#pragma unroll
    for (int i = 0; i < 2; ++i) { int R, C; stage_rc(tid * 16 + i * 8192, R, C); const int Rb = Epi::PERM ? ((R & ~31) + perm32(R & 31)) : R;
        voffA[i] = (unsigned)(R * K + C) * 2u; voffB[i] = (unsigned)(Rb * K + C) * 2u; }
    const size_t kstep = (size_t)(BK * 2);
    const size_t hstep = (size_t)HALF * K * 2;
    const size_t tstep = 2 * hstep;
    const unsigned ldsw = (unsigned)wid * 1024u;
    const int aoff = lds_byte(wr * 64 + fr, fq * 8), boff = lds_byte(wc * 32 + fr, fq * 8);
#define PG8_SA(b, h) (((b) * 2 + (h)) * HTB)
#define PG8_SB(b, h) ((4 + (b) * 2 + (h)) * HTB)
#define PG8_STAGE(bufoff, gbase, voff) do { _Pragma("unroll") for (int _i = 0; _i < 2; ++_i) \
        __builtin_amdgcn_global_load_lds((const unsigned*)((const char*)(gbase) + (voff)[_i]), (PG8_LAS unsigned*)(lds + (bufoff) + ldsw + _i * 8192), 16, 0, 0); } while (0)
#define PG8_LDA(dst, b, h) do { _Pragma("unroll") for (int m = 0; m < 4; ++m) _Pragma("unroll") for (int k = 0; k < 2; ++k) dst[m][k] = *(const PG8_LAS bf16x8*)(lds + PG8_SA(b, h) + aoff + m * 2048 + k * 1024); } while (0)
#define PG8_LDB(dst, b, h) do { _Pragma("unroll") for (int n = 0; n < 2; ++n) _Pragma("unroll") for (int k = 0; k < 2; ++k) dst[n][k] = *(const PG8_LAS bf16x8*)(lds + PG8_SB(b, h) + boff + n * 2048 + k * 1024); } while (0)
#define PG8_MMA(ai, bj, At, Bt) do { __builtin_amdgcn_s_setprio(1); _Pragma("unroll") for (int m = 0; m < 4; ++m) _Pragma("unroll") for (int n = 0; n < 2; ++n) _Pragma("unroll") for (int k = 0; k < 2; ++k) \
        acc[ai][bj][m][n] = __builtin_amdgcn_mfma_f32_16x16x32_bf16(Bt[n][k], At[m][k], acc[ai][bj][m][n], 0, 0, 0); __builtin_amdgcn_s_setprio(0); } while (0)
#define PG8_WAIT_V(n) asm volatile("s_waitcnt vmcnt(" #n ")" ::: "memory")
#define PG8_WAIT_L(n) asm volatile("s_waitcnt lgkmcnt(" #n ")" ::: "memory")
#define PG8_BAR __builtin_amdgcn_s_barrier()
#define PG8_SCHED __builtin_amdgcn_sched_barrier(0)
    Unit cur, nxt; int ui = 0;
    if (!S.next(0, cur)) return;
    f32x4 acc[2][2][4][2];
#pragma unroll
    for (int a = 0; a < 2; ++a)
#pragma unroll
        for (int b = 0; b < 2; ++b)
#pragma unroll
            for (int m = 0; m < 4; ++m)
#pragma unroll
                for (int n = 0; n < 2; ++n) acc[a][b][m][n] = (f32x4){0.f, 0.f, 0.f, 0.f};
    bf16x8 At[4][2], B0[2][2], B1[2][2];
    const char* cA = (const char*)g.A + (size_t)cur.pm * tstep; const char* cB = (const char*)g.Bt + (size_t)cur.pn * tstep;
    S.a_ready(cur);
    if constexpr (SP2) {
        PG8_STAGE(PG8_SB(0, 0), cB, voffB); PG8_STAGE(PG8_SB(0, 1), cB + hstep, voffB); PG8_STAGE(PG8_SA(0, 0), cA, voffA); PG8_STAGE(PG8_SA(0, 1), cA + hstep, voffA);
        if (wr == 1) PG8_BAR;
        PG8_WAIT_V(2); PG8_BAR;
        PG8_STAGE(PG8_SB(1, 0), cB + kstep, voffB); PG8_STAGE(PG8_SA(1, 0), cA + kstep, voffA); PG8_STAGE(PG8_SB(1, 1), cB + hstep + kstep, voffB);
        PG8_WAIT_V(6); PG8_BAR;
    } else {
        PG8_STAGE(PG8_SB(0, 0), cB, voffB); PG8_STAGE(PG8_SA(0, 0), cA, voffA); PG8_STAGE(PG8_SB(0, 1), cB + hstep, voffB); PG8_STAGE(PG8_SA(0, 1), cA + hstep, voffA);
        if (wr == 1) PG8_BAR;
        PG8_WAIT_V(4); PG8_BAR;
        PG8_STAGE(PG8_SB(1, 0), cB + kstep, voffB); PG8_STAGE(PG8_SA(1, 0), cA + kstep, voffA); PG8_STAGE(PG8_SB(1, 1), cB + hstep + kstep, voffB);
        PG8_WAIT_V(6); PG8_BAR;
    }
    for (;;) {
        const bool has_next = S.next(ui + 1, nxt);
        const char* nA = has_next ? (const char*)g.A + (size_t)nxt.pm * tstep : cA; const char* nB = has_next ? (const char*)g.Bt + (size_t)nxt.pn * tstep : cB;
        for (int t = 0; t < nt; t += 2) {
            const bool last = (t == nt - 2);
            const char* a1 = cA + (size_t)(t + 1) * kstep;
            const char* a2 = last ? nA : cA + (size_t)(t + 2) * kstep; const char* b2 = last ? nB : cB + (size_t)(t + 2) * kstep;
            const char* a3 = a2 + kstep; const char* b3 = b2 + kstep;
            if (last && has_next) S.a_ready(nxt);
            if constexpr (SP2) {
            PG8_LDB(B0, 0, 0); PG8_LDB(B1, 0, 1); PG8_SCHED; PG8_LDA(At, 0, 0); PG8_STAGE(PG8_SA(1, 1), a1 + hstep, voffA);
            PG8_WAIT_V(8); PG8_WAIT_L(0); PG8_BAR; PG8_MMA(0, 0, At, B0); PG8_MMA(0, 1, At, B1); PG8_BAR; PG8_SCHED;
            PG8_LDA(At, 0, 1); PG8_STAGE(PG8_SB(0, 0), b2, voffB); PG8_STAGE(PG8_SB(0, 1), b2 + hstep, voffB); PG8_STAGE(PG8_SA(0, 0), a2, voffA);
            PG8_WAIT_V(8); PG8_WAIT_L(0); PG8_BAR; PG8_MMA(1, 0, At, B0); PG8_MMA(1, 1, At, B1); PG8_BAR; PG8_SCHED;
            PG8_LDB(B0, 1, 0); PG8_LDB(B1, 1, 1); PG8_SCHED; PG8_LDA(At, 1, 0); PG8_STAGE(PG8_SA(0, 1), a2 + hstep, voffA);
            PG8_WAIT_V(8); PG8_WAIT_L(0); PG8_BAR; PG8_MMA(0, 0, At, B0); PG8_MMA(0, 1, At, B1); PG8_BAR; PG8_SCHED;
            PG8_LDA(At, 1, 1); PG8_STAGE(PG8_SB(1, 0), b3, voffB); PG8_STAGE(PG8_SB(1, 1), b3 + hstep, voffB); PG8_STAGE(PG8_SA(1, 0), a3, voffA);
            PG8_WAIT_V(8); PG8_WAIT_L(0); PG8_BAR; PG8_MMA(1, 0, At, B0); PG8_MMA(1, 1, At, B1); PG8_BAR; PG8_SCHED;
            } else {
            PG8_LDB(B0, 0, 0); PG8_SCHED; PG8_LDA(At, 0, 0); PG8_STAGE(PG8_SA(1, 1), a1 + hstep, voffA);
            PG8_WAIT_L(8); PG8_BAR; PG8_WAIT_L(0); PG8_MMA(0, 0, At, B0); PG8_BAR; PG8_SCHED;
            PG8_LDB(B1, 0, 1); PG8_STAGE(PG8_SB(0, 0), b2, voffB);
            PG8_BAR; PG8_WAIT_L(0); PG8_MMA(0, 1, At, B1); PG8_BAR;
            PG8_LDA(At, 0, 1); PG8_STAGE(PG8_SA(0, 0), a2, voffA);
            PG8_BAR; PG8_WAIT_L(0); PG8_MMA(1, 0, At, B0); PG8_BAR; PG8_SCHED;
            PG8_STAGE(PG8_SB(0, 1), b2 + hstep, voffB);
            PG8_WAIT_V(6); PG8_BAR; PG8_MMA(1, 1, At, B1); PG8_BAR;
            PG8_LDB(B0, 1, 0); PG8_SCHED; PG8_LDA(At, 1, 0); PG8_STAGE(PG8_SA(0, 1), a2 + hstep, voffA);
            PG8_WAIT_L(8); PG8_BAR; PG8_WAIT_L(0); PG8_MMA(0, 0, At, B0); PG8_BAR; PG8_SCHED;
            PG8_LDB(B1, 1, 1); PG8_STAGE(PG8_SB(1, 0), b3, voffB);
            PG8_BAR; PG8_WAIT_L(0); PG8_MMA(0, 1, At, B1); PG8_BAR;
            PG8_LDA(At, 1, 1); PG8_STAGE(PG8_SA(1, 0), a3, voffA);
            PG8_BAR; PG8_WAIT_L(0); PG8_MMA(1, 0, At, B0); PG8_BAR; PG8_SCHED;
            PG8_STAGE(PG8_SB(1, 1), b3 + hstep, voffB);
            PG8_WAIT_V(6); PG8_BAR; PG8_MMA(1, 1, At, B1); PG8_BAR;
            }
        }
        if constexpr (ALIGN_EPI) { if (wr == 0) PG8_BAR; }
        if constexpr (!Epi::AFTER_DRAIN) { E(acc, cur, wr, wc, fr, fq); S.done(cur); }
        if (!has_next) break;
#pragma unroll
        for (int a = 0; a < 2; ++a)
#pragma unroll
            for (int b = 0; b < 2; ++b)
#pragma unroll
                for (int m = 0; m < 4; ++m)
#pragma unroll
                    for (int n = 0; n < 2; ++n) acc[a][b][m][n] = (f32x4){0.f, 0.f, 0.f, 0.f};
        cur = nxt; cA = nA; cB = nB; ++ui;
        if constexpr (ALIGN_EPI) { if (wr == 1) PG8_BAR; }
    }
    PG8_WAIT_V(0);
    if constexpr (!ALIGN_EPI) { if (wr == 0) PG8_BAR; }
    PG8_BAR;
    if constexpr (Epi::AFTER_DRAIN) { E.fused(acc, cur, wr, wc, fr, fq, lds, wid, lane); S.done(cur); }
#undef PG8_SA
#undef PG8_SB
#undef PG8_STAGE
#undef PG8_LDA
#undef PG8_LDB
#undef PG8_MMA
#undef PG8_WAIT_V
#undef PG8_WAIT_L
#undef PG8_BAR
#undef PG8_SCHED
}
}
#include <hip/hip_bf16.h>
#include <cmath>
namespace attn_body {
using bf16=__hip_bfloat16;
using bf16x8=__attribute__((ext_vector_type(8)))short;
using s16x4=__attribute__((ext_vector_type(4)))short;
using f32x16=__attribute__((ext_vector_type(16)))float;
using u32x4=__attribute__((ext_vector_type(4)))unsigned;
constexpr int BATCH=4,NHEAD=16,SEQ=4096,D=64,DM=NHEAD*D;
constexpr int NW=8,QBLK=32,QB=QBLK*NW,KVBLK=64,NQB=SEQ/QB;
constexpr int ATTN_PITCH=DM, ATTN_UNIT_ROWS=QB;
__device__ __forceinline__ int crow(int r,int hi){return (r&3)+8*(r>>2)+4*hi;}
#define SBAR() __builtin_amdgcn_sched_barrier(0)
__device__ __forceinline__ void cmask(f32x16&p0,f32x16&p1,int jb,int qrel,int hi){
  const float NEG=-INFINITY; int kb=64*jb+4*hi;
  #pragma unroll
  for(int r=0;r<16;++r){int kv=kb+(r&3)+8*(r>>2); if(kv>qrel)p0[r]=NEG; if(kv+32>qrel)p1[r]=NEG;}
}

constexpr int NSLOT=3, SLOTB=8192;
constexpr int LDS_K=0, LDS_V=NSLOT*SLOTB, LDS_WS=2*NSLOT*SLOTB, LDS_OST=LDS_WS+NW*64*4, LDS_BYTES=LDS_OST+NW*4096;
constexpr float C2=0.125f*1.4426950408889634f;
__device__ __forceinline__ void glds16(const void*gsrc,unsigned lds_dst){unsigned keep;
  asm volatile("s_mov_b32 %0, m0\n\ts_mov_b32 m0, %2\n\ts_nop 0\n\tglobal_load_lds_dwordx4 %1, off\n\ts_mov_b32 m0, %0":"=&s"(keep):"v"(gsrc),"s"(lds_dst):"memory");}
__device__ __forceinline__ float max3f(float a,float b,float c){float r;asm("v_max3_f32 %0, %1, %2, %3":"=v"(r):"v"(a),"v"(b),"v"(c));return r;}
__device__ __forceinline__ float max2f(float a,float b){float r;asm("v_max_f32_e32 %0, %1, %2":"=v"(r):"v"(a),"v"(b));return r;}
__device__ __forceinline__ float fadd_s(float a,float b){float r;asm("v_add_f32_e32 %0, %1, %2":"=v"(r):"v"(a),"v"(b));return r;}
__device__ __forceinline__ float fsub_s(float a,float b){float r;asm("v_sub_f32_e32 %0, %1, %2":"=v"(r):"v"(a),"v"(b));return r;}
typedef float f32x2_t __attribute__((ext_vector_type(2))); typedef __bf16 bf16x2_t __attribute__((ext_vector_type(2)));
__device__ __forceinline__ unsigned cvtpk_s(float lo,float hi){f32x2_t v={lo,hi};bf16x2_t b=__builtin_convertvector(v,bf16x2_t);return __builtin_bit_cast(unsigned,b);}
#define WAIT_BAR(N) asm volatile("s_waitcnt vmcnt(" #N ") lgkmcnt(0)\n\ts_barrier":::"memory")

__device__ __forceinline__ void qkt(f32x16&p0,f32x16&p1,const char*Kslot,const bf16x8*qr,int r32,int hi){
  const char*kb=Kslot+hi*1024+r32*16;
  #pragma unroll
  for(int d0=0;d0<4;++d0){
    const bf16x8 b0=*reinterpret_cast<const bf16x8*>(kb+d0*2048);
    const bf16x8 b1=*reinterpret_cast<const bf16x8*>(kb+d0*2048+512);
    {p0=__builtin_amdgcn_mfma_f32_32x32x16_bf16(b0,qr[d0],p0,0,0,0);p1=__builtin_amdgcn_mfma_f32_32x32x16_bf16(b1,qr[d0],p1,0,0,0);}}
}
typedef __attribute__((address_space(3))) const char* lds_cptr;
typedef short v4i16_t __attribute__((ext_vector_type(4)));
__device__ __forceinline__ void kload8(bf16x8*kf,lds_cptr kp){
  kf[0]=*(const __attribute__((address_space(3))) bf16x8*)(kp);      kf[1]=*(const __attribute__((address_space(3))) bf16x8*)(kp+512);
  kf[2]=*(const __attribute__((address_space(3))) bf16x8*)(kp+2048); kf[3]=*(const __attribute__((address_space(3))) bf16x8*)(kp+2560);
  kf[4]=*(const __attribute__((address_space(3))) bf16x8*)(kp+4096); kf[5]=*(const __attribute__((address_space(3))) bf16x8*)(kp+4608);
  kf[6]=*(const __attribute__((address_space(3))) bf16x8*)(kp+6144); kf[7]=*(const __attribute__((address_space(3))) bf16x8*)(kp+6656);
}
__device__ __forceinline__ void kload2(bf16x8*kf,lds_cptr kp,int j){ kf[2*j]=*(const __attribute__((address_space(3))) bf16x8*)(kp+j*2048); kf[2*j+1]=*(const __attribute__((address_space(3))) bf16x8*)(kp+j*2048+512); }
__device__ __forceinline__ s16x4 vtr(lds_cptr p){ return __builtin_bit_cast(s16x4,__builtin_amdgcn_ds_read_tr16_b64_v4i16((__attribute__((address_space(3))) v4i16_t*)p)); }
__device__ __forceinline__ float rowmax(const f32x16&p0,const f32x16&p1){
  float a=max3f(p0[0],p0[1],p1[0]),b=max3f(p0[2],p0[3],p1[1]);a=max3f(a,p1[2],p1[3]);
  #pragma unroll
  for(int r=4;r<16;r+=4){a=max3f(a,p0[r],p0[r+1]);b=max3f(b,p0[r+2],p0[r+3]);a=max3f(a,p1[r],p1[r+1]);b=max3f(b,p1[r+2],p1[r+3]);}
  const float m=max2f(a,b);
  auto rr=__builtin_amdgcn_permlane32_swap(__float_as_uint(m),__float_as_uint(m),false,false);
  return max2f(__uint_as_float(rr[0]),__uint_as_float(rr[1]));
}
__device__ __forceinline__ void pv(f32x16*o,int vb,bf16x8 pa0,bf16x8 pa1,bf16x8 pa2,bf16x8 pa3){
  #pragma unroll
  for(int d0=0;d0<2;++d0){s16x4 lo[4],hi[4];
    #pragma unroll
    for(int ks=0;ks<4;++ks){
      asm volatile("ds_read_b64_tr_b16 %0,%1 offset:%c2":"=&v"(lo[ks]):"v"(vb),"i"(d0*4096+ks*1024):"memory");
      asm volatile("ds_read_b64_tr_b16 %0,%1 offset:%c2":"=&v"(hi[ks]):"v"(vb),"i"(d0*4096+ks*1024+512):"memory");}
    asm volatile("s_waitcnt lgkmcnt(0)":::"memory");SBAR();
    #define PK(k) (bf16x8){lo[k][0],lo[k][1],lo[k][2],lo[k][3],hi[k][0],hi[k][1],hi[k][2],hi[k][3]}
    o[d0]=__builtin_amdgcn_mfma_f32_32x32x16_bf16(pa0,PK(0),o[d0],0,0,0);
    o[d0]=__builtin_amdgcn_mfma_f32_32x32x16_bf16(pa1,PK(1),o[d0],0,0,0);
    o[d0]=__builtin_amdgcn_mfma_f32_32x32x16_bf16(pa2,PK(2),o[d0],0,0,0);
    o[d0]=__builtin_amdgcn_mfma_f32_32x32x16_bf16(pa3,PK(3),o[d0],0,0,0);
    #undef PK
  }
}

#ifndef ATTN_STORE16
#define ATTN_STORE16(p,v) (*(u32x4*)(p)=(v))
#endif
typedef float f32x4b __attribute__((ext_vector_type(4)));
typedef __attribute__((address_space(3))) const float* lds_fptr;
typedef __attribute__((address_space(3))) const f32x4b* lds_f4ptr;
template<int THRL> __device__ __forceinline__ void attn_unit(int b,int h,int qb,const bf16*Q,const bf16*__restrict__ K,const bf16*__restrict__ V,bf16*O,char*shm,lds_fptr cs,const int tid){
  const int lane=tid&63,r32=lane&31,hi=lane>>5; const int wid=__builtin_amdgcn_readfirstlane(tid>>6);
  const long rowbase=(long)b*SEQ; const int q0=qb*QB;
  const bf16*Qw=Q+(rowbase+q0+wid*QBLK)*DM+h*D;
  const bf16*Kh=K+rowbase*DM+h*D,*Vh=V+rowbase*DM+h*D;
  const unsigned lds0=(unsigned)(uintptr_t)shm;
  float*wsf=(float*)(shm+LDS_WS)+wid*64;
  const bf16*ksrc=Kh+(long)lane*DM+wid*8;
  const bf16*vsrc=Vh+(long)(16*(wid&3)+(lane>>2))*DM+(wid>>2)*32+(lane&3)*8;
  const unsigned kdst=lds0+LDS_K+wid*1024, vdst=lds0+LDS_V+wid*1024;
  #define DMA_K(t,slot) glds16(ksrc+(long)(t)*KVBLK*DM,(unsigned)__builtin_amdgcn_readfirstlane(kdst+(slot)))
  #define DMA_V(t,slot) glds16(vsrc+(long)(t)*KVBLK*DM,(unsigned)__builtin_amdgcn_readfirstlane(vdst+(slot)))
  const int vb0=(int)(lds0+LDS_V)+((lane>>4)&1)*32+(lane&3)*8+(4*hi+((lane&15)>>2))*64;
  const char*Kbase=shm+LDS_K; bf16x8 kf[8];
  const lds_cptr shm3=(lds_cptr)shm; const lds_cptr kp0=shm3+LDS_K+hi*1024+r32*16; const lds_cptr vp0=shm3+LDS_V+((lane>>4)&1)*32+(lane&3)*8+(4*hi+((lane&15)>>2))*64;
  const int NT=(q0+QB)/KVBLK;
  DMA_K(0,0);DMA_V(0,0);DMA_K(1,SLOTB);
  bf16x8 qr[4];
  #pragma unroll
  for(int d0=0;d0<4;++d0)qr[d0]=*reinterpret_cast<const bf16x8*>(&Qw[(long)r32*DM+d0*16+hi*8]);
  const int qrel=wid*QBLK+r32;
  const float ci2=cs[q0+qrel];
  float mhat=0.f,l_reg=0.f;f32x16 o[2];o[0]=f32x16{};o[1]=f32x16{};float nm=ci2;
  #define CINIT(P0,P1,t) do{ const lds_f4ptr cb_=(lds_f4ptr)(cs+64*(t)+4*hi); \
    _Pragma("unroll") for(int g_=0;g_<4;++g_){ const f32x4b n0_=cb_[2*g_], n1_=cb_[8+2*g_]; \
      P0[4*g_]=nm-n0_[0];P0[4*g_+1]=nm-n0_[1];P0[4*g_+2]=nm-n0_[2];P0[4*g_+3]=nm-n0_[3]; \
      P1[4*g_]=nm-n1_[0];P1[4*g_+1]=nm-n1_[1];P1[4*g_+2]=nm-n1_[2];P1[4*g_+3]=nm-n1_[3]; } }while(0)
  #define CMASK(P0,P1,t) do{int jb_=(t)-(NT-4); if(jb_>=0)cmask(P0,P1,jb_,qrel,hi);}while(0)
  bool resc=false;
  #define START(P0,P1) do{ const float rm=rowmax(P0,P1); resc=false; \
    { const float dl=rm; mhat=fadd_s(mhat,dl); \
      _Pragma("unroll") for(int r=0;r<16;++r){P0[r]=fsub_s(P0[r],dl);P1[r]=fsub_s(P1[r],dl);} \
      nm=ci2-mhat; } \
    _Pragma("unroll") for(int r=0;r<16;++r)P0[r]=__builtin_amdgcn_exp2f(P0[r]); }while(0)
  #define RESC() do{ if(resc){ asm volatile("s_waitcnt lgkmcnt(0)":::"memory"); \
      _Pragma("unroll") for(int d_=0;d_<2;++d_) _Pragma("unroll") for(int r=0;r<16;++r)o[d_][r]*=wsf[crow(r,hi)]; } }while(0)
  f32x16 pA0,pA1,pB0,pB1;
  int sl_prev=0,sl_cur=0,sl_next=SLOTB;
  #define ROT() do{sl_prev=sl_cur;sl_cur=sl_next;sl_next=(sl_next==(NSLOT-1)*SLOTB)?0:sl_next+SLOTB;}while(0)
  DMA_K(2,2*SLOTB);
  WAIT_BAR(3);
  CINIT(pA0,pA1,0);qkt(pA0,pA1,Kbase,qr,r32,hi);asm volatile("s_nop 15\n\ts_nop 7":"+v"(pA0),"+v"(pA1));CMASK(pA0,pA1,0);
  START(pA0,pA1);
  _Pragma("unroll") for(int r=0;r<16;++r)pA1[r]=__builtin_amdgcn_exp2f(pA1[r]);
  WAIT_BAR(0);
  DMA_K(3,0);DMA_V(1,SLOTB);
  ROT();
  kload8(kf,kp0+sl_cur);
  WAIT_BAR(2);
  s16x4 vlo[8],vhi[8]; u32x4 pw0,pw1,pw2,pw3;
  #define PKW(P,B) cvtpk_s(P[B],P[B+1])
  #define PAF(k) __builtin_bit_cast(bf16x8,pw##k)
  #define VFR(i) (bf16x8){vlo[i][0],vlo[i][1],vlo[i][2],vlo[i][3],vhi[i][0],vhi[i][1],vhi[i][2],vhi[i][3]}
  #define PIN(x) asm volatile("":"+v"(x))
  #define MX3(a,b,c) __builtin_fmaxf(__builtin_fmaxf((a),(b)),(c))
  #define GAPA(MF,A0,A1,A2,A3,W0,W1,PW) do{ MF; sacc+=A0; sacc+=A1; sacc+=A2; sacc+=A3; PIN(sacc); W0; W1; PIN(PW); SBAR(); }while(0)
  #define EX(v) __builtin_amdgcn_exp2f(v)
  #define GAPB(MF,X,B) do{ MF; X[B]=EX(X[B]); X[B+1]=EX(X[B+1]); X[B+2]=EX(X[B+2]); X[B+3]=EX(X[B+3]); PIN(X); SBAR(); }while(0)
  #define VRD(i) do{ vlo[i]=vtr(vp_+(((i)>>2)*4096+((i)&3)*1024)); vhi[i]=vtr(vp_+(((i)>>2)*4096+((i)&3)*1024+512)); }while(0)
  #define KRD(G,j) do{ if(G){ kload2(kf,kp0+sl_next,j); SBAR(); } }while(0)
  #define STEP(C0,C1,P0,P1,t,GK,GV,GL) do{ SBAR(); \
    const lds_cptr vp_=vp0+sl_prev; CINIT(C0,C1,t); SBAR(); \
    VRD(0); SBAR(); float sacc=(P0[0]+P0[1]); \
    GAPA(C0=__builtin_amdgcn_mfma_f32_32x32x16_bf16(kf[0],qr[0],C0,0,0,0), P0[2],P0[3],P0[4],P0[5],     pw0[0]=PKW(P0,0), pw0[1]=PKW(P0,2), pw0); \
    VRD(4); SBAR(); GAPA(C1=__builtin_amdgcn_mfma_f32_32x32x16_bf16(kf[1],qr[0],C1,0,0,0), P0[6],P0[7],P0[8],P0[9],     pw0[2]=PKW(P0,4), pw0[3]=PKW(P0,6), pw0); \
    VRD(1); SBAR(); GAPA(C0=__builtin_amdgcn_mfma_f32_32x32x16_bf16(kf[2],qr[1],C0,0,0,0),   P0[10],P0[11],P0[12],P0[13], pw1[0]=PKW(P0,8), pw1[1]=PKW(P0,10), pw1); \
    VRD(5); SBAR(); GAPA(C1=__builtin_amdgcn_mfma_f32_32x32x16_bf16(kf[3],qr[1],C1,0,0,0),   P0[14],P0[15],P1[0],P1[1],   pw1[2]=PKW(P0,12),pw1[3]=PKW(P0,14), pw1); \
    VRD(2); SBAR(); GAPA(C0=__builtin_amdgcn_mfma_f32_32x32x16_bf16(kf[4],qr[2],C0,0,0,0),   P1[2],P1[3],P1[4],P1[5],     pw2[0]=PKW(P1,0), pw2[1]=PKW(P1,2), pw2); \
    VRD(6); SBAR(); GAPA(C1=__builtin_amdgcn_mfma_f32_32x32x16_bf16(kf[5],qr[2],C1,0,0,0),   P1[6],P1[7],P1[8],P1[9],     pw2[2]=PKW(P1,4), pw2[3]=PKW(P1,6), pw2); \
    VRD(3); SBAR(); GAPA(C0=__builtin_amdgcn_mfma_f32_32x32x16_bf16(kf[6],qr[3],C0,0,0,0),   P1[10],P1[11],P1[12],P1[13], pw3[0]=PKW(P1,8), pw3[1]=PKW(P1,10), pw3); \
    VRD(7); SBAR(); GAPA(C1=__builtin_amdgcn_mfma_f32_32x32x16_bf16(kf[7],qr[3],C1,0,0,0),   P1[14],P1[15],0.f,0.f,       pw3[2]=PKW(P1,12),pw3[3]=PKW(P1,14), pw3); \
    l_reg+=sacc; \
    if(GK){DMA_K((t)+3,sl_cur);} if(GV){DMA_V((t)+1,sl_next);} \
    CMASK(C0,C1,t); \
    { float a=MX3(C0[0],C0[1],C1[0]),b=MX3(C0[2],C0[3],C1[1]); a=MX3(a,C1[2],C1[3]); \
      _Pragma("unroll") for(int r=4;r<16;r+=4){a=MX3(a,C0[r],C0[r+1]);b=MX3(b,C0[r+2],C0[r+3]);a=MX3(a,C1[r],C1[r+1]);b=MX3(b,C1[r+2],C1[r+3]);} \
      float rm=__builtin_fmaxf(a,b); { auto rr=__builtin_amdgcn_permlane32_swap(__float_as_uint(rm),__float_as_uint(rm),false,false); rm=__builtin_fmaxf(__uint_as_float(rr[0]),__uint_as_float(rr[1])); } \
      resc=false; \
      if(__builtin_expect(__any(rm>(float)THRL),0)){ const float dl=__builtin_fmaxf(rm,0.f); mhat+=dl; \
        _Pragma("unroll") for(int r=0;r<16;++r){C0[r]-=dl;C1[r]-=dl;} \
        nm=ci2-mhat; \
        const float f=__builtin_amdgcn_exp2f(-dl); l_reg*=f; if(hi==0)wsf[r32]=f; resc=true; } } \
    SBAR(); \
    GAPB(o[0]=__builtin_amdgcn_mfma_f32_32x32x16_bf16(PAF(0),VFR(0),o[0],0,0,0), C0,0); \
    GAPB(o[1]=__builtin_amdgcn_mfma_f32_32x32x16_bf16(PAF(0),VFR(4),o[1],0,0,0), C0,4); \
    KRD(GL,0); GAPB(o[0]=__builtin_amdgcn_mfma_f32_32x32x16_bf16(PAF(1),VFR(1),o[0],0,0,0), C0,8); \
    KRD(GL,1); GAPB(o[1]=__builtin_amdgcn_mfma_f32_32x32x16_bf16(PAF(1),VFR(5),o[1],0,0,0), C0,12); \
    KRD(GL,2); GAPB(o[0]=__builtin_amdgcn_mfma_f32_32x32x16_bf16(PAF(2),VFR(2),o[0],0,0,0), C1,0); \
    KRD(GL,3); GAPB(o[1]=__builtin_amdgcn_mfma_f32_32x32x16_bf16(PAF(2),VFR(6),o[1],0,0,0), C1,4); \
    GAPB(o[0]=__builtin_amdgcn_mfma_f32_32x32x16_bf16(PAF(3),VFR(3),o[0],0,0,0), C1,8); \
    GAPB(o[1]=__builtin_amdgcn_mfma_f32_32x32x16_bf16(PAF(3),VFR(7),o[1],0,0,0), C1,12); \
    }while(0)
  int t=1;
  #undef CMASK
  #define CMASK(P0,P1,t) do{}while(0)
  for(;t+5<NT;t+=2){
    STEP(pB0,pB1,pA0,pA1,t,true,true,true);     WAIT_BAR(2); RESC(); ROT();
    STEP(pA0,pA1,pB0,pB1,t+1,true,true,true);   WAIT_BAR(2); RESC(); ROT();
  }
  #undef CMASK
  #define CMASK(P0,P1,t) do{int jb_=(t)-(NT-4); if(jb_>=0)cmask(P0,P1,jb_,qrel,hi);}while(0)
  #define ENDW(tt) do{ if((tt)+3<NT){WAIT_BAR(2);} else if((tt)+2<NT){WAIT_BAR(1);} else {WAIT_BAR(0);} }while(0)
  for(;t+1<NT;t+=2){
    STEP(pB0,pB1,pA0,pA1,t,(t+3<NT),(t+1<NT),(t+1<NT));       ENDW(t);   RESC(); ROT();
    STEP(pA0,pA1,pB0,pB1,t+1,(t+4<NT),(t+2<NT),(t+2<NT));     ENDW(t+1); RESC(); ROT();
  }
  STEP(pB0,pB1,pA0,pA1,NT-1,false,false,false); RESC();
  { float sacc=pB0[0]+pB0[1]; _Pragma("unroll") for(int r=2;r<16;++r)sacc+=pB0[r]; _Pragma("unroll") for(int r=0;r<16;++r)sacc+=pB1[r]; l_reg+=sacc;
    pw0=(u32x4){PKW(pB0,0),PKW(pB0,2),PKW(pB0,4),PKW(pB0,6)};pw1=(u32x4){PKW(pB0,8),PKW(pB0,10),PKW(pB0,12),PKW(pB0,14)};pw2=(u32x4){PKW(pB1,0),PKW(pB1,2),PKW(pB1,4),PKW(pB1,6)};pw3=(u32x4){PKW(pB1,8),PKW(pB1,10),PKW(pB1,12),PKW(pB1,14)};
    SBAR(); pv(o,vb0+sl_cur,PAF(0),PAF(1),PAF(2),PAF(3)); }
  #undef PKW
  #undef PAF
  #undef VFR
  #undef PIN
  #undef MX3
  #undef GAPA
  #undef GAPB
  #undef EX
  #undef VRD
  #undef KRD
  #undef STEP
  #undef ENDW
  {auto rr=__builtin_amdgcn_permlane32_swap(__float_as_uint(l_reg),__float_as_uint(l_reg),false,false);l_reg=__uint_as_float(rr[0])+__uint_as_float(rr[1]);}
  if(hi==0)wsf[32+r32]=l_reg;asm volatile("s_waitcnt lgkmcnt(0)":::"memory");
  float rli[16];
  #pragma unroll
  for(int r=0;r<16;++r)rli[r]=__builtin_amdgcn_rcpf(wsf[32+crow(r,hi)]);
  bf16*Ow=O+(rowbase+q0+wid*QBLK)*DM+h*D;
  { bf16*stg=(bf16*)(shm+LDS_OST)+wid*2048;
    #pragma unroll
    for(int r=0;r<16;++r){const int orow=crow(r,hi);
      #pragma unroll
      for(int d0=0;d0<2;++d0)stg[orow*64+d0*32+r32]=__float2bfloat16(o[d0][r]*rli[r]);}
    asm volatile("s_waitcnt lgkmcnt(0)":::"memory");
    #pragma unroll
    for(int i=0;i<4;++i){const int row=i*8+(lane>>3),ch=lane&7; const u32x4 v=*(const u32x4*)(stg+row*64+ch*8); ATTN_STORE16(Ow+(long)row*DM+ch*8,v);} }
  asm volatile("s_waitcnt lgkmcnt(0)\n\ts_barrier":::"memory");
  #undef DMA_K
  #undef DMA_V
  #undef CINIT
  #undef CMASK
  #undef START
  #undef RESC
  #undef ROT
}
constexpr int ATTN_LDS_BYTES=LDS_BYTES;
struct AttnTensors { const bf16* Q; const bf16* K; const bf16* V; bf16* O; };
struct AttnUnit { int bh; int qb; };
struct StaticOrder {
  int vcu;
  __device__ __forceinline__ explicit StaticOrder(int grid,int block):vcu((block%8)*(grid/8)+block/8){}
  __device__ __forceinline__ bool next(int i,AttnUnit&u)const{ if(i>=4)return false; const int s=vcu&3; u.bh=vcu>>2; u.qb=(i==0)?s:(i==1)?7-s:(i==2)?8+s:15-s; return true; }
  __device__ __forceinline__ void a_ready(const AttnUnit&)const{}
  __device__ __forceinline__ void done(const AttnUnit&)const{}
};
#undef SBAR
#undef WAIT_BAR
}
#define LAS __attribute__((address_space(3)))
typedef unsigned short bf16;
typedef unsigned v4u __attribute__((ext_vector_type(4)));
typedef unsigned v2u __attribute__((ext_vector_type(2)));
typedef float f32x4 __attribute__((ext_vector_type(4)));
typedef float f32x16 __attribute__((ext_vector_type(16)));
typedef short bf16x8 __attribute__((ext_vector_type(8)));
typedef float f32x2s __attribute__((ext_vector_type(2)));

constexpr int NBATCH = 4, SEQ = 4096, M = NBATCH * SEQ, D = 1024, DFF = 2816, PLE = 256;
constexpr int EVEN_IN = 2560, FOX_IN = 3088, FOX_INP = 3328;
constexpr float LOG2E = 1.4426950408889634f;
constexpr float QSCALE = 0.125f * LOG2E;
constexpr float GN_EPS = 64e-5f;
constexpr size_t MiB = 1u << 20;
constexpr size_t WS_SSQ = 0;
constexpr size_t WS_C3 = 1 * MiB;
constexpr size_t WS_LF = 2 * MiB;
constexpr size_t WS_G2F = 3 * MiB;
constexpr size_t WS_WGU = 4 * MiB;
constexpr size_t WS_WD = 48 * MiB;
constexpr size_t WS_WG = 70 * MiB;
constexpr size_t WS_WP = 74 * MiB;
constexpr size_t WS_WIN0 = 75 * MiB, WS_WOUT0 = 80 * MiB, WS_WIN1 = 82 * MiB, WS_WOUT1 = 89 * MiB;
constexpr size_t WS_XB = 91 * MiB;
constexpr size_t WS_Y = 123 * MiB;
constexpr size_t WS_BIG = 155 * MiB;
constexpr size_t WS_PB = 243 * MiB;
constexpr size_t WS_SSQP = 251 * MiB;
constexpr size_t WS_END = 253 * MiB;
constexpr size_t WS_BAR = 0;
constexpr int LDS_BYTES = 147456, MISC_OFF = 147456 - 64;

#define LDS_WAIT() asm volatile("s_waitcnt lgkmcnt(0)" ::: "memory")
__device__ __forceinline__ unsigned pk2(float lo, float hi) { return pg8::cvt_pk_bf16(lo, hi); }
__device__ __forceinline__ float bflo(unsigned w) { return __uint_as_float(w << 16); }
__device__ __forceinline__ float bfhi(unsigned w) { return __uint_as_float(w & 0xffff0000u); }
__device__ __forceinline__ float bf2f(bf16 h) { return __uint_as_float((unsigned)h << 16); }
__device__ __forceinline__ float wave_sum(float v) {
#pragma unroll
    for (int o = 1; o < 64; o <<= 1) v += __shfl_xor(v, o);
    return v;
}
__device__ __forceinline__ int crow(int r, int hi) { return (r & 3) + 8 * (r >> 2) + 4 * hi; }
template <int CTRL> __device__ __forceinline__ float dpp_f(float x) { return __int_as_float(__builtin_amdgcn_update_dpp(0, __float_as_int(x), CTRL, 0xf, 0xf, true)); }
__device__ __forceinline__ float red16(float x) { x += dpp_f<0xB1>(x); x += dpp_f<0x4E>(x); x += dpp_f<0x141>(x); x += dpp_f<0x140>(x); return x; }
__device__ __forceinline__ float red8(float x) { x += dpp_f<0xB1>(x); x += dpp_f<0x4E>(x); x += dpp_f<0x141>(x); return x; }
__device__ __forceinline__ void unpack8(const v4u w, float (&f)[8]) { f[0] = bflo(w.x); f[1] = bfhi(w.x); f[2] = bflo(w.y); f[3] = bfhi(w.y); f[4] = bflo(w.z); f[5] = bfhi(w.z); f[6] = bflo(w.w); f[7] = bfhi(w.w); }
__device__ __forceinline__ bf16x8 pack8(const float (&f)[8]) { v4u w; w.x = pk2(f[0], f[1]); w.y = pk2(f[2], f[3]); w.z = pk2(f[4], f[5]); w.w = pk2(f[6], f[7]); return __builtin_bit_cast(bf16x8, w); }

__device__ __forceinline__ void conv_item(const float* W, int K, int N, int NP, bf16* WT, const float* gain, int mode, LAS float* scr, int item, int lane) {
    const int nblk = NP / 32, kb = item / nblk, nb = item - kb * nblk, k0 = 64 * kb, n0 = 32 * nb;
    int orow0 = n0;
    if (mode == 1) orow0 = (n0 < DFF) ? (n0 / 128) * 256 + (n0 % 128) : ((n0 - DFF) / 128) * 256 + 128 + ((n0 - DFF) % 128);
    const int nq = 4 * (lane & 7); const bool inb = (n0 + nq) < N;
#pragma unroll
    for (int i = 0; i < 8; ++i) { const int kk = 8 * i + (lane >> 3); f32x4 v = {0.f, 0.f, 0.f, 0.f}; if (inb) v = *(const f32x4*)(W + (size_t)(k0 + kk) * N + n0 + nq);
        if (gain) v = v * gain[k0 + kk];
        LAS float* d = scr + kk * 33 + nq; d[0] = v[0]; d[1] = v[1]; d[2] = v[2]; d[3] = v[3]; }
    LDS_WAIT(); asm volatile("" ::: "memory");
    const int c = lane & 7;
#pragma unroll
    for (int j = 0; j < 4; ++j) { const int nn = (lane >> 3) + 8 * j; const LAS float* s = scr + (8 * c) * 33 + nn;
        v4u o; o.x = pk2(s[0 * 33], s[1 * 33]); o.y = pk2(s[2 * 33], s[3 * 33]); o.z = pk2(s[4 * 33], s[5 * 33]); o.w = pk2(s[6 * 33], s[7 * 33]);
        *(v4u*)(WT + (size_t)(orow0 + nn) * K + k0 + 8 * c) = o; }
    LDS_WAIT(); asm volatile("" ::: "memory");
}

constexpr int VTP = 264;
__device__ __forceinline__ void swa_unit(int unit, const bf16* PROJ, bf16* Y, const float* sinks, LAS unsigned char* lds, int tid, int lane, int wid) {
    const int b = unit >> 6, kvh = (unit >> 5) & 1, qblk = unit & 31, q0 = qblk * 128; const size_t rb = (size_t)b * SEQ;
    asm volatile("" : "+s"(PROJ), "+s"(Y));
    LAS bf16* VT = (LAS bf16*)lds;
    for (int c = tid; c < 2048; c += 512) { const int kvl = c >> 3, ch = c & 7, tok = q0 - 128 + kvl; v4u v = {0u, 0u, 0u, 0u};
        if (tok >= 0) v = *(const v4u*)(PROJ + (rb + tok) * EVEN_IN + 640 + kvh * 64 + ch * 8);
        LAS bf16* d = VT + (ch * 8) * VTP + kvl;
        d[0 * VTP] = (bf16)(v.x & 0xffffu); d[1 * VTP] = (bf16)(v.x >> 16); d[2 * VTP] = (bf16)(v.y & 0xffffu); d[3 * VTP] = (bf16)(v.y >> 16);
        d[4 * VTP] = (bf16)(v.z & 0xffffu); d[5 * VTP] = (bf16)(v.z >> 16); d[6 * VTP] = (bf16)(v.w & 0xffffu); d[7 * VTP] = (bf16)(v.w >> 16); }
    __syncthreads();
    const int g = wid >> 1, qh = wid & 1, hq = kvh * 4 + g;
    const float slope2 = exp2f(-(float)(hq + 1)) * LOG2E, sink2 = sinks[hq] * LOG2E;
#pragma unroll 1
    for (int sb = 0; sb < 2; ++sb) {
        int r32 = lane & 31, hi = lane >> 5; asm volatile("" : "+v"(r32), "+v"(hi));
        const int qs = q0 + 64 * qh + 32 * sb;
        bf16x8 qf[4];
#pragma unroll
        for (int ks = 0; ks < 4; ++ks) qf[ks] = *(const bf16x8*)(PROJ + (rb + qs + r32) * EVEN_IN + hq * 64 + 16 * ks + 8 * hi);
        f32x16 sc[5];
#pragma unroll
        for (int kt = 0; kt < 5; ++kt) { int tk = qs - 128 + 32 * kt + r32; tk = tk < 0 ? 0 : tk; sc[kt] = f32x16{};
#pragma unroll
            for (int ks = 0; ks < 4; ++ks) { const bf16x8 kf = *(const bf16x8*)(PROJ + (rb + tk) * EVEN_IN + 512 + kvh * 64 + 16 * ks + 8 * hi);
                sc[kt] = __builtin_amdgcn_mfma_f32_32x32x16_bf16(kf, qf[ks], sc[kt], 0, 0, 0); }
            asm volatile("" ::: "memory"); }
        const int db = r32 + 128 - 4 * hi, kmin = 128 - qs - 4 * hi; const float ab = -slope2 * (float)db;
        float mx = sink2;
#pragma unroll
        for (int kt = 0; kt < 5; ++kt)
#pragma unroll
            for (int r = 0; r < 16; ++r) { const int kc = 32 * kt + (r & 3) + 8 * (r >> 2), dist = db - kc; const bool ok = ((unsigned)dist < 128u) && (kmin <= kc);
                const float s = ok ? fmaf(slope2, (float)kc, sc[kt][r] + ab) : -INFINITY; sc[kt][r] = s; mx = fmaxf(mx, s); }
        mx = fmaxf(mx, __shfl_xor(mx, 32));
        float l = 0.f;
#pragma unroll
        for (int kt = 0; kt < 5; ++kt)
#pragma unroll
            for (int r = 0; r < 16; ++r) { const float p = exp2f(sc[kt][r] - mx); sc[kt][r] = p; l += p; }
        l += __shfl_xor(l, 32); l += exp2f(sink2 - mx);
        const float rl = 1.0f / l;
        f32x16 o[2]; o[0] = f32x16{}; o[1] = f32x16{};
        const int kvl0 = 64 * qh + 32 * sb;
#pragma unroll
        for (int kt = 0; kt < 5; ++kt)
#pragma unroll
            for (int s2 = 0; s2 < 2; ++s2) { v4u pw; pw.x = pk2(sc[kt][8 * s2 + 0], sc[kt][8 * s2 + 1]); pw.y = pk2(sc[kt][8 * s2 + 2], sc[kt][8 * s2 + 3]); pw.z = pk2(sc[kt][8 * s2 + 4], sc[kt][8 * s2 + 5]); pw.w = pk2(sc[kt][8 * s2 + 6], sc[kt][8 * s2 + 7]);
                const bf16x8 pa = __builtin_bit_cast(bf16x8, pw);
#pragma unroll
                for (int db = 0; db < 2; ++db) { const LAS bf16* vp = VT + (32 * db + r32) * VTP + kvl0 + 32 * kt + 16 * s2 + 4 * hi;
                    const v2u lo = *(const LAS v2u*)vp, hh = *(const LAS v2u*)(vp + 8); v4u vw; vw.x = lo.x; vw.y = lo.y; vw.z = hh.x; vw.w = hh.y;
                    o[db] = __builtin_amdgcn_mfma_f32_32x32x16_bf16(pa, __builtin_bit_cast(bf16x8, vw), o[db], 0, 0, 0); } }
#pragma unroll
        for (int r = 0; r < 16; ++r) { const int qq = crow(r, hi); const float sc1 = __shfl(rl, qq);
            bf16* yp = Y + (rb + qs + qq) * 1024 + hq * 64 + r32;
            yp[0] = (bf16)(pk2(o[0][r] * sc1, 0.f) & 0xffffu); yp[32] = (bf16)(pk2(o[1][r] * sc1, 0.f) & 0xffffu); }
    }
    __syncthreads();
}
typedef unsigned v4u_unused_;
#define XB_TMO      128
#define XB_XCNT(j)  (256  + 64 * (j))
#define XB_XSUB(j)  (1280 + 64 * (j))
#define XB_XGEN(j)  (2304 + 64 * (j))
#define XB_TOP      3328
#define XB_TOPGEN   3392
#define XCD_BAR_WORDS 3456
#define XB_SPIN_CAP (1u << 18)

__device__ __forceinline__ unsigned xb_ld(unsigned* p)              { return __hip_atomic_load(p, __ATOMIC_RELAXED, __HIP_MEMORY_SCOPE_AGENT); }
__device__ __forceinline__ unsigned xb_add(unsigned* p, unsigned v) { return __hip_atomic_fetch_add(p, v, __ATOMIC_RELAXED, __HIP_MEMORY_SCOPE_AGENT); }
__device__ __forceinline__ unsigned xb_xcc_id() { return (unsigned)__builtin_amdgcn_s_getreg((3 << 11) | 20) & 0xFu; }
#define XB_SPIN(cond, bar) do { unsigned _sp = 0; while (cond) { __builtin_amdgcn_s_sleep(1); \
    if ((++_sp & 255u) == 0u) { if (xb_ld(&(bar)[XB_TMO])) break; if (_sp > XB_SPIN_CAP) { atomicAdd(&(bar)[XB_TMO], 1u); break; } } } } while (0)

struct XcdBarrier {
    unsigned* bar; unsigned x;
    volatile LAS unsigned* st;
};

__device__ __forceinline__ XcdBarrier xcd_barrier_post(unsigned* bar, volatile LAS unsigned* st) {
    XcdBarrier b; b.bar = bar; b.x = xb_xcc_id(); b.st = st;
    if (threadIdx.x == 0) (void)xb_add(&bar[XB_XCNT(b.x)], 1u);
    return b;
}
__device__ __forceinline__ void xcd_barrier_complete(unsigned* bar, unsigned x, unsigned& nloc, unsigned& nx) {
    const unsigned G = gridDim.x * gridDim.y * gridDim.z;
    unsigned sum, cnt, mine, sp = 0u;
    for (;;) {
        sum = 0u; cnt = 0u; mine = 0u;
#pragma unroll
        for (unsigned j = 0; j < 16; ++j) { const unsigned c = xb_ld(&bar[XB_XCNT(j)]); sum += c; cnt += (c > 0u) ? 1u : 0u; mine = (j == x) ? c : mine; }
        if (sum == G) break;
        __builtin_amdgcn_s_sleep(1);
        if ((++sp & 255u) == 0u) { if (xb_ld(&bar[XB_TMO])) break; if (sp > XB_SPIN_CAP) { atomicAdd(&bar[XB_TMO], 1u); break; } }
    }
    nloc = mine > 0u ? mine : 1u; nx = cnt > 0u ? cnt : 1u;
}

__device__ __forceinline__ void xcd_barrier(const XcdBarrier& b) {
    asm volatile("s_waitcnt vmcnt(0)" ::: "memory");
    __syncthreads();
    if (threadIdx.x == 0) {
        unsigned* bar = b.bar;
        __builtin_amdgcn_s_waitcnt(0);
        unsigned nloc = b.st[0], nx = b.st[1];
        if (nloc == 0u) { xcd_barrier_complete(bar, b.x, nloc, nx); b.st[0] = nloc; b.st[1] = nx; }
        const unsigned old = xb_add(&bar[XB_XSUB(b.x)], 1u);
        const unsigned gen = old / nloc;
        if (old + 1u == (gen + 1u) * nloc) {
            __builtin_amdgcn_fence(__ATOMIC_RELEASE, "agent");
            asm volatile("s_waitcnt vmcnt(0)" ::: "memory");
            const unsigned og = xb_add(&bar[XB_TOP], 1u);
            const unsigned tg = og / nx;
            if (og + 1u == (tg + 1u) * nx) xb_add(&bar[XB_TOPGEN], 1u);
            else XB_SPIN(xb_ld(&bar[XB_TOPGEN]) == tg, bar);
            __builtin_amdgcn_fence(__ATOMIC_ACQUIRE, "agent");
            xb_add(&bar[XB_XGEN(b.x)], 1u);
            asm volatile("s_waitcnt vmcnt(0)" ::: "memory");
        } else {
            XB_SPIN(xb_ld(&bar[XB_XGEN(b.x)]) == gen, bar);
            __builtin_amdgcn_fence(__ATOMIC_ACQUIRE, "agent");
            asm volatile("s_waitcnt vmcnt(0)" ::: "memory");
        }
    }
    __syncthreads();
}
constexpr int TC = 32, SBS = 340, LBS = 68;
constexpr int SBS_UNUSED_ = 336;
constexpr int RW_SBUF = 0, RW_SBUF_BYTES = TC * SBS * 4, RW_LW = 2 * RW_SBUF_BYTES, RW_LA = RW_LW + 2 * TC * LBS * 4, RW_EC = RW_LA + 2 * TC * LBS * 4, RW_BF = RW_EC + 2560;
__device__ __forceinline__ void rwkv_scan_unit(int unit, const bf16* PROJ, float* YRAW, float* C3, const float* mu, const float* w0, const float* w2, const float* a0, const float* a2,
                                               const float* k_k, const float* k_a, const float* r_k, LAS unsigned char* lds, const int lane, int wid) {
    const int role = (wid < 2) ? 0 : ((wid == 2 || wid == 3) ? 2 : 1), lw = wid - 2, ew = wid - 4;
    const int b = unit >> 6, h = (unit >> 3) & 7, rg = unit & 7; const size_t rb = (size_t)b * SEQ;
    const int r32 = lane & 31, hi = lane >> 5;
    constexpr int NCH = SEQ / TC;
    if (role == 2) {
        const int colx = 768 + ((lw == 0) ? 1536 : 1600); const float* Wl = (lw == 0) ? w2 : a2;
#pragma unroll
        for (int nb = 0; nb < 2; ++nb)
#pragma unroll
            for (int ks = 0; ks < 4; ++ks) { float f[8];
#pragma unroll
                for (int i = 0; i < 8; ++i) f[i] = Wl[(size_t)(16 * ks + 8 * hi + i) * 512 + h * 64 + 32 * nb + r32];
                *(LAS bf16x8*)(lds + RW_BF + (((lw * 2 + nb) * 4 + ks) * 64 + lane) * 16) = pack8(f); }
        ((LAS float*)(lds + RW_EC))[512 + lw * 64 + lane] = mu[colx - 768 + lane];
        v4u lcw[4], lpw[4];
#define LORA_LOAD(itn) do { const int tl_ = (itn) * TC + r32; const bf16* p_ = PROJ + (rb + tl_) * EVEN_IN + colx + 8 * hi; _Pragma("unroll") for (int ks = 0; ks < 4; ++ks) { lcw[ks] = *(const v4u*)(p_ + 16 * ks); \
            lpw[ks] = (v4u){0u, 0u, 0u, 0u}; if (tl_ > 0) lpw[ks] = *(const v4u*)(p_ - EVEN_IN + 16 * ks); } } while (0)
        LORA_LOAD(0);
#pragma unroll 1
        for (int it = 0; it < NCH + 2; ++it) {
            if (it < NCH) { bf16x8 afr[4];
#pragma unroll
                for (int ks = 0; ks < 4; ++ks) { float c[8], p[8]; unpack8(lcw[ks], c); unpack8(lpw[ks], p);
                    const LAS float* mq = (const LAS float*)(lds + RW_EC) + 512 + lw * 64 + 16 * ks + 8 * hi; const f32x4 m0 = *(const LAS f32x4*)mq, m1 = *(const LAS f32x4*)(mq + 4);
#pragma unroll
                    for (int i = 0; i < 8; ++i) { float x = c[i] + (p[i] - c[i]) * (i < 4 ? m0[i] : m1[i - 4]); if (lw == 0) x = 1.f - 2.f * __builtin_amdgcn_rcpf(1.f + __expf(2.f * x)); c[i] = x; }
                    afr[ks] = pack8(c); }
                if (it + 1 < NCH) LORA_LOAD(it + 1);
                LAS float* LB = (LAS float*)(lds + ((lw == 0) ? RW_LW : RW_LA)) + (it & 1) * (TC * LBS);
#pragma unroll
                for (int nb = 0; nb < 2; ++nb) { f32x16 acc = f32x16{};
#pragma unroll
                    for (int ks = 0; ks < 4; ++ks) acc = __builtin_amdgcn_mfma_f32_32x32x16_bf16(afr[ks], *(const LAS bf16x8*)(lds + RW_BF + (((lw * 2 + nb) * 4 + ks) * 64 + lane) * 16), acc, 0, 0, 0);
#pragma unroll
                    for (int r = 0; r < 16; ++r) LB[crow(r, hi) * LBS + 32 * nb + r32] = acc[r]; } }
            asm volatile("s_waitcnt lgkmcnt(0)\n\ts_barrier" ::: "memory");
        }
#undef LORA_LOAD
    } else if (role == 1) {
        const int el = ew * 64 + lane, s = el >> 3, g = el & 7;
        float ecc[8][8];
        { const int chn = h * 64 + 8 * g;
#pragma unroll
          for (int i = 0; i < 8; ++i) { ecc[0][i] = mu[chn + i]; ecc[1][i] = mu[512 + chn + i]; ecc[2][i] = mu[1024 + chn + i]; ecc[3][i] = w0[chn + i]; ecc[4][i] = a0[chn + i]; ecc[5][i] = k_k[chn + i]; ecc[6][i] = k_a[chn + i]; ecc[7][i] = r_k[chn + i]; } }
        v4u ecr, eck, ecv, epr, epk, epv;
#define ELEM_LOAD(cn) do { const int tl_ = (cn) * TC + s; const bf16* p_ = PROJ + (rb + tl_) * EVEN_IN + 768 + h * 64 + 8 * g; \
            ecr = *(const v4u*)p_; eck = *(const v4u*)(p_ + 512); ecv = *(const v4u*)(p_ + 1024); epr = (v4u){0u, 0u, 0u, 0u}; epk = epr; epv = epr; \
            if (tl_ > 0) { epr = *(const v4u*)(p_ - EVEN_IN); epk = *(const v4u*)(p_ - EVEN_IN + 512); epv = *(const v4u*)(p_ - EVEN_IN + 1024); } } while (0)
        ELEM_LOAD(0);
#pragma unroll 1
        for (int it = 0; it < NCH + 2; ++it) {
            const int c = it - 1;
            if (c >= 0 && c < NCH) { const size_t row = rb + c * TC + s;
                const LAS float* LW = (const LAS float*)(lds + RW_LW) + (c & 1) * (TC * LBS) + s * LBS + 8 * g; const LAS float* LA = (const LAS float*)(lds + RW_LA) + (c & 1) * (TC * LBS) + s * LBS + 8 * g;
                LAS float* sp = (LAS float*)(lds + RW_SBUF + (c & 1) * RW_SBUF_BYTES) + s * SBS;
                float ec[8];
#define LDEC(arr) do { _Pragma("unroll") for (int i_ = 0; i_ < 8; ++i_) ec[i_] = ecc[arr][i_]; } while (0)
                float r[8], k[8], v[8], t[8];
                unpack8(ecr, r); unpack8(epr, t); LDEC(0);
#pragma unroll
                for (int i = 0; i < 8; ++i) r[i] += (t[i] - r[i]) * ec[i];
                unpack8(eck, k); unpack8(epk, t); LDEC(1);
#pragma unroll
                for (int i = 0; i < 8; ++i) k[i] += (t[i] - k[i]) * ec[i];
                unpack8(ecv, v); unpack8(epv, t); LDEC(2);
#pragma unroll
                for (int i = 0; i < 8; ++i) v[i] += (t[i] - v[i]) * ec[i];
                if (c + 1 < NCH) ELEM_LOAD(c + 1);
                const f32x4 dw0 = *(const LAS f32x4*)LW, dw1 = *(const LAS f32x4*)(LW + 4), da0 = *(const LAS f32x4*)LA, da1 = *(const LAS f32x4*)(LA + 4);
                float w[8], a[8], kk[8], kp[8]; float n2 = 0.f;
#pragma unroll
                for (int i = 0; i < 8; ++i) w[i] = i < 4 ? dw0[i] : dw1[i - 4];
                LDEC(3);
#pragma unroll
                for (int i = 0; i < 8; ++i) w[i] = __expf(-0.60653065971f * pg8::sigm(ec[i] + w[i]));
                LDEC(4);
#pragma unroll
                for (int i = 0; i < 8; ++i) a[i] = pg8::sigm(ec[i] + (i < 4 ? da0[i] : da1[i - 4]));
                LDEC(5);
#pragma unroll
                for (int i = 0; i < 8; ++i) { kk[i] = k[i] * ec[i]; n2 += kk[i] * kk[i]; }
                LDEC(6);
#pragma unroll
                for (int i = 0; i < 8; ++i) kp[i] = k[i] * (1.f + (a[i] - 1.f) * ec[i]);
                LDEC(7);
                n2 = red8(n2); const float inv = __builtin_amdgcn_rsqf(fmaxf(n2, 1e-24f));
                float c1 = 0.f, c2 = 0.f, c3 = 0.f;
#pragma unroll
                for (int i = 0; i < 8; ++i) { kk[i] *= inv; t[i] = kk[i] * a[i]; c1 += t[i] * r[i]; c2 += kp[i] * r[i]; c3 += r[i] * kp[i] * ec[i]; }
#undef LDEC
                c1 = red8(c1); c2 = red8(c2); c3 = red8(c3);
                *(LAS f32x4*)(sp + 8 * g) = (f32x4){kk[0], kk[1], kk[2], kk[3]}; *(LAS f32x4*)(sp + 8 * g + 4) = (f32x4){kk[4], kk[5], kk[6], kk[7]};
                *(LAS f32x4*)(sp + 64 + 8 * g) = (f32x4){w[0] * r[0], w[1] * r[1], w[2] * r[2], w[3] * r[3]}; *(LAS f32x4*)(sp + 64 + 8 * g + 4) = (f32x4){w[4] * r[4], w[5] * r[5], w[6] * r[6], w[7] * r[7]};
                *(LAS f32x4*)(sp + 128 + 8 * g) = (f32x4){w[0], w[1], w[2], w[3]}; *(LAS f32x4*)(sp + 128 + 8 * g + 4) = (f32x4){w[4], w[5], w[6], w[7]};
                *(LAS f32x4*)(sp + 192 + 8 * g) = (f32x4){t[0], t[1], t[2], t[3]}; *(LAS f32x4*)(sp + 192 + 8 * g + 4) = (f32x4){t[4], t[5], t[6], t[7]};
                *(LAS f32x4*)(sp + 256 + 8 * g) = (f32x4){kp[0], kp[1], kp[2], kp[3]}; *(LAS f32x4*)(sp + 256 + 8 * g + 4) = (f32x4){kp[4], kp[5], kp[6], kp[7]};
                if (g == rg) { *(LAS f32x4*)(sp + 320) = (f32x4){v[0], v[1], v[2], v[3]}; *(LAS f32x4*)(sp + 324) = (f32x4){v[4], v[5], v[6], v[7]}; }
                if (g == 0) { sp[328] = c1; sp[329] = c2; if (rg == 0) C3[row * 8 + h] = c3; } }
            asm volatile("s_waitcnt lgkmcnt(0)\n\ts_barrier" ::: "memory");
        }
#undef ELEM_LOAD
    } else {
        const int rowl = 4 * (wid & 1) + (lane >> 4), cgp = lane & 15;
        f32x2s S01 = {0.f, 0.f}, S23 = {0.f, 0.f};
#pragma unroll 1
        for (int it = 0; it < NCH + 2; ++it) {
            const int c = it - 2;
            if (c >= 0) { const LAS float* SBF = (const LAS float*)(lds + RW_SBUF + (c & 1) * RW_SBUF_BYTES);
                float* yp = YRAW + (rb + (size_t)c * TC) * 512 + h * 64 + 8 * rg + rowl;
                __builtin_amdgcn_s_setprio(3);
                f32x4 kkA, wrA, wA, kaA, kpA, kkB, wrB, wB, kaB, kpB; float viA, viB; float pkeep = 0.f, qkeep = 0.f;
#define LDREC(X, s_) do { const LAS float* sp_ = SBF + (s_) * SBS; kk##X = *(const LAS f32x4*)(sp_ + 4 * cgp); wr##X = *(const LAS f32x4*)(sp_ + 64 + 4 * cgp); w##X = *(const LAS f32x4*)(sp_ + 128 + 4 * cgp); \
                    ka##X = *(const LAS f32x4*)(sp_ + 192 + 4 * cgp); kp##X = *(const LAS f32x4*)(sp_ + 256 + 4 * cgp); vi##X = sp_[320 + rowl]; } while (0)
#define LO2(v) __builtin_shufflevector(v, v, 0, 1)
#define HI2(v) __builtin_shufflevector(v, v, 2, 3)
#define STEPREC(X, s_) do { f32x2s pp = S01 * LO2(kk##X); pp = S23 * HI2(kk##X) + pp; f32x2s qq = S01 * LO2(wr##X); qq = S23 * HI2(wr##X) + qq; float p = pp[0] + pp[1], q = qq[0] + qq[1]; \
                    const f32x2s vv_ = {vi##X, vi##X}; const f32x2s u01_ = S01 * LO2(w##X) + LO2(kp##X) * vv_, u23_ = S23 * HI2(w##X) + HI2(kp##X) * vv_;     \
                    p += dpp_f<0xB1>(p); q += dpp_f<0xB1>(q); p += dpp_f<0x4E>(p); q += dpp_f<0x4E>(q); p += dpp_f<0x141>(p); q += dpp_f<0x141>(q); p += dpp_f<0x140>(p); q += dpp_f<0x140>(q); \
                    const f32x2s pv_ = {p, p}; \
                    S01 = u01_ - LO2(ka##X) * pv_; S23 = u23_ - HI2(ka##X) * pv_; \
                    pkeep = (((s_) & 15) == cgp) ? p : pkeep; qkeep = (((s_) & 15) == cgp) ? q : qkeep;     \
                    if (((s_) & 15) == 15) { const LAS float* sy_ = SBF + ((s_) - 15 + cgp) * SBS; const f32x2s cy_ = *(const LAS f32x2s*)(sy_ + 328); \
                        yp[(size_t)((s_) - 15 + cgp) * 512] = qkeep - pkeep * cy_[0] + sy_[320 + rowl] * cy_[1]; } } while (0)
                LDREC(A, 0);
#pragma unroll
                for (int s = 0; s < TC; s += 2) {
 LDREC(B, s + 1); STEPREC(A, s); LDREC(A, s + 2); STEPREC(B, s + 1); }
#undef LDREC
#undef STEPREC
#undef LO2
#undef HI2
                __builtin_amdgcn_s_setprio(0); }
            asm volatile("s_waitcnt lgkmcnt(0)\n\ts_barrier" ::: "memory");
        }
    }
    __syncthreads();
}

__device__ __forceinline__ void rwkv_post_unit(int tile, const bf16* PROJ, const float* YRAW, const float* C3, bf16* Y, const float* mu, const bf16* g2f, const float* ln_w, const float* ln_b, int lane, int wid) {
    asm volatile("" : "+s"(PROJ), "+s"(mu), "+s"(g2f), "+s"(YRAW));
    const int h = wid, r32 = lane & 31, hi = lane >> 5; const int tok0 = tile * 32; const bool first = (tok0 & (SEQ - 1)) == 0;
    bf16x8 afr[8];
    { const int tk = tok0 + r32; const bool hp = !(first && r32 == 0); v4u cwv[8], pwv[8];
      const __attribute__((address_space(1))) bf16* pg = (const __attribute__((address_space(1))) bf16*)(PROJ + (size_t)tk * EVEN_IN + 768 + 1664 + 8 * hi);
#pragma unroll
        for (int ks = 0; ks < 8; ++ks) { cwv[ks] = *(const __attribute__((address_space(1))) v4u*)(pg + 16 * ks); pwv[ks] = (v4u){0u, 0u, 0u, 0u};
            if (hp) pwv[ks] = *(const __attribute__((address_space(1))) v4u*)(pg - EVEN_IN + 16 * ks); }
#pragma unroll
        for (int ks = 0; ks < 8; ++ks) { float c[8], p[8]; unpack8(cwv[ks], c); unpack8(pwv[ks], p);
            const f32x4 m0 = *(const f32x4*)(mu + 1664 + 16 * ks + 8 * hi), m1 = *(const f32x4*)(mu + 1664 + 16 * ks + 8 * hi + 4);
#pragma unroll
            for (int i = 0; i < 8; ++i) c[i] = pg8::sigm(c[i] + (p[i] - c[i]) * (i < 4 ? m0[i] : m1[i - 4]));
            afr[ks] = pack8(c); } }
    f32x16 gt[2];
#pragma unroll
    for (int nb = 0; nb < 2; ++nb) { gt[nb] = f32x16{};
#pragma unroll
        for (int ks = 0; ks < 8; ++ks) { const bf16x8 bf = *(const bf16x8*)(g2f + ((size_t)((h * 2 + nb) * 8 + ks) * 64 + lane) * 8);
            gt[nb] = __builtin_amdgcn_mfma_f32_32x32x16_bf16(afr[ks], bf, gt[nb], 0, 0, 0); } }
    typedef const __attribute__((address_space(1))) float* gfp; typedef const __attribute__((address_space(1))) unsigned short* gup;
    const int ch0 = h * 64 + r32; const float lw0 = ln_w[ch0], lw1 = ln_w[ch0 + 32], lb0 = ln_b[ch0], lb1 = ln_b[ch0 + 32], mv0 = mu[1024 + ch0], mv1 = mu[1024 + ch0 + 32];
    float y0[16], y1[16], c3v[16]; unsigned vc[16], vp[16];
#pragma unroll
    for (int r = 0; r < 16; ++r) { const int tk = tok0 + crow(r, hi); gfp yp = (gfp)(YRAW + (size_t)tk * 512 + ch0); y0[r] = yp[0]; y1[r] = yp[32]; c3v[r] = ((gfp)C3)[(size_t)tk * 8 + h];
        gup vq = (gup)(PROJ + (size_t)tk * EVEN_IN + 768 + 1024 + ch0); vc[r] = (unsigned)vq[0] | ((unsigned)vq[32] << 16); vp[r] = 0u;
        if ((tk & (SEQ - 1)) != 0) vp[r] = (unsigned)vq[-EVEN_IN] | ((unsigned)vq[32 - EVEN_IN] << 16); }
#pragma unroll
    for (int r = 0; r < 16; ++r) { const int tk = tok0 + crow(r, hi);
        float s = y0[r] + y1[r]; s = red16(s); s += __shfl_xor(s, 16);
        const float mean = s * (1.f / 64.f), d0 = y0[r] - mean, d1 = y1[r] - mean; float q = d0 * d0 + d1 * d1; q = red16(q); q += __shfl_xor(q, 16);
        const float rstd = rsqrtf(q * (1.f / 64.f) + GN_EPS);
        const float cv0 = bflo(vc[r]), cv1 = bfhi(vc[r]), pv0 = bflo(vp[r]), pv1 = bfhi(vp[r]);
        const float v0 = cv0 + (pv0 - cv0) * mv0, v1 = cv1 + (pv1 - cv1) * mv1;
        const float o0 = (d0 * rstd * lw0 + lb0 + c3v[r] * v0) * gt[0][r], o1 = (d1 * rstd * lw1 + lb1 + c3v[r] * v1) * gt[1][r];
        bf16* op = Y + (size_t)tk * 1024 + 512 + ch0; op[0] = (bf16)(pk2(o0, 0.f) & 0xffffu); op[32] = (bf16)(pk2(o1, 0.f) & 0xffffu); }
}

__device__ __forceinline__ void fox_gate_pass(const bf16* XB, const bf16* Wf, const float* ssqv, const float* bfv, float* LF, int gw, int NGW, int lane) {
    typedef float f32x4g __attribute__((ext_vector_type(4)));
    const int fr = lane & 15, fq = lane >> 4;
    for (int t = gw; t < M / 16; t += NGW) {
        const bf16* ap = XB + (size_t)(t * 16 + fr) * D + 8 * fq; const bf16* bp = Wf + (size_t)fr * D + 8 * fq;
        f32x4g acc = {0.f, 0.f, 0.f, 0.f};
#pragma unroll 8
        for (int ks = 0; ks < D / 32; ++ks) acc = __builtin_amdgcn_mfma_f32_16x16x32_bf16(*(const bf16x8*)(ap + 32 * ks), *(const bf16x8*)(bp + 32 * ks), acc, 0, 0, 0);
        const float bn = bfv[fr];
#pragma unroll
        for (int j = 0; j < 4; ++j) { const int row = t * 16 + 4 * fq + j; const float z = fmaxf(acc[j] * pg8::rstd_of(ssqv, row) + bn, -80.f), e = __expf(-z);
            LF[(size_t)row * 16 + fr] = (e < 0.01f) ? -(e - 0.5f * e * e + e * e * e * (1.f / 3.f)) : -__logf(1.f + e); }
    }
}

__device__ __forceinline__ void fox_prefix(const float* LFbh, LAS float* cs, LAS float* wtot, int tid, int lane, int wid) {
    const float* lp = LFbh + (size_t)tid * 128;
    float s[8]; s[0] = lp[0]; s[1] = s[0] + lp[16]; s[2] = s[1] + lp[32]; s[3] = s[2] + lp[48]; s[4] = s[3] + lp[64]; s[5] = s[4] + lp[80]; s[6] = s[5] + lp[96]; s[7] = s[6] + lp[112];
    float incl = s[7];
#pragma unroll
    for (int o = 1; o < 64; o <<= 1) { const float t = __shfl_up(incl, o); if (lane >= o) incl += t; }
    if (lane == 63) wtot[wid] = incl;
    __syncthreads();
    float base = incl - s[7];
    for (int w = 0; w < wid; ++w) base += wtot[w];
#pragma unroll
    for (int i = 0; i < 8; ++i) cs[8 * tid + i] = (base + s[i]) * LOG2E;
    __syncthreads();
}
struct Args { const float* in[30]; float* out; unsigned char* ws; int ph_lo, ph_hi; };
#define AS4 __attribute__((address_space(4)))
#ifndef DUP_SWA
#define DUP_SWA 0
#endif
#ifndef DUP_SCAN
#define DUP_SCAN 0
#endif
#ifndef DUP_POST
#define DUP_POST 0
#endif
#ifndef DUP_GU
#define DUP_GU 0
#endif
#ifndef DUP_INPROJ
#define DUP_INPROJ 0
#endif
#ifndef DUP_P0
#define DUP_P0 0
#endif
#ifndef DUP_SYNC
#define DUP_SYNC 0
#endif
#define INP(i) (*(const float* const AS4*)(kp + 8 * (i)))
#define GSYNC() xcd_barrier(xbar)
#define FRESH() const AS4 char* kp = kp0; asm volatile("" : "+s"(kp)); unsigned char* ws = *(unsigned char* const AS4*)(kp + 248); float* X = *(float* const AS4*)(kp + 240); \
    int tid = threadIdx.x; asm volatile("" : "+v"(tid)); const int lane = tid & 63, wid = __builtin_amdgcn_readfirstlane(tid >> 6); \
    const int gw = bx * 8 + wid, NGW = G * 8; \
    float* ssq = (float*)(ws + WS_SSQP); float* C3 = (float*)(ws + WS_C3); float* LF = (float*)(ws + WS_LF); \
    bf16* XB = (bf16*)(ws + WS_XB); float* YRAW = (float*)(ws + WS_XB); bf16* Y = (bf16*)(ws + WS_Y); \
    bf16* H = (bf16*)(ws + WS_BIG); bf16* PROJ = (bf16*)(ws + WS_BIG); bf16* PP = (bf16*)(ws + WS_BIG); bf16* PB = (bf16*)(ws + WS_PB); \
    bf16* Qb = (bf16*)(ws + WS_BIG); bf16* Kb = Qb + (size_t)M * D; bf16* Vb = Kb + (size_t)M * D; \
    (void)X; (void)lane; (void)wid; (void)gw; (void)NGW; (void)ssq; (void)C3; (void)LF; (void)XB; (void)YRAW; (void)Y; (void)H; (void)PROJ; (void)PP; (void)PB; (void)Qb; (void)Kb; (void)Vb
__global__ void __launch_bounds__(512, 2) fwd_megakernel(Args a_unused) {
    extern __shared__ __attribute__((aligned(16))) unsigned char lds_raw[];
    cg::grid_group grid = cg::this_grid();
    LAS unsigned char* lds = (LAS unsigned char*)lds_raw;
    const int G = gridDim.x, bx = blockIdx.x;
    const AS4 char* kp0 = (const AS4 char*)__builtin_amdgcn_kernarg_segment_ptr();
    const int ph_lo = *(const int AS4*)(kp0 + 256), ph_hi = *(const int AS4*)(kp0 + 260);
    XcdBarrier xbar;
    { unsigned* barw = (unsigned*)(*(unsigned char* const AS4*)(kp0 + 248) + WS_BAR);
      if (bx == 0) for (int i = threadIdx.x; i < XCD_BAR_WORDS; i += 512) barw[i] = 0u;
      if (threadIdx.x < 4) ((LAS unsigned*)(lds + MISC_OFF))[threadIdx.x] = 0u;
      asm volatile("s_waitcnt vmcnt(0)" ::: "memory"); __syncthreads();
      grid.sync();
      __builtin_amdgcn_fence(__ATOMIC_ACQUIRE, "agent"); asm volatile("s_waitcnt vmcnt(0)" ::: "memory");
      xbar = xcd_barrier_post(barw, (volatile LAS unsigned*)(lds + MISC_OFF)); }

#ifdef NANFILL
    { FRESH(); v4u q = {0xffffffffu, 0xffffffffu, 0xffffffffu, 0xffffffffu};
      for (size_t i = (size_t)bx * 512 + tid; i < WS_END / 16; i += (size_t)G * 512) ((v4u*)ws)[i] = q;
      for (size_t i = (size_t)bx * 512 + tid; i < (size_t)M * D / 4; i += (size_t)G * 512) ((v4u*)X)[i] = q;
      for (int i = tid; i < LDS_BYTES / 4; i += 512) ((LAS unsigned*)lds)[i] = 0xffffffffu; }
    GSYNC();
#endif
    for (int dup = 0; dup < 1 + DUP_P0; ++dup)
    if (ph_lo == 0) {
        FRESH();
        LAS float* scr = (LAS float*)(lds + wid * 16384);
        constexpr int I_GU = (D / 64) * (2 * DFF / 32), I_D = (DFF / 64) * (D / 32), I_G = (D / 64) * (D / 32), I_P = (PLE / 64) * (D / 32), I_IN0 = (D / 64) * (EVEN_IN / 32), I_IN1 = (D / 64) * (FOX_INP / 32);
        constexpr int NITEMS = 4 * I_GU + 4 * I_D + 2 * I_G + 2 * I_P + I_IN0 + I_IN1 + 2 * I_G;
        for (int it = gw; it < NITEMS; it += NGW) {
            int r = it;
#define MAT(cnt, W_, K_, N_, NP_, WT_, G_, MODE_) if (r < (cnt)) { conv_item((W_), (K_), (N_), (NP_), (bf16*)(WT_), (G_), (MODE_), scr, r, lane); continue; } r -= (cnt);
            MAT(I_GU, INP(3), D, 2 * DFF, 2 * DFF, ws + WS_WGU, INP(2), 1)
            MAT(I_GU, INP(7), D, 2 * DFF, 2 * DFF, ws + WS_WGU + 11 * MiB, INP(6), 1)
            MAT(I_GU, INP(3) + (size_t)D * 2 * DFF, D, 2 * DFF, 2 * DFF, ws + WS_WGU + 22 * MiB, INP(2) + D, 1)
            MAT(I_GU, INP(7) + (size_t)D * 2 * DFF, D, 2 * DFF, 2 * DFF, ws + WS_WGU + 33 * MiB, INP(6) + D, 1)
            MAT(I_D, INP(4), DFF, D, D, ws + WS_WD, nullptr, 0)
            MAT(I_D, INP(8), DFF, D, D, ws + WS_WD + (size_t)D * DFF * 2, nullptr, 0)
            MAT(I_D, INP(4) + (size_t)D * DFF, DFF, D, D, ws + WS_WD + (size_t)D * DFF * 4, nullptr, 0)
            MAT(I_D, INP(8) + (size_t)D * DFF, DFF, D, D, ws + WS_WD + (size_t)D * DFF * 6, nullptr, 0)
            MAT(I_G, INP(10), D, D, D, ws + WS_WG, INP(9), 0)
            MAT(I_G, INP(10) + (size_t)D * D, D, D, D, ws + WS_WG + 2 * MiB, INP(9) + D, 0)
            MAT(I_P, INP(11), PLE, D, D, ws + WS_WP, nullptr, 0)
            MAT(I_P, INP(11) + (size_t)PLE * D, PLE, D, D, ws + WS_WP + (size_t)PLE * D * 2, nullptr, 0)
            MAT(I_IN0, INP(12), D, EVEN_IN, EVEN_IN, ws + WS_WIN0, INP(5), 0)
            MAT(I_IN1, INP(26), D, FOX_IN, FOX_INP, ws + WS_WIN1, INP(5) + D, 0)
            MAT(I_G, INP(13), D, D, D, ws + WS_WOUT0, nullptr, 0)
            MAT(I_G, INP(28), D, D, D, ws + WS_WOUT1, nullptr, 0)
#undef MAT
        }
        const float* x_in = INP(0);
        for (int m = gw; m < M; m += NGW) { const f32x4* xr = (const f32x4*)(x_in + (size_t)m * D) + lane; f32x4 v[4]; float s = 0.f;
#pragma unroll
            for (int j = 0; j < 4; ++j) { v[j] = xr[64 * j]; s += (v[j][0] * v[j][0] + v[j][1] * v[j][1]) + (v[j][2] * v[j][2] + v[j][3] * v[j][3]); }
            s = wave_sum(s); if (lane < 16) ssq[(size_t)m * 16 + lane] = (lane == 0) ? s : 0.f;
            v2u* o = (v2u*)(XB + (size_t)m * D) + lane;
#pragma unroll
            for (int j = 0; j < 4; ++j) { v2u w; w.x = pk2(v[j][0], v[j][1]); w.y = pk2(v[j][2], v[j][3]); o[64 * j] = w; } }
        const float* g2 = INP(20);
        for (int i = bx * 512 + tid; i < 8192; i += G * 512) { const int ln = i & 63, ks = (i >> 6) & 7, nb = (i >> 9) & 1, hh = i >> 10; float f[8];
#pragma unroll
            for (int j = 0; j < 8; ++j) f[j] = g2[(size_t)(16 * ks + 8 * (ln >> 5) + j) * 512 + hh * 64 + 32 * nb + (ln & 31)];
            ((bf16x8*)(ws + WS_G2F))[i] = pack8(f); }
    }
    if (ph_lo == 0 && ph_hi > 1) GSYNC();

#define GEMM(EpiT, Aptr, Bptr, Nn, Kk, Eobj) do { pg8::Gemm g_{(const pg8::bf16_t*)(Aptr), (const pg8::bf16_t*)(Bptr), M, (Nn), (Kk)}; pg8::StaticOrder S_; S_.init(M, (Nn), G, bx); \
        pg8::gemm_phase<EpiT, pg8::StaticOrder, true, true>(lds, g_, S_, (Eobj), tid); } while (0)
#pragma unroll 1
    for (int L = 0; L < 2; ++L) {
#pragma unroll 1
        for (int st = 0; st < 9; ++st) {
            const int ph = 1 + 9 * L + st; if (ph < ph_lo || ph >= ph_hi) continue;
            switch (st) {
            case 0: case 6: {
#if PHM & 1
                FRESH();
                for (int dup = 0; dup < 1 + DUP_GU; ++dup) {
                const int f = (st == 6); pg8::EpiGU E{H, ssq + (size_t)((f ? 2 : 0) & 1) * M * 16};
                GEMM(pg8::EpiGU, (L == 1 && st == 0) ? Y : XB, ws + WS_WGU + (size_t)(L * 2 + f) * 11 * MiB, 2 * DFF, D, E);
                __syncthreads(); }
#endif
            } break;
            case 1: case 5: case 7: {
#if PHM & 2
                FRESH();
                const bf16* A; const bf16* Bt; int K; float alpha; float* so;
                if (st == 5) { A = (L == 0) ? Y : Qb; Bt = (const bf16*)(ws + (L == 0 ? WS_WOUT0 : WS_WOUT1)); K = D; alpha = 1.f; so = ssq; }
                else { const int f = (st == 7); A = H; Bt = (const bf16*)(ws + WS_WD + (size_t)(L * 2 + f) * D * DFF * 2); K = DFF; alpha = 0.5f; so = ssq + (size_t)M * 16; }
                pg8::EpiRes E{(L == 0 && st == 1) ? INP(0) : (const float*)X, X, XB, so, alpha};
                GEMM(pg8::EpiRes, A, Bt, D, K, E);
                if (st == 7) {
                    const f32x4* ps = (const f32x4*)(INP(1) + (size_t)L * M * PLE);
                    for (int i = bx * 512 + tid; i < M * PLE / 8; i += G * 512) { const f32x4 u0 = ps[2 * i], u1 = ps[2 * i + 1]; v4u w; w.x = pk2(u0[0], u0[1]); w.y = pk2(u0[2], u0[3]); w.z = pk2(u1[0], u1[1]); w.w = pk2(u1[2], u1[3]); ((v4u*)PB)[i] = w; }
                }
#endif
            } break;
            case 2: {
#if PHM & 4
                FRESH();
                pg8::EpiStore E{Qb, L ? D : EVEN_IN, ssq + (size_t)M * 16, QSCALE, L ? 4 : 2, L ? 4 : 1000, (size_t)M * D, -1, LF, INP(27)};
                for (int dup = 0; dup < 1 + DUP_INPROJ; ++dup) { GEMM(pg8::EpiStore, XB, ws + (L ? WS_WIN1 : WS_WIN0), L ? 3 * D : EVEN_IN, D, E); __syncthreads(); }
                if (L == 1) fox_gate_pass(XB, (const bf16*)(ws + WS_WIN1) + (size_t)3 * D * D, ssq + (size_t)M * 16, INP(27), LF, gw, NGW, lane);
#endif
            } break;
            case 3: {
                if (L == 0) {
#if PHM & 8
                    { FRESH();
#pragma unroll 1
                    for (int dup = 0; dup < 1 + DUP_SWA; ++dup)
                    for (int u = bx; u < 256; u += G) swa_unit(u, PROJ, Y, INP(14), lds, tid, lane, wid); }
#endif
#if PHM & 16
                    { FRESH();
#pragma unroll 1
                    for (int dup = 0; dup < 1 + DUP_SCAN; ++dup)
                    for (int u = bx; u < 256; u += G) rwkv_scan_unit(u, PROJ, YRAW, C3, INP(15), INP(16), INP(17), INP(18), INP(19), INP(21), INP(22), INP(23), lds, lane, wid); }
#endif
                } else {
#if PHM & 32
                    FRESH();
                    const int vcu = (G % 8 == 0) ? (bx % 8) * (G / 8) + bx / 8 : bx;
#pragma unroll 1
                    for (int v = vcu; v < 256; v += G)
#pragma unroll 1
                        for (int i = 0; i < 4; ++i) { int tid2 = tid; asm volatile("" : "+v"(tid2)); const int lane2 = tid2 & 63, wid2 = __builtin_amdgcn_readfirstlane(tid2 >> 6); const int s = v & 3, bh = v >> 2, qb = (i == 0) ? s : (i == 1) ? 7 - s : (i == 2) ? 8 + s : 15 - s;
                            if (i == 0) fox_prefix(LF + (size_t)(bh >> 4) * SEQ * 16 + (bh & 15), (LAS float*)(lds + 98304), (LAS float*)(lds + 98304 + 16384), tid2, lane2, wid2);
                            attn_body::attn_unit<60>(bh >> 4, bh & 15, qb, (const attn_body::bf16*)Qb, (const attn_body::bf16*)Kb, (const attn_body::bf16*)Vb, (attn_body::bf16*)Qb, (char*)lds_raw, (attn_body::lds_fptr)(lds + 98304), tid2); }
#endif
                }
            } break;
            case 4: {
#if PHM & 64
                if (L == 0) { FRESH();
#pragma unroll 1
                    for (int dup = 0; dup < 1 + DUP_POST; ++dup)
                    for (int t = bx; t < M / 32; t += G) rwkv_post_unit(t, PROJ, YRAW, C3, Y, INP(15), (const bf16*)(ws + WS_G2F), INP(24), INP(25), lane, wid); }
#endif
            } break;
            case 8: {
#if PHM & 128
                FRESH();
#pragma unroll 1
                for (int mode = 0; mode < 2; ++mode) {
                    pg8::EpiPle E{mode, X, Y, PP, ssq + (size_t)M * 16, ssq};
                    GEMM(pg8::EpiPle, mode ? XB : PB, mode ? ws + WS_WG + (size_t)L * 2 * MiB : ws + WS_WP + (size_t)L * PLE * D * 2, D, mode ? D : PLE, E);
                    __syncthreads();
                }
#endif
            } break;
            }
            if (!(L == 1 && st == 4) && ph + 1 < ph_hi) { GSYNC(); for (int dup = 0; dup < DUP_SYNC; ++dup) GSYNC(); }
        }
    }
#undef GEMM
    if (ph_hi == 20) { FRESH(); const float* fg = INP(29); const float* s8 = ssq;
        for (int m = gw; m < M; m += NGW) { f32x4* xr = (f32x4*)(X + (size_t)m * D) + lane; const float rs = pg8::rstd_of(s8, m);
#pragma unroll
            for (int j = 0; j < 4; ++j) { const f32x4 gv = ((const f32x4*)fg)[lane + 64 * j]; xr[64 * j] = xr[64 * j] * rs * gv; } } }
}

extern "C" void kernel_launch(void* const* d_in, const int* in_sizes, int n_in, void* d_out, int out_size, void* d_ws, size_t ws_size, hipStream_t stream) {
    static int grid = 0;
    if (grid == 0) {
        if (n_in != 30 || out_size != M * D || ws_size < WS_END) { fprintf(stderr, "kernel_launch: unexpected shapes (n_in %d out %d ws %zu)\n", n_in, out_size, ws_size); grid = -1; return; }
        int dev = 0, cus = 0, per_cu = 0;
        if (hipGetDevice(&dev) != hipSuccess || hipDeviceGetAttribute(&cus, hipDeviceAttributeMultiprocessorCount, dev) != hipSuccess) { grid = -1; return; }
        if (hipFuncSetAttribute((const void*)fwd_megakernel, hipFuncAttributeMaxDynamicSharedMemorySize, LDS_BYTES) != hipSuccess) { fprintf(stderr, "kernel_launch: hipFuncSetAttribute failed\n"); grid = -1; return; }
        if (hipOccupancyMaxActiveBlocksPerMultiprocessor(&per_cu, (const void*)fwd_megakernel, 512, LDS_BYTES) != hipSuccess || per_cu < 1) { fprintf(stderr, "kernel_launch: occupancy query failed (%d)\n", per_cu); (void)hipGetLastError(); grid = -1; return; }
        grid = cus * per_cu;
        if (grid > 256) grid = 256;
    }
    if (grid < 0) return;
    Args a{};
    for (int i = 0; i < 30; ++i) a.in[i] = (const float*)d_in[i];
    a.out = (float*)d_out; a.ws = (unsigned char*)d_ws;
#ifndef N_LAUNCH_PER_PHASE
    a.ph_lo = 0; a.ph_hi = 20;
    { void* args[] = {&a};
      hipError_t e = hipLaunchCooperativeKernel((const void*)fwd_megakernel, dim3(grid), dim3(512), args, LDS_BYTES, stream);
      if (e != hipSuccess) fprintf(stderr, "cooperative launch failed: %s (grid %d)\n", hipGetErrorString(e), grid); }
#else
    for (int ph = 0; ph < 20; ++ph) { if (ph == 14) continue; a.ph_lo = ph; a.ph_hi = ph + 1; void* args[] = {&a};
      hipError_t e = hipLaunchCooperativeKernel((const void*)fwd_megakernel, dim3(grid), dim3(512), args, LDS_BYTES, stream);
      if (e != hipSuccess) { fprintf(stderr, "cooperative launch failed: %s (grid %d)\n", hipGetErrorString(e), grid); break; } }
#endif
}
```

```cpp
#include <hip/hip_runtime.h>
#include <hip/hip_cooperative_groups.h>
#include <hip/hip_bf16.h>
#include <cstdio>
#include <cstdint>
#include <cmath>
namespace cg = cooperative_groups;
#ifndef PHM
#define PHM 255
#endif
namespace pg8 {
#define PG8_LAS __attribute__((address_space(3)))
typedef unsigned short bf16_t;
typedef short bf16x8 __attribute__((ext_vector_type(8)));
typedef float f32x4 __attribute__((ext_vector_type(4)));
typedef unsigned u32x4 __attribute__((ext_vector_type(4)));
constexpr int BM = 256, BK = 64, HALF = 128, HTB = HALF * BK * 2  , STAGE_BYTES = 8 * HTB, NXCD = 8, WGM = 8;

__host__ __device__ __forceinline__ int lds_byte(int r, int c) { const int st = (r >> 4) * 2 + (c >> 5), rr = r & 15, cc = c & 31, ob = rr * 64 + cc * 2; return st * 1024 + (ob ^ (((ob >> 9) & 1) << 5)); }
__host__ __device__ __forceinline__ void stage_rc(int b, int& R, int& C) { const int st = b / 1024, sb = b % 1024, swz = sb ^ (((sb >> 9) & 1) << 5); R = (st >> 1) * 16 + swz / 64; C = (st & 1) * 32 + (swz % 64) / 2; }
__host__ __device__ __forceinline__ int perm32(int rho) { const int n = rho >> 4, i = rho & 15; return 8 * (i >> 2) + 4 * n + (i & 3); }

struct Unit { int pm, pn; };
struct Gemm { const bf16_t* A; const bf16_t* Bt; int M, N, K; };

struct StaticOrder {
    int nM, nN, nwg, G, c;
    __host__ __device__ void init(int M, int N, int G_, int c_) { nM = M / BM; nN = N / BM; nwg = nM * nN; G = G_; c = c_; }
    __host__ __device__ bool next(int i, Unit& u) const {
        const long L = (long)i * G + c; if (L >= nwg) return false;
        int wgid = (int)L; { const int q = nwg / NXCD, r = nwg % NXCD, xcd = wgid % NXCD, off = wgid / NXCD; wgid = (xcd < r ? xcd * (q + 1) : r * (q + 1) + (xcd - r) * q) + off; }
        const int nig = WGM * nN, gid = wgid / nig, fm = gid * WGM, gsz = (nM - fm) < WGM ? (nM - fm) : WGM;
        u.pm = fm + ((wgid % nig) % gsz); u.pn = (wgid % nig) / gsz; return true;
    }
    __device__ __forceinline__ void a_ready(const Unit&) const {}
    __device__ __forceinline__ void done(const Unit&) const {}
};

typedef float f32x2_c __attribute__((ext_vector_type(2))); typedef __bf16 bf16x2_c __attribute__((ext_vector_type(2)));
__device__ __forceinline__ unsigned cvt_pk_bf16(float lo, float hi) { f32x2_c v = {lo, hi}; bf16x2_c b = __builtin_convertvector(v, bf16x2_c); return __builtin_bit_cast(unsigned, b); }
typedef float f32x2 __attribute__((ext_vector_type(2)));
constexpr float NORM_EPS = 1e-6f;
__device__ __forceinline__ float ssq_sum(const float* ssq, int row) { const f32x4* p = (const f32x4*)(ssq + (size_t)row * 16); const f32x4 a = p[0], b = p[1], c = p[2], d = p[3];
    return ((a[0] + a[1]) + (a[2] + a[3])) + ((b[0] + b[1]) + (b[2] + b[3])) + (((c[0] + c[1]) + (c[2] + c[3])) + ((d[0] + d[1]) + (d[2] + d[3]))); }
__device__ __forceinline__ float rstd_of(const float* ssq, int row) { return rsqrtf(ssq_sum(ssq, row) * (1.0f / 1024.0f) + NORM_EPS); }
__device__ __forceinline__ float sigm(float x) { return __builtin_amdgcn_rcpf(1.0f + __expf(-x)); }
struct EpiGU { static constexpr bool PERM = true, AFTER_DRAIN = false;
    bf16_t* H; const float* ssq;
    __device__ __forceinline__ void operator()(const f32x4 (&acc)[2][2][4][2], const Unit& u, int wr, int wc, int fr, int fq) const {
        int row0 = u.pm * BM + wr * 64 + fr; asm volatile("" : "+v"(row0)); const int col0 = u.pn * 128 + wc * 32 + 8 * fq;
#pragma unroll
        for (int ai = 0; ai < 2; ++ai)
#pragma unroll
            for (int m = 0; m < 4; ++m) { const int row = row0 + ai * HALF + m * 16; const float rs = rstd_of(ssq, row);
                const f32x4 g0 = acc[ai][0][m][0] * rs, g1 = acc[ai][0][m][1] * rs, u0 = acc[ai][1][m][0] * rs, u1 = acc[ai][1][m][1] * rs;
                u32x4 w;
                w.x = cvt_pk_bf16(g0[0] * sigm(g0[0]) * u0[0], g0[1] * sigm(g0[1]) * u0[1]); w.y = cvt_pk_bf16(g0[2] * sigm(g0[2]) * u0[2], g0[3] * sigm(g0[3]) * u0[3]);
                w.z = cvt_pk_bf16(g1[0] * sigm(g1[0]) * u1[0], g1[1] * sigm(g1[1]) * u1[1]); w.w = cvt_pk_bf16(g1[2] * sigm(g1[2]) * u1[2], g1[3] * sigm(g1[3]) * u1[3]);
                *(u32x4*)(H + (size_t)row * 2816 + col0) = w; }
    }
};
struct EpiRes { static constexpr bool PERM = true, AFTER_DRAIN = false;
    const float* base; float* X; bf16_t* XB; float* ssq_out; float alpha;
    __device__ __forceinline__ void operator()(const f32x4 (&acc)[2][2][4][2], const Unit& u, int wr, int wc, int fr, int fq) const {
        int row0 = u.pm * BM + wr * 64 + fr; asm volatile("" : "+v"(row0)); const int col0 = u.pn * BM + wc * 32 + 8 * fq;
#pragma unroll
        for (int ai = 0; ai < 2; ++ai)
#pragma unroll
            for (int m = 0; m < 4; ++m) { const int row = row0 + ai * HALF + m * 16; float part = 0.f;
#pragma unroll
                for (int bj = 0; bj < 2; ++bj) { const size_t off = (size_t)row * 1024 + col0 + bj * HALF;
                    const f32x4 b0 = *(const f32x4*)(base + off), b1 = *(const f32x4*)(base + off + 4);
                    const f32x4 v0 = b0 + acc[ai][bj][m][0] * alpha, v1 = b1 + acc[ai][bj][m][1] * alpha;
                    *(f32x4*)(X + off) = v0; *(f32x4*)(X + off + 4) = v1;
                    u32x4 w; w.x = cvt_pk_bf16(v0[0], v0[1]); w.y = cvt_pk_bf16(v0[2], v0[3]); w.z = cvt_pk_bf16(v1[0], v1[1]); w.w = cvt_pk_bf16(v1[2], v1[3]);
                    *(u32x4*)(XB + off) = w;
                    part += (v0[0] * v0[0] + v0[1] * v0[1]) + (v0[2] * v0[2] + v0[3] * v0[3]) + (v1[0] * v1[0] + v1[1] * v1[1]) + (v1[2] * v1[2] + v1[3] * v1[3]); }
                part += __shfl_xor(part, 16); part += __shfl_xor(part, 32);
                if (fq == 0) ssq_out[(size_t)row * 16 + u.pn * 4 + wc] = part; }
    }
};
struct EpiPle { static constexpr bool PERM = true, AFTER_DRAIN = false;
    int mode; float* X; bf16_t* XB; bf16_t* PP; const float* ssq_in; float* ssq_out;
    __device__ __forceinline__ void operator()(const f32x4 (&acc)[2][2][4][2], const Unit& u, int wr, int wc, int fr, int fq) const {
        int row0 = u.pm * BM + wr * 64 + fr; asm volatile("" : "+v"(row0)); const int col0 = u.pn * BM + wc * 32 + 8 * fq;
#pragma unroll
        for (int ai = 0; ai < 2; ++ai)
#pragma unroll
            for (int m = 0; m < 4; ++m) { const int row = row0 + ai * HALF + m * 16; float part = 0.f; const float rs = mode ? rstd_of(ssq_in, row) : 1.f;
#pragma unroll
                for (int bj = 0; bj < 2; ++bj) { const size_t off = (size_t)row * 1024 + col0 + bj * HALF;
                    if (mode == 0) { const f32x4 v0 = acc[ai][bj][m][0], v1 = acc[ai][bj][m][1];
                        u32x4 w; w.x = cvt_pk_bf16(v0[0], v0[1]); w.y = cvt_pk_bf16(v0[2], v0[3]); w.z = cvt_pk_bf16(v1[0], v1[1]); w.w = cvt_pk_bf16(v1[2], v1[3]);
                        *(u32x4*)(PP + off) = w;
                    } else {
                        const u32x4 pw = *(const u32x4*)(PP + off);
                        const f32x4 p0 = {__uint_as_float(pw.x << 16), __uint_as_float(pw.x & 0xffff0000u), __uint_as_float(pw.y << 16), __uint_as_float(pw.y & 0xffff0000u)};
                        const f32x4 p1 = {__uint_as_float(pw.z << 16), __uint_as_float(pw.z & 0xffff0000u), __uint_as_float(pw.w << 16), __uint_as_float(pw.w & 0xffff0000u)};
                        const f32x4 b0 = *(const f32x4*)(X + off), b1 = *(const f32x4*)(X + off + 4);
                        const f32x4 a0 = acc[ai][bj][m][0] * rs, a1 = acc[ai][bj][m][1] * rs;
                        f32x4 v0, v1;
#pragma unroll
                        for (int j = 0; j < 4; ++j) { v0[j] = b0[j] + sigm(a0[j]) * p0[j]; v1[j] = b1[j] + sigm(a1[j]) * p1[j]; }
                        *(f32x4*)(X + off) = v0; *(f32x4*)(X + off + 4) = v1;
                        u32x4 w; w.x = cvt_pk_bf16(v0[0], v0[1]); w.y = cvt_pk_bf16(v0[2], v0[3]); w.z = cvt_pk_bf16(v1[0], v1[1]); w.w = cvt_pk_bf16(v1[2], v1[3]);
                        *(u32x4*)(XB + off) = w;
                        part += (v0[0] * v0[0] + v0[1] * v0[1]) + (v0[2] * v0[2] + v0[3] * v0[3]) + (v1[0] * v1[0] + v1[1] * v1[1]) + (v1[2] * v1[2] + v1[3] * v1[3]); } }
                if (mode) { part += __shfl_xor(part, 16); part += __shfl_xor(part, 32); if (fq == 0) ssq_out[(size_t)row * 16 + u.pn * 4 + wc] = part; } }
    }
};
struct EpiStore { static constexpr bool PERM = true, AFTER_DRAIN = false;
    bf16_t* O; int ldc; const float* ssq; float scale0; int scale_tiles; int split_tiles; size_t split_stride; int lf_tile; float* LF; const float* bfv;
    __device__ __forceinline__ void operator()(const f32x4 (&acc)[2][2][4][2], const Unit& u, int wr, int wc, int fr, int fq) const {
        int row0 = u.pm * BM + wr * 64 + fr; asm volatile("" : "+v"(row0));
        if (u.pn == lf_tile) {
            if (wc == 0 && fq < 2) {
#pragma unroll
                for (int ai = 0; ai < 2; ++ai)
#pragma unroll
                    for (int m = 0; m < 4; ++m) { const int row = row0 + ai * HALF + m * 16; const float rs = rstd_of(ssq, row);
#pragma unroll
                        for (int n = 0; n < 2; ++n) { f32x4 o;
#pragma unroll
                            for (int j = 0; j < 4; ++j) { const float z = fmaxf(acc[ai][0][m][n][j] * rs + bfv[8 * fq + 4 * n + j], -80.f), e = __expf(-z);
                                o[j] = (e < 0.01f) ? -(e - 0.5f * e * e + e * e * e * (1.f / 3.f)) : -__logf(1.f + e); }
                            *(f32x4*)(LF + (size_t)row * 16 + 8 * fq + 4 * n) = o; } }
            }
            return;
        }
        const int t = u.pn / split_tiles, ct = u.pn - t * split_tiles;
        bf16_t* base = O + (size_t)t * split_stride; const float sc = (u.pn < scale_tiles) ? scale0 : 1.f;
        const int col0 = ct * BM + wc * 32 + 8 * fq;
#pragma unroll
        for (int ai = 0; ai < 2; ++ai)
#pragma unroll
            for (int m = 0; m < 4; ++m) { const int row = row0 + ai * HALF + m * 16; const float rs = rstd_of(ssq, row) * sc;
#pragma unroll
                for (int bj = 0; bj < 2; ++bj) { const f32x4 v0 = acc[ai][bj][m][0] * rs, v1 = acc[ai][bj][m][1] * rs;
                    u32x4 w; w.x = cvt_pk_bf16(v0[0], v0[1]); w.y = cvt_pk_bf16(v0[2], v0[3]); w.z = cvt_pk_bf16(v1[0], v1[1]); w.w = cvt_pk_bf16(v1[2], v1[3]);
                    *(u32x4*)(base + (size_t)row * ldc + col0 + bj * HALF) = w; } }
    }
};

template <class Epi, class Sched, bool ALIGN_EPI = false, bool SP2 = false>
__device__ __forceinline__ void gemm_phase(PG8_LAS unsigned char* lds, const Gemm g, const Sched& S, const Epi& E, const int tid) {
    const int wid = __builtin_amdgcn_readfirstlane(tid >> 6), lane = tid & 63, wr = wid >> 2, wc = wid & 3, fr = lane & 15, fq = lane >> 4;
    const int K = g.K, nt = K / BK;
    unsigned voffA[2], voffB[2];
#pragma unroll
    for (int i = 0; i < 2; ++i) { int R, C; stage_rc(tid * 16 + i * 8192, R, C); const int Rb = Epi::PERM ? ((R & ~31) + perm32(R & 31)) : R;
        voffA[i] = (unsigned)(R * K + C) * 2u; voffB[i] = (unsigned)(Rb * K + C) * 2u; }
    const size_t kstep = (size_t)(BK * 2);
    const size_t hstep = (size_t)HALF * K * 2;
    const size_t tstep = 2 * hstep;
    const unsigned ldsw = (unsigned)wid * 1024u;
    const int aoff = lds_byte(wr * 64 + fr, fq * 8), boff = lds_byte(wc * 32 + fr, fq * 8);
#define PG8_SA(b, h) (((b) * 2 + (h)) * HTB)
#define PG8_SB(b, h) ((4 + (b) * 2 + (h)) * HTB)
#define PG8_STAGE(bufoff, gbase, voff) do { _Pragma("unroll") for (int _i = 0; _i < 2; ++_i) \
        __builtin_amdgcn_global_load_lds((const unsigned*)((const char*)(gbase) + (voff)[_i]), (PG8_LAS unsigned*)(lds + (bufoff) + ldsw + _i * 8192), 16, 0, 0); } while (0)
#define PG8_LDA(dst, b, h) do { _Pragma("unroll") for (int m = 0; m < 4; ++m) _Pragma("unroll") for (int k = 0; k < 2; ++k) dst[m][k] = *(const PG8_LAS bf16x8*)(lds + PG8_SA(b, h) + aoff + m * 2048 + k * 1024); } while (0)
#define PG8_LDB(dst, b, h) do { _Pragma("unroll") for (int n = 0; n < 2; ++n) _Pragma("unroll") for (int k = 0; k < 2; ++k) dst[n][k] = *(const PG8_LAS bf16x8*)(lds + PG8_SB(b, h) + boff + n * 2048 + k * 1024); } while (0)
#define PG8_MMA(ai, bj, At, Bt) do { __builtin_amdgcn_s_setprio(1); _Pragma("unroll") for (int m = 0; m < 4; ++m) _Pragma("unroll") for (int n = 0; n < 2; ++n) _Pragma("unroll") for (int k = 0; k < 2; ++k) \
        acc[ai][bj][m][n] = __builtin_amdgcn_mfma_f32_16x16x32_bf16(Bt[n][k], At[m][k], acc[ai][bj][m][n], 0, 0, 0); __builtin_amdgcn_s_setprio(0); } while (0)
#define PG8_WAIT_V(n) asm volatile("s_waitcnt vmcnt(" #n ")" ::: "memory")
#define PG8_WAIT_L(n) asm volatile("s_waitcnt lgkmcnt(" #n ")" ::: "memory")
#define PG8_BAR __builtin_amdgcn_s_barrier()
#define PG8_SCHED __builtin_amdgcn_sched_barrier(0)
    Unit cur, nxt; int ui = 0;
    if (!S.next(0, cur)) return;
    f32x4 acc[2][2][4][2];
#pragma unroll
    for (int a = 0; a < 2; ++a)
#pragma unroll
        for (int b = 0; b < 2; ++b)
#pragma unroll
            for (int m = 0; m < 4; ++m)
#pragma unroll
                for (int n = 0; n < 2; ++n) acc[a][b][m][n] = (f32x4){0.f, 0.f, 0.f, 0.f};
    bf16x8 At[4][2], B0[2][2], B1[2][2];
    const char* cA = (const char*)g.A + (size_t)cur.pm * tstep; const char* cB = (const char*)g.Bt + (size_t)cur.pn * tstep;
    S.a_ready(cur);
    if constexpr (SP2) {
        PG8_STAGE(PG8_SB(0, 0), cB, voffB); PG8_STAGE(PG8_SB(0, 1), cB + hstep, voffB); PG8_STAGE(PG8_SA(0, 0), cA, voffA); PG8_STAGE(PG8_SA(0, 1), cA + hstep, voffA);
        if (wr == 1) PG8_BAR;
        PG8_WAIT_V(2); PG8_BAR;
        PG8_STAGE(PG8_SB(1, 0), cB + kstep, voffB); PG8_STAGE(PG8_SA(1, 0), cA + kstep, voffA); PG8_STAGE(PG8_SB(1, 1), cB + hstep + kstep, voffB);
        PG8_WAIT_V(6); PG8_BAR;
    } else {
        PG8_STAGE(PG8_SB(0, 0), cB, voffB); PG8_STAGE(PG8_SA(0, 0), cA, voffA); PG8_STAGE(PG8_SB(0, 1), cB + hstep, voffB); PG8_STAGE(PG8_SA(0, 1), cA + hstep, voffA);
        if (wr == 1) PG8_BAR;
        PG8_WAIT_V(4); PG8_BAR;
        PG8_STAGE(PG8_SB(1, 0), cB + kstep, voffB); PG8_STAGE(PG8_SA(1, 0), cA + kstep, voffA); PG8_STAGE(PG8_SB(1, 1), cB + hstep + kstep, voffB);
        PG8_WAIT_V(6); PG8_BAR;
    }
    for (;;) {
        const bool has_next = S.next(ui + 1, nxt);
        const char* nA = has_next ? (const char*)g.A + (size_t)nxt.pm * tstep : cA; const char* nB = has_next ? (const char*)g.Bt + (size_t)nxt.pn * tstep : cB;
        for (int t = 0; t < nt; t += 2) {
            const bool last = (t == nt - 2);
            const char* a1 = cA + (size_t)(t + 1) * kstep;
            const char* a2 = last ? nA : cA + (size_t)(t + 2) * kstep; const char* b2 = last ? nB : cB + (size_t)(t + 2) * kstep;
            const char* a3 = a2 + kstep; const char* b3 = b2 + kstep;
            if (last && has_next) S.a_ready(nxt);
            if constexpr (SP2) {
            PG8_LDB(B0, 0, 0); PG8_LDB(B1, 0, 1); PG8_SCHED; PG8_LDA(At, 0, 0); PG8_STAGE(PG8_SA(1, 1), a1 + hstep, voffA);
            PG8_WAIT_V(8); PG8_WAIT_L(0); PG8_BAR; PG8_MMA(0, 0, At, B0); PG8_MMA(0, 1, At, B1); PG8_BAR; PG8_SCHED;
            PG8_LDA(At, 0, 1); PG8_STAGE(PG8_SB(0, 0), b2, voffB); PG8_STAGE(PG8_SB(0, 1), b2 + hstep, voffB); PG8_STAGE(PG8_SA(0, 0), a2, voffA);
            PG8_WAIT_V(8); PG8_WAIT_L(0); PG8_BAR; PG8_MMA(1, 0, At, B0); PG8_MMA(1, 1, At, B1); PG8_BAR; PG8_SCHED;
            PG8_LDB(B0, 1, 0); PG8_LDB(B1, 1, 1); PG8_SCHED; PG8_LDA(At, 1, 0); PG8_STAGE(PG8_SA(0, 1), a2 + hstep, voffA);
            PG8_WAIT_V(8); PG8_WAIT_L(0); PG8_BAR; PG8_MMA(0, 0, At, B0); PG8_MMA(0, 1, At, B1); PG8_BAR; PG8_SCHED;
            PG8_LDA(At, 1, 1); PG8_STAGE(PG8_SB(1, 0), b3, voffB); PG8_STAGE(PG8_SB(1, 1), b3 + hstep, voffB); PG8_STAGE(PG8_SA(1, 0), a3, voffA);
            PG8_WAIT_V(8); PG8_WAIT_L(0); PG8_BAR; PG8_MMA(1, 0, At, B0); PG8_MMA(1, 1, At, B1); PG8_BAR; PG8_SCHED;
            } else {
            PG8_LDB(B0, 0, 0); PG8_SCHED; PG8_LDA(At, 0, 0); PG8_STAGE(PG8_SA(1, 1), a1 + hstep, voffA);
            PG8_WAIT_L(8); PG8_BAR; PG8_WAIT_L(0); PG8_MMA(0, 0, At, B0); PG8_BAR; PG8_SCHED;
            PG8_LDB(B1, 0, 1); PG8_STAGE(PG8_SB(0, 0), b2, voffB);
            PG8_BAR; PG8_WAIT_L(0); PG8_MMA(0, 1, At, B1); PG8_BAR;
            PG8_LDA(At, 0, 1); PG8_STAGE(PG8_SA(0, 0), a2, voffA);
            PG8_BAR; PG8_WAIT_L(0); PG8_MMA(1, 0, At, B0); PG8_BAR; PG8_SCHED;
            PG8_STAGE(PG8_SB(0, 1), b2 + hstep, voffB);
            PG8_WAIT_V(6); PG8_BAR; PG8_MMA(1, 1, At, B1); PG8_BAR;
            PG8_LDB(B0, 1, 0); PG8_SCHED; PG8_LDA(At, 1, 0); PG8_STAGE(PG8_SA(0, 1), a2 + hstep, voffA);
            PG8_WAIT_L(8); PG8_BAR; PG8_WAIT_L(0); PG8_MMA(0, 0, At, B0); PG8_BAR; PG8_SCHED;
            PG8_LDB(B1, 1, 1); PG8_STAGE(PG8_SB(1, 0), b3, voffB);
            PG8_BAR; PG8_WAIT_L(0); PG8_MMA(0, 1, At, B1); PG8_BAR;
            PG8_LDA(At, 1, 1); PG8_STAGE(PG8_SA(1, 0), a3, voffA);
            PG8_BAR; PG8_WAIT_L(0); PG8_MMA(1, 0, At, B0); PG8_BAR; PG8_SCHED;
            PG8_STAGE(PG8_SB(1, 1), b3 + hstep, voffB);
            PG8_WAIT_V(6); PG8_BAR; PG8_MMA(1, 1, At, B1); PG8_BAR;
            }
        }
        if constexpr (ALIGN_EPI) { if (wr == 0) PG8_BAR; }
        if constexpr (!Epi::AFTER_DRAIN) { E(acc, cur, wr, wc, fr, fq); S.done(cur); }
        if (!has_next) break;
#pragma unroll
        for (int a = 0; a < 2; ++a)
#pragma unroll
            for (int b = 0; b < 2; ++b)
#pragma unroll
                for (int m = 0; m < 4; ++m)
#pragma unroll
                    for (int n = 0; n < 2; ++n) acc[a][b][m][n] = (f32x4){0.f, 0.f, 0.f, 0.f};
        cur = nxt; cA = nA; cB = nB; ++ui;
        if constexpr (ALIGN_EPI) { if (wr == 1) PG8_BAR; }
    }
    PG8_WAIT_V(0);
    if constexpr (!ALIGN_EPI) { if (wr == 0) PG8_BAR; }
    PG8_BAR;
    if constexpr (Epi::AFTER_DRAIN) { E.fused(acc, cur, wr, wc, fr, fq, lds, wid, lane); S.done(cur); }
#undef PG8_SA
#undef PG8_SB
#undef PG8_STAGE
#undef PG8_LDA
#undef PG8_LDB
#undef PG8_MMA
#undef PG8_WAIT_V
#undef PG8_WAIT_L
#undef PG8_BAR
#undef PG8_SCHED
}
}
#include <hip/hip_bf16.h>
#include <cmath>
namespace attn_body {
using bf16=__hip_bfloat16;
using bf16x8=__attribute__((ext_vector_type(8)))short;
using s16x4=__attribute__((ext_vector_type(4)))short;
using f32x16=__attribute__((ext_vector_type(16)))float;
using u32x4=__attribute__((ext_vector_type(4)))unsigned;
constexpr int BATCH=4,NHEAD=16,SEQ=4096,D=64,DM=NHEAD*D;
constexpr int NW=8,QBLK=32,QB=QBLK*NW,KVBLK=64,NQB=SEQ/QB;
constexpr int ATTN_PITCH=DM, ATTN_UNIT_ROWS=QB;
__device__ __forceinline__ int crow(int r,int hi){return (r&3)+8*(r>>2)+4*hi;}
#define SBAR() __builtin_amdgcn_sched_barrier(0)
__device__ __forceinline__ void cmask(f32x16&p0,f32x16&p1,int jb,int qrel,int hi){
  const float NEG=-INFINITY; int kb=64*jb+4*hi;
  #pragma unroll
  for(int r=0;r<16;++r){int kv=kb+(r&3)+8*(r>>2); if(kv>qrel)p0[r]=NEG; if(kv+32>qrel)p1[r]=NEG;}
}

constexpr int NSLOT=3, SLOTB=8192;
constexpr int LDS_K=0, LDS_V=NSLOT*SLOTB, LDS_WS=2*NSLOT*SLOTB, LDS_OST=LDS_WS+NW*64*4, LDS_BYTES=LDS_OST+NW*4096;
constexpr float C2=0.125f*1.4426950408889634f;
__device__ __forceinline__ void glds16(const void*gsrc,unsigned lds_dst){unsigned keep;
  asm volatile("s_mov_b32 %0, m0\n\ts_mov_b32 m0, %2\n\ts_nop 0\n\tglobal_load_lds_dwordx4 %1, off\n\ts_mov_b32 m0, %0":"=&s"(keep):"v"(gsrc),"s"(lds_dst):"memory");}
__device__ __forceinline__ float max3f(float a,float b,float c){float r;asm("v_max3_f32 %0, %1, %2, %3":"=v"(r):"v"(a),"v"(b),"v"(c));return r;}
__device__ __forceinline__ float max2f(float a,float b){float r;asm("v_max_f32_e32 %0, %1, %2":"=v"(r):"v"(a),"v"(b));return r;}
__device__ __forceinline__ float fadd_s(float a,float b){float r;asm("v_add_f32_e32 %0, %1, %2":"=v"(r):"v"(a),"v"(b));return r;}
__device__ __forceinline__ float fsub_s(float a,float b){float r;asm("v_sub_f32_e32 %0, %1, %2":"=v"(r):"v"(a),"v"(b));return r;}
typedef float f32x2_t __attribute__((ext_vector_type(2))); typedef __bf16 bf16x2_t __attribute__((ext_vector_type(2)));
__device__ __forceinline__ unsigned cvtpk_s(float lo,float hi){f32x2_t v={lo,hi};bf16x2_t b=__builtin_convertvector(v,bf16x2_t);return __builtin_bit_cast(unsigned,b);}
#define WAIT_BAR(N) asm volatile("s_waitcnt vmcnt(" #N ") lgkmcnt(0)\n\ts_barrier":::"memory")

__device__ __forceinline__ void qkt(f32x16&p0,f32x16&p1,const char*Kslot,const bf16x8*qr,int r32,int hi){
  const char*kb=Kslot+hi*1024+r32*16;
  #pragma unroll
  for(int d0=0;d0<4;++d0){
    const bf16x8 b0=*reinterpret_cast<const bf16x8*>(kb+d0*2048);
    const bf16x8 b1=*reinterpret_cast<const bf16x8*>(kb+d0*2048+512);
    {p0=__builtin_amdgcn_mfma_f32_32x32x16_bf16(b0,qr[d0],p0,0,0,0);p1=__builtin_amdgcn_mfma_f32_32x32x16_bf16(b1,qr[d0],p1,0,0,0);}}
}
typedef __attribute__((address_space(3))) const char* lds_cptr;
typedef short v4i16_t __attribute__((ext_vector_type(4)));
__device__ __forceinline__ void kload8(bf16x8*kf,lds_cptr kp){
  kf[0]=*(const __attribute__((address_space(3))) bf16x8*)(kp);      kf[1]=*(const __attribute__((address_space(3))) bf16x8*)(kp+512);
  kf[2]=*(const __attribute__((address_space(3))) bf16x8*)(kp+2048); kf[3]=*(const __attribute__((address_space(3))) bf16x8*)(kp+2560);
  kf[4]=*(const __attribute__((address_space(3))) bf16x8*)(kp+4096); kf[5]=*(const __attribute__((address_space(3))) bf16x8*)(kp+4608);
  kf[6]=*(const __attribute__((address_space(3))) bf16x8*)(kp+6144); kf[7]=*(const __attribute__((address_space(3))) bf16x8*)(kp+6656);
}
__device__ __forceinline__ void kload2(bf16x8*kf,lds_cptr kp,int j){ kf[2*j]=*(const __attribute__((address_space(3))) bf16x8*)(kp+j*2048); kf[2*j+1]=*(const __attribute__((address_space(3))) bf16x8*)(kp+j*2048+512); }
__device__ __forceinline__ s16x4 vtr(lds_cptr p){ return __builtin_bit_cast(s16x4,__builtin_amdgcn_ds_read_tr16_b64_v4i16((__attribute__((address_space(3))) v4i16_t*)p)); }
__device__ __forceinline__ float rowmax(const f32x16&p0,const f32x16&p1){
  float a=max3f(p0[0],p0[1],p1[0]),b=max3f(p0[2],p0[3],p1[1]);a=max3f(a,p1[2],p1[3]);
  #pragma unroll
  for(int r=4;r<16;r+=4){a=max3f(a,p0[r],p0[r+1]);b=max3f(b,p0[r+2],p0[r+3]);a=max3f(a,p1[r],p1[r+1]);b=max3f(b,p1[r+2],p1[r+3]);}
  const float m=max2f(a,b);
  auto rr=__builtin_amdgcn_permlane32_swap(__float_as_uint(m),__float_as_uint(m),false,false);
  return max2f(__uint_as_float(rr[0]),__uint_as_float(rr[1]));
}
__device__ __forceinline__ void pv(f32x16*o,int vb,bf16x8 pa0,bf16x8 pa1,bf16x8 pa2,bf16x8 pa3){
  #pragma unroll
  for(int d0=0;d0<2;++d0){s16x4 lo[4],hi[4];
    #pragma unroll
    for(int ks=0;ks<4;++ks){
      asm volatile("ds_read_b64_tr_b16 %0,%1 offset:%c2":"=&v"(lo[ks]):"v"(vb),"i"(d0*4096+ks*1024):"memory");
      asm volatile("ds_read_b64_tr_b16 %0,%1 offset:%c2":"=&v"(hi[ks]):"v"(vb),"i"(d0*4096+ks*1024+512):"memory");}
    asm volatile("s_waitcnt lgkmcnt(0)":::"memory");SBAR();
    #define PK(k) (bf16x8){lo[k][0],lo[k][1],lo[k][2],lo[k][3],hi[k][0],hi[k][1],hi[k][2],hi[k][3]}
    o[d0]=__builtin_amdgcn_mfma_f32_32x32x16_bf16(pa0,PK(0),o[d0],0,0,0);
    o[d0]=__builtin_amdgcn_mfma_f32_32x32x16_bf16(pa1,PK(1),o[d0],0,0,0);
    o[d0]=__builtin_amdgcn_mfma_f32_32x32x16_bf16(pa2,PK(2),o[d0],0,0,0);
    o[d0]=__builtin_amdgcn_mfma_f32_32x32x16_bf16(pa3,PK(3),o[d0],0,0,0);
    #undef PK
  }
}

#ifndef ATTN_STORE16
#define ATTN_STORE16(p,v) (*(u32x4*)(p)=(v))
#endif
typedef float f32x4b __attribute__((ext_vector_type(4)));
typedef __attribute__((address_space(3))) const float* lds_fptr;
typedef __attribute__((address_space(3))) const f32x4b* lds_f4ptr;
template<int THRL> __device__ __forceinline__ void attn_unit(int b,int h,int qb,const bf16*Q,const bf16*__restrict__ K,const bf16*__restrict__ V,bf16*O,char*shm,lds_fptr cs,const int tid){
  const int lane=tid&63,r32=lane&31,hi=lane>>5; const int wid=__builtin_amdgcn_readfirstlane(tid>>6);
  const long rowbase=(long)b*SEQ; const int q0=qb*QB;
  const bf16*Qw=Q+(rowbase+q0+wid*QBLK)*DM+h*D;
  const bf16*Kh=K+rowbase*DM+h*D,*Vh=V+rowbase*DM+h*D;
  const unsigned lds0=(unsigned)(uintptr_t)shm;
  float*wsf=(float*)(shm+LDS_WS)+wid*64;
  const bf16*ksrc=Kh+(long)lane*DM+wid*8;
  const bf16*vsrc=Vh+(long)(16*(wid&3)+(lane>>2))*DM+(wid>>2)*32+(lane&3)*8;
  const unsigned kdst=lds0+LDS_K+wid*1024, vdst=lds0+LDS_V+wid*1024;
  #define DMA_K(t,slot) glds16(ksrc+(long)(t)*KVBLK*DM,(unsigned)__builtin_amdgcn_readfirstlane(kdst+(slot)))
  #define DMA_V(t,slot) glds16(vsrc+(long)(t)*KVBLK*DM,(unsigned)__builtin_amdgcn_readfirstlane(vdst+(slot)))
  const int vb0=(int)(lds0+LDS_V)+((lane>>4)&1)*32+(lane&3)*8+(4*hi+((lane&15)>>2))*64;
  const char*Kbase=shm+LDS_K; bf16x8 kf[8];
  const lds_cptr shm3=(lds_cptr)shm; const lds_cptr kp0=shm3+LDS_K+hi*1024+r32*16; const lds_cptr vp0=shm3+LDS_V+((lane>>4)&1)*32+(lane&3)*8+(4*hi+((lane&15)>>2))*64;
  const int NT=(q0+QB)/KVBLK;
  DMA_K(0,0);DMA_V(0,0);DMA_K(1,SLOTB);
  bf16x8 qr[4];
  #pragma unroll
  for(int d0=0;d0<4;++d0)qr[d0]=*reinterpret_cast<const bf16x8*>(&Qw[(long)r32*DM+d0*16+hi*8]);
  const int qrel=wid*QBLK+r32;
  typedef __attribute__((address_space(3))) const unsigned long long* lds_u64p; typedef unsigned u32x2b __attribute__((ext_vector_type(2)));
  const lds_u64p ctr=(lds_u64p)cs;
  float ci2; { const unsigned long long w_=ctr[q0+qrel]; ci2=__uint_as_float((unsigned)w_<<16)+__uint_as_float((unsigned)w_&0xffff0000u)+__uint_as_float((unsigned)(w_>>32)<<16); }
  float mhat=0.f,l_reg=0.f;f32x16 o[2];o[0]=f32x16{};o[1]=f32x16{};float nm=ci2; bf16x8 bnm;
  #define MKBNM() do{ const unsigned h1_=cvtpk_s(nm,0.f)&0xffffu; const float r1_=nm-__uint_as_float(h1_<<16); const unsigned h2_=cvtpk_s(r1_,0.f)&0xffffu; const float r2_=r1_-__uint_as_float(h2_<<16); const unsigned h3_=cvtpk_s(r2_,0.f)&0xffffu; \
    u32x4 b_; b_.x=hi?0u:0xBF80BF80u; b_.y=hi?0u:(0xBF80u|(h1_<<16)); b_.z=hi?0u:(h2_|(h3_<<16)); b_.w=0u; bnm=__builtin_bit_cast(bf16x8,b_); }while(0)
  MKBNM();
  #define CINIT(P0,P1,t) do{ const unsigned long long w0_=ctr[64*(t)+r32], w1_=ctr[64*(t)+32+r32]; \
    u32x4 a0_; a0_.x=(unsigned)w0_; a0_.y=(unsigned)(w0_>>32)|0x3F800000u; a0_.z=0x3F803F80u; a0_.w=0u; u32x4 a1_; a1_.x=(unsigned)w1_; a1_.y=(unsigned)(w1_>>32)|0x3F800000u; a1_.z=0x3F803F80u; a1_.w=0u; \
    P0=__builtin_amdgcn_mfma_f32_32x32x16_bf16(__builtin_bit_cast(bf16x8,a0_),bnm,f32x16{},0,0,0); P1=__builtin_amdgcn_mfma_f32_32x32x16_bf16(__builtin_bit_cast(bf16x8,a1_),bnm,f32x16{},0,0,0); }while(0)
  #define CMASK(P0,P1,t) do{int jb_=(t)-(NT-4); if(jb_>=0)cmask(P0,P1,jb_,qrel,hi);}while(0)
  bool resc=false;
  #define START(P0,P1) do{ const float rm=rowmax(P0,P1); resc=false; \
    { const float dl=rm; mhat=fadd_s(mhat,dl); \
      _Pragma("unroll") for(int r=0;r<16;++r){P0[r]=fsub_s(P0[r],dl);P1[r]=fsub_s(P1[r],dl);} \
      nm=ci2-mhat; MKBNM(); } \
    _Pragma("unroll") for(int r=0;r<16;++r)P0[r]=__builtin_amdgcn_exp2f(P0[r]); }while(0)
  #define RESC() do{ if(resc){ asm volatile("s_waitcnt lgkmcnt(0)":::"memory"); \
      _Pragma("unroll") for(int d_=0;d_<2;++d_) _Pragma("unroll") for(int r=0;r<16;++r)o[d_][r]*=wsf[crow(r,hi)]; } }while(0)
  f32x16 pA0,pA1,pB0,pB1;
  int sl_prev=0,sl_cur=0,sl_next=SLOTB;
  #define ROT() do{sl_prev=sl_cur;sl_cur=sl_next;sl_next=(sl_next==(NSLOT-1)*SLOTB)?0:sl_next+SLOTB;}while(0)
  DMA_K(2,2*SLOTB);
  WAIT_BAR(3);
  CINIT(pA0,pA1,0);qkt(pA0,pA1,Kbase,qr,r32,hi);asm volatile("s_nop 15\n\ts_nop 7":"+v"(pA0),"+v"(pA1));CMASK(pA0,pA1,0);
  START(pA0,pA1);
  _Pragma("unroll") for(int r=0;r<16;++r)pA1[r]=__builtin_amdgcn_exp2f(pA1[r]);
  WAIT_BAR(0);
  DMA_K(3,0);DMA_V(1,SLOTB);
  ROT();
  kload8(kf,kp0+sl_cur);
  WAIT_BAR(2);
  s16x4 vlo[8],vhi[8]; u32x4 pw0,pw1,pw2,pw3;
  #define PKW(P,B) cvtpk_s(P[B],P[B+1])
  #define PAF(k) __builtin_bit_cast(bf16x8,pw##k)
  #define VFR(i) (bf16x8){vlo[i][0],vlo[i][1],vlo[i][2],vlo[i][3],vhi[i][0],vhi[i][1],vhi[i][2],vhi[i][3]}
  #define PIN(x) asm volatile("":"+v"(x))
  #define MX3(a,b,c) __builtin_fmaxf(__builtin_fmaxf((a),(b)),(c))
  #define GAPA(MF,A0,A1,A2,A3,W0,W1,PW) do{ MF; sacc+=A0; sacc+=A1; sacc+=A2; sacc+=A3; PIN(sacc); W0; W1; PIN(PW); SBAR(); }while(0)
  #define EX(v) __builtin_amdgcn_exp2f(v)
  #define GAPB(MF,X,B) do{ MF; X[B]=EX(X[B]); X[B+1]=EX(X[B+1]); X[B+2]=EX(X[B+2]); X[B+3]=EX(X[B+3]); PIN(X); SBAR(); }while(0)
  #define VRD(i) do{ vlo[i]=vtr(vp_+(((i)>>2)*4096+((i)&3)*1024)); vhi[i]=vtr(vp_+(((i)>>2)*4096+((i)&3)*1024+512)); }while(0)
  #define KRD(G,j) do{ if(G){ kload2(kf,kp0+sl_next,j); SBAR(); } }while(0)
  #define STEP(C0,C1,P0,P1,t,GK,GV,GL) do{ SBAR(); \
    const lds_cptr vp_=vp0+sl_prev; CINIT(C0,C1,t); SBAR(); \
    VRD(0); SBAR(); float sacc=(P0[0]+P0[1]); \
    GAPA(C0=__builtin_amdgcn_mfma_f32_32x32x16_bf16(kf[0],qr[0],C0,0,0,0), P0[2],P0[3],P0[4],P0[5],     pw0[0]=PKW(P0,0), pw0[1]=PKW(P0,2), pw0); \
    VRD(4); SBAR(); GAPA(C1=__builtin_amdgcn_mfma_f32_32x32x16_bf16(kf[1],qr[0],C1,0,0,0), P0[6],P0[7],P0[8],P0[9],     pw0[2]=PKW(P0,4), pw0[3]=PKW(P0,6), pw0); \
    VRD(1); SBAR(); GAPA(C0=__builtin_amdgcn_mfma_f32_32x32x16_bf16(kf[2],qr[1],C0,0,0,0),   P0[10],P0[11],P0[12],P0[13], pw1[0]=PKW(P0,8), pw1[1]=PKW(P0,10), pw1); \
    VRD(5); SBAR(); GAPA(C1=__builtin_amdgcn_mfma_f32_32x32x16_bf16(kf[3],qr[1],C1,0,0,0),   P0[14],P0[15],P1[0],P1[1],   pw1[2]=PKW(P0,12),pw1[3]=PKW(P0,14), pw1); \
    VRD(2); SBAR(); GAPA(C0=__builtin_amdgcn_mfma_f32_32x32x16_bf16(kf[4],qr[2],C0,0,0,0),   P1[2],P1[3],P1[4],P1[5],     pw2[0]=PKW(P1,0), pw2[1]=PKW(P1,2), pw2); \
    VRD(6); SBAR(); GAPA(C1=__builtin_amdgcn_mfma_f32_32x32x16_bf16(kf[5],qr[2],C1,0,0,0),   P1[6],P1[7],P1[8],P1[9],     pw2[2]=PKW(P1,4), pw2[3]=PKW(P1,6), pw2); \
    VRD(3); SBAR(); GAPA(C0=__builtin_amdgcn_mfma_f32_32x32x16_bf16(kf[6],qr[3],C0,0,0,0),   P1[10],P1[11],P1[12],P1[13], pw3[0]=PKW(P1,8), pw3[1]=PKW(P1,10), pw3); \
    VRD(7); SBAR(); GAPA(C1=__builtin_amdgcn_mfma_f32_32x32x16_bf16(kf[7],qr[3],C1,0,0,0),   P1[14],P1[15],0.f,0.f,       pw3[2]=PKW(P1,12),pw3[3]=PKW(P1,14), pw3); \
    l_reg+=sacc; \
    if(GK){DMA_K((t)+3,sl_cur);} if(GV){DMA_V((t)+1,sl_next);} \
    CMASK(C0,C1,t); \
    { float a=MX3(C0[0],C0[1],C1[0]),b=MX3(C0[2],C0[3],C1[1]); a=MX3(a,C1[2],C1[3]); \
      _Pragma("unroll") for(int r=4;r<16;r+=4){a=MX3(a,C0[r],C0[r+1]);b=MX3(b,C0[r+2],C0[r+3]);a=MX3(a,C1[r],C1[r+1]);b=MX3(b,C1[r+2],C1[r+3]);} \
      float rm=__builtin_fmaxf(a,b); { auto rr=__builtin_amdgcn_permlane32_swap(__float_as_uint(rm),__float_as_uint(rm),false,false); rm=__builtin_fmaxf(__uint_as_float(rr[0]),__uint_as_float(rr[1])); } \
      resc=false; \
      if(__builtin_expect(__any(rm>(float)THRL),0)){ const float dl=__builtin_fmaxf(rm,0.f); mhat+=dl; \
        _Pragma("unroll") for(int r=0;r<16;++r){C0[r]-=dl;C1[r]-=dl;} \
        nm=ci2-mhat; MKBNM(); \
        const float f=__builtin_amdgcn_exp2f(-dl); l_reg*=f; if(hi==0)wsf[r32]=f; resc=true; } } \
    SBAR(); \
    GAPB(o[0]=__builtin_amdgcn_mfma_f32_32x32x16_bf16(PAF(0),VFR(0),o[0],0,0,0), C0,0); \
    GAPB(o[1]=__builtin_amdgcn_mfma_f32_32x32x16_bf16(PAF(0),VFR(4),o[1],0,0,0), C0,4); \
    KRD(GL,0); GAPB(o[0]=__builtin_amdgcn_mfma_f32_32x32x16_bf16(PAF(1),VFR(1),o[0],0,0,0), C0,8); \
    KRD(GL,1); GAPB(o[1]=__builtin_amdgcn_mfma_f32_32x32x16_bf16(PAF(1),VFR(5),o[1],0,0,0), C0,12); \
    KRD(GL,2); GAPB(o[0]=__builtin_amdgcn_mfma_f32_32x32x16_bf16(PAF(2),VFR(2),o[0],0,0,0), C1,0); \
    KRD(GL,3); GAPB(o[1]=__builtin_amdgcn_mfma_f32_32x32x16_bf16(PAF(2),VFR(6),o[1],0,0,0), C1,4); \
    GAPB(o[0]=__builtin_amdgcn_mfma_f32_32x32x16_bf16(PAF(3),VFR(3),o[0],0,0,0), C1,8); \
    GAPB(o[1]=__builtin_amdgcn_mfma_f32_32x32x16_bf16(PAF(3),VFR(7),o[1],0,0,0), C1,12); \
    }while(0)
  int t=1;
  #undef CMASK
  #define CMASK(P0,P1,t) do{}while(0)
  for(;t+5<NT;t+=2){
    STEP(pB0,pB1,pA0,pA1,t,true,true,true);     WAIT_BAR(2); RESC(); ROT();
    STEP(pA0,pA1,pB0,pB1,t+1,true,true,true);   WAIT_BAR(2); RESC(); ROT();
  }
  #undef CMASK
  #define CMASK(P0,P1,t) do{int jb_=(t)-(NT-4); if(jb_>=0)cmask(P0,P1,jb_,qrel,hi);}while(0)
  #define ENDW(tt) do{ if((tt)+3<NT){WAIT_BAR(2);} else if((tt)+2<NT){WAIT_BAR(1);} else {WAIT_BAR(0);} }while(0)
  for(;t+1<NT;t+=2){
    STEP(pB0,pB1,pA0,pA1,t,(t+3<NT),(t+1<NT),(t+1<NT));       ENDW(t);   RESC(); ROT();
    STEP(pA0,pA1,pB0,pB1,t+1,(t+4<NT),(t+2<NT),(t+2<NT));     ENDW(t+1); RESC(); ROT();
  }
  STEP(pB0,pB1,pA0,pA1,NT-1,false,false,false); RESC();
  { float sacc=pB0[0]+pB0[1]; _Pragma("unroll") for(int r=2;r<16;++r)sacc+=pB0[r]; _Pragma("unroll") for(int r=0;r<16;++r)sacc+=pB1[r]; l_reg+=sacc;
    pw0=(u32x4){PKW(pB0,0),PKW(pB0,2),PKW(pB0,4),PKW(pB0,6)};pw1=(u32x4){PKW(pB0,8),PKW(pB0,10),PKW(pB0,12),PKW(pB0,14)};pw2=(u32x4){PKW(pB1,0),PKW(pB1,2),PKW(pB1,4),PKW(pB1,6)};pw3=(u32x4){PKW(pB1,8),PKW(pB1,10),PKW(pB1,12),PKW(pB1,14)};
    SBAR(); pv(o,vb0+sl_cur,PAF(0),PAF(1),PAF(2),PAF(3)); }
  #undef PKW
  #undef PAF
  #undef VFR
  #undef PIN
  #undef MX3
  #undef GAPA
  #undef GAPB
  #undef EX
  #undef VRD
  #undef KRD
  #undef STEP
  #undef ENDW
  {auto rr=__builtin_amdgcn_permlane32_swap(__float_as_uint(l_reg),__float_as_uint(l_reg),false,false);l_reg=__uint_as_float(rr[0])+__uint_as_float(rr[1]);}
  if(hi==0)wsf[32+r32]=l_reg;asm volatile("s_waitcnt lgkmcnt(0)":::"memory");
  float rli[16];
  #pragma unroll
  for(int r=0;r<16;++r)rli[r]=__builtin_amdgcn_rcpf(wsf[32+crow(r,hi)]);
  bf16*Ow=O+(rowbase+q0+wid*QBLK)*DM+h*D;
  { bf16*stg=(bf16*)(shm+LDS_OST)+wid*2048;
    #pragma unroll
    for(int r=0;r<16;++r){const int orow=crow(r,hi);
      #pragma unroll
      for(int d0=0;d0<2;++d0)stg[orow*64+d0*32+r32]=__float2bfloat16(o[d0][r]*rli[r]);}
    asm volatile("s_waitcnt lgkmcnt(0)":::"memory");
    #pragma unroll
    for(int i=0;i<4;++i){const int row=i*8+(lane>>3),ch=lane&7; const u32x4 v=*(const u32x4*)(stg+row*64+ch*8); ATTN_STORE16(Ow+(long)row*DM+ch*8,v);} }
  asm volatile("s_waitcnt lgkmcnt(0)\n\ts_barrier":::"memory");
  #undef DMA_K
  #undef DMA_V
  #undef CINIT
  #undef MKBNM
  #undef CMASK
  #undef START
  #undef RESC
  #undef ROT
}
constexpr int ATTN_LDS_BYTES=LDS_BYTES;
struct AttnTensors { const bf16* Q; const bf16* K; const bf16* V; bf16* O; };
struct AttnUnit { int bh; int qb; };
struct StaticOrder {
  int vcu;
  __device__ __forceinline__ explicit StaticOrder(int grid,int block):vcu((block%8)*(grid/8)+block/8){}
  __device__ __forceinline__ bool next(int i,AttnUnit&u)const{ if(i>=4)return false; const int s=vcu&3; u.bh=vcu>>2; u.qb=(i==0)?s:(i==1)?7-s:(i==2)?8+s:15-s; return true; }
  __device__ __forceinline__ void a_ready(const AttnUnit&)const{}
  __device__ __forceinline__ void done(const AttnUnit&)const{}
};
#undef SBAR
#undef WAIT_BAR
}
#define LAS __attribute__((address_space(3)))
typedef unsigned short bf16;
typedef unsigned v4u __attribute__((ext_vector_type(4)));
typedef unsigned v2u __attribute__((ext_vector_type(2)));
typedef float f32x4 __attribute__((ext_vector_type(4)));
typedef float f32x16 __attribute__((ext_vector_type(16)));
typedef short bf16x8 __attribute__((ext_vector_type(8)));
typedef float f32x2s __attribute__((ext_vector_type(2)));

constexpr int NBATCH = 4, SEQ = 4096, M = NBATCH * SEQ, D = 1024, DFF = 2816, PLE = 256;
constexpr int EVEN_IN = 2560, FOX_IN = 3088, FOX_INP = 3328;
constexpr float LOG2E = 1.4426950408889634f;
constexpr float QSCALE = 0.125f * LOG2E;
constexpr float GN_EPS = 64e-5f;
constexpr size_t MiB = 1u << 20;
constexpr size_t WS_SSQ = 0;
constexpr size_t WS_C3 = 1 * MiB;
constexpr size_t WS_LF = 2 * MiB;
constexpr size_t WS_G2F = 3 * MiB;
constexpr size_t WS_WGU = 4 * MiB;
constexpr size_t WS_WD = 48 * MiB;
constexpr size_t WS_WG = 70 * MiB;
constexpr size_t WS_WP = 74 * MiB;
constexpr size_t WS_WIN0 = 75 * MiB, WS_WOUT0 = 80 * MiB, WS_WIN1 = 82 * MiB, WS_WOUT1 = 89 * MiB;
constexpr size_t WS_XB = 91 * MiB;
constexpr size_t WS_Y = 123 * MiB;
constexpr size_t WS_BIG = 155 * MiB;
constexpr size_t WS_PB = 243 * MiB;
constexpr size_t WS_SSQP = 251 * MiB;
constexpr size_t WS_END = 253 * MiB;
constexpr size_t WS_BAR = 0;
constexpr int LDS_BYTES = 147456, MISC_OFF = 147456 - 64;

#define LDS_WAIT() asm volatile("s_waitcnt lgkmcnt(0)" ::: "memory")
__device__ __forceinline__ unsigned pk2(float lo, float hi) { return pg8::cvt_pk_bf16(lo, hi); }
__device__ __forceinline__ float bflo(unsigned w) { return __uint_as_float(w << 16); }
__device__ __forceinline__ float bfhi(unsigned w) { return __uint_as_float(w & 0xffff0000u); }
__device__ __forceinline__ float bf2f(bf16 h) { return __uint_as_float((unsigned)h << 16); }
__device__ __forceinline__ float wave_sum(float v) {
#pragma unroll
    for (int o = 1; o < 64; o <<= 1) v += __shfl_xor(v, o);
    return v;
}
__device__ __forceinline__ int crow(int r, int hi) { return (r & 3) + 8 * (r >> 2) + 4 * hi; }
template <int CTRL> __device__ __forceinline__ float dpp_f(float x) { return __int_as_float(__builtin_amdgcn_update_dpp(0, __float_as_int(x), CTRL, 0xf, 0xf, true)); }
__device__ __forceinline__ float red16(float x) { x += dpp_f<0xB1>(x); x += dpp_f<0x4E>(x); x += dpp_f<0x141>(x); x += dpp_f<0x140>(x); return x; }
__device__ __forceinline__ float red8(float x) { x += dpp_f<0xB1>(x); x += dpp_f<0x4E>(x); x += dpp_f<0x141>(x); return x; }
__device__ __forceinline__ void unpack8(const v4u w, float (&f)[8]) { f[0] = bflo(w.x); f[1] = bfhi(w.x); f[2] = bflo(w.y); f[3] = bfhi(w.y); f[4] = bflo(w.z); f[5] = bfhi(w.z); f[6] = bflo(w.w); f[7] = bfhi(w.w); }
__device__ __forceinline__ bf16x8 pack8(const float (&f)[8]) { v4u w; w.x = pk2(f[0], f[1]); w.y = pk2(f[2], f[3]); w.z = pk2(f[4], f[5]); w.w = pk2(f[6], f[7]); return __builtin_bit_cast(bf16x8, w); }

__device__ __forceinline__ void conv_item(const float* W, int K, int N, int NP, bf16* WT, const float* gain, int mode, LAS float* scr, int item, int lane) {
    const int nblk = NP / 32, kb = item / nblk, nb = item - kb * nblk, k0 = 64 * kb, n0 = 32 * nb;
    int orow0 = n0;
    if (mode == 1) orow0 = (n0 < DFF) ? (n0 / 128) * 256 + (n0 % 128) : ((n0 - DFF) / 128) * 256 + 128 + ((n0 - DFF) % 128);
    const int nq = 4 * (lane & 7); const bool inb = (n0 + nq) < N;
#pragma unroll
    for (int i = 0; i < 8; ++i) { const int kk = 8 * i + (lane >> 3); f32x4 v = {0.f, 0.f, 0.f, 0.f}; if (inb) v = *(const f32x4*)(W + (size_t)(k0 + kk) * N + n0 + nq);
        if (gain) v = v * gain[k0 + kk];
        LAS float* d = scr + kk * 33 + nq; d[0] = v[0]; d[1] = v[1]; d[2] = v[2]; d[3] = v[3]; }
    LDS_WAIT(); asm volatile("" ::: "memory");
    const int c = lane & 7;
#pragma unroll
    for (int j = 0; j < 4; ++j) { const int nn = (lane >> 3) + 8 * j; const LAS float* s = scr + (8 * c) * 33 + nn;
        v4u o; o.x = pk2(s[0 * 33], s[1 * 33]); o.y = pk2(s[2 * 33], s[3 * 33]); o.z = pk2(s[4 * 33], s[5 * 33]); o.w = pk2(s[6 * 33], s[7 * 33]);
        *(v4u*)(WT + (size_t)(orow0 + nn) * K + k0 + 8 * c) = o; }
    LDS_WAIT(); asm volatile("" ::: "memory");
}

constexpr int VTP = 264;
__device__ __forceinline__ void swa_unit(int unit, const bf16* PROJ, bf16* Y, const float* sinks, LAS unsigned char* lds, int tid, int lane, int wid) {
    const int b = unit >> 6, kvh = (unit >> 5) & 1, qblk = unit & 31, q0 = qblk * 128; const size_t rb = (size_t)b * SEQ;
    asm volatile("" : "+s"(PROJ), "+s"(Y));
    LAS bf16* VT = (LAS bf16*)lds;
    for (int c = tid; c < 2048; c += 512) { const int kvl = c >> 3, ch = c & 7, tok = q0 - 128 + kvl; v4u v = {0u, 0u, 0u, 0u};
        if (tok >= 0) v = *(const v4u*)(PROJ + (rb + tok) * EVEN_IN + 640 + kvh * 64 + ch * 8);
        LAS bf16* d = VT + (ch * 8) * VTP + kvl;
        d[0 * VTP] = (bf16)(v.x & 0xffffu); d[1 * VTP] = (bf16)(v.x >> 16); d[2 * VTP] = (bf16)(v.y & 0xffffu); d[3 * VTP] = (bf16)(v.y >> 16);
        d[4 * VTP] = (bf16)(v.z & 0xffffu); d[5 * VTP] = (bf16)(v.z >> 16); d[6 * VTP] = (bf16)(v.w & 0xffffu); d[7 * VTP] = (bf16)(v.w >> 16); }
    __syncthreads();
    const int g = wid >> 1, qh = wid & 1, hq = kvh * 4 + g;
    const float slope2 = exp2f(-(float)(hq + 1)) * LOG2E, sink2 = sinks[hq] * LOG2E;
#pragma unroll 1
    for (int sb = 0; sb < 2; ++sb) {
        int r32 = lane & 31, hi = lane >> 5; asm volatile("" : "+v"(r32), "+v"(hi));
        const int qs = q0 + 64 * qh + 32 * sb;
        bf16x8 qf[4];
#pragma unroll
        for (int ks = 0; ks < 4; ++ks) qf[ks] = *(const bf16x8*)(PROJ + (rb + qs + r32) * EVEN_IN + hq * 64 + 16 * ks + 8 * hi);
        f32x16 sc[5];
#pragma unroll
        for (int kt = 0; kt < 5; ++kt) { int tk = qs - 128 + 32 * kt + r32; tk = tk < 0 ? 0 : tk; sc[kt] = f32x16{};
#pragma unroll
            for (int ks = 0; ks < 4; ++ks) { const bf16x8 kf = *(const bf16x8*)(PROJ + (rb + tk) * EVEN_IN + 512 + kvh * 64 + 16 * ks + 8 * hi);
                sc[kt] = __builtin_amdgcn_mfma_f32_32x32x16_bf16(kf, qf[ks], sc[kt], 0, 0, 0); }
            asm volatile("" ::: "memory"); }
        const int db = r32 + 128 - 4 * hi, kmin = 128 - qs - 4 * hi; const float ab = -slope2 * (float)db;
        float mx = sink2;
#pragma unroll
        for (int kt = 0; kt < 5; ++kt)
#pragma unroll
            for (int r = 0; r < 16; ++r) { const int kc = 32 * kt + (r & 3) + 8 * (r >> 2), dist = db - kc; const bool ok = ((unsigned)dist < 128u) && (kmin <= kc);
                const float s = ok ? fmaf(slope2, (float)kc, sc[kt][r] + ab) : -INFINITY; sc[kt][r] = s; mx = fmaxf(mx, s); }
        mx = fmaxf(mx, __shfl_xor(mx, 32));
        float l = 0.f;
#pragma unroll
        for (int kt = 0; kt < 5; ++kt)
#pragma unroll
            for (int r = 0; r < 16; ++r) { const float p = exp2f(sc[kt][r] - mx); sc[kt][r] = p; l += p; }
        l += __shfl_xor(l, 32); l += exp2f(sink2 - mx);
        const float rl = 1.0f / l;
        f32x16 o[2]; o[0] = f32x16{}; o[1] = f32x16{};
        const int kvl0 = 64 * qh + 32 * sb;
#pragma unroll
        for (int kt = 0; kt < 5; ++kt)
#pragma unroll
            for (int s2 = 0; s2 < 2; ++s2) { v4u pw; pw.x = pk2(sc[kt][8 * s2 + 0], sc[kt][8 * s2 + 1]); pw.y = pk2(sc[kt][8 * s2 + 2], sc[kt][8 * s2 + 3]); pw.z = pk2(sc[kt][8 * s2 + 4], sc[kt][8 * s2 + 5]); pw.w = pk2(sc[kt][8 * s2 + 6], sc[kt][8 * s2 + 7]);
                const bf16x8 pa = __builtin_bit_cast(bf16x8, pw);
#pragma unroll
                for (int db = 0; db < 2; ++db) { const LAS bf16* vp = VT + (32 * db + r32) * VTP + kvl0 + 32 * kt + 16 * s2 + 4 * hi;
                    const v2u lo = *(const LAS v2u*)vp, hh = *(const LAS v2u*)(vp + 8); v4u vw; vw.x = lo.x; vw.y = lo.y; vw.z = hh.x; vw.w = hh.y;
                    o[db] = __builtin_amdgcn_mfma_f32_32x32x16_bf16(pa, __builtin_bit_cast(bf16x8, vw), o[db], 0, 0, 0); } }
#pragma unroll
        for (int r = 0; r < 16; ++r) { const int qq = crow(r, hi); const float sc1 = __shfl(rl, qq);
            bf16* yp = Y + (rb + qs + qq) * 1024 + hq * 64 + r32;
            yp[0] = (bf16)(pk2(o[0][r] * sc1, 0.f) & 0xffffu); yp[32] = (bf16)(pk2(o[1][r] * sc1, 0.f) & 0xffffu); }
    }
    __syncthreads();
}
typedef unsigned v4u_unused_;
#define XB_TMO      128
#define XB_XCNT(j)  (256  + 64 * (j))
#define XB_XSUB(j)  (1280 + 64 * (j))
#define XB_XGEN(j)  (2304 + 64 * (j))
#define XB_TOP      3328
#define XB_TOPGEN   3392
#define XCD_BAR_WORDS 3456
#define XB_SPIN_CAP (1u << 18)

__device__ __forceinline__ unsigned xb_ld(unsigned* p)              { return __hip_atomic_load(p, __ATOMIC_RELAXED, __HIP_MEMORY_SCOPE_AGENT); }
__device__ __forceinline__ unsigned xb_add(unsigned* p, unsigned v) { return __hip_atomic_fetch_add(p, v, __ATOMIC_RELAXED, __HIP_MEMORY_SCOPE_AGENT); }
__device__ __forceinline__ unsigned xb_xcc_id() { return (unsigned)__builtin_amdgcn_s_getreg((3 << 11) | 20) & 0xFu; }
#define XB_SPIN(cond, bar) do { unsigned _sp = 0; while (cond) { __builtin_amdgcn_s_sleep(1); \
    if ((++_sp & 255u) == 0u) { if (xb_ld(&(bar)[XB_TMO])) break; if (_sp > XB_SPIN_CAP) { atomicAdd(&(bar)[XB_TMO], 1u); break; } } } } while (0)

struct XcdBarrier {
    unsigned* bar; unsigned x;
    volatile LAS unsigned* st;
};

__device__ __forceinline__ XcdBarrier xcd_barrier_post(unsigned* bar, volatile LAS unsigned* st) {
    XcdBarrier b; b.bar = bar; b.x = xb_xcc_id(); b.st = st;
    if (threadIdx.x == 0) (void)xb_add(&bar[XB_XCNT(b.x)], 1u);
    return b;
}
__device__ __forceinline__ void xcd_barrier_complete(unsigned* bar, unsigned x, unsigned& nloc, unsigned& nx) {
    const unsigned G = gridDim.x * gridDim.y * gridDim.z;
    unsigned sum, cnt, mine, sp = 0u;
    for (;;) {
        sum = 0u; cnt = 0u; mine = 0u;
#pragma unroll
        for (unsigned j = 0; j < 16; ++j) { const unsigned c = xb_ld(&bar[XB_XCNT(j)]); sum += c; cnt += (c > 0u) ? 1u : 0u; mine = (j == x) ? c : mine; }
        if (sum == G) break;
        __builtin_amdgcn_s_sleep(1);
        if ((++sp & 255u) == 0u) { if (xb_ld(&bar[XB_TMO])) break; if (sp > XB_SPIN_CAP) { atomicAdd(&bar[XB_TMO], 1u); break; } }
    }
    nloc = mine > 0u ? mine : 1u; nx = cnt > 0u ? cnt : 1u;
}

__device__ __forceinline__ void xcd_barrier(const XcdBarrier& b) {
    asm volatile("s_waitcnt vmcnt(0)" ::: "memory");
    __syncthreads();
    if (threadIdx.x == 0) {
        unsigned* bar = b.bar;
        __builtin_amdgcn_s_waitcnt(0);
        unsigned nloc = b.st[0], nx = b.st[1];
        if (nloc == 0u) { xcd_barrier_complete(bar, b.x, nloc, nx); b.st[0] = nloc; b.st[1] = nx; }
        const unsigned old = xb_add(&bar[XB_XSUB(b.x)], 1u);
        const unsigned gen = old / nloc;
        if (old + 1u == (gen + 1u) * nloc) {
            __builtin_amdgcn_fence(__ATOMIC_RELEASE, "agent");
            asm volatile("s_waitcnt vmcnt(0)" ::: "memory");
            const unsigned og = xb_add(&bar[XB_TOP], 1u);
            const unsigned tg = og / nx;
            if (og + 1u == (tg + 1u) * nx) xb_add(&bar[XB_TOPGEN], 1u);
            else XB_SPIN(xb_ld(&bar[XB_TOPGEN]) == tg, bar);
            __builtin_amdgcn_fence(__ATOMIC_ACQUIRE, "agent");
            xb_add(&bar[XB_XGEN(b.x)], 1u);
            asm volatile("s_waitcnt vmcnt(0)" ::: "memory");
        } else {
            XB_SPIN(xb_ld(&bar[XB_XGEN(b.x)]) == gen, bar);
            __builtin_amdgcn_fence(__ATOMIC_ACQUIRE, "agent");
            asm volatile("s_waitcnt vmcnt(0)" ::: "memory");
        }
    }
    __syncthreads();
}
constexpr int TC = 32, SBS = 340, LBS = 68;
constexpr int SBS_UNUSED_ = 336;
constexpr int RW_SBUF = 0, RW_SBUF_BYTES = TC * SBS * 4, RW_LW = 2 * RW_SBUF_BYTES, RW_LA = RW_LW + 2 * TC * LBS * 4, RW_EC = RW_LA + 2 * TC * LBS * 4, RW_BF = RW_EC + 2560;
__device__ __forceinline__ void rwkv_scan_unit(int unit, const bf16* PROJ, float* YRAW, float* C3, const float* mu, const float* w0, const float* w2, const float* a0, const float* a2,
                                               const float* k_k, const float* k_a, const float* r_k, LAS unsigned char* lds, const int lane, int wid) {
    const int role = (wid < 2) ? 0 : ((wid == 2 || wid == 3) ? 2 : 1), lw = wid - 2, ew = wid - 4;
    const int b = unit >> 6, h = (unit >> 3) & 7, rg = unit & 7; const size_t rb = (size_t)b * SEQ;
    const int r32 = lane & 31, hi = lane >> 5;
    constexpr int NCH = SEQ / TC;
    if (role == 2) {
        const int colx = 768 + ((lw == 0) ? 1536 : 1600); const float* Wl = (lw == 0) ? w2 : a2;
#pragma unroll
        for (int nb = 0; nb < 2; ++nb)
#pragma unroll
            for (int ks = 0; ks < 4; ++ks) { float f[8];
#pragma unroll
                for (int i = 0; i < 8; ++i) f[i] = Wl[(size_t)(16 * ks + 8 * hi + i) * 512 + h * 64 + 32 * nb + r32];
                *(LAS bf16x8*)(lds + RW_BF + (((lw * 2 + nb) * 4 + ks) * 64 + lane) * 16) = pack8(f); }
        ((LAS float*)(lds + RW_EC))[512 + lw * 64 + lane] = mu[colx - 768 + lane];
        v4u lcw[4], lpw[4];
#define LORA_LOAD(itn) do { const int tl_ = (itn) * TC + r32; const bf16* p_ = PROJ + (rb + tl_) * EVEN_IN + colx + 8 * hi; _Pragma("unroll") for (int ks = 0; ks < 4; ++ks) { lcw[ks] = *(const v4u*)(p_ + 16 * ks); \
            lpw[ks] = (v4u){0u, 0u, 0u, 0u}; if (tl_ > 0) lpw[ks] = *(const v4u*)(p_ - EVEN_IN + 16 * ks); } } while (0)
        LORA_LOAD(0);
#pragma unroll 1
        for (int it = 0; it < NCH + 2; ++it) {
            if (it < NCH) { bf16x8 afr[4];
#pragma unroll
                for (int ks = 0; ks < 4; ++ks) { float c[8], p[8]; unpack8(lcw[ks], c); unpack8(lpw[ks], p);
                    const LAS float* mq = (const LAS float*)(lds + RW_EC) + 512 + lw * 64 + 16 * ks + 8 * hi; const f32x4 m0 = *(const LAS f32x4*)mq, m1 = *(const LAS f32x4*)(mq + 4);
#pragma unroll
                    for (int i = 0; i < 8; ++i) { float x = c[i] + (p[i] - c[i]) * (i < 4 ? m0[i] : m1[i - 4]); if (lw == 0) x = 1.f - 2.f * __builtin_amdgcn_rcpf(1.f + __expf(2.f * x)); c[i] = x; }
                    afr[ks] = pack8(c); }
                if (it + 1 < NCH) LORA_LOAD(it + 1);
                LAS float* LB = (LAS float*)(lds + ((lw == 0) ? RW_LW : RW_LA)) + (it & 1) * (TC * LBS);
#pragma unroll
                for (int nb = 0; nb < 2; ++nb) { f32x16 acc = f32x16{};
#pragma unroll
                    for (int ks = 0; ks < 4; ++ks) acc = __builtin_amdgcn_mfma_f32_32x32x16_bf16(afr[ks], *(const LAS bf16x8*)(lds + RW_BF + (((lw * 2 + nb) * 4 + ks) * 64 + lane) * 16), acc, 0, 0, 0);
#pragma unroll
                    for (int r = 0; r < 16; ++r) LB[crow(r, hi) * LBS + 32 * nb + r32] = acc[r]; } }
            asm volatile("s_waitcnt lgkmcnt(0)\n\ts_barrier" ::: "memory");
        }
#undef LORA_LOAD
    } else if (role == 1) {
        const int el = ew * 64 + lane, s = el >> 3, g = el & 7;
        float ecc[8][8];
        { const int chn = h * 64 + 8 * g;
#pragma unroll
          for (int i = 0; i < 8; ++i) { ecc[0][i] = mu[chn + i]; ecc[1][i] = mu[512 + chn + i]; ecc[2][i] = mu[1024 + chn + i]; ecc[3][i] = w0[chn + i]; ecc[4][i] = a0[chn + i]; ecc[5][i] = k_k[chn + i]; ecc[6][i] = k_a[chn + i]; ecc[7][i] = r_k[chn + i]; } }
        v4u ecr, eck, ecv, epr, epk, epv;
#define ELEM_LOAD(cn) do { const int tl_ = (cn) * TC + s; const bf16* p_ = PROJ + (rb + tl_) * EVEN_IN + 768 + h * 64 + 8 * g; \
            ecr = *(const v4u*)p_; eck = *(const v4u*)(p_ + 512); ecv = *(const v4u*)(p_ + 1024); epr = (v4u){0u, 0u, 0u, 0u}; epk = epr; epv = epr; \
            if (tl_ > 0) { epr = *(const v4u*)(p_ - EVEN_IN); epk = *(const v4u*)(p_ - EVEN_IN + 512); epv = *(const v4u*)(p_ - EVEN_IN + 1024); } } while (0)
        ELEM_LOAD(0);
#pragma unroll 1
        for (int it = 0; it < NCH + 2; ++it) {
            const int c = it - 1;
            if (c >= 0 && c < NCH) { const size_t row = rb + c * TC + s;
                const LAS float* LW = (const LAS float*)(lds + RW_LW) + (c & 1) * (TC * LBS) + s * LBS + 8 * g; const LAS float* LA = (const LAS float*)(lds + RW_LA) + (c & 1) * (TC * LBS) + s * LBS + 8 * g;
                LAS float* sp = (LAS float*)(lds + RW_SBUF + (c & 1) * RW_SBUF_BYTES) + s * SBS;
                float ec[8];
#define LDEC(arr) do { _Pragma("unroll") for (int i_ = 0; i_ < 8; ++i_) ec[i_] = ecc[arr][i_]; } while (0)
                float r[8], k[8], v[8], t[8];
                unpack8(ecr, r); unpack8(epr, t); LDEC(0);
#pragma unroll
                for (int i = 0; i < 8; ++i) r[i] += (t[i] - r[i]) * ec[i];
                unpack8(eck, k); unpack8(epk, t); LDEC(1);
#pragma unroll
                for (int i = 0; i < 8; ++i) k[i] += (t[i] - k[i]) * ec[i];
                unpack8(ecv, v); unpack8(epv, t); LDEC(2);
#pragma unroll
                for (int i = 0; i < 8; ++i) v[i] += (t[i] - v[i]) * ec[i];
                if (c + 1 < NCH) ELEM_LOAD(c + 1);
                const f32x4 dw0 = *(const LAS f32x4*)LW, dw1 = *(const LAS f32x4*)(LW + 4), da0 = *(const LAS f32x4*)LA, da1 = *(const LAS f32x4*)(LA + 4);
                float w[8], a[8], kk[8], kp[8]; float n2 = 0.f;
#pragma unroll
                for (int i = 0; i < 8; ++i) w[i] = i < 4 ? dw0[i] : dw1[i - 4];
                LDEC(3);
#pragma unroll
                for (int i = 0; i < 8; ++i) w[i] = __expf(-0.60653065971f * pg8::sigm(ec[i] + w[i]));
                LDEC(4);
#pragma unroll
                for (int i = 0; i < 8; ++i) a[i] = pg8::sigm(ec[i] + (i < 4 ? da0[i] : da1[i - 4]));
                LDEC(5);
#pragma unroll
                for (int i = 0; i < 8; ++i) { kk[i] = k[i] * ec[i]; n2 += kk[i] * kk[i]; }
                LDEC(6);
#pragma unroll
                for (int i = 0; i < 8; ++i) kp[i] = k[i] * (1.f + (a[i] - 1.f) * ec[i]);
                LDEC(7);
                n2 = red8(n2); const float inv = __builtin_amdgcn_rsqf(fmaxf(n2, 1e-24f));
                float c1 = 0.f, c2 = 0.f, c3 = 0.f;
#pragma unroll
                for (int i = 0; i < 8; ++i) { kk[i] *= inv; t[i] = kk[i] * a[i]; c1 += t[i] * r[i]; c2 += kp[i] * r[i]; c3 += r[i] * kp[i] * ec[i]; }
#undef LDEC
                c1 = red8(c1); c2 = red8(c2); c3 = red8(c3);
                *(LAS f32x4*)(sp + 8 * g) = (f32x4){kk[0], kk[1], kk[2], kk[3]}; *(LAS f32x4*)(sp + 8 * g + 4) = (f32x4){kk[4], kk[5], kk[6], kk[7]};
                *(LAS f32x4*)(sp + 64 + 8 * g) = (f32x4){w[0] * r[0], w[1] * r[1], w[2] * r[2], w[3] * r[3]}; *(LAS f32x4*)(sp + 64 + 8 * g + 4) = (f32x4){w[4] * r[4], w[5] * r[5], w[6] * r[6], w[7] * r[7]};
                *(LAS f32x4*)(sp + 128 + 8 * g) = (f32x4){w[0], w[1], w[2], w[3]}; *(LAS f32x4*)(sp + 128 + 8 * g + 4) = (f32x4){w[4], w[5], w[6], w[7]};
                *(LAS f32x4*)(sp + 192 + 8 * g) = (f32x4){t[0], t[1], t[2], t[3]}; *(LAS f32x4*)(sp + 192 + 8 * g + 4) = (f32x4){t[4], t[5], t[6], t[7]};
                *(LAS f32x4*)(sp + 256 + 8 * g) = (f32x4){kp[0], kp[1], kp[2], kp[3]}; *(LAS f32x4*)(sp + 256 + 8 * g + 4) = (f32x4){kp[4], kp[5], kp[6], kp[7]};
                if (g == rg) { *(LAS f32x4*)(sp + 320) = (f32x4){v[0], v[1], v[2], v[3]}; *(LAS f32x4*)(sp + 324) = (f32x4){v[4], v[5], v[6], v[7]}; }
                if (g == 0) { sp[328] = c1; sp[329] = c2; if (rg == 0) C3[row * 8 + h] = c3; } }
            asm volatile("s_waitcnt lgkmcnt(0)\n\ts_barrier" ::: "memory");
        }
#undef ELEM_LOAD
    } else {
        const int rowl = 4 * (wid & 1) + (lane >> 4), cgp = lane & 15;
        f32x2s S01 = {0.f, 0.f}, S23 = {0.f, 0.f};
#pragma unroll 1
        for (int it = 0; it < NCH + 2; ++it) {
            const int c = it - 2;
            if (c >= 0) { const LAS float* SBF = (const LAS float*)(lds + RW_SBUF + (c & 1) * RW_SBUF_BYTES);
                float* yp = YRAW + (rb + (size_t)c * TC) * 512 + h * 64 + 8 * rg + rowl;
                __builtin_amdgcn_s_setprio(3);
                f32x4 kkA, wrA, wA, kaA, kpA, kkB, wrB, wB, kaB, kpB; float viA, viB; float pkeep = 0.f, qkeep = 0.f;
#define LDREC(X, s_) do { const LAS float* sp_ = SBF + (s_) * SBS; kk##X = *(const LAS f32x4*)(sp_ + 4 * cgp); wr##X = *(const LAS f32x4*)(sp_ + 64 + 4 * cgp); w##X = *(const LAS f32x4*)(sp_ + 128 + 4 * cgp); \
                    ka##X = *(const LAS f32x4*)(sp_ + 192 + 4 * cgp); kp##X = *(const LAS f32x4*)(sp_ + 256 + 4 * cgp); vi##X = sp_[320 + rowl]; } while (0)
#define LO2(v) __builtin_shufflevector(v, v, 0, 1)
#define HI2(v) __builtin_shufflevector(v, v, 2, 3)
#define STEPREC(X, s_) do { f32x2s pp = S01 * LO2(kk##X); pp = S23 * HI2(kk##X) + pp; f32x2s qq = S01 * LO2(wr##X); qq = S23 * HI2(wr##X) + qq; float p = pp[0] + pp[1], q = qq[0] + qq[1]; \
                    const f32x2s vv_ = {vi##X, vi##X}; const f32x2s u01_ = S01 * LO2(w##X) + LO2(kp##X) * vv_, u23_ = S23 * HI2(w##X) + HI2(kp##X) * vv_;     \
                    p += dpp_f<0xB1>(p); q += dpp_f<0xB1>(q); p += dpp_f<0x4E>(p); q += dpp_f<0x4E>(q); p += dpp_f<0x141>(p); q += dpp_f<0x141>(q); p += dpp_f<0x140>(p); q += dpp_f<0x140>(q); \
                    const f32x2s pv_ = {p, p}; \
                    S01 = u01_ - LO2(ka##X) * pv_; S23 = u23_ - HI2(ka##X) * pv_; \
                    pkeep = (((s_) & 15) == cgp) ? p : pkeep; qkeep = (((s_) & 15) == cgp) ? q : qkeep;     \
                    if (((s_) & 15) == 15) { const LAS float* sy_ = SBF + ((s_) - 15 + cgp) * SBS; const f32x2s cy_ = *(const LAS f32x2s*)(sy_ + 328); \
                        yp[(size_t)((s_) - 15 + cgp) * 512] = qkeep - pkeep * cy_[0] + sy_[320 + rowl] * cy_[1]; } } while (0)
                LDREC(A, 0);
#pragma unroll
                for (int s = 0; s < TC; s += 2) {
 LDREC(B, s + 1); STEPREC(A, s); LDREC(A, s + 2); STEPREC(B, s + 1); }
#undef LDREC
#undef STEPREC
#undef LO2
#undef HI2
                __builtin_amdgcn_s_setprio(0); }
            asm volatile("s_waitcnt lgkmcnt(0)\n\ts_barrier" ::: "memory");
        }
    }
    __syncthreads();
}

__device__ __forceinline__ void rwkv_post_unit(int tile, const bf16* PROJ, const float* YRAW, const float* C3, bf16* Y, const float* mu, const bf16* g2f, const float* ln_w, const float* ln_b, int lane, int wid) {
    asm volatile("" : "+s"(PROJ), "+s"(mu), "+s"(g2f), "+s"(YRAW));
    const int h = wid, r32 = lane & 31, hi = lane >> 5; const int tok0 = tile * 32; const bool first = (tok0 & (SEQ - 1)) == 0;
    bf16x8 afr[8];
    { const int tk = tok0 + r32; const bool hp = !(first && r32 == 0); v4u cwv[8], pwv[8];
      const __attribute__((address_space(1))) bf16* pg = (const __attribute__((address_space(1))) bf16*)(PROJ + (size_t)tk * EVEN_IN + 768 + 1664 + 8 * hi);
#pragma unroll
        for (int ks = 0; ks < 8; ++ks) { cwv[ks] = *(const __attribute__((address_space(1))) v4u*)(pg + 16 * ks); pwv[ks] = (v4u){0u, 0u, 0u, 0u};
            if (hp) pwv[ks] = *(const __attribute__((address_space(1))) v4u*)(pg - EVEN_IN + 16 * ks); }
#pragma unroll
        for (int ks = 0; ks < 8; ++ks) { float c[8], p[8]; unpack8(cwv[ks], c); unpack8(pwv[ks], p);
            const f32x4 m0 = *(const f32x4*)(mu + 1664 + 16 * ks + 8 * hi), m1 = *(const f32x4*)(mu + 1664 + 16 * ks + 8 * hi + 4);
#pragma unroll
            for (int i = 0; i < 8; ++i) c[i] = pg8::sigm(c[i] + (p[i] - c[i]) * (i < 4 ? m0[i] : m1[i - 4]));
            afr[ks] = pack8(c); } }
    f32x16 gt[2];
#pragma unroll
    for (int nb = 0; nb < 2; ++nb) { gt[nb] = f32x16{};
#pragma unroll
        for (int ks = 0; ks < 8; ++ks) { const bf16x8 bf = *(const bf16x8*)(g2f + ((size_t)((h * 2 + nb) * 8 + ks) * 64 + lane) * 8);
            gt[nb] = __builtin_amdgcn_mfma_f32_32x32x16_bf16(afr[ks], bf, gt[nb], 0, 0, 0); } }
    typedef const __attribute__((address_space(1))) float* gfp; typedef const __attribute__((address_space(1))) unsigned short* gup;
    const int ch0 = h * 64 + r32; const float lw0 = ln_w[ch0], lw1 = ln_w[ch0 + 32], lb0 = ln_b[ch0], lb1 = ln_b[ch0 + 32], mv0 = mu[1024 + ch0], mv1 = mu[1024 + ch0 + 32];
    float y0[16], y1[16], c3v[16]; unsigned vc[16], vp[16];
#pragma unroll
    for (int r = 0; r < 16; ++r) { const int tk = tok0 + crow(r, hi); gfp yp = (gfp)(YRAW + (size_t)tk * 512 + ch0); y0[r] = yp[0]; y1[r] = yp[32]; c3v[r] = ((gfp)C3)[(size_t)tk * 8 + h];
        gup vq = (gup)(PROJ + (size_t)tk * EVEN_IN + 768 + 1024 + ch0); vc[r] = (unsigned)vq[0] | ((unsigned)vq[32] << 16); vp[r] = 0u;
        if ((tk & (SEQ - 1)) != 0) vp[r] = (unsigned)vq[-EVEN_IN] | ((unsigned)vq[32 - EVEN_IN] << 16); }
#pragma unroll
    for (int r = 0; r < 16; ++r) { const int tk = tok0 + crow(r, hi);
        float s = y0[r] + y1[r]; s = red16(s); s += __shfl_xor(s, 16);
        const float mean = s * (1.f / 64.f), d0 = y0[r] - mean, d1 = y1[r] - mean; float q = d0 * d0 + d1 * d1; q = red16(q); q += __shfl_xor(q, 16);
        const float rstd = rsqrtf(q * (1.f / 64.f) + GN_EPS);
        const float cv0 = bflo(vc[r]), cv1 = bfhi(vc[r]), pv0 = bflo(vp[r]), pv1 = bfhi(vp[r]);
        const float v0 = cv0 + (pv0 - cv0) * mv0, v1 = cv1 + (pv1 - cv1) * mv1;
        const float o0 = (d0 * rstd * lw0 + lb0 + c3v[r] * v0) * gt[0][r], o1 = (d1 * rstd * lw1 + lb1 + c3v[r] * v1) * gt[1][r];
        bf16* op = Y + (size_t)tk * 1024 + 512 + ch0; op[0] = (bf16)(pk2(o0, 0.f) & 0xffffu); op[32] = (bf16)(pk2(o1, 0.f) & 0xffffu); }
}

__device__ __forceinline__ void fox_gate_pass(const bf16* XB, const bf16* Wf, const float* ssqv, const float* bfv, float* LF, int gw, int NGW, int lane) {
    typedef float f32x4g __attribute__((ext_vector_type(4)));
    const int fr = lane & 15, fq = lane >> 4;
    for (int t = gw; t < M / 16; t += NGW) {
        const bf16* ap = XB + (size_t)(t * 16 + fr) * D + 8 * fq; const bf16* bp = Wf + (size_t)fr * D + 8 * fq;
        f32x4g acc = {0.f, 0.f, 0.f, 0.f};
#pragma unroll 8
        for (int ks = 0; ks < D / 32; ++ks) acc = __builtin_amdgcn_mfma_f32_16x16x32_bf16(*(const bf16x8*)(ap + 32 * ks), *(const bf16x8*)(bp + 32 * ks), acc, 0, 0, 0);
        const float bn = bfv[fr];
#pragma unroll
        for (int j = 0; j < 4; ++j) { const int row = t * 16 + 4 * fq + j; const float z = fmaxf(acc[j] * pg8::rstd_of(ssqv, row) + bn, -80.f), e = __expf(-z);
            LF[(size_t)row * 16 + fr] = (e < 0.01f) ? -(e - 0.5f * e * e + e * e * e * (1.f / 3.f)) : -__logf(1.f + e); }
    }
}

__device__ __forceinline__ void fox_prefix(const float* LFbh, LAS float* cs, LAS float* wtot, int tid, int lane, int wid) {
    const float* lp = LFbh + (size_t)tid * 128;
    float s[8]; s[0] = lp[0]; s[1] = s[0] + lp[16]; s[2] = s[1] + lp[32]; s[3] = s[2] + lp[48]; s[4] = s[3] + lp[64]; s[5] = s[4] + lp[80]; s[6] = s[5] + lp[96]; s[7] = s[6] + lp[112];
    float incl = s[7];
#pragma unroll
    for (int o = 1; o < 64; o <<= 1) { const float t = __shfl_up(incl, o); if (lane >= o) incl += t; }
    if (lane == 63) wtot[wid] = incl;
    __syncthreads();
    float base = incl - s[7];
    for (int w = 0; w < wid; ++w) base += wtot[w];
#pragma unroll
    for (int i = 0; i < 8; ++i) { const float v = (base + s[i]) * LOG2E;
        const unsigned h1 = pk2(v, 0.f) & 0xffffu; const float r1 = v - __uint_as_float(h1 << 16); const unsigned h2 = pk2(r1, 0.f) & 0xffffu; const float r2 = r1 - __uint_as_float(h2 << 16); const unsigned h3 = pk2(r2, 0.f) & 0xffffu;
        ((LAS v2u*)cs)[8 * tid + i] = (v2u){h1 | (h2 << 16), h3}; }
    __syncthreads();
}
struct Args { const float* in[30]; float* out; unsigned char* ws; int ph_lo, ph_hi; };
#define AS4 __attribute__((address_space(4)))
#ifndef DUP_SWA
#define DUP_SWA 0
#endif
#ifndef DUP_SCAN
#define DUP_SCAN 0
#endif
#ifndef DUP_POST
#define DUP_POST 0
#endif
#ifndef DUP_GU
#define DUP_GU 0
#endif
#ifndef DUP_INPROJ
#define DUP_INPROJ 0
#endif
#ifndef DUP_P0
#define DUP_P0 0
#endif
#ifndef DUP_SYNC
#define DUP_SYNC 0
#endif
#define INP(i) (*(const float* const AS4*)(kp + 8 * (i)))
#define GSYNC() xcd_barrier(xbar)
#define FRESH() const AS4 char* kp = kp0; asm volatile("" : "+s"(kp)); unsigned char* ws = *(unsigned char* const AS4*)(kp + 248); float* X = *(float* const AS4*)(kp + 240); \
    int tid = threadIdx.x; asm volatile("" : "+v"(tid)); const int lane = tid & 63, wid = __builtin_amdgcn_readfirstlane(tid >> 6); \
    const int gw = bx * 8 + wid, NGW = G * 8; \
    float* ssq = (float*)(ws + WS_SSQP); float* C3 = (float*)(ws + WS_C3); float* LF = (float*)(ws + WS_LF); \
    bf16* XB = (bf16*)(ws + WS_XB); float* YRAW = (float*)(ws + WS_XB); bf16* Y = (bf16*)(ws + WS_Y); \
    bf16* H = (bf16*)(ws + WS_BIG); bf16* PROJ = (bf16*)(ws + WS_BIG); bf16* PP = (bf16*)(ws + WS_BIG); bf16* PB = (bf16*)(ws + WS_PB); \
    bf16* Qb = (bf16*)(ws + WS_BIG); bf16* Kb = Qb + (size_t)M * D; bf16* Vb = Kb + (size_t)M * D; \
    (void)X; (void)lane; (void)wid; (void)gw; (void)NGW; (void)ssq; (void)C3; (void)LF; (void)XB; (void)YRAW; (void)Y; (void)H; (void)PROJ; (void)PP; (void)PB; (void)Qb; (void)Kb; (void)Vb
__global__ void __launch_bounds__(512, 2) fwd_megakernel(Args a_unused) {
    extern __shared__ __attribute__((aligned(16))) unsigned char lds_raw[];
    cg::grid_group grid = cg::this_grid();
    LAS unsigned char* lds = (LAS unsigned char*)lds_raw;
    const int G = gridDim.x, bx = blockIdx.x;
    const AS4 char* kp0 = (const AS4 char*)__builtin_amdgcn_kernarg_segment_ptr();
    const int ph_lo = *(const int AS4*)(kp0 + 256), ph_hi = *(const int AS4*)(kp0 + 260);
    XcdBarrier xbar;
    { unsigned* barw = (unsigned*)(*(unsigned char* const AS4*)(kp0 + 248) + WS_BAR);
      if (bx == 0) for (int i = threadIdx.x; i < XCD_BAR_WORDS; i += 512) barw[i] = 0u;
      if (threadIdx.x < 4) ((LAS unsigned*)(lds + MISC_OFF))[threadIdx.x] = 0u;
      asm volatile("s_waitcnt vmcnt(0)" ::: "memory"); __syncthreads();
      grid.sync();
      __builtin_amdgcn_fence(__ATOMIC_ACQUIRE, "agent"); asm volatile("s_waitcnt vmcnt(0)" ::: "memory");
      xbar = xcd_barrier_post(barw, (volatile LAS unsigned*)(lds + MISC_OFF)); }

#ifdef NANFILL
    { FRESH(); v4u q = {0xffffffffu, 0xffffffffu, 0xffffffffu, 0xffffffffu};
      for (size_t i = (size_t)bx * 512 + tid; i < WS_END / 16; i += (size_t)G * 512) ((v4u*)ws)[i] = q;
      for (size_t i = (size_t)bx * 512 + tid; i < (size_t)M * D / 4; i += (size_t)G * 512) ((v4u*)X)[i] = q;
      for (int i = tid; i < LDS_BYTES / 4; i += 512) ((LAS unsigned*)lds)[i] = 0xffffffffu; }
    GSYNC();
#endif
    for (int dup = 0; dup < 1 + DUP_P0; ++dup)
    if (ph_lo == 0) {
        FRESH();
        LAS float* scr = (LAS float*)(lds + wid * 16384);
        constexpr int I_GU = (D / 64) * (2 * DFF / 32), I_D = (DFF / 64) * (D / 32), I_G = (D / 64) * (D / 32), I_P = (PLE / 64) * (D / 32), I_IN0 = (D / 64) * (EVEN_IN / 32), I_IN1 = (D / 64) * (FOX_INP / 32);
        constexpr int NITEMS = 4 * I_GU + 4 * I_D + 2 * I_G + 2 * I_P + I_IN0 + I_IN1 + 2 * I_G;
        for (int it = gw; it < NITEMS; it += NGW) {
            int r = it;
#define MAT(cnt, W_, K_, N_, NP_, WT_, G_, MODE_) if (r < (cnt)) { conv_item((W_), (K_), (N_), (NP_), (bf16*)(WT_), (G_), (MODE_), scr, r, lane); continue; } r -= (cnt);
            MAT(I_GU, INP(3), D, 2 * DFF, 2 * DFF, ws + WS_WGU, INP(2), 1)
            MAT(I_GU, INP(7), D, 2 * DFF, 2 * DFF, ws + WS_WGU + 11 * MiB, INP(6), 1)
            MAT(I_GU, INP(3) + (size_t)D * 2 * DFF, D, 2 * DFF, 2 * DFF, ws + WS_WGU + 22 * MiB, INP(2) + D, 1)
            MAT(I_GU, INP(7) + (size_t)D * 2 * DFF, D, 2 * DFF, 2 * DFF, ws + WS_WGU + 33 * MiB, INP(6) + D, 1)
            MAT(I_D, INP(4), DFF, D, D, ws + WS_WD, nullptr, 0)
            MAT(I_D, INP(8), DFF, D, D, ws + WS_WD + (size_t)D * DFF * 2, nullptr, 0)
            MAT(I_D, INP(4) + (size_t)D * DFF, DFF, D, D, ws + WS_WD + (size_t)D * DFF * 4, nullptr, 0)
            MAT(I_D, INP(8) + (size_t)D * DFF, DFF, D, D, ws + WS_WD + (size_t)D * DFF * 6, nullptr, 0)
            MAT(I_G, INP(10), D, D, D, ws + WS_WG, INP(9), 0)
            MAT(I_G, INP(10) + (size_t)D * D, D, D, D, ws + WS_WG + 2 * MiB, INP(9) + D, 0)
            MAT(I_P, INP(11), PLE, D, D, ws + WS_WP, nullptr, 0)
            MAT(I_P, INP(11) + (size_t)PLE * D, PLE, D, D, ws + WS_WP + (size_t)PLE * D * 2, nullptr, 0)
            MAT(I_IN0, INP(12), D, EVEN_IN, EVEN_IN, ws + WS_WIN0, INP(5), 0)
            MAT(I_IN1, INP(26), D, FOX_IN, FOX_INP, ws + WS_WIN1, INP(5) + D, 0)
            MAT(I_G, INP(13), D, D, D, ws + WS_WOUT0, nullptr, 0)
            MAT(I_G, INP(28), D, D, D, ws + WS_WOUT1, nullptr, 0)
#undef MAT
        }
        const float* x_in = INP(0);
        for (int m = gw; m < M; m += NGW) { const f32x4* xr = (const f32x4*)(x_in + (size_t)m * D) + lane; f32x4 v[4]; float s = 0.f;
#pragma unroll
            for (int j = 0; j < 4; ++j) { v[j] = xr[64 * j]; s += (v[j][0] * v[j][0] + v[j][1] * v[j][1]) + (v[j][2] * v[j][2] + v[j][3] * v[j][3]); }
            s = wave_sum(s); if (lane < 16) ssq[(size_t)m * 16 + lane] = (lane == 0) ? s : 0.f;
            v2u* o = (v2u*)(XB + (size_t)m * D) + lane;
#pragma unroll
            for (int j = 0; j < 4; ++j) { v2u w; w.x = pk2(v[j][0], v[j][1]); w.y = pk2(v[j][2], v[j][3]); o[64 * j] = w; } }
        const float* g2 = INP(20);
        for (int i = bx * 512 + tid; i < 8192; i += G * 512) { const int ln = i & 63, ks = (i >> 6) & 7, nb = (i >> 9) & 1, hh = i >> 10; float f[8];
#pragma unroll
            for (int j = 0; j < 8; ++j) f[j] = g2[(size_t)(16 * ks + 8 * (ln >> 5) + j) * 512 + hh * 64 + 32 * nb + (ln & 31)];
            ((bf16x8*)(ws + WS_G2F))[i] = pack8(f); }
    }
    if (ph_lo == 0 && ph_hi > 1) GSYNC();

#define GEMM(EpiT, Aptr, Bptr, Nn, Kk, Eobj) do { pg8::Gemm g_{(const pg8::bf16_t*)(Aptr), (const pg8::bf16_t*)(Bptr), M, (Nn), (Kk)}; pg8::StaticOrder S_; S_.init(M, (Nn), G, bx); \
        pg8::gemm_phase<EpiT, pg8::StaticOrder, true, true>(lds, g_, S_, (Eobj), tid); } while (0)
#pragma unroll 1
    for (int L = 0; L < 2; ++L) {
#pragma unroll 1
        for (int st = 0; st < 9; ++st) {
            const int ph = 1 + 9 * L + st; if (ph < ph_lo || ph >= ph_hi) continue;
            switch (st) {
            case 0: case 6: {
#if PHM & 1
                FRESH();
                for (int dup = 0; dup < 1 + DUP_GU; ++dup) {
                const int f = (st == 6); pg8::EpiGU E{H, ssq + (size_t)((f ? 2 : 0) & 1) * M * 16};
                GEMM(pg8::EpiGU, (L == 1 && st == 0) ? Y : XB, ws + WS_WGU + (size_t)(L * 2 + f) * 11 * MiB, 2 * DFF, D, E);
                __syncthreads(); }
#endif
            } break;
            case 1: case 5: case 7: {
#if PHM & 2
                FRESH();
                const bf16* A; const bf16* Bt; int K; float alpha; float* so;
                if (st == 5) { A = (L == 0) ? Y : Qb; Bt = (const bf16*)(ws + (L == 0 ? WS_WOUT0 : WS_WOUT1)); K = D; alpha = 1.f; so = ssq; }
                else { const int f = (st == 7); A = H; Bt = (const bf16*)(ws + WS_WD + (size_t)(L * 2 + f) * D * DFF * 2); K = DFF; alpha = 0.5f; so = ssq + (size_t)M * 16; }
                pg8::EpiRes E{(L == 0 && st == 1) ? INP(0) : (const float*)X, X, XB, so, alpha};
                GEMM(pg8::EpiRes, A, Bt, D, K, E);
                if (st == 7) {
                    const f32x4* ps = (const f32x4*)(INP(1) + (size_t)L * M * PLE);
                    for (int i = bx * 512 + tid; i < M * PLE / 8; i += G * 512) { const f32x4 u0 = ps[2 * i], u1 = ps[2 * i + 1]; v4u w; w.x = pk2(u0[0], u0[1]); w.y = pk2(u0[2], u0[3]); w.z = pk2(u1[0], u1[1]); w.w = pk2(u1[2], u1[3]); ((v4u*)PB)[i] = w; }
                }
#endif
            } break;
            case 2: {
#if PHM & 4
                FRESH();
                pg8::EpiStore E{Qb, L ? D : EVEN_IN, ssq + (size_t)M * 16, QSCALE, L ? 4 : 2, L ? 4 : 1000, (size_t)M * D, -1, LF, INP(27)};
                for (int dup = 0; dup < 1 + DUP_INPROJ; ++dup) { GEMM(pg8::EpiStore, XB, ws + (L ? WS_WIN1 : WS_WIN0), L ? 3 * D : EVEN_IN, D, E); __syncthreads(); }
                if (L == 1) fox_gate_pass(XB, (const bf16*)(ws + WS_WIN1) + (size_t)3 * D * D, ssq + (size_t)M * 16, INP(27), LF, gw, NGW, lane);
#endif
            } break;
            case 3: {
                if (L == 0) {
#if PHM & 8
                    { FRESH();
#pragma unroll 1
                    for (int dup = 0; dup < 1 + DUP_SWA; ++dup)
                    for (int u = bx; u < 256; u += G) swa_unit(u, PROJ, Y, INP(14), lds, tid, lane, wid); }
#endif
#if PHM & 16
                    { FRESH();
#pragma unroll 1
                    for (int dup = 0; dup < 1 + DUP_SCAN; ++dup)
                    for (int u = bx; u < 256; u += G) rwkv_scan_unit(u, PROJ, YRAW, C3, INP(15), INP(16), INP(17), INP(18), INP(19), INP(21), INP(22), INP(23), lds, lane, wid); }
#endif
                } else {
#if PHM & 32
                    FRESH();
                    const int vcu = (G % 8 == 0) ? (bx % 8) * (G / 8) + bx / 8 : bx;
#pragma unroll 1
                    for (int v = vcu; v < 256; v += G)
#pragma unroll 1
                        for (int i = 0; i < 4; ++i) { int tid2 = tid; asm volatile("" : "+v"(tid2)); const int lane2 = tid2 & 63, wid2 = __builtin_amdgcn_readfirstlane(tid2 >> 6); const int s = v & 3, bh = v >> 2, qb = (i == 0) ? s : (i == 1) ? 7 - s : (i == 2) ? 8 + s : 15 - s;
                            if (i == 0) fox_prefix(LF + (size_t)(bh >> 4) * SEQ * 16 + (bh & 15), (LAS float*)(lds + 98304), (LAS float*)(lds + 131072), tid2, lane2, wid2);
                            attn_body::attn_unit<60>(bh >> 4, bh & 15, qb, (const attn_body::bf16*)Qb, (const attn_body::bf16*)Kb, (const attn_body::bf16*)Vb, (attn_body::bf16*)Qb, (char*)lds_raw, (attn_body::lds_fptr)(lds + 98304), tid2); }
#endif
                }
            } break;
            case 4: {
#if PHM & 64
                if (L == 0) { FRESH();
#pragma unroll 1
                    for (int dup = 0; dup < 1 + DUP_POST; ++dup)
                    for (int t = bx; t < M / 32; t += G) rwkv_post_unit(t, PROJ, YRAW, C3, Y, INP(15), (const bf16*)(ws + WS_G2F), INP(24), INP(25), lane, wid); }
#endif
            } break;
            case 8: {
#if PHM & 128
                FRESH();
#pragma unroll 1
                for (int mode = 0; mode < 2; ++mode) {
                    pg8::EpiPle E{mode, X, Y, PP, ssq + (size_t)M * 16, ssq};
                    GEMM(pg8::EpiPle, mode ? XB : PB, mode ? ws + WS_WG + (size_t)L * 2 * MiB : ws + WS_WP + (size_t)L * PLE * D * 2, D, mode ? D : PLE, E);
                    __syncthreads();
                }
#endif
            } break;
            }
            if (!(L == 1 && st == 4) && ph + 1 < ph_hi) { GSYNC(); for (int dup = 0; dup < DUP_SYNC; ++dup) GSYNC(); }
        }
    }
#undef GEMM
    if (ph_hi == 20) { FRESH(); const float* fg = INP(29); const float* s8 = ssq;
        for (int m = gw; m < M; m += NGW) { f32x4* xr = (f32x4*)(X + (size_t)m * D) + lane; const float rs = pg8::rstd_of(s8, m);
#pragma unroll
            for (int j = 0; j < 4; ++j) { const f32x4 gv = ((const f32x4*)fg)[lane + 64 * j]; xr[64 * j] = xr[64 * j] * rs * gv; } } }
}

extern "C" void kernel_launch(void* const* d_in, const int* in_sizes, int n_in, void* d_out, int out_size, void* d_ws, size_t ws_size, hipStream_t stream) {
    static int grid = 0;
    if (grid == 0) {
        if (n_in != 30 || out_size != M * D || ws_size < WS_END) { fprintf(stderr, "kernel_launch: unexpected shapes (n_in %d out %d ws %zu)\n", n_in, out_size, ws_size); grid = -1; return; }
        int dev = 0, cus = 0, per_cu = 0;
        if (hipGetDevice(&dev) != hipSuccess || hipDeviceGetAttribute(&cus, hipDeviceAttributeMultiprocessorCount, dev) != hipSuccess) { grid = -1; return; }
        if (hipFuncSetAttribute((const void*)fwd_megakernel, hipFuncAttributeMaxDynamicSharedMemorySize, LDS_BYTES) != hipSuccess) { fprintf(stderr, "kernel_launch: hipFuncSetAttribute failed\n"); grid = -1; return; }
        if (hipOccupancyMaxActiveBlocksPerMultiprocessor(&per_cu, (const void*)fwd_megakernel, 512, LDS_BYTES) != hipSuccess || per_cu < 1) { fprintf(stderr, "kernel_launch: occupancy query failed (%d)\n", per_cu); (void)hipGetLastError(); grid = -1; return; }
        grid = cus * per_cu;
        if (grid > 256) grid = 256;
    }
    if (grid < 0) return;
    Args a{};
    for (int i = 0; i < 30; ++i) a.in[i] = (const float*)d_in[i];
    a.out = (float*)d_out; a.ws = (unsigned char*)d_ws;
#ifndef N_LAUNCH_PER_PHASE
    a.ph_lo = 0; a.ph_hi = 20;
    { void* args[] = {&a};
      hipError_t e = hipLaunchCooperativeKernel((const void*)fwd_megakernel, dim3(grid), dim3(512), args, LDS_BYTES, stream);
      if (e != hipSuccess) fprintf(stderr, "cooperative launch failed: %s (grid %d)\n", hipGetErrorString(e), grid); }
#else
    for (int ph = 0; ph < 20; ++ph) { if (ph == 14) continue; a.ph_lo = ph; a.ph_hi = ph + 1; void* args[] = {&a};
      hipError_t e = hipLaunchCooperativeKernel((const void*)fwd_megakernel, dim3(grid), dim3(512), args, LDS_BYTES, stream);
      if (e != hipSuccess) { fprintf(stderr, "cooperative launch failed: %s (grid %d)\n", hipGetErrorString(e), grid); break; } }
#endif
}
```

```cpp
#include <hip/hip_runtime.h>
#include <hip/hip_cooperative_groups.h>
#include <hip/hip_bf16.h>
#include <cstdio>
#include <cstdint>
#include <cmath>
namespace cg = cooperative_groups;
#ifndef PHM
#define PHM 255
#endif
namespace pg8 {
#define PG8_LAS __attribute__((address_space(3)))
typedef unsigned short bf16_t;
typedef short bf16x8 __attribute__((ext_vector_type(8)));
typedef float f32x4 __attribute__((ext_vector_type(4)));
typedef unsigned u32x4 __attribute__((ext_vector_type(4)));
constexpr int BM = 256, BK = 64, HALF = 128, HTB = HALF * BK * 2  , STAGE_BYTES = 8 * HTB, NXCD = 8, WGM = 8;

__host__ __device__ __forceinline__ int lds_byte(int r, int c) { const int st = (r >> 4) * 2 + (c >> 5), rr = r & 15, cc = c & 31, ob = rr * 64 + cc * 2; return st * 1024 + (ob ^ (((ob >> 9) & 1) << 5)); }
__host__ __device__ __forceinline__ void stage_rc(int b, int& R, int& C) { const int st = b / 1024, sb = b % 1024, swz = sb ^ (((sb >> 9) & 1) << 5); R = (st >> 1) * 16 + swz / 64; C = (st & 1) * 32 + (swz % 64) / 2; }
__host__ __device__ __forceinline__ int perm32(int rho) { const int n = rho >> 4, i = rho & 15; return 8 * (i >> 2) + 4 * n + (i & 3); }

struct Unit { int pm, pn; };
struct Gemm { const bf16_t* A; const bf16_t* Bt; int M, N, K; };

struct StaticOrder {
    int nM, nN, nwg, G, c;
    __host__ __device__ void init(int M, int N, int G_, int c_) { nM = M / BM; nN = N / BM; nwg = nM * nN; G = G_; c = c_; }
    __host__ __device__ bool next(int i, Unit& u) const {
        const long L = (long)i * G + c; if (L >= nwg) return false;
        int wgid = (int)L; { const int q = nwg / NXCD, r = nwg % NXCD, xcd = wgid % NXCD, off = wgid / NXCD; wgid = (xcd < r ? xcd * (q + 1) : r * (q + 1) + (xcd - r) * q) + off; }
        const int nig = WGM * nN, gid = wgid / nig, fm = gid * WGM, gsz = (nM - fm) < WGM ? (nM - fm) : WGM;
        u.pm = fm + ((wgid % nig) % gsz); u.pn = (wgid % nig) / gsz; return true;
    }
    __device__ __forceinline__ void a_ready(const Unit&) const {}
    __device__ __forceinline__ void done(const Unit&) const {}
};

typedef float f32x2_c __attribute__((ext_vector_type(2))); typedef __bf16 bf16x2_c __attribute__((ext_vector_type(2)));
__device__ __forceinline__ unsigned cvt_pk_bf16(float lo, float hi) { f32x2_c v = {lo, hi}; bf16x2_c b = __builtin_convertvector(v, bf16x2_c); return __builtin_bit_cast(unsigned, b); }
typedef float f32x2 __attribute__((ext_vector_type(2)));
constexpr float NORM_EPS = 1e-6f;
__device__ __forceinline__ float ssq_sum(const float* ssq, int row) { const f32x4* p = (const f32x4*)(ssq + (size_t)row * 16); const f32x4 a = p[0], b = p[1], c = p[2], d = p[3];
    return ((a[0] + a[1]) + (a[2] + a[3])) + ((b[0] + b[1]) + (b[2] + b[3])) + (((c[0] + c[1]) + (c[2] + c[3])) + ((d[0] + d[1]) + (d[2] + d[3]))); }
__device__ __forceinline__ float rstd_of(const float* ssq, int row) { return rsqrtf(ssq_sum(ssq, row) * (1.0f / 1024.0f) + NORM_EPS); }
__device__ __forceinline__ float sigm(float x) { return __builtin_amdgcn_rcpf(1.0f + __expf(-x)); }
struct EpiGU { static constexpr bool PERM = true, AFTER_DRAIN = false;
    bf16_t* H; const float* ssq;
    __device__ __forceinline__ void operator()(const f32x4 (&acc)[2][2][4][2], const Unit& u, int wr, int wc, int fr, int fq) const {
        int row0 = u.pm * BM + wr * 64 + fr; asm volatile("" : "+v"(row0)); const int col0 = u.pn * 128 + wc * 32 + 8 * fq;
#pragma unroll
        for (int ai = 0; ai < 2; ++ai)
#pragma unroll
            for (int m = 0; m < 4; ++m) { const int row = row0 + ai * HALF + m * 16; const float rs = rstd_of(ssq, row);
                const f32x4 g0 = acc[ai][0][m][0] * rs, g1 = acc[ai][0][m][1] * rs, u0 = acc[ai][1][m][0] * rs, u1 = acc[ai][1][m][1] * rs;
                u32x4 w;
                w.x = cvt_pk_bf16(g0[0] * sigm(g0[0]) * u0[0], g0[1] * sigm(g0[1]) * u0[1]); w.y = cvt_pk_bf16(g0[2] * sigm(g0[2]) * u0[2], g0[3] * sigm(g0[3]) * u0[3]);
                w.z = cvt_pk_bf16(g1[0] * sigm(g1[0]) * u1[0], g1[1] * sigm(g1[1]) * u1[1]); w.w = cvt_pk_bf16(g1[2] * sigm(g1[2]) * u1[2], g1[3] * sigm(g1[3]) * u1[3]);
                *(u32x4*)(H + (size_t)row * 2816 + col0) = w; }
    }
};
struct EpiRes { static constexpr bool PERM = true, AFTER_DRAIN = false;
    const float* base; float* X; bf16_t* XB; float* ssq_out; float alpha;
    __device__ __forceinline__ void operator()(const f32x4 (&acc)[2][2][4][2], const Unit& u, int wr, int wc, int fr, int fq) const {
        int row0 = u.pm * BM + wr * 64 + fr; asm volatile("" : "+v"(row0)); const int col0 = u.pn * BM + wc * 32 + 8 * fq;
#pragma unroll
        for (int ai = 0; ai < 2; ++ai)
#pragma unroll
            for (int m = 0; m < 4; ++m) { const int row = row0 + ai * HALF + m * 16; float part = 0.f;
#pragma unroll
                for (int bj = 0; bj < 2; ++bj) { const size_t off = (size_t)row * 1024 + col0 + bj * HALF;
                    const f32x4 b0 = *(const f32x4*)(base + off), b1 = *(const f32x4*)(base + off + 4);
                    const f32x4 v0 = b0 + acc[ai][bj][m][0] * alpha, v1 = b1 + acc[ai][bj][m][1] * alpha;
                    *(f32x4*)(X + off) = v0; *(f32x4*)(X + off + 4) = v1;
                    u32x4 w; w.x = cvt_pk_bf16(v0[0], v0[1]); w.y = cvt_pk_bf16(v0[2], v0[3]); w.z = cvt_pk_bf16(v1[0], v1[1]); w.w = cvt_pk_bf16(v1[2], v1[3]);
                    *(u32x4*)(XB + off) = w;
                    part += (v0[0] * v0[0] + v0[1] * v0[1]) + (v0[2] * v0[2] + v0[3] * v0[3]) + (v1[0] * v1[0] + v1[1] * v1[1]) + (v1[2] * v1[2] + v1[3] * v1[3]); }
                part += __shfl_xor(part, 16); part += __shfl_xor(part, 32);
                if (fq == 0) ssq_out[(size_t)row * 16 + u.pn * 4 + wc] = part; }
    }
};
struct EpiPle { static constexpr bool PERM = true, AFTER_DRAIN = false;
    int mode; float* X; bf16_t* XB; bf16_t* PP; const float* ssq_in; float* ssq_out;
    __device__ __forceinline__ void operator()(const f32x4 (&acc)[2][2][4][2], const Unit& u, int wr, int wc, int fr, int fq) const {
        int row0 = u.pm * BM + wr * 64 + fr; asm volatile("" : "+v"(row0)); const int col0 = u.pn * BM + wc * 32 + 8 * fq;
#pragma unroll
        for (int ai = 0; ai < 2; ++ai)
#pragma unroll
            for (int m = 0; m < 4; ++m) { const int row = row0 + ai * HALF + m * 16; float part = 0.f; const float rs = mode ? rstd_of(ssq_in, row) : 1.f;
#pragma unroll
                for (int bj = 0; bj < 2; ++bj) { const size_t off = (size_t)row * 1024 + col0 + bj * HALF;
                    if (mode == 0) { const f32x4 v0 = acc[ai][bj][m][0], v1 = acc[ai][bj][m][1];
                        u32x4 w; w.x = cvt_pk_bf16(v0[0], v0[1]); w.y = cvt_pk_bf16(v0[2], v0[3]); w.z = cvt_pk_bf16(v1[0], v1[1]); w.w = cvt_pk_bf16(v1[2], v1[3]);
                        *(u32x4*)(PP + off) = w;
                    } else {
                        const u32x4 pw = *(const u32x4*)(PP + off);
                        const f32x4 p0 = {__uint_as_float(pw.x << 16), __uint_as_float(pw.x & 0xffff0000u), __uint_as_float(pw.y << 16), __uint_as_float(pw.y & 0xffff0000u)};
                        const f32x4 p1 = {__uint_as_float(pw.z << 16), __uint_as_float(pw.z & 0xffff0000u), __uint_as_float(pw.w << 16), __uint_as_float(pw.w & 0xffff0000u)};
                        const f32x4 b0 = *(const f32x4*)(X + off), b1 = *(const f32x4*)(X + off + 4);
                        const f32x4 a0 = acc[ai][bj][m][0] * rs, a1 = acc[ai][bj][m][1] * rs;
                        f32x4 v0, v1;
#pragma unroll
                        for (int j = 0; j < 4; ++j) { v0[j] = b0[j] + sigm(a0[j]) * p0[j]; v1[j] = b1[j] + sigm(a1[j]) * p1[j]; }
                        *(f32x4*)(X + off) = v0; *(f32x4*)(X + off + 4) = v1;
                        u32x4 w; w.x = cvt_pk_bf16(v0[0], v0[1]); w.y = cvt_pk_bf16(v0[2], v0[3]); w.z = cvt_pk_bf16(v1[0], v1[1]); w.w = cvt_pk_bf16(v1[2], v1[3]);
                        *(u32x4*)(XB + off) = w;
                        part += (v0[0] * v0[0] + v0[1] * v0[1]) + (v0[2] * v0[2] + v0[3] * v0[3]) + (v1[0] * v1[0] + v1[1] * v1[1]) + (v1[2] * v1[2] + v1[3] * v1[3]); } }
                if (mode) { part += __shfl_xor(part, 16); part += __shfl_xor(part, 32); if (fq == 0) ssq_out[(size_t)row * 16 + u.pn * 4 + wc] = part; } }
    }
};
struct EpiStore { static constexpr bool PERM = true, AFTER_DRAIN = false;
    bf16_t* O; int ldc; const float* ssq; float scale0; int scale_tiles; int split_tiles; size_t split_stride; int lf_tile; float* LF; const float* bfv;
    __device__ __forceinline__ void operator()(const f32x4 (&acc)[2][2][4][2], const Unit& u, int wr, int wc, int fr, int fq) const {
        int row0 = u.pm * BM + wr * 64 + fr; asm volatile("" : "+v"(row0));
        if (u.pn == lf_tile) {
            if (wc == 0 && fq < 2) {
#pragma unroll
                for (int ai = 0; ai < 2; ++ai)
#pragma unroll
                    for (int m = 0; m < 4; ++m) { const int row = row0 + ai * HALF + m * 16; const float rs = rstd_of(ssq, row);
#pragma unroll
                        for (int n = 0; n < 2; ++n) { f32x4 o;
#pragma unroll
                            for (int j = 0; j < 4; ++j) { const float z = fmaxf(acc[ai][0][m][n][j] * rs + bfv[8 * fq + 4 * n + j], -80.f), e = __expf(-z);
                                o[j] = (e < 0.01f) ? -(e - 0.5f * e * e + e * e * e * (1.f / 3.f)) : -__logf(1.f + e); }
                            *(f32x4*)(LF + (size_t)row * 16 + 8 * fq + 4 * n) = o; } }
            }
            return;
        }
        const int t = u.pn / split_tiles, ct = u.pn - t * split_tiles;
        bf16_t* base = O + (size_t)t * split_stride; const float sc = (u.pn < scale_tiles) ? scale0 : 1.f;
        const int col0 = ct * BM + wc * 32 + 8 * fq;
#pragma unroll
        for (int ai = 0; ai < 2; ++ai)
#pragma unroll
            for (int m = 0; m < 4; ++m) { const int row = row0 + ai * HALF + m * 16; const float rs = rstd_of(ssq, row) * sc;
#pragma unroll
                for (int bj = 0; bj < 2; ++bj) { const f32x4 v0 = acc[ai][bj][m][0] * rs, v1 = acc[ai][bj][m][1] * rs;
                    u32x4 w; w.x = cvt_pk_bf16(v0[0], v0[1]); w.y = cvt_pk_bf16(v0[2], v0[3]); w.z = cvt_pk_bf16(v1[0], v1[1]); w.w = cvt_pk_bf16(v1[2], v1[3]);
                    *(u32x4*)(base + (size_t)row * ldc + col0 + bj * HALF) = w; } }
    }
};

template <class Epi, class Sched, bool ALIGN_EPI = false, bool SP2 = false>
__device__ __forceinline__ void gemm_phase(PG8_LAS unsigned char* lds, const Gemm g, const Sched& S, const Epi& E, const int tid) {
    const int wid = __builtin_amdgcn_readfirstlane(tid >> 6), lane = tid & 63, wr = wid >> 2, wc = wid & 3, fr = lane & 15, fq = lane >> 4;
    const int K = g.K, nt = K / BK;
    unsigned voffA[2], voffB[2];
#pragma unroll
    for (int i = 0; i < 2; ++i) { int R, C; stage_rc(tid * 16 + i * 8192, R, C); const int Rb = Epi::PERM ? ((R & ~31) + perm32(R & 31)) : R;
        voffA[i] = (unsigned)(R * K + C) * 2u; voffB[i] = (unsigned)(Rb * K + C) * 2u; }
    const size_t kstep = (size_t)(BK * 2);
    const size_t hstep = (size_t)HALF * K * 2;
    const size_t tstep = 2 * hstep;
    const unsigned ldsw = (unsigned)wid * 1024u;
    const int aoff = lds_byte(wr * 64 + fr, fq * 8), boff = lds_byte(wc * 32 + fr, fq * 8);
#define PG8_SA(b, h) (((b) * 2 + (h)) * HTB)
#define PG8_SB(b, h) ((4 + (b) * 2 + (h)) * HTB)
#define PG8_STAGE(bufoff, gbase, voff) do { _Pragma("unroll") for (int _i = 0; _i < 2; ++_i) \
        __builtin_amdgcn_global_load_lds((const unsigned*)((const char*)(gbase) + (voff)[_i]), (PG8_LAS unsigned*)(lds + (bufoff) + ldsw + _i * 8192), 16, 0, 0); } while (0)
#define PG8_LDA(dst, b, h) do { _Pragma("unroll") for (int m = 0; m < 4; ++m) _Pragma("unroll") for (int k = 0; k < 2; ++k) dst[m][k] = *(const PG8_LAS bf16x8*)(lds + PG8_SA(b, h) + aoff + m * 2048 + k * 1024); } while (0)
#define PG8_LDB(dst, b, h) do { _Pragma("unroll") for (int n = 0; n < 2; ++n) _Pragma("unroll") for (int k = 0; k < 2; ++k) dst[n][k] = *(const PG8_LAS bf16x8*)(lds + PG8_SB(b, h) + boff + n * 2048 + k * 1024); } while (0)
#define PG8_MMA(ai, bj, At, Bt) do { __builtin_amdgcn_s_setprio(1); _Pragma("unroll") for (int m = 0; m < 4; ++m) _Pragma("unroll") for (int n = 0; n < 2; ++n) _Pragma("unroll") for (int k = 0; k < 2; ++k) \
        acc[ai][bj][m][n] = __builtin_amdgcn_mfma_f32_16x16x32_bf16(Bt[n][k], At[m][k], acc[ai][bj][m][n], 0, 0, 0); __builtin_amdgcn_s_setprio(0); } while (0)
#define PG8_WAIT_V(n) asm volatile("s_waitcnt vmcnt(" #n ")" ::: "memory")
#define PG8_WAIT_L(n) asm volatile("s_waitcnt lgkmcnt(" #n ")" ::: "memory")
#define PG8_BAR __builtin_amdgcn_s_barrier()
#define PG8_SCHED __builtin_amdgcn_sched_barrier(0)
    Unit cur, nxt; int ui = 0;
    if (!S.next(0, cur)) return;
    f32x4 acc[2][2][4][2];
#pragma unroll
    for (int a = 0; a < 2; ++a)
#pragma unroll
        for (int b = 0; b < 2; ++b)
#pragma unroll
            for (int m = 0; m < 4; ++m)
#pragma unroll
                for (int n = 0; n < 2; ++n) acc[a][b][m][n] = (f32x4){0.f, 0.f, 0.f, 0.f};
    bf16x8 At[4][2], B0[2][2], B1[2][2];
    const char* cA = (const char*)g.A + (size_t)cur.pm * tstep; const char* cB = (const char*)g.Bt + (size_t)cur.pn * tstep;
    S.a_ready(cur);
    if constexpr (SP2) {
        PG8_STAGE(PG8_SB(0, 0), cB, voffB); PG8_STAGE(PG8_SB(0, 1), cB + hstep, voffB); PG8_STAGE(PG8_SA(0, 0), cA, voffA); PG8_STAGE(PG8_SA(0, 1), cA + hstep, voffA);
        if (wr == 1) PG8_BAR;
        PG8_WAIT_V(2); PG8_BAR;
        PG8_STAGE(PG8_SB(1, 0), cB + kstep, voffB); PG8_STAGE(PG8_SA(1, 0), cA + kstep, voffA); PG8_STAGE(PG8_SB(1, 1), cB + hstep + kstep, voffB);
        PG8_WAIT_V(6); PG8_BAR;
    } else {
        PG8_STAGE(PG8_SB(0, 0), cB, voffB); PG8_STAGE(PG8_SA(0, 0), cA, voffA); PG8_STAGE(PG8_SB(0, 1), cB + hstep, voffB); PG8_STAGE(PG8_SA(0, 1), cA + hstep, voffA);
        if (wr == 1) PG8_BAR;
        PG8_WAIT_V(4); PG8_BAR;
        PG8_STAGE(PG8_SB(1, 0), cB + kstep, voffB); PG8_STAGE(PG8_SA(1, 0), cA + kstep, voffA); PG8_STAGE(PG8_SB(1, 1), cB + hstep + kstep, voffB);
        PG8_WAIT_V(6); PG8_BAR;
    }
    for (;;) {
        const bool has_next = S.next(ui + 1, nxt);
        const char* nA = has_next ? (const char*)g.A + (size_t)nxt.pm * tstep : cA; const char* nB = has_next ? (const char*)g.Bt + (size_t)nxt.pn * tstep : cB;
        for (int t = 0; t < nt; t += 2) {
            const bool last = (t == nt - 2);
            const char* a1 = cA + (size_t)(t + 1) * kstep;
            const char* a2 = last ? nA : cA + (size_t)(t + 2) * kstep; const char* b2 = last ? nB : cB + (size_t)(t + 2) * kstep;
            const char* a3 = a2 + kstep; const char* b3 = b2 + kstep;
            if (last && has_next) S.a_ready(nxt);
            if constexpr (SP2) {
            PG8_LDB(B0, 0, 0); PG8_LDB(B1, 0, 1); PG8_SCHED; PG8_LDA(At, 0, 0); PG8_STAGE(PG8_SA(1, 1), a1 + hstep, voffA);
            PG8_WAIT_V(8); PG8_WAIT_L(0); PG8_BAR; PG8_MMA(0, 0, At, B0); PG8_MMA(0, 1, At, B1); PG8_BAR; PG8_SCHED;
            PG8_LDA(At, 0, 1); PG8_STAGE(PG8_SB(0, 0), b2, voffB); PG8_STAGE(PG8_SB(0, 1), b2 + hstep, voffB); PG8_STAGE(PG8_SA(0, 0), a2, voffA);
            PG8_WAIT_V(8); PG8_WAIT_L(0); PG8_BAR; PG8_MMA(1, 0, At, B0); PG8_MMA(1, 1, At, B1); PG8_BAR; PG8_SCHED;
            PG8_LDB(B0, 1, 0); PG8_LDB(B1, 1, 1); PG8_SCHED; PG8_LDA(At, 1, 0); PG8_STAGE(PG8_SA(0, 1), a2 + hstep, voffA);
            PG8_WAIT_V(8); PG8_WAIT_L(0); PG8_BAR; PG8_MMA(0, 0, At, B0); PG8_MMA(0, 1, At, B1); PG8_BAR; PG8_SCHED;
            PG8_LDA(At, 1, 1); PG8_STAGE(PG8_SB(1, 0), b3, voffB); PG8_STAGE(PG8_SB(1, 1), b3 + hstep, voffB); PG8_STAGE(PG8_SA(1, 0), a3, voffA);
            PG8_WAIT_V(8); PG8_WAIT_L(0); PG8_BAR; PG8_MMA(1, 0, At, B0); PG8_MMA(1, 1, At, B1); PG8_BAR; PG8_SCHED;
            } else {
            PG8_LDB(B0, 0, 0); PG8_SCHED; PG8_LDA(At, 0, 0); PG8_STAGE(PG8_SA(1, 1), a1 + hstep, voffA);
            PG8_WAIT_L(8); PG8_BAR; PG8_WAIT_L(0); PG8_MMA(0, 0, At, B0); PG8_BAR; PG8_SCHED;
            PG8_LDB(B1, 0, 1); PG8_STAGE(PG8_SB(0, 0), b2, voffB);
            PG8_BAR; PG8_WAIT_L(0); PG8_MMA(0, 1, At, B1); PG8_BAR;
            PG8_LDA(At, 0, 1); PG8_STAGE(PG8_SA(0, 0), a2, voffA);
            PG8_BAR; PG8_WAIT_L(0); PG8_MMA(1, 0, At, B0); PG8_BAR; PG8_SCHED;
            PG8_STAGE(PG8_SB(0, 1), b2 + hstep, voffB);
            PG8_WAIT_V(6); PG8_BAR; PG8_MMA(1, 1, At, B1); PG8_BAR;
            PG8_LDB(B0, 1, 0); PG8_SCHED; PG8_LDA(At, 1, 0); PG8_STAGE(PG8_SA(0, 1), a2 + hstep, voffA);
            PG8_WAIT_L(8); PG8_BAR; PG8_WAIT_L(0); PG8_MMA(0, 0, At, B0); PG8_BAR; PG8_SCHED;
            PG8_LDB(B1, 1, 1); PG8_STAGE(PG8_SB(1, 0), b3, voffB);
            PG8_BAR; PG8_WAIT_L(0); PG8_MMA(0, 1, At, B1); PG8_BAR;
            PG8_LDA(At, 1, 1); PG8_STAGE(PG8_SA(1, 0), a3, voffA);
            PG8_BAR; PG8_WAIT_L(0); PG8_MMA(1, 0, At, B0); PG8_BAR; PG8_SCHED;
            PG8_STAGE(PG8_SB(1, 1), b3 + hstep, voffB);
            PG8_WAIT_V(6); PG8_BAR; PG8_MMA(1, 1, At, B1); PG8_BAR;
            }
        }
        if constexpr (ALIGN_EPI) { if (wr == 0) PG8_BAR; }
        if constexpr (!Epi::AFTER_DRAIN) { E(acc, cur, wr, wc, fr, fq); S.done(cur); }
        if (!has_next) break;
#pragma unroll
        for (int a = 0; a < 2; ++a)
#pragma unroll
            for (int b = 0; b < 2; ++b)
#pragma unroll
                for (int m = 0; m < 4; ++m)
#pragma unroll
                    for (int n = 0; n < 2; ++n) acc[a][b][m][n] = (f32x4){0.f, 0.f, 0.f, 0.f};
        cur = nxt; cA = nA; cB = nB; ++ui;
        if constexpr (ALIGN_EPI) { if (wr == 1) PG8_BAR; }
    }
    PG8_WAIT_V(0);
    if constexpr (!ALIGN_EPI) { if (wr == 0) PG8_BAR; }
    PG8_BAR;
    if constexpr (Epi::AFTER_DRAIN) { E.fused(acc, cur, wr, wc, fr, fq, lds, wid, lane); S.done(cur); }
#undef PG8_SA
#undef PG8_SB
#undef PG8_STAGE
#undef PG8_LDA
#undef PG8_LDB
#undef PG8_MMA
#undef PG8_WAIT_V
#undef PG8_WAIT_L
#undef PG8_BAR
#undef PG8_SCHED
}
}
#include <hip/hip_bf16.h>
#include <cmath>
namespace attn_body {
using bf16=__hip_bfloat16;
using bf16x8=__attribute__((ext_vector_type(8)))short;
using s16x4=__attribute__((ext_vector_type(4)))short;
using f32x16=__attribute__((ext_vector_type(16)))float;
using u32x4=__attribute__((ext_vector_type(4)))unsigned;
constexpr int BATCH=4,NHEAD=16,SEQ=4096,D=64,DM=NHEAD*D;
constexpr int NW=8,QBLK=32,QB=QBLK*NW,KVBLK=64,NQB=SEQ/QB;
constexpr int ATTN_PITCH=DM, ATTN_UNIT_ROWS=QB;
__device__ __forceinline__ int crow(int r,int hi){return (r&3)+8*(r>>2)+4*hi;}
#define SBAR() __builtin_amdgcn_sched_barrier(0)
__device__ __forceinline__ void cmask(f32x16&p0,f32x16&p1,int jb,int qrel,int hi){
  const float NEG=-INFINITY; int kb=64*jb+4*hi;
  #pragma unroll
  for(int r=0;r<16;++r){int kv=kb+(r&3)+8*(r>>2); if(kv>qrel)p0[r]=NEG; if(kv+32>qrel)p1[r]=NEG;}
}

constexpr int NSLOT=3, SLOTB=8192;
constexpr int LDS_K=0, LDS_V=NSLOT*SLOTB, LDS_WS=2*NSLOT*SLOTB, LDS_OST=LDS_WS+NW*64*4, LDS_BYTES=LDS_OST+NW*4096;
constexpr float C2=0.125f*1.4426950408889634f;
__device__ __forceinline__ void glds16(const void*gsrc,unsigned lds_dst){unsigned keep;
  asm volatile("s_mov_b32 %0, m0\n\ts_mov_b32 m0, %2\n\ts_nop 0\n\tglobal_load_lds_dwordx4 %1, off\n\ts_mov_b32 m0, %0":"=&s"(keep):"v"(gsrc),"s"(lds_dst):"memory");}
__device__ __forceinline__ float max3f(float a,float b,float c){float r;asm("v_max3_f32 %0, %1, %2, %3":"=v"(r):"v"(a),"v"(b),"v"(c));return r;}
__device__ __forceinline__ float max2f(float a,float b){float r;asm("v_max_f32_e32 %0, %1, %2":"=v"(r):"v"(a),"v"(b));return r;}
__device__ __forceinline__ float fadd_s(float a,float b){float r;asm("v_add_f32_e32 %0, %1, %2":"=v"(r):"v"(a),"v"(b));return r;}
__device__ __forceinline__ float fsub_s(float a,float b){float r;asm("v_sub_f32_e32 %0, %1, %2":"=v"(r):"v"(a),"v"(b));return r;}
typedef float f32x2_t __attribute__((ext_vector_type(2))); typedef __bf16 bf16x2_t __attribute__((ext_vector_type(2)));
__device__ __forceinline__ unsigned cvtpk_s(float lo,float hi){f32x2_t v={lo,hi};bf16x2_t b=__builtin_convertvector(v,bf16x2_t);return __builtin_bit_cast(unsigned,b);}
#define WAIT_BAR(N) asm volatile("s_waitcnt vmcnt(" #N ") lgkmcnt(0)\n\ts_barrier":::"memory")

__device__ __forceinline__ void qkt(f32x16&p0,f32x16&p1,const char*Kslot,const bf16x8*qr,int r32,int hi){
  const char*kb=Kslot+hi*1024+r32*16;
  #pragma unroll
  for(int d0=0;d0<4;++d0){
    const bf16x8 b0=*reinterpret_cast<const bf16x8*>(kb+d0*2048);
    const bf16x8 b1=*reinterpret_cast<const bf16x8*>(kb+d0*2048+512);
    {p0=__builtin_amdgcn_mfma_f32_32x32x16_bf16(b0,qr[d0],p0,0,0,0);p1=__builtin_amdgcn_mfma_f32_32x32x16_bf16(b1,qr[d0],p1,0,0,0);}}
}
typedef __attribute__((address_space(3))) const char* lds_cptr;
typedef short v4i16_t __attribute__((ext_vector_type(4)));
__device__ __forceinline__ void kload8(bf16x8*kf,lds_cptr kp){
  kf[0]=*(const __attribute__((address_space(3))) bf16x8*)(kp);      kf[1]=*(const __attribute__((address_space(3))) bf16x8*)(kp+512);
  kf[2]=*(const __attribute__((address_space(3))) bf16x8*)(kp+2048); kf[3]=*(const __attribute__((address_space(3))) bf16x8*)(kp+2560);
  kf[4]=*(const __attribute__((address_space(3))) bf16x8*)(kp+4096); kf[5]=*(const __attribute__((address_space(3))) bf16x8*)(kp+4608);
  kf[6]=*(const __attribute__((address_space(3))) bf16x8*)(kp+6144); kf[7]=*(const __attribute__((address_space(3))) bf16x8*)(kp+6656);
}
__device__ __forceinline__ void kload2(bf16x8*kf,lds_cptr kp,int j){ kf[2*j]=*(const __attribute__((address_space(3))) bf16x8*)(kp+j*2048); kf[2*j+1]=*(const __attribute__((address_space(3))) bf16x8*)(kp+j*2048+512); }
__device__ __forceinline__ s16x4 vtr(lds_cptr p){ return __builtin_bit_cast(s16x4,__builtin_amdgcn_ds_read_tr16_b64_v4i16((__attribute__((address_space(3))) v4i16_t*)p)); }
__device__ __forceinline__ float rowmax(const f32x16&p0,const f32x16&p1){
  float a=max3f(p0[0],p0[1],p1[0]),b=max3f(p0[2],p0[3],p1[1]);a=max3f(a,p1[2],p1[3]);
  #pragma unroll
  for(int r=4;r<16;r+=4){a=max3f(a,p0[r],p0[r+1]);b=max3f(b,p0[r+2],p0[r+3]);a=max3f(a,p1[r],p1[r+1]);b=max3f(b,p1[r+2],p1[r+3]);}
  const float m=max2f(a,b);
  auto rr=__builtin_amdgcn_permlane32_swap(__float_as_uint(m),__float_as_uint(m),false,false);
  return max2f(__uint_as_float(rr[0]),__uint_as_float(rr[1]));
}
__device__ __forceinline__ void pv(f32x16*o,int vb,bf16x8 pa0,bf16x8 pa1,bf16x8 pa2,bf16x8 pa3){
  #pragma unroll
  for(int d0=0;d0<2;++d0){s16x4 lo[4],hi[4];
    #pragma unroll
    for(int ks=0;ks<4;++ks){
      asm volatile("ds_read_b64_tr_b16 %0,%1 offset:%c2":"=&v"(lo[ks]):"v"(vb),"i"(d0*4096+ks*1024):"memory");
      asm volatile("ds_read_b64_tr_b16 %0,%1 offset:%c2":"=&v"(hi[ks]):"v"(vb),"i"(d0*4096+ks*1024+512):"memory");}
    asm volatile("s_waitcnt lgkmcnt(0)":::"memory");SBAR();
    #define PK(k) (bf16x8){lo[k][0],lo[k][1],lo[k][2],lo[k][3],hi[k][0],hi[k][1],hi[k][2],hi[k][3]}
    o[d0]=__builtin_amdgcn_mfma_f32_32x32x16_bf16(pa0,PK(0),o[d0],0,0,0);
    o[d0]=__builtin_amdgcn_mfma_f32_32x32x16_bf16(pa1,PK(1),o[d0],0,0,0);
    o[d0]=__builtin_amdgcn_mfma_f32_32x32x16_bf16(pa2,PK(2),o[d0],0,0,0);
    o[d0]=__builtin_amdgcn_mfma_f32_32x32x16_bf16(pa3,PK(3),o[d0],0,0,0);
    #undef PK
  }
}

#ifndef ATTN_STORE16
#define ATTN_STORE16(p,v) (*(u32x4*)(p)=(v))
#endif
typedef float f32x4b __attribute__((ext_vector_type(4)));
typedef __attribute__((address_space(3))) const float* lds_fptr;
typedef __attribute__((address_space(3))) const f32x4b* lds_f4ptr;
template<int THRL> __device__ __forceinline__ void attn_unit(int b,int h,int qb,const bf16*Q,const bf16*__restrict__ K,const bf16*__restrict__ V,bf16*O,char*shm,lds_fptr cs,const int tid){
  const int lane=tid&63,r32=lane&31,hi=lane>>5; const int wid=__builtin_amdgcn_readfirstlane(tid>>6);
  const long rowbase=(long)b*SEQ; const int q0=qb*QB;
  const bf16*Qw=Q+(rowbase+q0+wid*QBLK)*DM+h*D;
  const bf16*Kh=K+rowbase*DM+h*D,*Vh=V+rowbase*DM+h*D;
  const unsigned lds0=(unsigned)(uintptr_t)shm;
  float*wsf=(float*)(shm+LDS_WS)+wid*64;
  const bf16*ksrc=Kh+(long)lane*DM+wid*8;
  const bf16*vsrc=Vh+(long)(16*(wid&3)+(lane>>2))*DM+(wid>>2)*32+(lane&3)*8;
  const unsigned kdst=lds0+LDS_K+wid*1024, vdst=lds0+LDS_V+wid*1024;
  #define DMA_K(t,slot) glds16(ksrc+(long)(t)*KVBLK*DM,(unsigned)__builtin_amdgcn_readfirstlane(kdst+(slot)))
  #define DMA_V(t,slot) glds16(vsrc+(long)(t)*KVBLK*DM,(unsigned)__builtin_amdgcn_readfirstlane(vdst+(slot)))
  const int vb0=(int)(lds0+LDS_V)+((lane>>4)&1)*32+(lane&3)*8+(4*hi+((lane&15)>>2))*64;
  const char*Kbase=shm+LDS_K; bf16x8 kf[8];
  const lds_cptr shm3=(lds_cptr)shm; const lds_cptr kp0=shm3+LDS_K+hi*1024+r32*16; const lds_cptr vp0=shm3+LDS_V+((lane>>4)&1)*32+(lane&3)*8+(4*hi+((lane&15)>>2))*64;
  const int NT=(q0+QB)/KVBLK;
  DMA_K(0,0);DMA_V(0,0);DMA_K(1,SLOTB);
  bf16x8 qr[4];
  #pragma unroll
  for(int d0=0;d0<4;++d0)qr[d0]=*reinterpret_cast<const bf16x8*>(&Qw[(long)r32*DM+d0*16+hi*8]);
  const int qrel=wid*QBLK+r32;
  typedef __attribute__((address_space(3))) const unsigned long long* lds_u64p; typedef unsigned u32x2b __attribute__((ext_vector_type(2)));
  const lds_u64p ctr=(lds_u64p)cs;
  float ci2; { const unsigned long long w_=ctr[q0+qrel]; ci2=__uint_as_float((unsigned)w_<<16)+__uint_as_float((unsigned)w_&0xffff0000u)+__uint_as_float((unsigned)(w_>>32)<<16); }
  float mhat=0.f,l_reg=0.f;f32x16 o[2];o[0]=f32x16{};o[1]=f32x16{};float nm=ci2; bf16x8 bnm;
  #define MKBNM() do{ const unsigned h1_=cvtpk_s(nm,0.f)&0xffffu; const float r1_=nm-__uint_as_float(h1_<<16); const unsigned h2_=cvtpk_s(r1_,0.f)&0xffffu; const float r2_=r1_-__uint_as_float(h2_<<16); const unsigned h3_=cvtpk_s(r2_,0.f)&0xffffu; \
    u32x4 b_; b_.x=hi?0u:0xBF80BF80u; b_.y=hi?0u:(0xBF80u|(h1_<<16)); b_.z=hi?0u:(h2_|(h3_<<16)); b_.w=0u; bnm=__builtin_bit_cast(bf16x8,b_); }while(0)
  MKBNM();
  #define CINIT(P0,P1,t) do{ const unsigned long long w0_=ctr[64*(t)+r32], w1_=ctr[64*(t)+32+r32]; \
    u32x4 a0_; a0_.x=(unsigned)w0_; a0_.y=(unsigned)(w0_>>32)|0x3F800000u; a0_.z=0x3F803F80u; a0_.w=0u; u32x4 a1_; a1_.x=(unsigned)w1_; a1_.y=(unsigned)(w1_>>32)|0x3F800000u; a1_.z=0x3F803F80u; a1_.w=0u; \
    P0=__builtin_amdgcn_mfma_f32_32x32x16_bf16(__builtin_bit_cast(bf16x8,a0_),bnm,f32x16{},0,0,0); P1=__builtin_amdgcn_mfma_f32_32x32x16_bf16(__builtin_bit_cast(bf16x8,a1_),bnm,f32x16{},0,0,0); }while(0)
  #define CMASK(P0,P1,t) do{int jb_=(t)-(NT-4); if(jb_>=0)cmask(P0,P1,jb_,qrel,hi);}while(0)
  bool resc=false;
  #define START(P0,P1) do{ const float rm=rowmax(P0,P1); resc=false; \
    { const float dl=rm; mhat=fadd_s(mhat,dl); \
      _Pragma("unroll") for(int r=0;r<16;++r){P0[r]=fsub_s(P0[r],dl);P1[r]=fsub_s(P1[r],dl);} \
      nm=ci2-mhat; MKBNM(); } \
    _Pragma("unroll") for(int r=0;r<16;++r)P0[r]=__builtin_amdgcn_exp2f(P0[r]); }while(0)
  #define RESC() do{ if(resc){ asm volatile("s_waitcnt lgkmcnt(0)":::"memory"); \
      _Pragma("unroll") for(int d_=0;d_<2;++d_) _Pragma("unroll") for(int r=0;r<16;++r)o[d_][r]*=wsf[crow(r,hi)]; } }while(0)
  f32x16 pA0,pA1,pB0,pB1;
  int sl_prev=0,sl_cur=0,sl_next=SLOTB;
  #define ROT() do{sl_prev=sl_cur;sl_cur=sl_next;sl_next=(sl_next==(NSLOT-1)*SLOTB)?0:sl_next+SLOTB;}while(0)
  DMA_K(2,2*SLOTB);
  WAIT_BAR(3);
  CINIT(pA0,pA1,0);qkt(pA0,pA1,Kbase,qr,r32,hi);asm volatile("s_nop 15\n\ts_nop 7":"+v"(pA0),"+v"(pA1));CMASK(pA0,pA1,0);
  START(pA0,pA1);
  _Pragma("unroll") for(int r=0;r<16;++r)pA1[r]=__builtin_amdgcn_exp2f(pA1[r]);
  WAIT_BAR(0);
  DMA_K(3,0);DMA_V(1,SLOTB);
  ROT();
  kload8(kf,kp0+sl_cur);
  WAIT_BAR(2);
  s16x4 vlo[8],vhi[8]; u32x4 pw0,pw1,pw2,pw3;
  #define PKW(P,B) cvtpk_s(P[B],P[B+1])
  #define PAF(k) __builtin_bit_cast(bf16x8,pw##k)
  #define VFR(i) (bf16x8){vlo[i][0],vlo[i][1],vlo[i][2],vlo[i][3],vhi[i][0],vhi[i][1],vhi[i][2],vhi[i][3]}
  #define PIN(x) asm volatile("":"+v"(x))
  #define MX3(a,b,c) __builtin_fmaxf(__builtin_fmaxf((a),(b)),(c))
  #define GAPA(MF,A0,A1,A2,A3,W0,W1,PW) do{ MF; sacc+=A0; sacc+=A1; sacc+=A2; sacc+=A3; PIN(sacc); W0; W1; PIN(PW); SBAR(); }while(0)
  #define EX(v) __builtin_amdgcn_exp2f(v)
  #define GAPB(MF,X,B) do{ MF; X[B]=EX(X[B]); X[B+1]=EX(X[B+1]); X[B+2]=EX(X[B+2]); X[B+3]=EX(X[B+3]); PIN(X); SBAR(); }while(0)
  #define VRD(i) do{ vlo[i]=vtr(vp_+(((i)>>2)*4096+((i)&3)*1024)); vhi[i]=vtr(vp_+(((i)>>2)*4096+((i)&3)*1024+512)); }while(0)
  #define KRD(G,j) do{ if(G){ kload2(kf,kp0+sl_next,j); SBAR(); } }while(0)
  #define STEP(C0,C1,P0,P1,t,GK,GV,GL) do{ SBAR(); \
    const lds_cptr vp_=vp0+sl_prev; CINIT(C0,C1,t); SBAR(); \
    VRD(0); SBAR(); float sacc=(P0[0]+P0[1]); \
    GAPA(C0=__builtin_amdgcn_mfma_f32_32x32x16_bf16(kf[0],qr[0],C0,0,0,0), P0[2],P0[3],P0[4],P0[5],     pw0[0]=PKW(P0,0), pw0[1]=PKW(P0,2), pw0); \
    VRD(4); SBAR(); GAPA(C1=__builtin_amdgcn_mfma_f32_32x32x16_bf16(kf[1],qr[0],C1,0,0,0), P0[6],P0[7],P0[8],P0[9],     pw0[2]=PKW(P0,4), pw0[3]=PKW(P0,6), pw0); \
    VRD(1); SBAR(); GAPA(C0=__builtin_amdgcn_mfma_f32_32x32x16_bf16(kf[2],qr[1],C0,0,0,0),   P0[10],P0[11],P0[12],P0[13], pw1[0]=PKW(P0,8), pw1[1]=PKW(P0,10), pw1); \
    VRD(5); SBAR(); GAPA(C1=__builtin_amdgcn_mfma_f32_32x32x16_bf16(kf[3],qr[1],C1,0,0,0),   P0[14],P0[15],P1[0],P1[1],   pw1[2]=PKW(P0,12),pw1[3]=PKW(P0,14), pw1); \
    VRD(2); SBAR(); GAPA(C0=__builtin_amdgcn_mfma_f32_32x32x16_bf16(kf[4],qr[2],C0,0,0,0),   P1[2],P1[3],P1[4],P1[5],     pw2[0]=PKW(P1,0), pw2[1]=PKW(P1,2), pw2); \
    VRD(6); SBAR(); GAPA(C1=__builtin_amdgcn_mfma_f32_32x32x16_bf16(kf[5],qr[2],C1,0,0,0),   P1[6],P1[7],P1[8],P1[9],     pw2[2]=PKW(P1,4), pw2[3]=PKW(P1,6), pw2); \
    VRD(3); SBAR(); GAPA(C0=__builtin_amdgcn_mfma_f32_32x32x16_bf16(kf[6],qr[3],C0,0,0,0),   P1[10],P1[11],P1[12],P1[13], pw3[0]=PKW(P1,8), pw3[1]=PKW(P1,10), pw3); \
    VRD(7); SBAR(); GAPA(C1=__builtin_amdgcn_mfma_f32_32x32x16_bf16(kf[7],qr[3],C1,0,0,0),   P1[14],P1[15],0.f,0.f,       pw3[2]=PKW(P1,12),pw3[3]=PKW(P1,14), pw3); \
    l_reg+=sacc; \
    if(GK){DMA_K((t)+3,sl_cur);} if(GV){DMA_V((t)+1,sl_next);} \
    CMASK(C0,C1,t); \
    { float a=MX3(C0[0],C0[1],C1[0]),b=MX3(C0[2],C0[3],C1[1]); a=MX3(a,C1[2],C1[3]); \
      _Pragma("unroll") for(int r=4;r<16;r+=4){a=MX3(a,C0[r],C0[r+1]);b=MX3(b,C0[r+2],C0[r+3]);a=MX3(a,C1[r],C1[r+1]);b=MX3(b,C1[r+2],C1[r+3]);} \
      float rm=__builtin_fmaxf(a,b); { auto rr=__builtin_amdgcn_permlane32_swap(__float_as_uint(rm),__float_as_uint(rm),false,false); rm=__builtin_fmaxf(__uint_as_float(rr[0]),__uint_as_float(rr[1])); } \
      resc=false; \
      if(__builtin_expect(__any(rm>(float)THRL),0)){ const float dl=__builtin_fmaxf(rm,0.f); mhat+=dl; \
        _Pragma("unroll") for(int r=0;r<16;++r){C0[r]-=dl;C1[r]-=dl;} \
        nm=ci2-mhat; MKBNM(); \
        const float f=__builtin_amdgcn_exp2f(-dl); l_reg*=f; if(hi==0)wsf[r32]=f; resc=true; } } \
    SBAR(); \
    GAPB(o[0]=__builtin_amdgcn_mfma_f32_32x32x16_bf16(PAF(0),VFR(0),o[0],0,0,0), C0,0); \
    GAPB(o[1]=__builtin_amdgcn_mfma_f32_32x32x16_bf16(PAF(0),VFR(4),o[1],0,0,0), C0,4); \
    KRD(GL,0); GAPB(o[0]=__builtin_amdgcn_mfma_f32_32x32x16_bf16(PAF(1),VFR(1),o[0],0,0,0), C0,8); \
    KRD(GL,1); GAPB(o[1]=__builtin_amdgcn_mfma_f32_32x32x16_bf16(PAF(1),VFR(5),o[1],0,0,0), C0,12); \
    KRD(GL,2); GAPB(o[0]=__builtin_amdgcn_mfma_f32_32x32x16_bf16(PAF(2),VFR(2),o[0],0,0,0), C1,0); \
    KRD(GL,3); GAPB(o[1]=__builtin_amdgcn_mfma_f32_32x32x16_bf16(PAF(2),VFR(6),o[1],0,0,0), C1,4); \
    GAPB(o[0]=__builtin_amdgcn_mfma_f32_32x32x16_bf16(PAF(3),VFR(3),o[0],0,0,0), C1,8); \
    GAPB(o[1]=__builtin_amdgcn_mfma_f32_32x32x16_bf16(PAF(3),VFR(7),o[1],0,0,0), C1,12); \
    }while(0)
  int t=1;
  #undef CMASK
  #define CMASK(P0,P1,t) do{}while(0)
  for(;t+5<NT;t+=2){
    STEP(pB0,pB1,pA0,pA1,t,true,true,true);     WAIT_BAR(2); RESC(); ROT();
    STEP(pA0,pA1,pB0,pB1,t+1,true,true,true);   WAIT_BAR(2); RESC(); ROT();
  }
  #undef CMASK
  #define CMASK(P0,P1,t) do{int jb_=(t)-(NT-4); if(jb_>=0)cmask(P0,P1,jb_,qrel,hi);}while(0)
  #define ENDW(tt) do{ if((tt)+3<NT){WAIT_BAR(2);} else if((tt)+2<NT){WAIT_BAR(1);} else {WAIT_BAR(0);} }while(0)
  for(;t+1<NT;t+=2){
    STEP(pB0,pB1,pA0,pA1,t,(t+3<NT),(t+1<NT),(t+1<NT));       ENDW(t);   RESC(); ROT();
    STEP(pA0,pA1,pB0,pB1,t+1,(t+4<NT),(t+2<NT),(t+2<NT));     ENDW(t+1); RESC(); ROT();
  }
  STEP(pB0,pB1,pA0,pA1,NT-1,false,false,false); RESC();
  { float sacc=pB0[0]+pB0[1]; _Pragma("unroll") for(int r=2;r<16;++r)sacc+=pB0[r]; _Pragma("unroll") for(int r=0;r<16;++r)sacc+=pB1[r]; l_reg+=sacc;
    pw0=(u32x4){PKW(pB0,0),PKW(pB0,2),PKW(pB0,4),PKW(pB0,6)};pw1=(u32x4){PKW(pB0,8),PKW(pB0,10),PKW(pB0,12),PKW(pB0,14)};pw2=(u32x4){PKW(pB1,0),PKW(pB1,2),PKW(pB1,4),PKW(pB1,6)};pw3=(u32x4){PKW(pB1,8),PKW(pB1,10),PKW(pB1,12),PKW(pB1,14)};
    SBAR(); pv(o,vb0+sl_cur,PAF(0),PAF(1),PAF(2),PAF(3)); }
  #undef PKW
  #undef PAF
  #undef VFR
  #undef PIN
  #undef MX3
  #undef GAPA
  #undef GAPB
  #undef EX
  #undef VRD
  #undef KRD
  #undef STEP
  #undef ENDW
  {auto rr=__builtin_amdgcn_permlane32_swap(__float_as_uint(l_reg),__float_as_uint(l_reg),false,false);l_reg=__uint_as_float(rr[0])+__uint_as_float(rr[1]);}
  if(hi==0)wsf[32+r32]=l_reg;asm volatile("s_waitcnt lgkmcnt(0)":::"memory");
  float rli[16];
  #pragma unroll
  for(int r=0;r<16;++r)rli[r]=__builtin_amdgcn_rcpf(wsf[32+crow(r,hi)]);
  bf16*Ow=O+(rowbase+q0+wid*QBLK)*DM+h*D;
  { bf16*stg=(bf16*)(shm+LDS_OST)+wid*2048;
    #pragma unroll
    for(int r=0;r<16;++r){const int orow=crow(r,hi);
      #pragma unroll
      for(int d0=0;d0<2;++d0)stg[orow*64+d0*32+r32]=__float2bfloat16(o[d0][r]*rli[r]);}
    asm volatile("s_waitcnt lgkmcnt(0)":::"memory");
    #pragma unroll
    for(int i=0;i<4;++i){const int row=i*8+(lane>>3),ch=lane&7; const u32x4 v=*(const u32x4*)(stg+row*64+ch*8); ATTN_STORE16(Ow+(long)row*DM+ch*8,v);} }
  asm volatile("s_waitcnt lgkmcnt(0)\n\ts_barrier":::"memory");
  #undef DMA_K
  #undef DMA_V
  #undef CINIT
  #undef MKBNM
  #undef CMASK
  #undef START
  #undef RESC
  #undef ROT
}
constexpr int ATTN_LDS_BYTES=LDS_BYTES;
struct AttnTensors { const bf16* Q; const bf16* K; const bf16* V; bf16* O; };
struct AttnUnit { int bh; int qb; };
struct StaticOrder {
  int vcu;
  __device__ __forceinline__ explicit StaticOrder(int grid,int block):vcu((block%8)*(grid/8)+block/8){}
  __device__ __forceinline__ bool next(int i,AttnUnit&u)const{ if(i>=4)return false; const int s=vcu&3; u.bh=vcu>>2; u.qb=(i==0)?s:(i==1)?7-s:(i==2)?8+s:15-s; return true; }
  __device__ __forceinline__ void a_ready(const AttnUnit&)const{}
  __device__ __forceinline__ void done(const AttnUnit&)const{}
};
#undef SBAR
#undef WAIT_BAR
}
#define LAS __attribute__((address_space(3)))
typedef unsigned short bf16;
typedef unsigned v4u __attribute__((ext_vector_type(4)));
typedef unsigned v2u __attribute__((ext_vector_type(2)));
typedef float f32x4 __attribute__((ext_vector_type(4)));
typedef float f32x16 __attribute__((ext_vector_type(16)));
typedef short bf16x8 __attribute__((ext_vector_type(8)));
typedef float f32x2s __attribute__((ext_vector_type(2)));

constexpr int NBATCH = 4, SEQ = 4096, M = NBATCH * SEQ, D = 1024, DFF = 2816, PLE = 256;
constexpr int EVEN_IN = 2560, FOX_IN = 3088, FOX_INP = 3328;
constexpr float LOG2E = 1.4426950408889634f;
constexpr float QSCALE = 0.125f * LOG2E;
constexpr float GN_EPS = 64e-5f;
constexpr size_t MiB = 1u << 20;
constexpr size_t WS_SSQ = 0;
constexpr size_t WS_C3 = 1 * MiB;
constexpr size_t WS_LF = 2 * MiB;
constexpr size_t WS_G2F = 3 * MiB;
constexpr size_t WS_WGU = 4 * MiB;
constexpr size_t WS_WD = 48 * MiB;
constexpr size_t WS_WG = 70 * MiB;
constexpr size_t WS_WP = 74 * MiB;
constexpr size_t WS_WIN0 = 75 * MiB, WS_WOUT0 = 80 * MiB, WS_WIN1 = 82 * MiB, WS_WOUT1 = 89 * MiB;
constexpr size_t WS_XB = 91 * MiB;
constexpr size_t WS_Y = 123 * MiB;
constexpr size_t WS_BIG = 155 * MiB;
constexpr size_t WS_PB = 243 * MiB;
constexpr size_t WS_SSQP = 251 * MiB;
constexpr size_t WS_END = 253 * MiB;
constexpr size_t WS_BAR = 0;
constexpr int LDS_BYTES = 147456, MISC_OFF = 147456 - 64;

#define LDS_WAIT() asm volatile("s_waitcnt lgkmcnt(0)" ::: "memory")
__device__ __forceinline__ unsigned pk2(float lo, float hi) { return pg8::cvt_pk_bf16(lo, hi); }
__device__ __forceinline__ float bflo(unsigned w) { return __uint_as_float(w << 16); }
__device__ __forceinline__ float bfhi(unsigned w) { return __uint_as_float(w & 0xffff0000u); }
__device__ __forceinline__ float bf2f(bf16 h) { return __uint_as_float((unsigned)h << 16); }
__device__ __forceinline__ float wave_sum(float v) {
#pragma unroll
    for (int o = 1; o < 64; o <<= 1) v += __shfl_xor(v, o);
    return v;
}
__device__ __forceinline__ int crow(int r, int hi) { return (r & 3) + 8 * (r >> 2) + 4 * hi; }
template <int CTRL> __device__ __forceinline__ float dpp_f(float x) { return __int_as_float(__builtin_amdgcn_update_dpp(0, __float_as_int(x), CTRL, 0xf, 0xf, true)); }
__device__ __forceinline__ float red16(float x) { x += dpp_f<0xB1>(x); x += dpp_f<0x4E>(x); x += dpp_f<0x141>(x); x += dpp_f<0x140>(x); return x; }
__device__ __forceinline__ float red8(float x) { x += dpp_f<0xB1>(x); x += dpp_f<0x4E>(x); x += dpp_f<0x141>(x); return x; }
__device__ __forceinline__ void unpack8(const v4u w, float (&f)[8]) { f[0] = bflo(w.x); f[1] = bfhi(w.x); f[2] = bflo(w.y); f[3] = bfhi(w.y); f[4] = bflo(w.z); f[5] = bfhi(w.z); f[6] = bflo(w.w); f[7] = bfhi(w.w); }
__device__ __forceinline__ bf16x8 pack8(const float (&f)[8]) { v4u w; w.x = pk2(f[0], f[1]); w.y = pk2(f[2], f[3]); w.z = pk2(f[4], f[5]); w.w = pk2(f[6], f[7]); return __builtin_bit_cast(bf16x8, w); }

__device__ __forceinline__ void conv_item(const float* W, int K, int N, int NP, bf16* WT, const float* gain, int mode, LAS float* scr, int item, int lane) {
    const int nblk = NP / 32, kb = item / nblk, nb = item - kb * nblk, k0 = 64 * kb, n0 = 32 * nb;
    int orow0 = n0;
    if (mode == 1) orow0 = (n0 < DFF) ? (n0 / 128) * 256 + (n0 % 128) : ((n0 - DFF) / 128) * 256 + 128 + ((n0 - DFF) % 128);
    const int nq = 4 * (lane & 7); const bool inb = (n0 + nq) < N;
#pragma unroll
    for (int i = 0; i < 8; ++i) { const int kk = 8 * i + (lane >> 3); f32x4 v = {0.f, 0.f, 0.f, 0.f}; if (inb) v = *(const f32x4*)(W + (size_t)(k0 + kk) * N + n0 + nq);
        if (gain) v = v * gain[k0 + kk];
        LAS float* d = scr + kk * 33 + nq; d[0] = v[0]; d[1] = v[1]; d[2] = v[2]; d[3] = v[3]; }
    LDS_WAIT(); asm volatile("" ::: "memory");
    const int c = lane & 7;
#pragma unroll
    for (int j = 0; j < 4; ++j) { const int nn = (lane >> 3) + 8 * j; const LAS float* s = scr + (8 * c) * 33 + nn;
        v4u o; o.x = pk2(s[0 * 33], s[1 * 33]); o.y = pk2(s[2 * 33], s[3 * 33]); o.z = pk2(s[4 * 33], s[5 * 33]); o.w = pk2(s[6 * 33], s[7 * 33]);
        *(v4u*)(WT + (size_t)(orow0 + nn) * K + k0 + 8 * c) = o; }
    LDS_WAIT(); asm volatile("" ::: "memory");
}

constexpr int VTP = 264;
__device__ __forceinline__ void swa_unit(int unit, const bf16* PROJ, bf16* Y, const float* sinks, LAS unsigned char* lds, int tid, int lane, int wid) {
    const int b = unit >> 6, kvh = (unit >> 5) & 1, qblk = unit & 31, q0 = qblk * 128; const size_t rb = (size_t)b * SEQ;
    asm volatile("" : "+s"(PROJ), "+s"(Y));
    LAS bf16* VT = (LAS bf16*)lds;
    for (int c = tid; c < 2048; c += 512) { const int kvl = c >> 3, ch = c & 7, tok = q0 - 128 + kvl; v4u v = {0u, 0u, 0u, 0u};
        if (tok >= 0) v = *(const v4u*)(PROJ + (rb + tok) * EVEN_IN + 640 + kvh * 64 + ch * 8);
        LAS bf16* d = VT + (ch * 8) * VTP + kvl;
        d[0 * VTP] = (bf16)(v.x & 0xffffu); d[1 * VTP] = (bf16)(v.x >> 16); d[2 * VTP] = (bf16)(v.y & 0xffffu); d[3 * VTP] = (bf16)(v.y >> 16);
        d[4 * VTP] = (bf16)(v.z & 0xffffu); d[5 * VTP] = (bf16)(v.z >> 16); d[6 * VTP] = (bf16)(v.w & 0xffffu); d[7 * VTP] = (bf16)(v.w >> 16); }
    __syncthreads();
    const int g = wid >> 1, qh = wid & 1, hq = kvh * 4 + g;
    const float slope2 = exp2f(-(float)(hq + 1)) * LOG2E, sink2 = sinks[hq] * LOG2E;
#pragma unroll 1
    for (int sb = 0; sb < 2; ++sb) {
        int r32 = lane & 31, hi = lane >> 5; asm volatile("" : "+v"(r32), "+v"(hi));
        const int qs = q0 + 64 * qh + 32 * sb;
        bf16x8 qf[4];
#pragma unroll
        for (int ks = 0; ks < 4; ++ks) qf[ks] = *(const bf16x8*)(PROJ + (rb + qs + r32) * EVEN_IN + hq * 64 + 16 * ks + 8 * hi);
        f32x16 sc[5];
#pragma unroll
        for (int kt = 0; kt < 5; ++kt) { int tk = qs - 128 + 32 * kt + r32; tk = tk < 0 ? 0 : tk; sc[kt] = f32x16{};
#pragma unroll
            for (int ks = 0; ks < 4; ++ks) { const bf16x8 kf = *(const bf16x8*)(PROJ + (rb + tk) * EVEN_IN + 512 + kvh * 64 + 16 * ks + 8 * hi);
                sc[kt] = __builtin_amdgcn_mfma_f32_32x32x16_bf16(kf, qf[ks], sc[kt], 0, 0, 0); } }
        const int db = r32 + 128 - 4 * hi, kmin = 128 - qs - 4 * hi; const float ab = -slope2 * (float)db;
        float mx = sink2;
#pragma unroll
        for (int kt = 0; kt < 5; ++kt)
#pragma unroll
            for (int r = 0; r < 16; ++r) { const int kc = 32 * kt + (r & 3) + 8 * (r >> 2), dist = db - kc; const bool ok = ((unsigned)dist < 128u) && (kmin <= kc);
                const float s = ok ? fmaf(slope2, (float)kc, sc[kt][r] + ab) : -INFINITY; sc[kt][r] = s; mx = fmaxf(mx, s); }
        mx = fmaxf(mx, __shfl_xor(mx, 32));
        float l = 0.f;
#pragma unroll
        for (int kt = 0; kt < 5; ++kt)
#pragma unroll
            for (int r = 0; r < 16; ++r) { const float p = exp2f(sc[kt][r] - mx); sc[kt][r] = p; l += p; }
        l += __shfl_xor(l, 32); l += exp2f(sink2 - mx);
        const float rl = 1.0f / l;
        f32x16 o[2]; o[0] = f32x16{}; o[1] = f32x16{};
        const int kvl0 = 64 * qh + 32 * sb;
#pragma unroll
        for (int kt = 0; kt < 5; ++kt)
#pragma unroll
            for (int s2 = 0; s2 < 2; ++s2) { v4u pw; pw.x = pk2(sc[kt][8 * s2 + 0], sc[kt][8 * s2 + 1]); pw.y = pk2(sc[kt][8 * s2 + 2], sc[kt][8 * s2 + 3]); pw.z = pk2(sc[kt][8 * s2 + 4], sc[kt][8 * s2 + 5]); pw.w = pk2(sc[kt][8 * s2 + 6], sc[kt][8 * s2 + 7]);
                const bf16x8 pa = __builtin_bit_cast(bf16x8, pw);
#pragma unroll
                for (int db = 0; db < 2; ++db) { const LAS bf16* vp = VT + (32 * db + r32) * VTP + kvl0 + 32 * kt + 16 * s2 + 4 * hi;
                    const v2u lo = *(const LAS v2u*)vp, hh = *(const LAS v2u*)(vp + 8); v4u vw; vw.x = lo.x; vw.y = lo.y; vw.z = hh.x; vw.w = hh.y;
                    o[db] = __builtin_amdgcn_mfma_f32_32x32x16_bf16(pa, __builtin_bit_cast(bf16x8, vw), o[db], 0, 0, 0); } }
#pragma unroll
        for (int r = 0; r < 16; ++r) { const int qq = crow(r, hi); const float sc1 = __shfl(rl, qq);
            bf16* yp = Y + (rb + qs + qq) * 1024 + hq * 64 + r32;
            yp[0] = (bf16)(pk2(o[0][r] * sc1, 0.f) & 0xffffu); yp[32] = (bf16)(pk2(o[1][r] * sc1, 0.f) & 0xffffu); }
    }
    __syncthreads();
}
typedef unsigned v4u_unused_;
#define XB_TMO      128
#define XB_XCNT(j)  (256  + 64 * (j))
#define XB_XSUB(j)  (1280 + 64 * (j))
#define XB_XGEN(j)  (2304 + 64 * (j))
#define XB_TOP      3328
#define XB_TOPGEN   3392
#define XCD_BAR_WORDS 3456
#define XB_SPIN_CAP (1u << 18)

__device__ __forceinline__ unsigned xb_ld(unsigned* p)              { return __hip_atomic_load(p, __ATOMIC_RELAXED, __HIP_MEMORY_SCOPE_AGENT); }
__device__ __forceinline__ unsigned xb_add(unsigned* p, unsigned v) { return __hip_atomic_fetch_add(p, v, __ATOMIC_RELAXED, __HIP_MEMORY_SCOPE_AGENT); }
__device__ __forceinline__ unsigned xb_xcc_id() { return (unsigned)__builtin_amdgcn_s_getreg((3 << 11) | 20) & 0xFu; }
#define XB_SPIN(cond, bar) do { unsigned _sp = 0; while (cond) { __builtin_amdgcn_s_sleep(1); \
    if ((++_sp & 255u) == 0u) { if (xb_ld(&(bar)[XB_TMO])) break; if (_sp > XB_SPIN_CAP) { atomicAdd(&(bar)[XB_TMO], 1u); break; } } } } while (0)

struct XcdBarrier {
    unsigned* bar; unsigned x;
    volatile LAS unsigned* st;
};

__device__ __forceinline__ XcdBarrier xcd_barrier_post(unsigned* bar, volatile LAS unsigned* st) {
    XcdBarrier b; b.bar = bar; b.x = xb_xcc_id(); b.st = st;
    if (threadIdx.x == 0) (void)xb_add(&bar[XB_XCNT(b.x)], 1u);
    return b;
}
__device__ __forceinline__ void xcd_barrier_complete(unsigned* bar, unsigned x, unsigned& nloc, unsigned& nx) {
    const unsigned G = gridDim.x * gridDim.y * gridDim.z;
    unsigned sum, cnt, mine, sp = 0u;
    for (;;) {
        sum = 0u; cnt = 0u; mine = 0u;
#pragma unroll
        for (unsigned j = 0; j < 16; ++j) { const unsigned c = xb_ld(&bar[XB_XCNT(j)]); sum += c; cnt += (c > 0u) ? 1u : 0u; mine = (j == x) ? c : mine; }
        if (sum == G) break;
        __builtin_amdgcn_s_sleep(1);
        if ((++sp & 255u) == 0u) { if (xb_ld(&bar[XB_TMO])) break; if (sp > XB_SPIN_CAP) { atomicAdd(&bar[XB_TMO], 1u); break; } }
    }
    nloc = mine > 0u ? mine : 1u; nx = cnt > 0u ? cnt : 1u;
}

__device__ __forceinline__ void xcd_barrier(const XcdBarrier& b) {
    asm volatile("s_waitcnt vmcnt(0)" ::: "memory");
    __syncthreads();
    if (threadIdx.x == 0) {
        unsigned* bar = b.bar;
        __builtin_amdgcn_s_waitcnt(0);
        unsigned nloc = b.st[0], nx = b.st[1];
        if (nloc == 0u) { xcd_barrier_complete(bar, b.x, nloc, nx); b.st[0] = nloc; b.st[1] = nx; }
        const unsigned old = xb_add(&bar[XB_XSUB(b.x)], 1u);
        const unsigned gen = old / nloc;
        if (old + 1u == (gen + 1u) * nloc) {
            __builtin_amdgcn_fence(__ATOMIC_RELEASE, "agent");
            asm volatile("s_waitcnt vmcnt(0)" ::: "memory");
            const unsigned og = xb_add(&bar[XB_TOP], 1u);
            const unsigned tg = og / nx;
            if (og + 1u == (tg + 1u) * nx) xb_add(&bar[XB_TOPGEN], 1u);
            else XB_SPIN(xb_ld(&bar[XB_TOPGEN]) == tg, bar);
            __builtin_amdgcn_fence(__ATOMIC_ACQUIRE, "agent");
            xb_add(&bar[XB_XGEN(b.x)], 1u);
            asm volatile("s_waitcnt vmcnt(0)" ::: "memory");
        } else {
            XB_SPIN(xb_ld(&bar[XB_XGEN(b.x)]) == gen, bar);
            __builtin_amdgcn_fence(__ATOMIC_ACQUIRE, "agent");
            asm volatile("s_waitcnt vmcnt(0)" ::: "memory");
        }
    }
    __syncthreads();
}
constexpr int TC = 32, SBS = 340, LBS = 68;
constexpr int SBS_UNUSED_ = 336;
constexpr int RW_SBUF = 0, RW_SBUF_BYTES = TC * SBS * 4, RW_LW = 2 * RW_SBUF_BYTES, RW_LA = RW_LW + 2 * TC * LBS * 4, RW_EC = RW_LA + 2 * TC * LBS * 4, RW_BF = RW_EC + 2560;
__device__ __forceinline__ void rwkv_scan_unit(int unit, const bf16* PROJ, float* YRAW, float* C3, const float* mu, const float* w0, const float* w2, const float* a0, const float* a2,
                                               const float* k_k, const float* k_a, const float* r_k, LAS unsigned char* lds, const int lane, int wid) {
    const int role = (wid < 2) ? 0 : ((wid == 2 || wid == 3) ? 2 : 1), lw = wid - 2, ew = wid - 4;
    const int b = unit >> 6, h = (unit >> 3) & 7, rg = unit & 7; const size_t rb = (size_t)b * SEQ;
    const int r32 = lane & 31, hi = lane >> 5;
    constexpr int NCH = SEQ / TC;
    if (role == 2) {
        const int colx = 768 + ((lw == 0) ? 1536 : 1600); const float* Wl = (lw == 0) ? w2 : a2;
#pragma unroll
        for (int nb = 0; nb < 2; ++nb)
#pragma unroll
            for (int ks = 0; ks < 4; ++ks) { float f[8];
#pragma unroll
                for (int i = 0; i < 8; ++i) f[i] = Wl[(size_t)(16 * ks + 8 * hi + i) * 512 + h * 64 + 32 * nb + r32];
                *(LAS bf16x8*)(lds + RW_BF + (((lw * 2 + nb) * 4 + ks) * 64 + lane) * 16) = pack8(f); }
        ((LAS float*)(lds + RW_EC))[512 + lw * 64 + lane] = mu[colx - 768 + lane];
        v4u lcw[4], lpw[4];
#define LORA_LOAD(itn) do { const int tl_ = (itn) * TC + r32; const bf16* p_ = PROJ + (rb + tl_) * EVEN_IN + colx + 8 * hi; _Pragma("unroll") for (int ks = 0; ks < 4; ++ks) { lcw[ks] = *(const v4u*)(p_ + 16 * ks); \
            lpw[ks] = (v4u){0u, 0u, 0u, 0u}; if (tl_ > 0) lpw[ks] = *(const v4u*)(p_ - EVEN_IN + 16 * ks); } } while (0)
        LORA_LOAD(0);
#pragma unroll 1
        for (int it = 0; it < NCH + 2; ++it) {
            if (it < NCH) { bf16x8 afr[4];
#pragma unroll
                for (int ks = 0; ks < 4; ++ks) { float c[8], p[8]; unpack8(lcw[ks], c); unpack8(lpw[ks], p);
                    const LAS float* mq = (const LAS float*)(lds + RW_EC) + 512 + lw * 64 + 16 * ks + 8 * hi; const f32x4 m0 = *(const LAS f32x4*)mq, m1 = *(const LAS f32x4*)(mq + 4);
#pragma unroll
                    for (int i = 0; i < 8; ++i) { float x = c[i] + (p[i] - c[i]) * (i < 4 ? m0[i] : m1[i - 4]); if (lw == 0) x = 1.f - 2.f * __builtin_amdgcn_rcpf(1.f + __expf(2.f * x)); c[i] = x; }
                    afr[ks] = pack8(c); }
                if (it + 1 < NCH) LORA_LOAD(it + 1);
                LAS float* LB = (LAS float*)(lds + ((lw == 0) ? RW_LW : RW_LA)) + (it & 1) * (TC * LBS);
#pragma unroll
                for (int nb = 0; nb < 2; ++nb) { f32x16 acc = f32x16{};
#pragma unroll
                    for (int ks = 0; ks < 4; ++ks) acc = __builtin_amdgcn_mfma_f32_32x32x16_bf16(afr[ks], *(const LAS bf16x8*)(lds + RW_BF + (((lw * 2 + nb) * 4 + ks) * 64 + lane) * 16), acc, 0, 0, 0);
#pragma unroll
                    for (int r = 0; r < 16; ++r) LB[crow(r, hi) * LBS + 32 * nb + r32] = acc[r]; } }
            asm volatile("s_waitcnt lgkmcnt(0)\n\ts_barrier" ::: "memory");
        }
#undef LORA_LOAD
    } else if (role == 1) {
        const int el = ew * 64 + lane, s = el >> 3, g = el & 7;
        float ecc[8][8];
        { const int chn = h * 64 + 8 * g;
#pragma unroll
          for (int i = 0; i < 8; ++i) { ecc[0][i] = mu[chn + i]; ecc[1][i] = mu[512 + chn + i]; ecc[2][i] = mu[1024 + chn + i]; ecc[3][i] = w0[chn + i]; ecc[4][i] = a0[chn + i]; ecc[5][i] = k_k[chn + i]; ecc[6][i] = k_a[chn + i]; ecc[7][i] = r_k[chn + i]; } }
        v4u ecr, eck, ecv, epr, epk, epv;
#define ELEM_LOAD(cn) do { const int tl_ = (cn) * TC + s; const bf16* p_ = PROJ + (rb + tl_) * EVEN_IN + 768 + h * 64 + 8 * g; \
            ecr = *(const v4u*)p_; eck = *(const v4u*)(p_ + 512); ecv = *(const v4u*)(p_ + 1024); epr = (v4u){0u, 0u, 0u, 0u}; epk = epr; epv = epr; \
            if (tl_ > 0) { epr = *(const v4u*)(p_ - EVEN_IN); epk = *(const v4u*)(p_ - EVEN_IN + 512); epv = *(const v4u*)(p_ - EVEN_IN + 1024); } } while (0)
        ELEM_LOAD(0);
#pragma unroll 1
        for (int it = 0; it < NCH + 2; ++it) {
            const int c = it - 1;
            if (c >= 0 && c < NCH) { const size_t row = rb + c * TC + s;
                const LAS float* LW = (const LAS float*)(lds + RW_LW) + (c & 1) * (TC * LBS) + s * LBS + 8 * g; const LAS float* LA = (const LAS float*)(lds + RW_LA) + (c & 1) * (TC * LBS) + s * LBS + 8 * g;
                LAS float* sp = (LAS float*)(lds + RW_SBUF + (c & 1) * RW_SBUF_BYTES) + s * SBS;
                float ec[8];
#define LDEC(arr) do { _Pragma("unroll") for (int i_ = 0; i_ < 8; ++i_) ec[i_] = ecc[arr][i_]; } while (0)
                float r[8], k[8], v[8], t[8];
                unpack8(ecr, r); unpack8(epr, t); LDEC(0);
#pragma unroll
                for (int i = 0; i < 8; ++i) r[i] += (t[i] - r[i]) * ec[i];
                unpack8(eck, k); unpack8(epk, t); LDEC(1);
#pragma unroll
                for (int i = 0; i < 8; ++i) k[i] += (t[i] - k[i]) * ec[i];
                unpack8(ecv, v); unpack8(epv, t); LDEC(2);
#pragma unroll
                for (int i = 0; i < 8; ++i) v[i] += (t[i] - v[i]) * ec[i];
                if (c + 1 < NCH) ELEM_LOAD(c + 1);
                const f32x4 dw0 = *(const LAS f32x4*)LW, dw1 = *(const LAS f32x4*)(LW + 4), da0 = *(const LAS f32x4*)LA, da1 = *(const LAS f32x4*)(LA + 4);
                float w[8], a[8], kk[8], kp[8]; float n2 = 0.f;
#pragma unroll
                for (int i = 0; i < 8; ++i) w[i] = i < 4 ? dw0[i] : dw1[i - 4];
                LDEC(3);
#pragma unroll
                for (int i = 0; i < 8; ++i) w[i] = __expf(-0.60653065971f * pg8::sigm(ec[i] + w[i]));
                LDEC(4);
#pragma unroll
                for (int i = 0; i < 8; ++i) a[i] = pg8::sigm(ec[i] + (i < 4 ? da0[i] : da1[i - 4]));
                LDEC(5);
#pragma unroll
                for (int i = 0; i < 8; ++i) { kk[i] = k[i] * ec[i]; n2 += kk[i] * kk[i]; }
                LDEC(6);
#pragma unroll
                for (int i = 0; i < 8; ++i) kp[i] = k[i] * (1.f + (a[i] - 1.f) * ec[i]);
                LDEC(7);
                n2 = red8(n2); const float inv = __builtin_amdgcn_rsqf(fmaxf(n2, 1e-24f));
                float c1 = 0.f, c2 = 0.f, c3 = 0.f;
#pragma unroll
                for (int i = 0; i < 8; ++i) { kk[i] *= inv; t[i] = kk[i] * a[i]; c1 += t[i] * r[i]; c2 += kp[i] * r[i]; c3 += r[i] * kp[i] * ec[i]; }
#undef LDEC
                c1 = red8(c1); c2 = red8(c2); c3 = red8(c3);
                *(LAS f32x4*)(sp + 8 * g) = (f32x4){kk[0], kk[1], kk[2], kk[3]}; *(LAS f32x4*)(sp + 8 * g + 4) = (f32x4){kk[4], kk[5], kk[6], kk[7]};
                *(LAS f32x4*)(sp + 64 + 8 * g) = (f32x4){w[0] * r[0], w[1] * r[1], w[2] * r[2], w[3] * r[3]}; *(LAS f32x4*)(sp + 64 + 8 * g + 4) = (f32x4){w[4] * r[4], w[5] * r[5], w[6] * r[6], w[7] * r[7]};
                *(LAS f32x4*)(sp + 128 + 8 * g) = (f32x4){w[0], w[1], w[2], w[3]}; *(LAS f32x4*)(sp + 128 + 8 * g + 4) = (f32x4){w[4], w[5], w[6], w[7]};
                *(LAS f32x4*)(sp + 192 + 8 * g) = (f32x4){t[0], t[1], t[2], t[3]}; *(LAS f32x4*)(sp + 192 + 8 * g + 4) = (f32x4){t[4], t[5], t[6], t[7]};
                *(LAS f32x4*)(sp + 256 + 8 * g) = (f32x4){kp[0], kp[1], kp[2], kp[3]}; *(LAS f32x4*)(sp + 256 + 8 * g + 4) = (f32x4){kp[4], kp[5], kp[6], kp[7]};
                if (g == rg) { *(LAS f32x4*)(sp + 320) = (f32x4){v[0], v[1], v[2], v[3]}; *(LAS f32x4*)(sp + 324) = (f32x4){v[4], v[5], v[6], v[7]}; }
                if (g == 0) { sp[328] = c1; sp[329] = c2; if (rg == 0) C3[row * 8 + h] = c3; } }
            asm volatile("s_waitcnt lgkmcnt(0)\n\ts_barrier" ::: "memory");
        }
#undef ELEM_LOAD
    } else {
        const int rowl = 4 * (wid & 1) + (lane >> 4), cgp = lane & 15;
        f32x2s S01 = {0.f, 0.f}, S23 = {0.f, 0.f};
#pragma unroll 1
        for (int it = 0; it < NCH + 2; ++it) {
            const int c = it - 2;
            if (c >= 0) { const LAS float* SBF = (const LAS float*)(lds + RW_SBUF + (c & 1) * RW_SBUF_BYTES);
                float* yp = YRAW + (rb + (size_t)c * TC) * 512 + h * 64 + 8 * rg + rowl;
                __builtin_amdgcn_s_setprio(3);
                f32x4 kkA, wrA, wA, kaA, kpA, kkB, wrB, wB, kaB, kpB; float viA, viB; float pkeep = 0.f, qkeep = 0.f;
#define LDREC(X, s_) do { const LAS float* sp_ = SBF + (s_) * SBS; kk##X = *(const LAS f32x4*)(sp_ + 4 * cgp); wr##X = *(const LAS f32x4*)(sp_ + 64 + 4 * cgp); w##X = *(const LAS f32x4*)(sp_ + 128 + 4 * cgp); \
                    ka##X = *(const LAS f32x4*)(sp_ + 192 + 4 * cgp); kp##X = *(const LAS f32x4*)(sp_ + 256 + 4 * cgp); vi##X = sp_[320 + rowl]; } while (0)
#define LO2(v) __builtin_shufflevector(v, v, 0, 1)
#define HI2(v) __builtin_shufflevector(v, v, 2, 3)
#define STEPREC(X, s_) do { f32x2s pp = S01 * LO2(kk##X); pp = S23 * HI2(kk##X) + pp; f32x2s qq = S01 * LO2(wr##X); qq = S23 * HI2(wr##X) + qq; float p = pp[0] + pp[1], q = qq[0] + qq[1]; \
                    const f32x2s vv_ = {vi##X, vi##X}; const f32x2s u01_ = S01 * LO2(w##X) + LO2(kp##X) * vv_, u23_ = S23 * HI2(w##X) + HI2(kp##X) * vv_;     \
                    p += dpp_f<0xB1>(p); q += dpp_f<0xB1>(q); p += dpp_f<0x4E>(p); q += dpp_f<0x4E>(q); p += dpp_f<0x141>(p); q += dpp_f<0x141>(q); p += dpp_f<0x140>(p); q += dpp_f<0x140>(q); \
                    const f32x2s pv_ = {p, p}; \
                    S01 = u01_ - LO2(ka##X) * pv_; S23 = u23_ - HI2(ka##X) * pv_; \
                    pkeep = (((s_) & 15) == cgp) ? p : pkeep; qkeep = (((s_) & 15) == cgp) ? q : qkeep;     \
                    if (((s_) & 15) == 15) { const LAS float* sy_ = SBF + ((s_) - 15 + cgp) * SBS; const f32x2s cy_ = *(const LAS f32x2s*)(sy_ + 328); \
                        yp[(size_t)((s_) - 15 + cgp) * 512] = qkeep - pkeep * cy_[0] + sy_[320 + rowl] * cy_[1]; } } while (0)
                LDREC(A, 0);
#pragma unroll
                for (int s = 0; s < TC; s += 2) {
 LDREC(B, s + 1); STEPREC(A, s); LDREC(A, s + 2); STEPREC(B, s + 1); }
#undef LDREC
#undef STEPREC
#undef LO2
#undef HI2
                __builtin_amdgcn_s_setprio(0); }
            asm volatile("s_waitcnt lgkmcnt(0)\n\ts_barrier" ::: "memory");
        }
    }
    __syncthreads();
}

__device__ __forceinline__ void rwkv_post_unit(int tile, const bf16* PROJ, const float* YRAW, const float* C3, bf16* Y, const float* mu, const bf16* g2f, const float* ln_w, const float* ln_b, int lane, int wid) {
    asm volatile("" : "+s"(PROJ), "+s"(mu), "+s"(g2f), "+s"(YRAW));
    const int h = wid, r32 = lane & 31, hi = lane >> 5; const int tok0 = tile * 32; const bool first = (tok0 & (SEQ - 1)) == 0;
    bf16x8 afr[8];
    { const int tk = tok0 + r32; const bool hp = !(first && r32 == 0); v4u cwv[8], pwv[8];
      const __attribute__((address_space(1))) bf16* pg = (const __attribute__((address_space(1))) bf16*)(PROJ + (size_t)tk * EVEN_IN + 768 + 1664 + 8 * hi);
#pragma unroll
        for (int ks = 0; ks < 8; ++ks) { cwv[ks] = *(const __attribute__((address_space(1))) v4u*)(pg + 16 * ks); pwv[ks] = (v4u){0u, 0u, 0u, 0u};
            if (hp) pwv[ks] = *(const __attribute__((address_space(1))) v4u*)(pg - EVEN_IN + 16 * ks); }
#pragma unroll
        for (int ks = 0; ks < 8; ++ks) { float c[8], p[8]; unpack8(cwv[ks], c); unpack8(pwv[ks], p);
            const f32x4 m0 = *(const f32x4*)(mu + 1664 + 16 * ks + 8 * hi), m1 = *(const f32x4*)(mu + 1664 + 16 * ks + 8 * hi + 4);
#pragma unroll
            for (int i = 0; i < 8; ++i) c[i] = pg8::sigm(c[i] + (p[i] - c[i]) * (i < 4 ? m0[i] : m1[i - 4]));
            afr[ks] = pack8(c); } }
    f32x16 gt[2];
#pragma unroll
    for (int nb = 0; nb < 2; ++nb) { gt[nb] = f32x16{};
#pragma unroll
        for (int ks = 0; ks < 8; ++ks) { const bf16x8 bf = *(const bf16x8*)(g2f + ((size_t)((h * 2 + nb) * 8 + ks) * 64 + lane) * 8);
            gt[nb] = __builtin_amdgcn_mfma_f32_32x32x16_bf16(afr[ks], bf, gt[nb], 0, 0, 0); } }
    typedef const __attribute__((address_space(1))) float* gfp; typedef const __attribute__((address_space(1))) unsigned short* gup;
    const int ch0 = h * 64 + r32; const float lw0 = ln_w[ch0], lw1 = ln_w[ch0 + 32], lb0 = ln_b[ch0], lb1 = ln_b[ch0 + 32], mv0 = mu[1024 + ch0], mv1 = mu[1024 + ch0 + 32];
    float y0[16], y1[16], c3v[16]; unsigned vc[16], vp[16];
#pragma unroll
    for (int r = 0; r < 16; ++r) { const int tk = tok0 + crow(r, hi); gfp yp = (gfp)(YRAW + (size_t)tk * 512 + ch0); y0[r] = yp[0]; y1[r] = yp[32]; c3v[r] = ((gfp)C3)[(size_t)tk * 8 + h];
        gup vq = (gup)(PROJ + (size_t)tk * EVEN_IN + 768 + 1024 + ch0); vc[r] = (unsigned)vq[0] | ((unsigned)vq[32] << 16); vp[r] = 0u;
        if ((tk & (SEQ - 1)) != 0) vp[r] = (unsigned)vq[-EVEN_IN] | ((unsigned)vq[32 - EVEN_IN] << 16); }
#pragma unroll
    for (int r = 0; r < 16; ++r) { const int tk = tok0 + crow(r, hi);
        float s = y0[r] + y1[r]; s = red16(s); s += __shfl_xor(s, 16);
        const float mean = s * (1.f / 64.f), d0 = y0[r] - mean, d1 = y1[r] - mean; float q = d0 * d0 + d1 * d1; q = red16(q); q += __shfl_xor(q, 16);
        const float rstd = rsqrtf(q * (1.f / 64.f) + GN_EPS);
        const float cv0 = bflo(vc[r]), cv1 = bfhi(vc[r]), pv0 = bflo(vp[r]), pv1 = bfhi(vp[r]);
        const float v0 = cv0 + (pv0 - cv0) * mv0, v1 = cv1 + (pv1 - cv1) * mv1;
        const float o0 = (d0 * rstd * lw0 + lb0 + c3v[r] * v0) * gt[0][r], o1 = (d1 * rstd * lw1 + lb1 + c3v[r] * v1) * gt[1][r];
        bf16* op = Y + (size_t)tk * 1024 + 512 + ch0; op[0] = (bf16)(pk2(o0, 0.f) & 0xffffu); op[32] = (bf16)(pk2(o1, 0.f) & 0xffffu); }
}

__device__ __forceinline__ void fox_gate_pass(const bf16* XB, const bf16* Wf, const float* ssqv, const float* bfv, float* LF, int gw, int NGW, int lane) {
    typedef float f32x4g __attribute__((ext_vector_type(4)));
    const int fr = lane & 15, fq = lane >> 4;
    for (int t = gw; t < M / 16; t += NGW) {
        const bf16* ap = XB + (size_t)(t * 16 + fr) * D + 8 * fq; const bf16* bp = Wf + (size_t)fr * D + 8 * fq;
        f32x4g acc = {0.f, 0.f, 0.f, 0.f};
#pragma unroll 8
        for (int ks = 0; ks < D / 32; ++ks) acc = __builtin_amdgcn_mfma_f32_16x16x32_bf16(*(const bf16x8*)(ap + 32 * ks), *(const bf16x8*)(bp + 32 * ks), acc, 0, 0, 0);
        const float bn = bfv[fr];
#pragma unroll
        for (int j = 0; j < 4; ++j) { const int row = t * 16 + 4 * fq + j; const float z = fmaxf(acc[j] * pg8::rstd_of(ssqv, row) + bn, -80.f), e = __expf(-z);
            LF[(size_t)row * 16 + fr] = (e < 0.01f) ? -(e - 0.5f * e * e + e * e * e * (1.f / 3.f)) : -__logf(1.f + e); }
    }
}

__device__ __forceinline__ void fox_prefix(const float* LFbh, LAS float* cs, LAS float* wtot, int tid, int lane, int wid) {
    const float* lp = LFbh + (size_t)tid * 128;
    float s[8]; s[0] = lp[0]; s[1] = s[0] + lp[16]; s[2] = s[1] + lp[32]; s[3] = s[2] + lp[48]; s[4] = s[3] + lp[64]; s[5] = s[4] + lp[80]; s[6] = s[5] + lp[96]; s[7] = s[6] + lp[112];
    float incl = s[7];
#pragma unroll
    for (int o = 1; o < 64; o <<= 1) { const float t = __shfl_up(incl, o); if (lane >= o) incl += t; }
    if (lane == 63) wtot[wid] = incl;
    __syncthreads();
    float base = incl - s[7];
    for (int w = 0; w < wid; ++w) base += wtot[w];
#pragma unroll
    for (int i = 0; i < 8; ++i) { const float v = (base + s[i]) * LOG2E;
        const unsigned h1 = pk2(v, 0.f) & 0xffffu; const float r1 = v - __uint_as_float(h1 << 16); const unsigned h2 = pk2(r1, 0.f) & 0xffffu; const float r2 = r1 - __uint_as_float(h2 << 16); const unsigned h3 = pk2(r2, 0.f) & 0xffffu;
        ((LAS v2u*)cs)[8 * tid + i] = (v2u){h1 | (h2 << 16), h3}; }
    __syncthreads();
}
struct Args { const float* in[30]; float* out; unsigned char* ws; int ph_lo, ph_hi; };
#define AS4 __attribute__((address_space(4)))
#ifndef DUP_SWA
#define DUP_SWA 0
#endif
#ifndef DUP_SCAN
#define DUP_SCAN 0
#endif
#ifndef DUP_POST
#define DUP_POST 0
#endif
#ifndef DUP_GU
#define DUP_GU 0
#endif
#ifndef DUP_INPROJ
#define DUP_INPROJ 0
#endif
#ifndef DUP_P0
#define DUP_P0 0
#endif
#ifndef DUP_SYNC
#define DUP_SYNC 0
#endif
#define INP(i) (*(const float* const AS4*)(kp + 8 * (i)))
#define GSYNC() xcd_barrier(xbar)
#define FRESH() const AS4 char* kp = kp0; asm volatile("" : "+s"(kp)); unsigned char* ws = *(unsigned char* const AS4*)(kp + 248); float* X = *(float* const AS4*)(kp + 240); \
    int tid = threadIdx.x; asm volatile("" : "+v"(tid)); const int lane = tid & 63, wid = __builtin_amdgcn_readfirstlane(tid >> 6); \
    const int gw = bx * 8 + wid, NGW = G * 8; \
    float* ssq = (float*)(ws + WS_SSQP); float* C3 = (float*)(ws + WS_C3); float* LF = (float*)(ws + WS_LF); \
    bf16* XB = (bf16*)(ws + WS_XB); float* YRAW = (float*)(ws + WS_XB); bf16* Y = (bf16*)(ws + WS_Y); \
    bf16* H = (bf16*)(ws + WS_BIG); bf16* PROJ = (bf16*)(ws + WS_BIG); bf16* PP = (bf16*)(ws + WS_BIG); bf16* PB = (bf16*)(ws + WS_PB); \
    bf16* Qb = (bf16*)(ws + WS_BIG); bf16* Kb = Qb + (size_t)M * D; bf16* Vb = Kb + (size_t)M * D; \
    (void)X; (void)lane; (void)wid; (void)gw; (void)NGW; (void)ssq; (void)C3; (void)LF; (void)XB; (void)YRAW; (void)Y; (void)H; (void)PROJ; (void)PP; (void)PB; (void)Qb; (void)Kb; (void)Vb
__global__ void __launch_bounds__(512, 2) fwd_megakernel(Args a_unused) {
    extern __shared__ __attribute__((aligned(16))) unsigned char lds_raw[];
    cg::grid_group grid = cg::this_grid();
    LAS unsigned char* lds = (LAS unsigned char*)lds_raw;
    const int G = gridDim.x, bx = blockIdx.x;
    const AS4 char* kp0 = (const AS4 char*)__builtin_amdgcn_kernarg_segment_ptr();
    const int ph_lo = *(const int AS4*)(kp0 + 256), ph_hi = *(const int AS4*)(kp0 + 260);
    XcdBarrier xbar;
    { unsigned* barw = (unsigned*)(*(unsigned char* const AS4*)(kp0 + 248) + WS_BAR);
      if (bx == 0) for (int i = threadIdx.x; i < XCD_BAR_WORDS; i += 512) barw[i] = 0u;
      if (threadIdx.x < 4) ((LAS unsigned*)(lds + MISC_OFF))[threadIdx.x] = 0u;
      asm volatile("s_waitcnt vmcnt(0)" ::: "memory"); __syncthreads();
      grid.sync();
      __builtin_amdgcn_fence(__ATOMIC_ACQUIRE, "agent"); asm volatile("s_waitcnt vmcnt(0)" ::: "memory");
      xbar = xcd_barrier_post(barw, (volatile LAS unsigned*)(lds + MISC_OFF)); }

#ifdef NANFILL
    { FRESH(); v4u q = {0xffffffffu, 0xffffffffu, 0xffffffffu, 0xffffffffu};
      for (size_t i = (size_t)bx * 512 + tid; i < WS_END / 16; i += (size_t)G * 512) ((v4u*)ws)[i] = q;
      for (size_t i = (size_t)bx * 512 + tid; i < (size_t)M * D / 4; i += (size_t)G * 512) ((v4u*)X)[i] = q;
      for (int i = tid; i < LDS_BYTES / 4; i += 512) ((LAS unsigned*)lds)[i] = 0xffffffffu; }
    GSYNC();
#endif
    for (int dup = 0; dup < 1 + DUP_P0; ++dup)
    if (ph_lo == 0) {
        FRESH();
        LAS float* scr = (LAS float*)(lds + wid * 16384);
        constexpr int I_GU = (D / 64) * (2 * DFF / 32), I_D = (DFF / 64) * (D / 32), I_G = (D / 64) * (D / 32), I_P = (PLE / 64) * (D / 32), I_IN0 = (D / 64) * (EVEN_IN / 32), I_IN1 = (D / 64) * (FOX_INP / 32);
        constexpr int NITEMS = 4 * I_GU + 4 * I_D + 2 * I_G + 2 * I_P + I_IN0 + I_IN1 + 2 * I_G;
        for (int it = gw; it < NITEMS; it += NGW) {
            int r = it;
#define MAT(cnt, W_, K_, N_, NP_, WT_, G_, MODE_) if (r < (cnt)) { conv_item((W_), (K_), (N_), (NP_), (bf16*)(WT_), (G_), (MODE_), scr, r, lane); continue; } r -= (cnt);
            MAT(I_GU, INP(3), D, 2 * DFF, 2 * DFF, ws + WS_WGU, INP(2), 1)
            MAT(I_GU, INP(7), D, 2 * DFF, 2 * DFF, ws + WS_WGU + 11 * MiB, INP(6), 1)
            MAT(I_GU, INP(3) + (size_t)D * 2 * DFF, D, 2 * DFF, 2 * DFF, ws + WS_WGU + 22 * MiB, INP(2) + D, 1)
            MAT(I_GU, INP(7) + (size_t)D * 2 * DFF, D, 2 * DFF, 2 * DFF, ws + WS_WGU + 33 * MiB, INP(6) + D, 1)
            MAT(I_D, INP(4), DFF, D, D, ws + WS_WD, nullptr, 0)
            MAT(I_D, INP(8), DFF, D, D, ws + WS_WD + (size_t)D * DFF * 2, nullptr, 0)
            MAT(I_D, INP(4) + (size_t)D * DFF, DFF, D, D, ws + WS_WD + (size_t)D * DFF * 4, nullptr, 0)
            MAT(I_D, INP(8) + (size_t)D * DFF, DFF, D, D, ws + WS_WD + (size_t)D * DFF * 6, nullptr, 0)
            MAT(I_G, INP(10), D, D, D, ws + WS_WG, INP(9), 0)
            MAT(I_G, INP(10) + (size_t)D * D, D, D, D, ws + WS_WG + 2 * MiB, INP(9) + D, 0)
            MAT(I_P, INP(11), PLE, D, D, ws + WS_WP, nullptr, 0)
            MAT(I_P, INP(11) + (size_t)PLE * D, PLE, D, D, ws + WS_WP + (size_t)PLE * D * 2, nullptr, 0)
            MAT(I_IN0, INP(12), D, EVEN_IN, EVEN_IN, ws + WS_WIN0, INP(5), 0)
            MAT(I_IN1, INP(26), D, FOX_IN, FOX_INP, ws + WS_WIN1, INP(5) + D, 0)
            MAT(I_G, INP(13), D, D, D, ws + WS_WOUT0, nullptr, 0)
            MAT(I_G, INP(28), D, D, D, ws + WS_WOUT1, nullptr, 0)
#undef MAT
        }
        const float* x_in = INP(0);
        for (int m = gw; m < M; m += NGW) { const f32x4* xr = (const f32x4*)(x_in + (size_t)m * D) + lane; f32x4 v[4]; float s = 0.f;
#pragma unroll
            for (int j = 0; j < 4; ++j) { v[j] = xr[64 * j]; s += (v[j][0] * v[j][0] + v[j][1] * v[j][1]) + (v[j][2] * v[j][2] + v[j][3] * v[j][3]); }
            s = wave_sum(s); if (lane < 16) ssq[(size_t)m * 16 + lane] = (lane == 0) ? s : 0.f;
            v2u* o = (v2u*)(XB + (size_t)m * D) + lane;
#pragma unroll
            for (int j = 0; j < 4; ++j) { v2u w; w.x = pk2(v[j][0], v[j][1]); w.y = pk2(v[j][2], v[j][3]); o[64 * j] = w; } }
        const float* g2 = INP(20);
        for (int i = bx * 512 + tid; i < 8192; i += G * 512) { const int ln = i & 63, ks = (i >> 6) & 7, nb = (i >> 9) & 1, hh = i >> 10; float f[8];
#pragma unroll
            for (int j = 0; j < 8; ++j) f[j] = g2[(size_t)(16 * ks + 8 * (ln >> 5) + j) * 512 + hh * 64 + 32 * nb + (ln & 31)];
            ((bf16x8*)(ws + WS_G2F))[i] = pack8(f); }
    }
    if (ph_lo == 0 && ph_hi > 1) GSYNC();

#define GEMM(EpiT, Aptr, Bptr, Nn, Kk, Eobj) do { pg8::Gemm g_{(const pg8::bf16_t*)(Aptr), (const pg8::bf16_t*)(Bptr), M, (Nn), (Kk)}; pg8::StaticOrder S_; S_.init(M, (Nn), G, bx); \
        pg8::gemm_phase<EpiT, pg8::StaticOrder, true, true>(lds, g_, S_, (Eobj), tid); } while (0)
#pragma unroll 1
    for (int L = 0; L < 2; ++L) {
#pragma unroll 1
        for (int st = 0; st < 9; ++st) {
            const int ph = 1 + 9 * L + st; if (ph < ph_lo || ph >= ph_hi) continue;
            switch (st) {
            case 0: case 6: {
#if PHM & 1
                FRESH();
                for (int dup = 0; dup < 1 + DUP_GU; ++dup) {
                const int f = (st == 6); pg8::EpiGU E{H, ssq + (size_t)((f ? 2 : 0) & 1) * M * 16};
                GEMM(pg8::EpiGU, (L == 1 && st == 0) ? Y : XB, ws + WS_WGU + (size_t)(L * 2 + f) * 11 * MiB, 2 * DFF, D, E);
                __syncthreads(); }
#endif
            } break;
            case 1: case 5: case 7: {
#if PHM & 2
                FRESH();
                const bf16* A; const bf16* Bt; int K; float alpha; float* so;
                if (st == 5) { A = (L == 0) ? Y : Qb; Bt = (const bf16*)(ws + (L == 0 ? WS_WOUT0 : WS_WOUT1)); K = D; alpha = 1.f; so = ssq; }
                else { const int f = (st == 7); A = H; Bt = (const bf16*)(ws + WS_WD + (size_t)(L * 2 + f) * D * DFF * 2); K = DFF; alpha = 0.5f; so = ssq + (size_t)M * 16; }
                pg8::EpiRes E{(L == 0 && st == 1) ? INP(0) : (const float*)X, X, XB, so, alpha};
                GEMM(pg8::EpiRes, A, Bt, D, K, E);
                if (st == 7) {
                    const f32x4* ps = (const f32x4*)(INP(1) + (size_t)L * M * PLE);
                    for (int i = bx * 512 + tid; i < M * PLE / 8; i += G * 512) { const f32x4 u0 = ps[2 * i], u1 = ps[2 * i + 1]; v4u w; w.x = pk2(u0[0], u0[1]); w.y = pk2(u0[2], u0[3]); w.z = pk2(u1[0], u1[1]); w.w = pk2(u1[2], u1[3]); ((v4u*)PB)[i] = w; }
                }
#endif
            } break;
            case 2: {
#if PHM & 4
                FRESH();
                pg8::EpiStore E{Qb, L ? D : EVEN_IN, ssq + (size_t)M * 16, QSCALE, L ? 4 : 2, L ? 4 : 1000, (size_t)M * D, -1, LF, INP(27)};
                for (int dup = 0; dup < 1 + DUP_INPROJ; ++dup) { GEMM(pg8::EpiStore, XB, ws + (L ? WS_WIN1 : WS_WIN0), L ? 3 * D : EVEN_IN, D, E); __syncthreads(); }
                if (L == 1) fox_gate_pass(XB, (const bf16*)(ws + WS_WIN1) + (size_t)3 * D * D, ssq + (size_t)M * 16, INP(27), LF, gw, NGW, lane);
#endif
            } break;
            case 3: {
                if (L == 0) {
#if PHM & 8
                    { FRESH();
#pragma unroll 1
                    for (int dup = 0; dup < 1 + DUP_SWA; ++dup)
                    for (int u = bx; u < 256; u += G) swa_unit(u, PROJ, Y, INP(14), lds, tid, lane, wid); }
#endif
#if PHM & 16
                    { FRESH();
#pragma unroll 1
                    for (int dup = 0; dup < 1 + DUP_SCAN; ++dup)
                    for (int u = bx; u < 256; u += G) rwkv_scan_unit(u, PROJ, YRAW, C3, INP(15), INP(16), INP(17), INP(18), INP(19), INP(21), INP(22), INP(23), lds, lane, wid); }
#endif
                } else {
#if PHM & 32
                    FRESH();
                    const int vcu = (G % 8 == 0) ? (bx % 8) * (G / 8) + bx / 8 : bx;
#pragma unroll 1
                    for (int v = vcu; v < 256; v += G)
#pragma unroll 1
                        for (int i = 0; i < 4; ++i) { int tid2 = tid; asm volatile("" : "+v"(tid2)); const int lane2 = tid2 & 63, wid2 = __builtin_amdgcn_readfirstlane(tid2 >> 6); const int s = v & 3, bh = v >> 2, qb = (i == 0) ? s : (i == 1) ? 7 - s : (i == 2) ? 8 + s : 15 - s;
                            if (i == 0) fox_prefix(LF + (size_t)(bh >> 4) * SEQ * 16 + (bh & 15), (LAS float*)(lds + 98304), (LAS float*)(lds + 131072), tid2, lane2, wid2);
                            attn_body::attn_unit<60>(bh >> 4, bh & 15, qb, (const attn_body::bf16*)Qb, (const attn_body::bf16*)Kb, (const attn_body::bf16*)Vb, (attn_body::bf16*)Qb, (char*)lds_raw, (attn_body::lds_fptr)(lds + 98304), tid2); }
#endif
                }
            } break;
            case 4: {
#if PHM & 64
                if (L == 0) { FRESH();
#pragma unroll 1
                    for (int dup = 0; dup < 1 + DUP_POST; ++dup)
                    for (int t = bx; t < M / 32; t += G) rwkv_post_unit(t, PROJ, YRAW, C3, Y, INP(15), (const bf16*)(ws + WS_G2F), INP(24), INP(25), lane, wid); }
#endif
            } break;
            case 8: {
#if PHM & 128
                FRESH();
#pragma unroll 1
                for (int mode = 0; mode < 2; ++mode) {
                    pg8::EpiPle E{mode, X, Y, PP, ssq + (size_t)M * 16, ssq};
                    GEMM(pg8::EpiPle, mode ? XB : PB, mode ? ws + WS_WG + (size_t)L * 2 * MiB : ws + WS_WP + (size_t)L * PLE * D * 2, D, mode ? D : PLE, E);
                    __syncthreads();
                }
#endif
            } break;
            }
            if (!(L == 1 && st == 4) && ph + 1 < ph_hi) { GSYNC(); for (int dup = 0; dup < DUP_SYNC; ++dup) GSYNC(); }
        }
    }
#undef GEMM
    if (ph_hi == 20) { FRESH(); const float* fg = INP(29); const float* s8 = ssq;
        for (int m = gw; m < M; m += NGW) { f32x4* xr = (f32x4*)(X + (size_t)m * D) + lane; const float rs = pg8::rstd_of(s8, m);
#pragma unroll
            for (int j = 0; j < 4; ++j) { const f32x4 gv = ((const f32x4*)fg)[lane + 64 * j]; xr[64 * j] = xr[64 * j] * rs * gv; } } }
}

extern "C" void kernel_launch(void* const* d_in, const int* in_sizes, int n_in, void* d_out, int out_size, void* d_ws, size_t ws_size, hipStream_t stream) {
    static int grid = 0;
    if (grid == 0) {
        if (n_in != 30 || out_size != M * D || ws_size < WS_END) { fprintf(stderr, "kernel_launch: unexpected shapes (n_in %d out %d ws %zu)\n", n_in, out_size, ws_size); grid = -1; return; }
        int dev = 0, cus = 0, per_cu = 0;
        if (hipGetDevice(&dev) != hipSuccess || hipDeviceGetAttribute(&cus, hipDeviceAttributeMultiprocessorCount, dev) != hipSuccess) { grid = -1; return; }
        if (hipFuncSetAttribute((const void*)fwd_megakernel, hipFuncAttributeMaxDynamicSharedMemorySize, LDS_BYTES) != hipSuccess) { fprintf(stderr, "kernel_launch: hipFuncSetAttribute failed\n"); grid = -1; return; }
        if (hipOccupancyMaxActiveBlocksPerMultiprocessor(&per_cu, (const void*)fwd_megakernel, 512, LDS_BYTES) != hipSuccess || per_cu < 1) { fprintf(stderr, "kernel_launch: occupancy query failed (%d)\n", per_cu); (void)hipGetLastError(); grid = -1; return; }
        grid = cus * per_cu;
        if (grid > 256) grid = 256;
    }
    if (grid < 0) return;
    Args a{};
    for (int i = 0; i < 30; ++i) a.in[i] = (const float*)d_in[i];
    a.out = (float*)d_out; a.ws = (unsigned char*)d_ws;
#ifndef N_LAUNCH_PER_PHASE
    a.ph_lo = 0; a.ph_hi = 20;
    { void* args[] = {&a};
      hipError_t e = hipLaunchCooperativeKernel((const void*)fwd_megakernel, dim3(grid), dim3(512), args, LDS_BYTES, stream);
      if (e != hipSuccess) fprintf(stderr, "cooperative launch failed: %s (grid %d)\n", hipGetErrorString(e), grid); }
#else
    for (int ph = 0; ph < 20; ++ph) { if (ph == 14) continue; a.ph_lo = ph; a.ph_hi = ph + 1; void* args[] = {&a};
      hipError_t e = hipLaunchCooperativeKernel((const void*)fwd_megakernel, dim3(grid), dim3(512), args, LDS_BYTES, stream);
      if (e != hipSuccess) { fprintf(stderr, "cooperative launch failed: %s (grid %d)\n", hipGetErrorString(e), grid); break; } }
#endif
}
```

```cpp
#include <hip/hip_runtime.h>
#include <hip/hip_cooperative_groups.h>
#include <hip/hip_bf16.h>
#include <cstdio>
#include <cstdint>
#include <cmath>
namespace cg = cooperative_groups;
#ifndef PHM
#define PHM 255
#endif
namespace pg8 {
#define PG8_LAS __attribute__((address_space(3)))
typedef unsigned short bf16_t;
typedef short bf16x8 __attribute__((ext_vector_type(8)));
typedef float f32x4 __attribute__((ext_vector_type(4)));
typedef unsigned u32x4 __attribute__((ext_vector_type(4)));
constexpr int BM = 256, BK = 64, HALF = 128, HTB = HALF * BK * 2  , STAGE_BYTES = 8 * HTB, NXCD = 8, WGM = 8;

__host__ __device__ __forceinline__ int lds_byte(int r, int c) { const int st = (r >> 4) * 2 + (c >> 5), rr = r & 15, cc = c & 31, ob = rr * 64 + cc * 2; return st * 1024 + (ob ^ (((ob >> 9) & 1) << 5)); }
__host__ __device__ __forceinline__ void stage_rc(int b, int& R, int& C) { const int st = b / 1024, sb = b % 1024, swz = sb ^ (((sb >> 9) & 1) << 5); R = (st >> 1) * 16 + swz / 64; C = (st & 1) * 32 + (swz % 64) / 2; }
__host__ __device__ __forceinline__ int perm32(int rho) { const int n = rho >> 4, i = rho & 15; return 8 * (i >> 2) + 4 * n + (i & 3); }

struct Unit { int pm, pn; };
struct Gemm { const bf16_t* A; const bf16_t* Bt; int M, N, K; };

struct StaticOrder {
    int nM, nN, nwg, G, c;
    __host__ __device__ void init(int M, int N, int G_, int c_) { nM = M / BM; nN = N / BM; nwg = nM * nN; G = G_; c = c_; }
    __host__ __device__ bool next(int i, Unit& u) const {
        const long L = (long)i * G + c; if (L >= nwg) return false;
        int wgid = (int)L; { const int q = nwg / NXCD, r = nwg % NXCD, xcd = wgid % NXCD, off = wgid / NXCD; wgid = (xcd < r ? xcd * (q + 1) : r * (q + 1) + (xcd - r) * q) + off; }
        const int nig = WGM * nN, gid = wgid / nig, fm = gid * WGM, gsz = (nM - fm) < WGM ? (nM - fm) : WGM;
        u.pm = fm + ((wgid % nig) % gsz); u.pn = (wgid % nig) / gsz; return true;
    }
    __device__ __forceinline__ void a_ready(const Unit&) const {}
    __device__ __forceinline__ void done(const Unit&) const {}
};

typedef float f32x2_c __attribute__((ext_vector_type(2))); typedef __bf16 bf16x2_c __attribute__((ext_vector_type(2)));
__device__ __forceinline__ unsigned cvt_pk_bf16(float lo, float hi) { f32x2_c v = {lo, hi}; bf16x2_c b = __builtin_convertvector(v, bf16x2_c); return __builtin_bit_cast(unsigned, b); }
typedef float f32x2 __attribute__((ext_vector_type(2)));
constexpr float NORM_EPS = 1e-6f;
__device__ __forceinline__ float ssq_sum(const float* ssq, int row) { const f32x4* p = (const f32x4*)(ssq + (size_t)row * 16); const f32x4 a = p[0], b = p[1], c = p[2], d = p[3];
    return ((a[0] + a[1]) + (a[2] + a[3])) + ((b[0] + b[1]) + (b[2] + b[3])) + (((c[0] + c[1]) + (c[2] + c[3])) + ((d[0] + d[1]) + (d[2] + d[3]))); }
__device__ __forceinline__ float rstd_of(const float* ssq, int row) { return rsqrtf(ssq_sum(ssq, row) * (1.0f / 1024.0f) + NORM_EPS); }
__device__ __forceinline__ float sigm(float x) { return __builtin_amdgcn_rcpf(1.0f + __expf(-x)); }
struct EpiGU { static constexpr bool PERM = true, AFTER_DRAIN = false;
    bf16_t* H; const float* ssq;
    __device__ __forceinline__ void operator()(const f32x4 (&acc)[2][2][4][2], const Unit& u, int wr, int wc, int fr, int fq) const {
        int row0 = u.pm * BM + wr * 64 + fr; asm volatile("" : "+v"(row0)); const int col0 = u.pn * 128 + wc * 32 + 8 * fq;
#pragma unroll
        for (int ai = 0; ai < 2; ++ai)
#pragma unroll
            for (int m = 0; m < 4; ++m) { const int row = row0 + ai * HALF + m * 16; const float rs = rstd_of(ssq, row);
                const f32x4 g0 = acc[ai][0][m][0] * rs, g1 = acc[ai][0][m][1] * rs, u0 = acc[ai][1][m][0] * rs, u1 = acc[ai][1][m][1] * rs;
                u32x4 w;
                w.x = cvt_pk_bf16(g0[0] * sigm(g0[0]) * u0[0], g0[1] * sigm(g0[1]) * u0[1]); w.y = cvt_pk_bf16(g0[2] * sigm(g0[2]) * u0[2], g0[3] * sigm(g0[3]) * u0[3]);
                w.z = cvt_pk_bf16(g1[0] * sigm(g1[0]) * u1[0], g1[1] * sigm(g1[1]) * u1[1]); w.w = cvt_pk_bf16(g1[2] * sigm(g1[2]) * u1[2], g1[3] * sigm(g1[3]) * u1[3]);
                *(u32x4*)(H + (size_t)row * 2816 + col0) = w; }
    }
};
struct EpiRes { static constexpr bool PERM = true, AFTER_DRAIN = false;
    const float* base; float* X; bf16_t* XB; float* ssq_out; float alpha;
    __device__ __forceinline__ void operator()(const f32x4 (&acc)[2][2][4][2], const Unit& u, int wr, int wc, int fr, int fq) const {
        int row0 = u.pm * BM + wr * 64 + fr; asm volatile("" : "+v"(row0)); const int col0 = u.pn * BM + wc * 32 + 8 * fq;
#pragma unroll
        for (int ai = 0; ai < 2; ++ai)
#pragma unroll
            for (int m = 0; m < 4; ++m) { const int row = row0 + ai * HALF + m * 16; float part = 0.f;
#pragma unroll
                for (int bj = 0; bj < 2; ++bj) { const size_t off = (size_t)row * 1024 + col0 + bj * HALF;
                    const f32x4 b0 = *(const f32x4*)(base + off), b1 = *(const f32x4*)(base + off + 4);
                    const f32x4 v0 = b0 + acc[ai][bj][m][0] * alpha, v1 = b1 + acc[ai][bj][m][1] * alpha;
                    *(f32x4*)(X + off) = v0; *(f32x4*)(X + off + 4) = v1;
                    u32x4 w; w.x = cvt_pk_bf16(v0[0], v0[1]); w.y = cvt_pk_bf16(v0[2], v0[3]); w.z = cvt_pk_bf16(v1[0], v1[1]); w.w = cvt_pk_bf16(v1[2], v1[3]);
                    *(u32x4*)(XB + off) = w;
                    part += (v0[0] * v0[0] + v0[1] * v0[1]) + (v0[2] * v0[2] + v0[3] * v0[3]) + (v1[0] * v1[0] + v1[1] * v1[1]) + (v1[2] * v1[2] + v1[3] * v1[3]); }
                part += __shfl_xor(part, 16); part += __shfl_xor(part, 32);
                if (fq == 0) ssq_out[(size_t)row * 16 + u.pn * 4 + wc] = part; }
    }
};
struct EpiPle { static constexpr bool PERM = true, AFTER_DRAIN = false;
    int mode; float* X; bf16_t* XB; bf16_t* PP; const float* ssq_in; float* ssq_out;
    __device__ __forceinline__ void operator()(const f32x4 (&acc)[2][2][4][2], const Unit& u, int wr, int wc, int fr, int fq) const {
        int row0 = u.pm * BM + wr * 64 + fr; asm volatile("" : "+v"(row0)); const int col0 = u.pn * BM + wc * 32 + 8 * fq;
#pragma unroll
        for (int ai = 0; ai < 2; ++ai)
#pragma unroll
            for (int m = 0; m < 4; ++m) { const int row = row0 + ai * HALF + m * 16; float part = 0.f; const float rs = mode ? rstd_of(ssq_in, row) : 1.f;
#pragma unroll
                for (int bj = 0; bj < 2; ++bj) { const size_t off = (size_t)row * 1024 + col0 + bj * HALF;
                    if (mode == 0) { const f32x4 v0 = acc[ai][bj][m][0], v1 = acc[ai][bj][m][1];
                        u32x4 w; w.x = cvt_pk_bf16(v0[0], v0[1]); w.y = cvt_pk_bf16(v0[2], v0[3]); w.z = cvt_pk_bf16(v1[0], v1[1]); w.w = cvt_pk_bf16(v1[2], v1[3]);
                        *(u32x4*)(PP + off) = w;
                    } else {
                        const u32x4 pw = *(const u32x4*)(PP + off);
                        const f32x4 p0 = {__uint_as_float(pw.x << 16), __uint_as_float(pw.x & 0xffff0000u), __uint_as_float(pw.y << 16), __uint_as_float(pw.y & 0xffff0000u)};
                        const f32x4 p1 = {__uint_as_float(pw.z << 16), __uint_as_float(pw.z & 0xffff0000u), __uint_as_float(pw.w << 16), __uint_as_float(pw.w & 0xffff0000u)};
                        const f32x4 b0 = *(const f32x4*)(X + off), b1 = *(const f32x4*)(X + off + 4);
                        const f32x4 a0 = acc[ai][bj][m][0] * rs, a1 = acc[ai][bj][m][1] * rs;
                        f32x4 v0, v1;
#pragma unroll
                        for (int j = 0; j < 4; ++j) { v0[j] = b0[j] + sigm(a0[j]) * p0[j]; v1[j] = b1[j] + sigm(a1[j]) * p1[j]; }
                        *(f32x4*)(X + off) = v0; *(f32x4*)(X + off + 4) = v1;
                        u32x4 w; w.x = cvt_pk_bf16(v0[0], v0[1]); w.y = cvt_pk_bf16(v0[2], v0[3]); w.z = cvt_pk_bf16(v1[0], v1[1]); w.w = cvt_pk_bf16(v1[2], v1[3]);
                        if (XB) *(u32x4*)(XB + off) = w;
                        part += (v0[0] * v0[0] + v0[1] * v0[1]) + (v0[2] * v0[2] + v0[3] * v0[3]) + (v1[0] * v1[0] + v1[1] * v1[1]) + (v1[2] * v1[2] + v1[3] * v1[3]); } }
                if (mode) { part += __shfl_xor(part, 16); part += __shfl_xor(part, 32); if (fq == 0) ssq_out[(size_t)row * 16 + u.pn * 4 + wc] = part; } }
    }
};
struct EpiStore { static constexpr bool PERM = true, AFTER_DRAIN = false;
    bf16_t* O; int ldc; const float* ssq; float scale0; int scale_tiles; int split_tiles; size_t split_stride; int lf_tile; float* LF; const float* bfv;
    __device__ __forceinline__ void operator()(const f32x4 (&acc)[2][2][4][2], const Unit& u, int wr, int wc, int fr, int fq) const {
        int row0 = u.pm * BM + wr * 64 + fr; asm volatile("" : "+v"(row0));
        if (u.pn == lf_tile) {
            if (wc == 0 && fq < 2) {
#pragma unroll
                for (int ai = 0; ai < 2; ++ai)
#pragma unroll
                    for (int m = 0; m < 4; ++m) { const int row = row0 + ai * HALF + m * 16; const float rs = rstd_of(ssq, row);
#pragma unroll
                        for (int n = 0; n < 2; ++n) { f32x4 o;
#pragma unroll
                            for (int j = 0; j < 4; ++j) { const float z = fmaxf(acc[ai][0][m][n][j] * rs + bfv[8 * fq + 4 * n + j], -80.f), e = __expf(-z);
                                o[j] = (e < 0.01f) ? -(e - 0.5f * e * e + e * e * e * (1.f / 3.f)) : -__logf(1.f + e); }
                            *(f32x4*)(LF + (size_t)row * 16 + 8 * fq + 4 * n) = o; } }
            }
            return;
        }
        const int t = u.pn / split_tiles, ct = u.pn - t * split_tiles;
        bf16_t* base = O + (size_t)t * split_stride; const float sc = (u.pn < scale_tiles) ? scale0 : 1.f;
        const int col0 = ct * BM + wc * 32 + 8 * fq;
#pragma unroll
        for (int ai = 0; ai < 2; ++ai)
#pragma unroll
            for (int m = 0; m < 4; ++m) { const int row = row0 + ai * HALF + m * 16; const float rs = rstd_of(ssq, row) * sc;
#pragma unroll
                for (int bj = 0; bj < 2; ++bj) { const f32x4 v0 = acc[ai][bj][m][0] * rs, v1 = acc[ai][bj][m][1] * rs;
                    u32x4 w; w.x = cvt_pk_bf16(v0[0], v0[1]); w.y = cvt_pk_bf16(v0[2], v0[3]); w.z = cvt_pk_bf16(v1[0], v1[1]); w.w = cvt_pk_bf16(v1[2], v1[3]);
                    *(u32x4*)(base + (size_t)row * ldc + col0 + bj * HALF) = w; } }
    }
};

template <class Epi, class Sched, bool ALIGN_EPI = false, bool SP2 = false>
__device__ __forceinline__ void gemm_phase(PG8_LAS unsigned char* lds, const Gemm g, const Sched& S, const Epi& E, const int tid) {
    const int wid = __builtin_amdgcn_readfirstlane(tid >> 6), lane = tid & 63, wr = wid >> 2, wc = wid & 3, fr = lane & 15, fq = lane >> 4;
    const int K = g.K, nt = K / BK;
    unsigned voffA[2], voffB[2];
#pragma unroll
    for (int i = 0; i < 2; ++i) { int R, C; stage_rc(tid * 16 + i * 8192, R, C); const int Rb = Epi::PERM ? ((R & ~31) + perm32(R & 31)) : R;
        voffA[i] = (unsigned)(R * K + C) * 2u; voffB[i] = (unsigned)(Rb * K + C) * 2u; }
    const size_t kstep = (size_t)(BK * 2);
    const size_t hstep = (size_t)HALF * K * 2;
    const size_t tstep = 2 * hstep;
    const unsigned ldsw = (unsigned)wid * 1024u;
    const int aoff = lds_byte(wr * 64 + fr, fq * 8), boff = lds_byte(wc * 32 + fr, fq * 8);
#define PG8_SA(b, h) (((b) * 2 + (h)) * HTB)
#define PG8_SB(b, h) ((4 + (b) * 2 + (h)) * HTB)
#define PG8_STAGE(bufoff, gbase, voff) do { _Pragma("unroll") for (int _i = 0; _i < 2; ++_i) \
        __builtin_amdgcn_global_load_lds((const unsigned*)((const char*)(gbase) + (voff)[_i]), (PG8_LAS unsigned*)(lds + (bufoff) + ldsw + _i * 8192), 16, 0, 0); } while (0)
#define PG8_LDA(dst, b, h) do { _Pragma("unroll") for (int m = 0; m < 4; ++m) _Pragma("unroll") for (int k = 0; k < 2; ++k) dst[m][k] = *(const PG8_LAS bf16x8*)(lds + PG8_SA(b, h) + aoff + m * 2048 + k * 1024); } while (0)
#define PG8_LDB(dst, b, h) do { _Pragma("unroll") for (int n = 0; n < 2; ++n) _Pragma("unroll") for (int k = 0; k < 2; ++k) dst[n][k] = *(const PG8_LAS bf16x8*)(lds + PG8_SB(b, h) + boff + n * 2048 + k * 1024); } while (0)
#define PG8_MMA(ai, bj, At, Bt) do { __builtin_amdgcn_s_setprio(1); _Pragma("unroll") for (int m = 0; m < 4; ++m) _Pragma("unroll") for (int n = 0; n < 2; ++n) _Pragma("unroll") for (int k = 0; k < 2; ++k) \
        acc[ai][bj][m][n] = __builtin_amdgcn_mfma_f32_16x16x32_bf16(Bt[n][k], At[m][k], acc[ai][bj][m][n], 0, 0, 0); __builtin_amdgcn_s_setprio(0); } while (0)
#define PG8_WAIT_V(n) asm volatile("s_waitcnt vmcnt(" #n ")" ::: "memory")
#define PG8_WAIT_L(n) asm volatile("s_waitcnt lgkmcnt(" #n ")" ::: "memory")
#define PG8_BAR __builtin_amdgcn_s_barrier()
#define PG8_SCHED __builtin_amdgcn_sched_barrier(0)
    Unit cur, nxt; int ui = 0;
    if (!S.next(0, cur)) return;
    f32x4 acc[2][2][4][2];
#pragma unroll
    for (int a = 0; a < 2; ++a)
#pragma unroll
        for (int b = 0; b < 2; ++b)
#pragma unroll
            for (int m = 0; m < 4; ++m)
#pragma unroll
                for (int n = 0; n < 2; ++n) acc[a][b][m][n] = (f32x4){0.f, 0.f, 0.f, 0.f};
    bf16x8 At[4][2], B0[2][2], B1[2][2];
    const char* cA = (const char*)g.A + (size_t)cur.pm * tstep; const char* cB = (const char*)g.Bt + (size_t)cur.pn * tstep;
    S.a_ready(cur);
    if constexpr (SP2) {
        PG8_STAGE(PG8_SB(0, 0), cB, voffB); PG8_STAGE(PG8_SB(0, 1), cB + hstep, voffB); PG8_STAGE(PG8_SA(0, 0), cA, voffA); PG8_STAGE(PG8_SA(0, 1), cA + hstep, voffA);
        if (wr == 1) PG8_BAR;
        PG8_WAIT_V(2); PG8_BAR;
        PG8_STAGE(PG8_SB(1, 0), cB + kstep, voffB); PG8_STAGE(PG8_SA(1, 0), cA + kstep, voffA); PG8_STAGE(PG8_SB(1, 1), cB + hstep + kstep, voffB);
        PG8_WAIT_V(6); PG8_BAR;
    } else {
        PG8_STAGE(PG8_SB(0, 0), cB, voffB); PG8_STAGE(PG8_SA(0, 0), cA, voffA); PG8_STAGE(PG8_SB(0, 1), cB + hstep, voffB); PG8_STAGE(PG8_SA(0, 1), cA + hstep, voffA);
        if (wr == 1) PG8_BAR;
        PG8_WAIT_V(4); PG8_BAR;
        PG8_STAGE(PG8_SB(1, 0), cB + kstep, voffB); PG8_STAGE(PG8_SA(1, 0), cA + kstep, voffA); PG8_STAGE(PG8_SB(1, 1), cB + hstep + kstep, voffB);
        PG8_WAIT_V(6); PG8_BAR;
    }
    for (;;) {
        const bool has_next = S.next(ui + 1, nxt);
        const char* nA = has_next ? (const char*)g.A + (size_t)nxt.pm * tstep : cA; const char* nB = has_next ? (const char*)g.Bt + (size_t)nxt.pn * tstep : cB;
        for (int t = 0; t < nt; t += 2) {
            const bool last = (t == nt - 2);
            const char* a1 = cA + (size_t)(t + 1) * kstep;
            const char* a2 = last ? nA : cA + (size_t)(t + 2) * kstep; const char* b2 = last ? nB : cB + (size_t)(t + 2) * kstep;
            const char* a3 = a2 + kstep; const char* b3 = b2 + kstep;
            if (last && has_next) S.a_ready(nxt);
            if constexpr (SP2) {
            PG8_LDB(B0, 0, 0); PG8_LDB(B1, 0, 1); PG8_SCHED; PG8_LDA(At, 0, 0); PG8_STAGE(PG8_SA(1, 1), a1 + hstep, voffA);
            PG8_WAIT_V(8); PG8_WAIT_L(0); PG8_BAR; PG8_MMA(0, 0, At, B0); PG8_MMA(0, 1, At, B1); PG8_BAR; PG8_SCHED;
            PG8_LDA(At, 0, 1); PG8_STAGE(PG8_SB(0, 0), b2, voffB); PG8_STAGE(PG8_SB(0, 1), b2 + hstep, voffB); PG8_STAGE(PG8_SA(0, 0), a2, voffA);
            PG8_WAIT_V(8); PG8_WAIT_L(0); PG8_BAR; PG8_MMA(1, 0, At, B0); PG8_MMA(1, 1, At, B1); PG8_BAR; PG8_SCHED;
            PG8_LDB(B0, 1, 0); PG8_LDB(B1, 1, 1); PG8_SCHED; PG8_LDA(At, 1, 0); PG8_STAGE(PG8_SA(0, 1), a2 + hstep, voffA);
            PG8_WAIT_V(8); PG8_WAIT_L(0); PG8_BAR; PG8_MMA(0, 0, At, B0); PG8_MMA(0, 1, At, B1); PG8_BAR; PG8_SCHED;
            PG8_LDA(At, 1, 1); PG8_STAGE(PG8_SB(1, 0), b3, voffB); PG8_STAGE(PG8_SB(1, 1), b3 + hstep, voffB); PG8_STAGE(PG8_SA(1, 0), a3, voffA);
            PG8_WAIT_V(8); PG8_WAIT_L(0); PG8_BAR; PG8_MMA(1, 0, At, B0); PG8_MMA(1, 1, At, B1); PG8_BAR; PG8_SCHED;
            } else {
            PG8_LDB(B0, 0, 0); PG8_SCHED; PG8_LDA(At, 0, 0); PG8_STAGE(PG8_SA(1, 1), a1 + hstep, voffA);
            PG8_WAIT_L(8); PG8_BAR; PG8_WAIT_L(0); PG8_MMA(0, 0, At, B0); PG8_BAR; PG8_SCHED;
            PG8_LDB(B1, 0, 1); PG8_STAGE(PG8_SB(0, 0), b2, voffB);
            PG8_BAR; PG8_WAIT_L(0); PG8_MMA(0, 1, At, B1); PG8_BAR;
            PG8_LDA(At, 0, 1); PG8_STAGE(PG8_SA(0, 0), a2, voffA);
            PG8_BAR; PG8_WAIT_L(0); PG8_MMA(1, 0, At, B0); PG8_BAR; PG8_SCHED;
            PG8_STAGE(PG8_SB(0, 1), b2 + hstep, voffB);
            PG8_WAIT_V(6); PG8_BAR; PG8_MMA(1, 1, At, B1); PG8_BAR;
            PG8_LDB(B0, 1, 0); PG8_SCHED; PG8_LDA(At, 1, 0); PG8_STAGE(PG8_SA(0, 1), a2 + hstep, voffA);
            PG8_WAIT_L(8); PG8_BAR; PG8_WAIT_L(0); PG8_MMA(0, 0, At, B0); PG8_BAR; PG8_SCHED;
            PG8_LDB(B1, 1, 1); PG8_STAGE(PG8_SB(1, 0), b3, voffB);
            PG8_BAR; PG8_WAIT_L(0); PG8_MMA(0, 1, At, B1); PG8_BAR;
            PG8_LDA(At, 1, 1); PG8_STAGE(PG8_SA(1, 0), a3, voffA);
            PG8_BAR; PG8_WAIT_L(0); PG8_MMA(1, 0, At, B0); PG8_BAR; PG8_SCHED;
            PG8_STAGE(PG8_SB(1, 1), b3 + hstep, voffB);
            PG8_WAIT_V(6); PG8_BAR; PG8_MMA(1, 1, At, B1); PG8_BAR;
            }
        }
        if constexpr (ALIGN_EPI) { if (wr == 0) PG8_BAR; }
        if constexpr (!Epi::AFTER_DRAIN) { E(acc, cur, wr, wc, fr, fq); S.done(cur); }
        if (!has_next) break;
#pragma unroll
        for (int a = 0; a < 2; ++a)
#pragma unroll
            for (int b = 0; b < 2; ++b)
#pragma unroll
                for (int m = 0; m < 4; ++m)
#pragma unroll
                    for (int n = 0; n < 2; ++n) acc[a][b][m][n] = (f32x4){0.f, 0.f, 0.f, 0.f};
        cur = nxt; cA = nA; cB = nB; ++ui;
        if constexpr (ALIGN_EPI) { if (wr == 1) PG8_BAR; }
    }
    PG8_WAIT_V(0);
    if constexpr (!ALIGN_EPI) { if (wr == 0) PG8_BAR; }
    PG8_BAR;
    if constexpr (Epi::AFTER_DRAIN) { E.fused(acc, cur, wr, wc, fr, fq, lds, wid, lane); S.done(cur); }
#undef PG8_SA
#undef PG8_SB
#undef PG8_STAGE
#undef PG8_LDA
#undef PG8_LDB
#undef PG8_MMA
#undef PG8_WAIT_V
#undef PG8_WAIT_L
#undef PG8_BAR
#undef PG8_SCHED
}
}
#include <hip/hip_bf16.h>
#include <cmath>
namespace attn_body {
using bf16=__hip_bfloat16;
using bf16x8=__attribute__((ext_vector_type(8)))short;
using s16x4=__attribute__((ext_vector_type(4)))short;
using f32x16=__attribute__((ext_vector_type(16)))float;
using u32x4=__attribute__((ext_vector_type(4)))unsigned;
constexpr int BATCH=4,NHEAD=16,SEQ=4096,D=64,DM=NHEAD*D;
constexpr int NW=8,QBLK=32,QB=QBLK*NW,KVBLK=64,NQB=SEQ/QB;
constexpr int ATTN_PITCH=DM, ATTN_UNIT_ROWS=QB;
__device__ __forceinline__ int crow(int r,int hi){return (r&3)+8*(r>>2)+4*hi;}
#define SBAR() __builtin_amdgcn_sched_barrier(0)
__device__ __forceinline__ void cmask(f32x16&p0,f32x16&p1,int jb,int qrel,int hi){
  const float NEG=-INFINITY; int kb=64*jb+4*hi;
  #pragma unroll
  for(int r=0;r<16;++r){int kv=kb+(r&3)+8*(r>>2); if(kv>qrel)p0[r]=NEG; if(kv+32>qrel)p1[r]=NEG;}
}

constexpr int NSLOT=3, SLOTB=8192;
constexpr int LDS_K=0, LDS_V=NSLOT*SLOTB, LDS_WS=2*NSLOT*SLOTB, LDS_OST=LDS_WS+NW*64*4, LDS_BYTES=LDS_OST+NW*4096;
constexpr float C2=0.125f*1.4426950408889634f;
__device__ __forceinline__ void glds16(const void*gsrc,unsigned lds_dst){unsigned keep;
  asm volatile("s_mov_b32 %0, m0\n\ts_mov_b32 m0, %2\n\ts_nop 0\n\tglobal_load_lds_dwordx4 %1, off\n\ts_mov_b32 m0, %0":"=&s"(keep):"v"(gsrc),"s"(lds_dst):"memory");}
__device__ __forceinline__ float max3f(float a,float b,float c){float r;asm("v_max3_f32 %0, %1, %2, %3":"=v"(r):"v"(a),"v"(b),"v"(c));return r;}
__device__ __forceinline__ float max2f(float a,float b){float r;asm("v_max_f32_e32 %0, %1, %2":"=v"(r):"v"(a),"v"(b));return r;}
__device__ __forceinline__ float fadd_s(float a,float b){float r;asm("v_add_f32_e32 %0, %1, %2":"=v"(r):"v"(a),"v"(b));return r;}
__device__ __forceinline__ float fsub_s(float a,float b){float r;asm("v_sub_f32_e32 %0, %1, %2":"=v"(r):"v"(a),"v"(b));return r;}
typedef float f32x2_t __attribute__((ext_vector_type(2))); typedef __bf16 bf16x2_t __attribute__((ext_vector_type(2)));
__device__ __forceinline__ unsigned cvtpk_s(float lo,float hi){f32x2_t v={lo,hi};bf16x2_t b=__builtin_convertvector(v,bf16x2_t);return __builtin_bit_cast(unsigned,b);}
#define WAIT_BAR(N) asm volatile("s_waitcnt vmcnt(" #N ") lgkmcnt(0)\n\ts_barrier":::"memory")

__device__ __forceinline__ void qkt(f32x16&p0,f32x16&p1,const char*Kslot,const bf16x8*qr,int r32,int hi){
  const char*kb=Kslot+hi*1024+r32*16;
  #pragma unroll
  for(int d0=0;d0<4;++d0){
    const bf16x8 b0=*reinterpret_cast<const bf16x8*>(kb+d0*2048);
    const bf16x8 b1=*reinterpret_cast<const bf16x8*>(kb+d0*2048+512);
    {p0=__builtin_amdgcn_mfma_f32_32x32x16_bf16(b0,qr[d0],p0,0,0,0);p1=__builtin_amdgcn_mfma_f32_32x32x16_bf16(b1,qr[d0],p1,0,0,0);}}
}
typedef __attribute__((address_space(3))) const char* lds_cptr;
typedef short v4i16_t __attribute__((ext_vector_type(4)));
__device__ __forceinline__ void kload8(bf16x8*kf,lds_cptr kp){
  kf[0]=*(const __attribute__((address_space(3))) bf16x8*)(kp);      kf[1]=*(const __attribute__((address_space(3))) bf16x8*)(kp+512);
  kf[2]=*(const __attribute__((address_space(3))) bf16x8*)(kp+2048); kf[3]=*(const __attribute__((address_space(3))) bf16x8*)(kp+2560);
  kf[4]=*(const __attribute__((address_space(3))) bf16x8*)(kp+4096); kf[5]=*(const __attribute__((address_space(3))) bf16x8*)(kp+4608);
  kf[6]=*(const __attribute__((address_space(3))) bf16x8*)(kp+6144); kf[7]=*(const __attribute__((address_space(3))) bf16x8*)(kp+6656);
}
__device__ __forceinline__ void kload2(bf16x8*kf,lds_cptr kp,int j){ kf[2*j]=*(const __attribute__((address_space(3))) bf16x8*)(kp+j*2048); kf[2*j+1]=*(const __attribute__((address_space(3))) bf16x8*)(kp+j*2048+512); }
__device__ __forceinline__ s16x4 vtr(lds_cptr p){ return __builtin_bit_cast(s16x4,__builtin_amdgcn_ds_read_tr16_b64_v4i16((__attribute__((address_space(3))) v4i16_t*)p)); }
__device__ __forceinline__ float rowmax(const f32x16&p0,const f32x16&p1){
  float a=max3f(p0[0],p0[1],p1[0]),b=max3f(p0[2],p0[3],p1[1]);a=max3f(a,p1[2],p1[3]);
  #pragma unroll
  for(int r=4;r<16;r+=4){a=max3f(a,p0[r],p0[r+1]);b=max3f(b,p0[r+2],p0[r+3]);a=max3f(a,p1[r],p1[r+1]);b=max3f(b,p1[r+2],p1[r+3]);}
  const float m=max2f(a,b);
  auto rr=__builtin_amdgcn_permlane32_swap(__float_as_uint(m),__float_as_uint(m),false,false);
  return max2f(__uint_as_float(rr[0]),__uint_as_float(rr[1]));
}
__device__ __forceinline__ void pv(f32x16*o,int vb,bf16x8 pa0,bf16x8 pa1,bf16x8 pa2,bf16x8 pa3){
  #pragma unroll
  for(int d0=0;d0<2;++d0){s16x4 lo[4],hi[4];
    #pragma unroll
    for(int ks=0;ks<4;++ks){
      asm volatile("ds_read_b64_tr_b16 %0,%1 offset:%c2":"=&v"(lo[ks]):"v"(vb),"i"(d0*4096+ks*1024):"memory");
      asm volatile("ds_read_b64_tr_b16 %0,%1 offset:%c2":"=&v"(hi[ks]):"v"(vb),"i"(d0*4096+ks*1024+512):"memory");}
    asm volatile("s_waitcnt lgkmcnt(0)":::"memory");SBAR();
    #define PK(k) (bf16x8){lo[k][0],lo[k][1],lo[k][2],lo[k][3],hi[k][0],hi[k][1],hi[k][2],hi[k][3]}
    o[d0]=__builtin_amdgcn_mfma_f32_32x32x16_bf16(pa0,PK(0),o[d0],0,0,0);
    o[d0]=__builtin_amdgcn_mfma_f32_32x32x16_bf16(pa1,PK(1),o[d0],0,0,0);
    o[d0]=__builtin_amdgcn_mfma_f32_32x32x16_bf16(pa2,PK(2),o[d0],0,0,0);
    o[d0]=__builtin_amdgcn_mfma_f32_32x32x16_bf16(pa3,PK(3),o[d0],0,0,0);
    #undef PK
  }
}

#ifndef ATTN_STORE16
#define ATTN_STORE16(p,v) (*(u32x4*)(p)=(v))
#endif
typedef float f32x4b __attribute__((ext_vector_type(4)));
typedef __attribute__((address_space(3))) const float* lds_fptr;
typedef __attribute__((address_space(3))) const f32x4b* lds_f4ptr;
template<int THRL> __device__ __forceinline__ void attn_unit(int b,int h,int qb,const bf16*Q,const bf16*__restrict__ K,const bf16*__restrict__ V,bf16*O,char*shm,lds_fptr cs,const int tid){
  const int lane=tid&63,r32=lane&31,hi=lane>>5; const int wid=__builtin_amdgcn_readfirstlane(tid>>6);
  const long rowbase=(long)b*SEQ; const int q0=qb*QB;
  const bf16*Qw=Q+(rowbase+q0+wid*QBLK)*DM+h*D;
  const bf16*Kh=K+rowbase*DM+h*D,*Vh=V+rowbase*DM+h*D;
  const unsigned lds0=(unsigned)(uintptr_t)shm;
  float*wsf=(float*)(shm+LDS_WS)+wid*64;
  const bf16*ksrc=Kh+(long)lane*DM+wid*8;
  const bf16*vsrc=Vh+(long)(16*(wid&3)+(lane>>2))*DM+(wid>>2)*32+(lane&3)*8;
  const unsigned kdst=lds0+LDS_K+wid*1024, vdst=lds0+LDS_V+wid*1024;
  #define DMA_K(t,slot) glds16(ksrc+(long)(t)*KVBLK*DM,(unsigned)__builtin_amdgcn_readfirstlane(kdst+(slot)))
  #define DMA_V(t,slot) glds16(vsrc+(long)(t)*KVBLK*DM,(unsigned)__builtin_amdgcn_readfirstlane(vdst+(slot)))
  const int vb0=(int)(lds0+LDS_V)+((lane>>4)&1)*32+(lane&3)*8+(4*hi+((lane&15)>>2))*64;
  const char*Kbase=shm+LDS_K; bf16x8 kf[8];
  const lds_cptr shm3=(lds_cptr)shm; const lds_cptr kp0=shm3+LDS_K+hi*1024+r32*16; const lds_cptr vp0=shm3+LDS_V+((lane>>4)&1)*32+(lane&3)*8+(4*hi+((lane&15)>>2))*64;
  const int NT=(q0+QB)/KVBLK;
  DMA_K(0,0);DMA_V(0,0);DMA_K(1,SLOTB);
  bf16x8 qr[4];
  #pragma unroll
  for(int d0=0;d0<4;++d0)qr[d0]=*reinterpret_cast<const bf16x8*>(&Qw[(long)r32*DM+d0*16+hi*8]);
  const int qrel=wid*QBLK+r32;
  typedef __attribute__((address_space(3))) const unsigned long long* lds_u64p; typedef unsigned u32x2b __attribute__((ext_vector_type(2)));
  const lds_u64p ctr=(lds_u64p)cs;
  float ci2; { const unsigned long long w_=ctr[q0+qrel]; ci2=__uint_as_float((unsigned)w_<<16)+__uint_as_float((unsigned)w_&0xffff0000u)+__uint_as_float((unsigned)(w_>>32)<<16); }
  float mhat=0.f,l_reg=0.f;f32x16 o[2];o[0]=f32x16{};o[1]=f32x16{};float nm=ci2; bf16x8 bnm;
  #define MKBNM() do{ const unsigned h1_=cvtpk_s(nm,0.f)&0xffffu; const float r1_=nm-__uint_as_float(h1_<<16); const unsigned h2_=cvtpk_s(r1_,0.f)&0xffffu; const float r2_=r1_-__uint_as_float(h2_<<16); const unsigned h3_=cvtpk_s(r2_,0.f)&0xffffu; \
    u32x4 b_; b_.x=hi?0u:0xBF80BF80u; b_.y=hi?0u:(0xBF80u|(h1_<<16)); b_.z=hi?0u:(h2_|(h3_<<16)); b_.w=0u; bnm=__builtin_bit_cast(bf16x8,b_); }while(0)
  MKBNM();
  #define CINIT(P0,P1,t) do{ const unsigned long long w0_=ctr[64*(t)+r32], w1_=ctr[64*(t)+32+r32]; \
    u32x4 a0_; a0_.x=(unsigned)w0_; a0_.y=(unsigned)(w0_>>32)|0x3F800000u; a0_.z=0x3F803F80u; a0_.w=0u; u32x4 a1_; a1_.x=(unsigned)w1_; a1_.y=(unsigned)(w1_>>32)|0x3F800000u; a1_.z=0x3F803F80u; a1_.w=0u; \
    P0=__builtin_amdgcn_mfma_f32_32x32x16_bf16(__builtin_bit_cast(bf16x8,a0_),bnm,f32x16{},0,0,0); P1=__builtin_amdgcn_mfma_f32_32x32x16_bf16(__builtin_bit_cast(bf16x8,a1_),bnm,f32x16{},0,0,0); }while(0)
  #define CMASK(P0,P1,t) do{int jb_=(t)-(NT-4); if(jb_>=0)cmask(P0,P1,jb_,qrel,hi);}while(0)
  bool resc=false;
  #define START(P0,P1) do{ const float rm=rowmax(P0,P1); resc=false; \
    { const float dl=rm; mhat=fadd_s(mhat,dl); \
      _Pragma("unroll") for(int r=0;r<16;++r){P0[r]=fsub_s(P0[r],dl);P1[r]=fsub_s(P1[r],dl);} \
      nm=ci2-mhat; MKBNM(); } \
    _Pragma("unroll") for(int r=0;r<16;++r)P0[r]=__builtin_amdgcn_exp2f(P0[r]); }while(0)
  #define RESC() do{ if(resc){ asm volatile("s_waitcnt lgkmcnt(0)":::"memory"); \
      _Pragma("unroll") for(int d_=0;d_<2;++d_) _Pragma("unroll") for(int r=0;r<16;++r)o[d_][r]*=wsf[crow(r,hi)]; } }while(0)
  f32x16 pA0,pA1,pB0,pB1;
  int sl_prev=0,sl_cur=0,sl_next=SLOTB;
  #define ROT() do{sl_prev=sl_cur;sl_cur=sl_next;sl_next=(sl_next==(NSLOT-1)*SLOTB)?0:sl_next+SLOTB;}while(0)
  DMA_K(2,2*SLOTB);
  WAIT_BAR(3);
  CINIT(pA0,pA1,0);qkt(pA0,pA1,Kbase,qr,r32,hi);asm volatile("s_nop 15\n\ts_nop 7":"+v"(pA0),"+v"(pA1));CMASK(pA0,pA1,0);
  START(pA0,pA1);
  _Pragma("unroll") for(int r=0;r<16;++r)pA1[r]=__builtin_amdgcn_exp2f(pA1[r]);
  WAIT_BAR(0);
  DMA_K(3,0);DMA_V(1,SLOTB);
  ROT();
  kload8(kf,kp0+sl_cur);
  WAIT_BAR(2);
  s16x4 vlo[8],vhi[8]; u32x4 pw0,pw1,pw2,pw3;
  #define PKW(P,B) cvtpk_s(P[B],P[B+1])
  #define PAF(k) __builtin_bit_cast(bf16x8,pw##k)
  #define VFR(i) (bf16x8){vlo[i][0],vlo[i][1],vlo[i][2],vlo[i][3],vhi[i][0],vhi[i][1],vhi[i][2],vhi[i][3]}
  #define PIN(x) asm volatile("":"+v"(x))
  #define MX3(a,b,c) __builtin_fmaxf(__builtin_fmaxf((a),(b)),(c))
  #define GAPA(MF,A0,A1,A2,A3,W0,W1,PW) do{ MF; sacc+=A0; sacc+=A1; sacc+=A2; sacc+=A3; PIN(sacc); W0; W1; PIN(PW); SBAR(); }while(0)
  #define EX(v) __builtin_amdgcn_exp2f(v)
  #define GAPB(MF,X,B) do{ MF; X[B]=EX(X[B]); X[B+1]=EX(X[B+1]); X[B+2]=EX(X[B+2]); X[B+3]=EX(X[B+3]); PIN(X); SBAR(); }while(0)
  #define VRD(i) do{ vlo[i]=vtr(vp_+(((i)>>2)*4096+((i)&3)*1024)); vhi[i]=vtr(vp_+(((i)>>2)*4096+((i)&3)*1024+512)); }while(0)
  #define KRD(G,j) do{ if(G){ kload2(kf,kp0+sl_next,j); SBAR(); } }while(0)
  #define STEP(C0,C1,P0,P1,t,GK,GV,GL) do{ SBAR(); \
    const lds_cptr vp_=vp0+sl_prev; CINIT(C0,C1,t); SBAR(); \
    VRD(0); SBAR(); float sacc=(P0[0]+P0[1]); \
    GAPA(C0=__builtin_amdgcn_mfma_f32_32x32x16_bf16(kf[0],qr[0],C0,0,0,0), P0[2],P0[3],P0[4],P0[5],     pw0[0]=PKW(P0,0), pw0[1]=PKW(P0,2), pw0); \
    VRD(4); SBAR(); GAPA(C1=__builtin_amdgcn_mfma_f32_32x32x16_bf16(kf[1],qr[0],C1,0,0,0), P0[6],P0[7],P0[8],P0[9],     pw0[2]=PKW(P0,4), pw0[3]=PKW(P0,6), pw0); \
    VRD(1); SBAR(); GAPA(C0=__builtin_amdgcn_mfma_f32_32x32x16_bf16(kf[2],qr[1],C0,0,0,0),   P0[10],P0[11],P0[12],P0[13], pw1[0]=PKW(P0,8), pw1[1]=PKW(P0,10), pw1); \
    VRD(5); SBAR(); GAPA(C1=__builtin_amdgcn_mfma_f32_32x32x16_bf16(kf[3],qr[1],C1,0,0,0),   P0[14],P0[15],P1[0],P1[1],   pw1[2]=PKW(P0,12),pw1[3]=PKW(P0,14), pw1); \
    VRD(2); SBAR(); GAPA(C0=__builtin_amdgcn_mfma_f32_32x32x16_bf16(kf[4],qr[2],C0,0,0,0),   P1[2],P1[3],P1[4],P1[5],     pw2[0]=PKW(P1,0), pw2[1]=PKW(P1,2), pw2); \
    VRD(6); SBAR(); GAPA(C1=__builtin_amdgcn_mfma_f32_32x32x16_bf16(kf[5],qr[2],C1,0,0,0),   P1[6],P1[7],P1[8],P1[9],     pw2[2]=PKW(P1,4), pw2[3]=PKW(P1,6), pw2); \
    VRD(3); SBAR(); GAPA(C0=__builtin_amdgcn_mfma_f32_32x32x16_bf16(kf[6],qr[3],C0,0,0,0),   P1[10],P1[11],P1[12],P1[13], pw3[0]=PKW(P1,8), pw3[1]=PKW(P1,10), pw3); \
    VRD(7); SBAR(); GAPA(C1=__builtin_amdgcn_mfma_f32_32x32x16_bf16(kf[7],qr[3],C1,0,0,0),   P1[14],P1[15],0.f,0.f,       pw3[2]=PKW(P1,12),pw3[3]=PKW(P1,14), pw3); \
    l_reg+=sacc; \
    if(GK){DMA_K((t)+3,sl_cur);} if(GV){DMA_V((t)+1,sl_next);} \
    CMASK(C0,C1,t); \
    { float a=MX3(C0[0],C0[1],C1[0]),b=MX3(C0[2],C0[3],C1[1]); a=MX3(a,C1[2],C1[3]); \
      _Pragma("unroll") for(int r=4;r<16;r+=4){a=MX3(a,C0[r],C0[r+1]);b=MX3(b,C0[r+2],C0[r+3]);a=MX3(a,C1[r],C1[r+1]);b=MX3(b,C1[r+2],C1[r+3]);} \
      float rm=__builtin_fmaxf(a,b); { auto rr=__builtin_amdgcn_permlane32_swap(__float_as_uint(rm),__float_as_uint(rm),false,false); rm=__builtin_fmaxf(__uint_as_float(rr[0]),__uint_as_float(rr[1])); } \
      resc=false; \
      if(__builtin_expect(__any(rm>(float)THRL),0)){ const float dl=__builtin_fmaxf(rm,0.f); mhat+=dl; \
        _Pragma("unroll") for(int r=0;r<16;++r){C0[r]-=dl;C1[r]-=dl;} \
        nm=ci2-mhat; MKBNM(); \
        const float f=__builtin_amdgcn_exp2f(-dl); l_reg*=f; if(hi==0)wsf[r32]=f; resc=true; } } \
    SBAR(); \
    GAPB(o[0]=__builtin_amdgcn_mfma_f32_32x32x16_bf16(PAF(0),VFR(0),o[0],0,0,0), C0,0); \
    GAPB(o[1]=__builtin_amdgcn_mfma_f32_32x32x16_bf16(PAF(0),VFR(4),o[1],0,0,0), C0,4); \
    KRD(GL,0); GAPB(o[0]=__builtin_amdgcn_mfma_f32_32x32x16_bf16(PAF(1),VFR(1),o[0],0,0,0), C0,8); \
    KRD(GL,1); GAPB(o[1]=__builtin_amdgcn_mfma_f32_32x32x16_bf16(PAF(1),VFR(5),o[1],0,0,0), C0,12); \
    KRD(GL,2); GAPB(o[0]=__builtin_amdgcn_mfma_f32_32x32x16_bf16(PAF(2),VFR(2),o[0],0,0,0), C1,0); \
    KRD(GL,3); GAPB(o[1]=__builtin_amdgcn_mfma_f32_32x32x16_bf16(PAF(2),VFR(6),o[1],0,0,0), C1,4); \
    GAPB(o[0]=__builtin_amdgcn_mfma_f32_32x32x16_bf16(PAF(3),VFR(3),o[0],0,0,0), C1,8); \
    GAPB(o[1]=__builtin_amdgcn_mfma_f32_32x32x16_bf16(PAF(3),VFR(7),o[1],0,0,0), C1,12); \
    }while(0)
  int t=1;
  #undef CMASK
  #define CMASK(P0,P1,t) do{}while(0)
  for(;t+5<NT;t+=2){
    STEP(pB0,pB1,pA0,pA1,t,true,true,true);     WAIT_BAR(2); RESC(); ROT();
    STEP(pA0,pA1,pB0,pB1,t+1,true,true,true);   WAIT_BAR(2); RESC(); ROT();
  }
  #undef CMASK
  #define CMASK(P0,P1,t) do{int jb_=(t)-(NT-4); if(jb_>=0)cmask(P0,P1,jb_,qrel,hi);}while(0)
  #define ENDW(tt) do{ if((tt)+3<NT){WAIT_BAR(2);} else if((tt)+2<NT){WAIT_BAR(1);} else {WAIT_BAR(0);} }while(0)
  for(;t+1<NT;t+=2){
    STEP(pB0,pB1,pA0,pA1,t,(t+3<NT),(t+1<NT),(t+1<NT));       ENDW(t);   RESC(); ROT();
    STEP(pA0,pA1,pB0,pB1,t+1,(t+4<NT),(t+2<NT),(t+2<NT));     ENDW(t+1); RESC(); ROT();
  }
  STEP(pB0,pB1,pA0,pA1,NT-1,false,false,false); RESC();
  { float sacc=pB0[0]+pB0[1]; _Pragma("unroll") for(int r=2;r<16;++r)sacc+=pB0[r]; _Pragma("unroll") for(int r=0;r<16;++r)sacc+=pB1[r]; l_reg+=sacc;
    pw0=(u32x4){PKW(pB0,0),PKW(pB0,2),PKW(pB0,4),PKW(pB0,6)};pw1=(u32x4){PKW(pB0,8),PKW(pB0,10),PKW(pB0,12),PKW(pB0,14)};pw2=(u32x4){PKW(pB1,0),PKW(pB1,2),PKW(pB1,4),PKW(pB1,6)};pw3=(u32x4){PKW(pB1,8),PKW(pB1,10),PKW(pB1,12),PKW(pB1,14)};
    SBAR(); pv(o,vb0+sl_cur,PAF(0),PAF(1),PAF(2),PAF(3)); }
  #undef PKW
  #undef PAF
  #undef VFR
  #undef PIN
  #undef MX3
  #undef GAPA
  #undef GAPB
  #undef EX
  #undef VRD
  #undef KRD
  #undef STEP
  #undef ENDW
  {auto rr=__builtin_amdgcn_permlane32_swap(__float_as_uint(l_reg),__float_as_uint(l_reg),false,false);l_reg=__uint_as_float(rr[0])+__uint_as_float(rr[1]);}
  if(hi==0)wsf[32+r32]=l_reg;asm volatile("s_waitcnt lgkmcnt(0)":::"memory");
  float rli[16];
  #pragma unroll
  for(int r=0;r<16;++r)rli[r]=__builtin_amdgcn_rcpf(wsf[32+crow(r,hi)]);
  bf16*Ow=O+(rowbase+q0+wid*QBLK)*DM+h*D;
  { bf16*stg=(bf16*)(shm+LDS_OST)+wid*2048;
    #pragma unroll
    for(int r=0;r<16;++r){const int orow=crow(r,hi);
      #pragma unroll
      for(int d0=0;d0<2;++d0)stg[orow*64+d0*32+r32]=__float2bfloat16(o[d0][r]*rli[r]);}
    asm volatile("s_waitcnt lgkmcnt(0)":::"memory");
    #pragma unroll
    for(int i=0;i<4;++i){const int row=i*8+(lane>>3),ch=lane&7; const u32x4 v=*(const u32x4*)(stg+row*64+ch*8); ATTN_STORE16(Ow+(long)row*DM+ch*8,v);} }
  asm volatile("s_waitcnt lgkmcnt(0)\n\ts_barrier":::"memory");
  #undef DMA_K
  #undef DMA_V
  #undef CINIT
  #undef MKBNM
  #undef CMASK
  #undef START
  #undef RESC
  #undef ROT
}
constexpr int ATTN_LDS_BYTES=LDS_BYTES;
struct AttnTensors { const bf16* Q; const bf16* K; const bf16* V; bf16* O; };
struct AttnUnit { int bh; int qb; };
struct StaticOrder {
  int vcu;
  __device__ __forceinline__ explicit StaticOrder(int grid,int block):vcu((block%8)*(grid/8)+block/8){}
  __device__ __forceinline__ bool next(int i,AttnUnit&u)const{ if(i>=4)return false; const int s=vcu&3; u.bh=vcu>>2; u.qb=(i==0)?s:(i==1)?7-s:(i==2)?8+s:15-s; return true; }
  __device__ __forceinline__ void a_ready(const AttnUnit&)const{}
  __device__ __forceinline__ void done(const AttnUnit&)const{}
};
#undef SBAR
#undef WAIT_BAR
}
#define LAS __attribute__((address_space(3)))
typedef unsigned short bf16;
typedef unsigned v4u __attribute__((ext_vector_type(4)));
typedef unsigned v2u __attribute__((ext_vector_type(2)));
typedef float f32x4 __attribute__((ext_vector_type(4)));
typedef float f32x16 __attribute__((ext_vector_type(16)));
typedef short bf16x8 __attribute__((ext_vector_type(8)));
typedef float f32x2s __attribute__((ext_vector_type(2)));

constexpr int NBATCH = 4, SEQ = 4096, M = NBATCH * SEQ, D = 1024, DFF = 2816, PLE = 256;
constexpr int EVEN_IN = 2560, FOX_IN = 3088, FOX_INP = 3328;
constexpr float LOG2E = 1.4426950408889634f;
constexpr float QSCALE = 0.125f * LOG2E;
constexpr float GN_EPS = 64e-5f;
constexpr size_t MiB = 1u << 20;
constexpr size_t WS_SSQ = 0;
constexpr size_t WS_C3 = 1 * MiB;
constexpr size_t WS_LF = 2 * MiB;
constexpr size_t WS_G2F = 3 * MiB;
constexpr size_t WS_WGU = 4 * MiB;
constexpr size_t WS_WD = 48 * MiB;
constexpr size_t WS_WG = 70 * MiB;
constexpr size_t WS_WP = 74 * MiB;
constexpr size_t WS_WIN0 = 75 * MiB, WS_WOUT0 = 80 * MiB, WS_WIN1 = 82 * MiB, WS_WOUT1 = 89 * MiB;
constexpr size_t WS_XB = 91 * MiB;
constexpr size_t WS_Y = 123 * MiB;
constexpr size_t WS_BIG = 155 * MiB;
constexpr size_t WS_PB = 243 * MiB;
constexpr size_t WS_SSQP = 251 * MiB;
constexpr size_t WS_END = 253 * MiB;
constexpr size_t WS_BAR = 0;
constexpr int LDS_BYTES = 147456, MISC_OFF = 147456 - 64;

#define LDS_WAIT() asm volatile("s_waitcnt lgkmcnt(0)" ::: "memory")
__device__ __forceinline__ unsigned pk2(float lo, float hi) { return pg8::cvt_pk_bf16(lo, hi); }
__device__ __forceinline__ float bflo(unsigned w) { return __uint_as_float(w << 16); }
__device__ __forceinline__ float bfhi(unsigned w) { return __uint_as_float(w & 0xffff0000u); }
__device__ __forceinline__ float bf2f(bf16 h) { return __uint_as_float((unsigned)h << 16); }
__device__ __forceinline__ float wave_sum(float v) {
#pragma unroll
    for (int o = 1; o < 64; o <<= 1) v += __shfl_xor(v, o);
    return v;
}
__device__ __forceinline__ int crow(int r, int hi) { return (r & 3) + 8 * (r >> 2) + 4 * hi; }
template <int CTRL> __device__ __forceinline__ float dpp_f(float x) { return __int_as_float(__builtin_amdgcn_update_dpp(0, __float_as_int(x), CTRL, 0xf, 0xf, true)); }
__device__ __forceinline__ float red16(float x) { x += dpp_f<0xB1>(x); x += dpp_f<0x4E>(x); x += dpp_f<0x141>(x); x += dpp_f<0x140>(x); return x; }
__device__ __forceinline__ float red8(float x) { x += dpp_f<0xB1>(x); x += dpp_f<0x4E>(x); x += dpp_f<0x141>(x); return x; }
__device__ __forceinline__ void unpack8(const v4u w, float (&f)[8]) { f[0] = bflo(w.x); f[1] = bfhi(w.x); f[2] = bflo(w.y); f[3] = bfhi(w.y); f[4] = bflo(w.z); f[5] = bfhi(w.z); f[6] = bflo(w.w); f[7] = bfhi(w.w); }
__device__ __forceinline__ bf16x8 pack8(const float (&f)[8]) { v4u w; w.x = pk2(f[0], f[1]); w.y = pk2(f[2], f[3]); w.z = pk2(f[4], f[5]); w.w = pk2(f[6], f[7]); return __builtin_bit_cast(bf16x8, w); }

__device__ __forceinline__ void conv_item(const float* W, int K, int N, int NP, bf16* WT, const float* gain, int mode, LAS float* scr, int item, int lane) {
    const int nblk = NP / 32, kb = item / nblk, nb = item - kb * nblk, k0 = 64 * kb, n0 = 32 * nb;
    int orow0 = n0;
    if (mode == 1) orow0 = (n0 < DFF) ? (n0 / 128) * 256 + (n0 % 128) : ((n0 - DFF) / 128) * 256 + 128 + ((n0 - DFF) % 128);
    const int nq = 4 * (lane & 7); const bool inb = (n0 + nq) < N;
#pragma unroll
    for (int i = 0; i < 8; ++i) { const int kk = 8 * i + (lane >> 3); f32x4 v = {0.f, 0.f, 0.f, 0.f}; if (inb) v = *(const f32x4*)(W + (size_t)(k0 + kk) * N + n0 + nq);
        if (gain) v = v * gain[k0 + kk];
        LAS float* d = scr + kk * 33 + nq; d[0] = v[0]; d[1] = v[1]; d[2] = v[2]; d[3] = v[3]; }
    LDS_WAIT(); asm volatile("" ::: "memory");
    const int c = lane & 7;
#pragma unroll
    for (int j = 0; j < 4; ++j) { const int nn = (lane >> 3) + 8 * j; const LAS float* s = scr + (8 * c) * 33 + nn;
        v4u o; o.x = pk2(s[0 * 33], s[1 * 33]); o.y = pk2(s[2 * 33], s[3 * 33]); o.z = pk2(s[4 * 33], s[5 * 33]); o.w = pk2(s[6 * 33], s[7 * 33]);
        *(v4u*)(WT + (size_t)(orow0 + nn) * K + k0 + 8 * c) = o; }
    LDS_WAIT(); asm volatile("" ::: "memory");
}

constexpr int VTP = 264;
__device__ __forceinline__ void swa_unit(int unit, const bf16* PROJ, bf16* Y, const float* sinks, LAS unsigned char* lds, int tid, int lane, int wid) {
    const int b = unit >> 6, kvh = (unit >> 5) & 1, qblk = unit & 31, q0 = qblk * 128; const size_t rb = (size_t)b * SEQ;
    asm volatile("" : "+s"(PROJ), "+s"(Y));
    LAS bf16* VT = (LAS bf16*)lds;
    for (int c = tid; c < 2048; c += 512) { const int kvl = c >> 3, ch = c & 7, tok = q0 - 128 + kvl; v4u v = {0u, 0u, 0u, 0u};
        if (tok >= 0) v = *(const v4u*)(PROJ + (rb + tok) * EVEN_IN + 640 + kvh * 64 + ch * 8);
        LAS bf16* d = VT + (ch * 8) * VTP + kvl;
        d[0 * VTP] = (bf16)(v.x & 0xffffu); d[1 * VTP] = (bf16)(v.x >> 16); d[2 * VTP] = (bf16)(v.y & 0xffffu); d[3 * VTP] = (bf16)(v.y >> 16);
        d[4 * VTP] = (bf16)(v.z & 0xffffu); d[5 * VTP] = (bf16)(v.z >> 16); d[6 * VTP] = (bf16)(v.w & 0xffffu); d[7 * VTP] = (bf16)(v.w >> 16); }
    __syncthreads();
    const int g = wid >> 1, qh = wid & 1, hq = kvh * 4 + g;
    const float slope2 = exp2f(-(float)(hq + 1)) * LOG2E, sink2 = sinks[hq] * LOG2E;
#pragma unroll 1
    for (int sb = 0; sb < 2; ++sb) {
        int r32 = lane & 31, hi = lane >> 5; asm volatile("" : "+v"(r32), "+v"(hi));
        const int qs = q0 + 64 * qh + 32 * sb;
        bf16x8 qf[4];
#pragma unroll
        for (int ks = 0; ks < 4; ++ks) qf[ks] = *(const bf16x8*)(PROJ + (rb + qs + r32) * EVEN_IN + hq * 64 + 16 * ks + 8 * hi);
        f32x16 sc[5];
#pragma unroll
        for (int kt = 0; kt < 5; ++kt) { int tk = qs - 128 + 32 * kt + r32; tk = tk < 0 ? 0 : tk; sc[kt] = f32x16{};
#pragma unroll
            for (int ks = 0; ks < 4; ++ks) { const bf16x8 kf = *(const bf16x8*)(PROJ + (rb + tk) * EVEN_IN + 512 + kvh * 64 + 16 * ks + 8 * hi);
                sc[kt] = __builtin_amdgcn_mfma_f32_32x32x16_bf16(kf, qf[ks], sc[kt], 0, 0, 0); } }
        const int db = r32 + 128 - 4 * hi, kmin = 128 - qs - 4 * hi; const float ab = -slope2 * (float)db;
        float mx = sink2;
#pragma unroll
        for (int kt = 0; kt < 5; ++kt)
#pragma unroll
            for (int r = 0; r < 16; ++r) { const int kc = 32 * kt + (r & 3) + 8 * (r >> 2), dist = db - kc; const bool ok = ((unsigned)dist < 128u) && (kmin <= kc);
                const float s = ok ? fmaf(slope2, (float)kc, sc[kt][r] + ab) : -INFINITY; sc[kt][r] = s; mx = fmaxf(mx, s); }
        mx = fmaxf(mx, __shfl_xor(mx, 32));
        float l = 0.f;
#pragma unroll
        for (int kt = 0; kt < 5; ++kt)
#pragma unroll
            for (int r = 0; r < 16; ++r) { const float p = exp2f(sc[kt][r] - mx); sc[kt][r] = p; l += p; }
        l += __shfl_xor(l, 32); l += exp2f(sink2 - mx);
        const float rl = 1.0f / l;
        f32x16 o[2]; o[0] = f32x16{}; o[1] = f32x16{};
        const int kvl0 = 64 * qh + 32 * sb;
#pragma unroll
        for (int kt = 0; kt < 5; ++kt)
#pragma unroll
            for (int s2 = 0; s2 < 2; ++s2) { v4u pw; pw.x = pk2(sc[kt][8 * s2 + 0], sc[kt][8 * s2 + 1]); pw.y = pk2(sc[kt][8 * s2 + 2], sc[kt][8 * s2 + 3]); pw.z = pk2(sc[kt][8 * s2 + 4], sc[kt][8 * s2 + 5]); pw.w = pk2(sc[kt][8 * s2 + 6], sc[kt][8 * s2 + 7]);
                const bf16x8 pa = __builtin_bit_cast(bf16x8, pw);
#pragma unroll
                for (int db = 0; db < 2; ++db) { const LAS bf16* vp = VT + (32 * db + r32) * VTP + kvl0 + 32 * kt + 16 * s2 + 4 * hi;
                    const v2u lo = *(const LAS v2u*)vp, hh = *(const LAS v2u*)(vp + 8); v4u vw; vw.x = lo.x; vw.y = lo.y; vw.z = hh.x; vw.w = hh.y;
                    o[db] = __builtin_amdgcn_mfma_f32_32x32x16_bf16(pa, __builtin_bit_cast(bf16x8, vw), o[db], 0, 0, 0); } }
#pragma unroll
        for (int r = 0; r < 16; ++r) { const int qq = crow(r, hi); const float sc1 = __shfl(rl, qq);
            bf16* yp = Y + (rb + qs + qq) * 1024 + hq * 64 + r32;
            yp[0] = (bf16)(pk2(o[0][r] * sc1, 0.f) & 0xffffu); yp[32] = (bf16)(pk2(o[1][r] * sc1, 0.f) & 0xffffu); }
    }
    __syncthreads();
}
typedef unsigned v4u_unused_;
#define XB_TMO      128
#define XB_XCNT(j)  (256  + 64 * (j))
#define XB_XSUB(j)  (1280 + 64 * (j))
#define XB_XGEN(j)  (2304 + 64 * (j))
#define XB_TOP      3328
#define XB_TOPGEN   3392
#define XCD_BAR_WORDS 3456
#define XB_SPIN_CAP (1u << 18)

__device__ __forceinline__ unsigned xb_ld(unsigned* p)              { return __hip_atomic_load(p, __ATOMIC_RELAXED, __HIP_MEMORY_SCOPE_AGENT); }
__device__ __forceinline__ unsigned xb_add(unsigned* p, unsigned v) { return __hip_atomic_fetch_add(p, v, __ATOMIC_RELAXED, __HIP_MEMORY_SCOPE_AGENT); }
__device__ __forceinline__ unsigned xb_xcc_id() { return (unsigned)__builtin_amdgcn_s_getreg((3 << 11) | 20) & 0xFu; }
#define XB_SPIN(cond, bar) do { unsigned _sp = 0; while (cond) { __builtin_amdgcn_s_sleep(1); \
    if ((++_sp & 255u) == 0u) { if (xb_ld(&(bar)[XB_TMO])) break; if (_sp > XB_SPIN_CAP) { atomicAdd(&(bar)[XB_TMO], 1u); break; } } } } while (0)

struct XcdBarrier {
    unsigned* bar; unsigned x;
    volatile LAS unsigned* st;
};

__device__ __forceinline__ XcdBarrier xcd_barrier_post(unsigned* bar, volatile LAS unsigned* st) {
    XcdBarrier b; b.bar = bar; b.x = xb_xcc_id(); b.st = st;
    if (threadIdx.x == 0) (void)xb_add(&bar[XB_XCNT(b.x)], 1u);
    return b;
}
__device__ __forceinline__ void xcd_barrier_complete(unsigned* bar, unsigned x, unsigned& nloc, unsigned& nx) {
    const unsigned G = gridDim.x * gridDim.y * gridDim.z;
    unsigned sum, cnt, mine, sp = 0u;
    for (;;) {
        sum = 0u; cnt = 0u; mine = 0u;
#pragma unroll
        for (unsigned j = 0; j < 16; ++j) { const unsigned c = xb_ld(&bar[XB_XCNT(j)]); sum += c; cnt += (c > 0u) ? 1u : 0u; mine = (j == x) ? c : mine; }
        if (sum == G) break;
        __builtin_amdgcn_s_sleep(1);
        if ((++sp & 255u) == 0u) { if (xb_ld(&bar[XB_TMO])) break; if (sp > XB_SPIN_CAP) { atomicAdd(&bar[XB_TMO], 1u); break; } }
    }
    nloc = mine > 0u ? mine : 1u; nx = cnt > 0u ? cnt : 1u;
}

__device__ __forceinline__ void xcd_barrier(const XcdBarrier& b) {
    asm volatile("s_waitcnt vmcnt(0)" ::: "memory");
    __syncthreads();
    if (threadIdx.x == 0) {
        unsigned* bar = b.bar;
        __builtin_amdgcn_s_waitcnt(0);
        unsigned nloc = b.st[0], nx = b.st[1];
        if (nloc == 0u) { xcd_barrier_complete(bar, b.x, nloc, nx); b.st[0] = nloc; b.st[1] = nx; }
        const unsigned old = xb_add(&bar[XB_XSUB(b.x)], 1u);
        const unsigned gen = old / nloc;
        if (old + 1u == (gen + 1u) * nloc) {
            __builtin_amdgcn_fence(__ATOMIC_RELEASE, "agent");
            asm volatile("s_waitcnt vmcnt(0)" ::: "memory");
            const unsigned og = xb_add(&bar[XB_TOP], 1u);
            const unsigned tg = og / nx;
            if (og + 1u == (tg + 1u) * nx) xb_add(&bar[XB_TOPGEN], 1u);
            else XB_SPIN(xb_ld(&bar[XB_TOPGEN]) == tg, bar);
            __builtin_amdgcn_fence(__ATOMIC_ACQUIRE, "agent");
            xb_add(&bar[XB_XGEN(b.x)], 1u);
            asm volatile("s_waitcnt vmcnt(0)" ::: "memory");
        } else {
            XB_SPIN(xb_ld(&bar[XB_XGEN(b.x)]) == gen, bar);
            __builtin_amdgcn_fence(__ATOMIC_ACQUIRE, "agent");
            asm volatile("s_waitcnt vmcnt(0)" ::: "memory");
        }
    }
    __syncthreads();
}
constexpr int TC = 32, SBS = 340, LBS = 68;
constexpr int SBS_UNUSED_ = 336;
constexpr int RW_SBUF = 0, RW_SBUF_BYTES = TC * SBS * 4, RW_LW = 2 * RW_SBUF_BYTES, RW_LA = RW_LW + 2 * TC * LBS * 4, RW_EC = RW_LA + 2 * TC * LBS * 4, RW_BF = RW_EC + 2560;
__device__ __forceinline__ void rwkv_scan_unit(int unit, const bf16* PROJ, float* YRAW, float* C3, const float* mu, const float* w0, const float* w2, const float* a0, const float* a2,
                                               const float* k_k, const float* k_a, const float* r_k, LAS unsigned char* lds, const int lane, int wid) {
    const int role = (wid < 2) ? 0 : ((wid == 2 || wid == 3) ? 2 : 1), lw = wid - 2, ew = wid - 4;
    const int b = unit >> 6, h = (unit >> 3) & 7, rg = unit & 7; const size_t rb = (size_t)b * SEQ;
    const int r32 = lane & 31, hi = lane >> 5;
    constexpr int NCH = SEQ / TC;
    if (role == 2) {
        const int colx = 768 + ((lw == 0) ? 1536 : 1600); const float* Wl = (lw == 0) ? w2 : a2;
#pragma unroll
        for (int nb = 0; nb < 2; ++nb)
#pragma unroll
            for (int ks = 0; ks < 4; ++ks) { float f[8];
#pragma unroll
                for (int i = 0; i < 8; ++i) f[i] = Wl[(size_t)(16 * ks + 8 * hi + i) * 512 + h * 64 + 32 * nb + r32];
                *(LAS bf16x8*)(lds + RW_BF + (((lw * 2 + nb) * 4 + ks) * 64 + lane) * 16) = pack8(f); }
        ((LAS float*)(lds + RW_EC))[512 + lw * 64 + lane] = mu[colx - 768 + lane];
        v4u lcw[4], lpw[4];
#define LORA_LOAD(itn) do { const int tl_ = (itn) * TC + r32; const bf16* p_ = PROJ + (rb + tl_) * EVEN_IN + colx + 8 * hi; _Pragma("unroll") for (int ks = 0; ks < 4; ++ks) { lcw[ks] = *(const v4u*)(p_ + 16 * ks); \
            lpw[ks] = (v4u){0u, 0u, 0u, 0u}; if (tl_ > 0) lpw[ks] = *(const v4u*)(p_ - EVEN_IN + 16 * ks); } } while (0)
        LORA_LOAD(0);
#pragma unroll 1
        for (int it = 0; it < NCH + 2; ++it) {
            if (it < NCH) { bf16x8 afr[4];
#pragma unroll
                for (int ks = 0; ks < 4; ++ks) { float c[8], p[8]; unpack8(lcw[ks], c); unpack8(lpw[ks], p);
                    const LAS float* mq = (const LAS float*)(lds + RW_EC) + 512 + lw * 64 + 16 * ks + 8 * hi; const f32x4 m0 = *(const LAS f32x4*)mq, m1 = *(const LAS f32x4*)(mq + 4);
#pragma unroll
                    for (int i = 0; i < 8; ++i) { float x = c[i] + (p[i] - c[i]) * (i < 4 ? m0[i] : m1[i - 4]); if (lw == 0) x = 1.f - 2.f * __builtin_amdgcn_rcpf(1.f + __expf(2.f * x)); c[i] = x; }
                    afr[ks] = pack8(c); }
                if (it + 1 < NCH) LORA_LOAD(it + 1);
                LAS float* LB = (LAS float*)(lds + ((lw == 0) ? RW_LW : RW_LA)) + (it & 1) * (TC * LBS);
#pragma unroll
                for (int nb = 0; nb < 2; ++nb) { f32x16 acc = f32x16{};
#pragma unroll
                    for (int ks = 0; ks < 4; ++ks) acc = __builtin_amdgcn_mfma_f32_32x32x16_bf16(afr[ks], *(const LAS bf16x8*)(lds + RW_BF + (((lw * 2 + nb) * 4 + ks) * 64 + lane) * 16), acc, 0, 0, 0);
#pragma unroll
                    for (int r = 0; r < 16; ++r) LB[crow(r, hi) * LBS + 32 * nb + r32] = acc[r]; } }
            asm volatile("s_waitcnt lgkmcnt(0)\n\ts_barrier" ::: "memory");
        }
#undef LORA_LOAD
    } else if (role == 1) {
        const int el = ew * 64 + lane, s = el >> 3, g = el & 7;
        float ecc[8][8];
        { const int chn = h * 64 + 8 * g;
#pragma unroll
          for (int i = 0; i < 8; ++i) { ecc[0][i] = mu[chn + i]; ecc[1][i] = mu[512 + chn + i]; ecc[2][i] = mu[1024 + chn + i]; ecc[3][i] = w0[chn + i]; ecc[4][i] = a0[chn + i]; ecc[5][i] = k_k[chn + i]; ecc[6][i] = k_a[chn + i]; ecc[7][i] = r_k[chn + i]; } }
        v4u ecr, eck, ecv, epr, epk, epv;
#define ELEM_LOAD(cn) do { const int tl_ = (cn) * TC + s; const bf16* p_ = PROJ + (rb + tl_) * EVEN_IN + 768 + h * 64 + 8 * g; \
            ecr = *(const v4u*)p_; eck = *(const v4u*)(p_ + 512); ecv = *(const v4u*)(p_ + 1024); epr = (v4u){0u, 0u, 0u, 0u}; epk = epr; epv = epr; \
            if (tl_ > 0) { epr = *(const v4u*)(p_ - EVEN_IN); epk = *(const v4u*)(p_ - EVEN_IN + 512); epv = *(const v4u*)(p_ - EVEN_IN + 1024); } } while (0)
        ELEM_LOAD(0);
#pragma unroll 1
        for (int it = 0; it < NCH + 2; ++it) {
            const int c = it - 1;
            if (c >= 0 && c < NCH) { const size_t row = rb + c * TC + s;
                const LAS float* LW = (const LAS float*)(lds + RW_LW) + (c & 1) * (TC * LBS) + s * LBS + 8 * g; const LAS float* LA = (const LAS float*)(lds + RW_LA) + (c & 1) * (TC * LBS) + s * LBS + 8 * g;
                LAS float* sp = (LAS float*)(lds + RW_SBUF + (c & 1) * RW_SBUF_BYTES) + s * SBS;
                float ec[8];
#define LDEC(arr) do { _Pragma("unroll") for (int i_ = 0; i_ < 8; ++i_) ec[i_] = ecc[arr][i_]; } while (0)
                float r[8], k[8], v[8], t[8];
                unpack8(ecr, r); unpack8(epr, t); LDEC(0);
#pragma unroll
                for (int i = 0; i < 8; ++i) r[i] += (t[i] - r[i]) * ec[i];
                unpack8(eck, k); unpack8(epk, t); LDEC(1);
#pragma unroll
                for (int i = 0; i < 8; ++i) k[i] += (t[i] - k[i]) * ec[i];
                unpack8(ecv, v); unpack8(epv, t); LDEC(2);
#pragma unroll
                for (int i = 0; i < 8; ++i) v[i] += (t[i] - v[i]) * ec[i];
                if (c + 1 < NCH) ELEM_LOAD(c + 1);
                const f32x4 dw0 = *(const LAS f32x4*)LW, dw1 = *(const LAS f32x4*)(LW + 4), da0 = *(const LAS f32x4*)LA, da1 = *(const LAS f32x4*)(LA + 4);
                float w[8], a[8], kk[8], kp[8]; float n2 = 0.f;
#pragma unroll
                for (int i = 0; i < 8; ++i) w[i] = i < 4 ? dw0[i] : dw1[i - 4];
                LDEC(3);
#pragma unroll
                for (int i = 0; i < 8; ++i) w[i] = __expf(-0.60653065971f * pg8::sigm(ec[i] + w[i]));
                LDEC(4);
#pragma unroll
                for (int i = 0; i < 8; ++i) a[i] = pg8::sigm(ec[i] + (i < 4 ? da0[i] : da1[i - 4]));
                LDEC(5);
#pragma unroll
                for (int i = 0; i < 8; ++i) { kk[i] = k[i] * ec[i]; n2 += kk[i] * kk[i]; }
                LDEC(6);
#pragma unroll
                for (int i = 0; i < 8; ++i) kp[i] = k[i] * (1.f + (a[i] - 1.f) * ec[i]);
                LDEC(7);
                n2 = red8(n2); const float inv = __builtin_amdgcn_rsqf(fmaxf(n2, 1e-24f));
                float c1 = 0.f, c2 = 0.f, c3 = 0.f;
#pragma unroll
                for (int i = 0; i < 8; ++i) { kk[i] *= inv; t[i] = kk[i] * a[i]; c1 += t[i] * r[i]; c2 += kp[i] * r[i]; c3 += r[i] * kp[i] * ec[i]; }
#undef LDEC
                c1 = red8(c1); c2 = red8(c2); c3 = red8(c3);
                *(LAS f32x4*)(sp + 8 * g) = (f32x4){kk[0], kk[1], kk[2], kk[3]}; *(LAS f32x4*)(sp + 8 * g + 4) = (f32x4){kk[4], kk[5], kk[6], kk[7]};
                *(LAS f32x4*)(sp + 64 + 8 * g) = (f32x4){w[0] * r[0], w[1] * r[1], w[2] * r[2], w[3] * r[3]}; *(LAS f32x4*)(sp + 64 + 8 * g + 4) = (f32x4){w[4] * r[4], w[5] * r[5], w[6] * r[6], w[7] * r[7]};
                *(LAS f32x4*)(sp + 128 + 8 * g) = (f32x4){w[0], w[1], w[2], w[3]}; *(LAS f32x4*)(sp + 128 + 8 * g + 4) = (f32x4){w[4], w[5], w[6], w[7]};
                *(LAS f32x4*)(sp + 192 + 8 * g) = (f32x4){t[0], t[1], t[2], t[3]}; *(LAS f32x4*)(sp + 192 + 8 * g + 4) = (f32x4){t[4], t[5], t[6], t[7]};
                *(LAS f32x4*)(sp + 256 + 8 * g) = (f32x4){kp[0], kp[1], kp[2], kp[3]}; *(LAS f32x4*)(sp + 256 + 8 * g + 4) = (f32x4){kp[4], kp[5], kp[6], kp[7]};
                if (g == rg) { *(LAS f32x4*)(sp + 320) = (f32x4){v[0], v[1], v[2], v[3]}; *(LAS f32x4*)(sp + 324) = (f32x4){v[4], v[5], v[6], v[7]}; }
                if (g == 0) { sp[328] = c1; sp[329] = c2; if (rg == 0) C3[row * 8 + h] = c3; } }
            asm volatile("s_waitcnt lgkmcnt(0)\n\ts_barrier" ::: "memory");
        }
#undef ELEM_LOAD
    } else {
        const int rowl = 4 * (wid & 1) + (lane >> 4), cgp = lane & 15;
        f32x2s S01 = {0.f, 0.f}, S23 = {0.f, 0.f};
#pragma unroll 1
        for (int it = 0; it < NCH + 2; ++it) {
            const int c = it - 2;
            if (c >= 0) { const LAS float* SBF = (const LAS float*)(lds + RW_SBUF + (c & 1) * RW_SBUF_BYTES);
                float* yp = YRAW + (rb + (size_t)c * TC) * 512 + h * 64 + 8 * rg + rowl;
                __builtin_amdgcn_s_setprio(3);
                f32x4 kkA, wrA, wA, kaA, kpA, kkB, wrB, wB, kaB, kpB; float viA, viB; float pkeep = 0.f, qkeep = 0.f;
#define LDREC(X, s_) do { const LAS float* sp_ = SBF + (s_) * SBS; kk##X = *(const LAS f32x4*)(sp_ + 4 * cgp); wr##X = *(const LAS f32x4*)(sp_ + 64 + 4 * cgp); w##X = *(const LAS f32x4*)(sp_ + 128 + 4 * cgp); \
                    ka##X = *(const LAS f32x4*)(sp_ + 192 + 4 * cgp); kp##X = *(const LAS f32x4*)(sp_ + 256 + 4 * cgp); vi##X = sp_[320 + rowl]; } while (0)
#define LO2(v) __builtin_shufflevector(v, v, 0, 1)
#define HI2(v) __builtin_shufflevector(v, v, 2, 3)
#define STEPREC(X, s_) do { f32x2s pp = S01 * LO2(kk##X); pp = S23 * HI2(kk##X) + pp; f32x2s qq = S01 * LO2(wr##X); qq = S23 * HI2(wr##X) + qq; float p = pp[0] + pp[1], q = qq[0] + qq[1]; \
                    const f32x2s vv_ = {vi##X, vi##X}; const f32x2s u01_ = S01 * LO2(w##X) + LO2(kp##X) * vv_, u23_ = S23 * HI2(w##X) + HI2(kp##X) * vv_;     \
                    p += dpp_f<0xB1>(p); q += dpp_f<0xB1>(q); p += dpp_f<0x4E>(p); q += dpp_f<0x4E>(q); p += dpp_f<0x141>(p); q += dpp_f<0x141>(q); p += dpp_f<0x140>(p); q += dpp_f<0x140>(q); \
                    const f32x2s pv_ = {p, p}; \
                    S01 = u01_ - LO2(ka##X) * pv_; S23 = u23_ - HI2(ka##X) * pv_; \
                    pkeep = (((s_) & 15) == cgp) ? p : pkeep; qkeep = (((s_) & 15) == cgp) ? q : qkeep;     \
                    if (((s_) & 15) == 15) { const LAS float* sy_ = SBF + ((s_) - 15 + cgp) * SBS; const f32x2s cy_ = *(const LAS f32x2s*)(sy_ + 328); \
                        yp[(size_t)((s_) - 15 + cgp) * 512] = qkeep - pkeep * cy_[0] + sy_[320 + rowl] * cy_[1]; } } while (0)
                LDREC(A, 0);
#pragma unroll
                for (int s = 0; s < TC; s += 2) {
 LDREC(B, s + 1); STEPREC(A, s); LDREC(A, s + 2); STEPREC(B, s + 1); }
#undef LDREC
#undef STEPREC
#undef LO2
#undef HI2
                __builtin_amdgcn_s_setprio(0); }
            asm volatile("s_waitcnt lgkmcnt(0)\n\ts_barrier" ::: "memory");
        }
    }
    __syncthreads();
}

__device__ __forceinline__ void rwkv_post_unit(int tile, const bf16* PROJ, const float* YRAW, const float* C3, bf16* Y, const float* mu, const bf16* g2f, const float* ln_w, const float* ln_b, int lane, int wid) {
    asm volatile("" : "+s"(PROJ), "+s"(mu), "+s"(g2f), "+s"(YRAW));
    const int h = wid, r32 = lane & 31, hi = lane >> 5; const int tok0 = tile * 32; const bool first = (tok0 & (SEQ - 1)) == 0;
    bf16x8 afr[8];
    { const int tk = tok0 + r32; const bool hp = !(first && r32 == 0); v4u cwv[8], pwv[8];
      const __attribute__((address_space(1))) bf16* pg = (const __attribute__((address_space(1))) bf16*)(PROJ + (size_t)tk * EVEN_IN + 768 + 1664 + 8 * hi);
#pragma unroll
        for (int ks = 0; ks < 8; ++ks) { cwv[ks] = *(const __attribute__((address_space(1))) v4u*)(pg + 16 * ks); pwv[ks] = (v4u){0u, 0u, 0u, 0u};
            if (hp) pwv[ks] = *(const __attribute__((address_space(1))) v4u*)(pg - EVEN_IN + 16 * ks); }
#pragma unroll
        for (int ks = 0; ks < 8; ++ks) { float c[8], p[8]; unpack8(cwv[ks], c); unpack8(pwv[ks], p);
            const f32x4 m0 = *(const f32x4*)(mu + 1664 + 16 * ks + 8 * hi), m1 = *(const f32x4*)(mu + 1664 + 16 * ks + 8 * hi + 4);
#pragma unroll
            for (int i = 0; i < 8; ++i) c[i] = pg8::sigm(c[i] + (p[i] - c[i]) * (i < 4 ? m0[i] : m1[i - 4]));
            afr[ks] = pack8(c); } }
    f32x16 gt[2];
#pragma unroll
    for (int nb = 0; nb < 2; ++nb) { gt[nb] = f32x16{};
#pragma unroll
        for (int ks = 0; ks < 8; ++ks) { const bf16x8 bf = *(const bf16x8*)(g2f + ((size_t)((h * 2 + nb) * 8 + ks) * 64 + lane) * 8);
            gt[nb] = __builtin_amdgcn_mfma_f32_32x32x16_bf16(afr[ks], bf, gt[nb], 0, 0, 0); } }
    typedef const __attribute__((address_space(1))) float* gfp; typedef const __attribute__((address_space(1))) unsigned short* gup;
    const int ch0 = h * 64 + r32; const float lw0 = ln_w[ch0], lw1 = ln_w[ch0 + 32], lb0 = ln_b[ch0], lb1 = ln_b[ch0 + 32], mv0 = mu[1024 + ch0], mv1 = mu[1024 + ch0 + 32];
    float y0[16], y1[16], c3v[16]; unsigned vc[16], vp[16];
#pragma unroll
    for (int r = 0; r < 16; ++r) { const int tk = tok0 + crow(r, hi); gfp yp = (gfp)(YRAW + (size_t)tk * 512 + ch0); y0[r] = yp[0]; y1[r] = yp[32]; c3v[r] = ((gfp)C3)[(size_t)tk * 8 + h];
        gup vq = (gup)(PROJ + (size_t)tk * EVEN_IN + 768 + 1024 + ch0); vc[r] = (unsigned)vq[0] | ((unsigned)vq[32] << 16); vp[r] = 0u;
        if ((tk & (SEQ - 1)) != 0) vp[r] = (unsigned)vq[-EVEN_IN] | ((unsigned)vq[32 - EVEN_IN] << 16); }
#pragma unroll
    for (int r = 0; r < 16; ++r) { const int tk = tok0 + crow(r, hi);
        float s = y0[r] + y1[r]; s = red16(s); s += __shfl_xor(s, 16);
        const float mean = s * (1.f / 64.f), d0 = y0[r] - mean, d1 = y1[r] - mean; float q = d0 * d0 + d1 * d1; q = red16(q); q += __shfl_xor(q, 16);
        const float rstd = rsqrtf(q * (1.f / 64.f) + GN_EPS);
        const float cv0 = bflo(vc[r]), cv1 = bfhi(vc[r]), pv0 = bflo(vp[r]), pv1 = bfhi(vp[r]);
        const float v0 = cv0 + (pv0 - cv0) * mv0, v1 = cv1 + (pv1 - cv1) * mv1;
        const float o0 = (d0 * rstd * lw0 + lb0 + c3v[r] * v0) * gt[0][r], o1 = (d1 * rstd * lw1 + lb1 + c3v[r] * v1) * gt[1][r];
        bf16* op = Y + (size_t)tk * 1024 + 512 + ch0; op[0] = (bf16)(pk2(o0, 0.f) & 0xffffu); op[32] = (bf16)(pk2(o1, 0.f) & 0xffffu); }
}

__device__ __forceinline__ void fox_gate_pass(const bf16* XB, const bf16* Wf, const float* ssqv, const float* bfv, float* LF, int gw, int NGW, int lane) {
    typedef float f32x4g __attribute__((ext_vector_type(4)));
    const int fr = lane & 15, fq = lane >> 4;
    for (int t = gw; t < M / 16; t += NGW) {
        const bf16* ap = XB + (size_t)(t * 16 + fr) * D + 8 * fq; const bf16* bp = Wf + (size_t)fr * D + 8 * fq;
        f32x4g acc = {0.f, 0.f, 0.f, 0.f};
#pragma unroll 8
        for (int ks = 0; ks < D / 32; ++ks) acc = __builtin_amdgcn_mfma_f32_16x16x32_bf16(*(const bf16x8*)(ap + 32 * ks), *(const bf16x8*)(bp + 32 * ks), acc, 0, 0, 0);
        const float bn = bfv[fr];
#pragma unroll
        for (int j = 0; j < 4; ++j) { const int row = t * 16 + 4 * fq + j; const float z = fmaxf(acc[j] * pg8::rstd_of(ssqv, row) + bn, -80.f), e = __expf(-z);
            LF[(size_t)row * 16 + fr] = (e < 0.01f) ? -(e - 0.5f * e * e + e * e * e * (1.f / 3.f)) : -__logf(1.f + e); }
    }
}

__device__ __forceinline__ void fox_prefix(const float* LFbh, LAS float* cs, LAS float* wtot, int tid, int lane, int wid) {
    const float* lp = LFbh + (size_t)tid * 128;
    float s[8]; s[0] = lp[0]; s[1] = s[0] + lp[16]; s[2] = s[1] + lp[32]; s[3] = s[2] + lp[48]; s[4] = s[3] + lp[64]; s[5] = s[4] + lp[80]; s[6] = s[5] + lp[96]; s[7] = s[6] + lp[112];
    float incl = s[7];
#pragma unroll
    for (int o = 1; o < 64; o <<= 1) { const float t = __shfl_up(incl, o); if (lane >= o) incl += t; }
    if (lane == 63) wtot[wid] = incl;
    __syncthreads();
    float base = incl - s[7];
    for (int w = 0; w < wid; ++w) base += wtot[w];
#pragma unroll
    for (int i = 0; i < 8; ++i) { const float v = (base + s[i]) * LOG2E;
        const unsigned h1 = pk2(v, 0.f) & 0xffffu; const float r1 = v - __uint_as_float(h1 << 16); const unsigned h2 = pk2(r1, 0.f) & 0xffffu; const float r2 = r1 - __uint_as_float(h2 << 16); const unsigned h3 = pk2(r2, 0.f) & 0xffffu;
        ((LAS v2u*)cs)[8 * tid + i] = (v2u){h1 | (h2 << 16), h3}; }
    __syncthreads();
}
struct Args { const float* in[30]; float* out; unsigned char* ws; int ph_lo, ph_hi; };
#define AS4 __attribute__((address_space(4)))
#ifndef DUP_SWA
#define DUP_SWA 0
#endif
#ifndef DUP_SCAN
#define DUP_SCAN 0
#endif
#ifndef DUP_POST
#define DUP_POST 0
#endif
#ifndef DUP_GU
#define DUP_GU 0
#endif
#ifndef DUP_INPROJ
#define DUP_INPROJ 0
#endif
#ifndef DUP_P0
#define DUP_P0 0
#endif
#ifndef DUP_SYNC
#define DUP_SYNC 0
#endif
#define INP(i) (*(const float* const AS4*)(kp + 8 * (i)))
#define GSYNC() xcd_barrier(xbar)
#define FRESH() const AS4 char* kp = kp0; asm volatile("" : "+s"(kp)); unsigned char* ws = *(unsigned char* const AS4*)(kp + 248); float* X = *(float* const AS4*)(kp + 240); \
    int tid = threadIdx.x; asm volatile("" : "+v"(tid)); const int lane = tid & 63, wid = __builtin_amdgcn_readfirstlane(tid >> 6); \
    const int gw = bx * 8 + wid, NGW = G * 8; \
    float* ssq = (float*)(ws + WS_SSQP); float* C3 = (float*)(ws + WS_C3); float* LF = (float*)(ws + WS_LF); \
    bf16* XB = (bf16*)(ws + WS_XB); float* YRAW = (float*)(ws + WS_XB); bf16* Y = (bf16*)(ws + WS_Y); \
    bf16* H = (bf16*)(ws + WS_BIG); bf16* PROJ = (bf16*)(ws + WS_BIG); bf16* PP = (bf16*)(ws + WS_BIG); bf16* PB = (bf16*)(ws + WS_PB); \
    bf16* Qb = (bf16*)(ws + WS_BIG); bf16* Kb = Qb + (size_t)M * D; bf16* Vb = Kb + (size_t)M * D; \
    (void)X; (void)lane; (void)wid; (void)gw; (void)NGW; (void)ssq; (void)C3; (void)LF; (void)XB; (void)YRAW; (void)Y; (void)H; (void)PROJ; (void)PP; (void)PB; (void)Qb; (void)Kb; (void)Vb
__global__ void __launch_bounds__(512, 2) fwd_megakernel(Args a_unused) {
    extern __shared__ __attribute__((aligned(16))) unsigned char lds_raw[];
    cg::grid_group grid = cg::this_grid();
    LAS unsigned char* lds = (LAS unsigned char*)lds_raw;
    const int G = gridDim.x, bx = blockIdx.x;
    const AS4 char* kp0 = (const AS4 char*)__builtin_amdgcn_kernarg_segment_ptr();
    const int ph_lo = *(const int AS4*)(kp0 + 256), ph_hi = *(const int AS4*)(kp0 + 260);
    XcdBarrier xbar;
    { unsigned* barw = (unsigned*)(*(unsigned char* const AS4*)(kp0 + 248) + WS_BAR);
      if (bx == 0) for (int i = threadIdx.x; i < XCD_BAR_WORDS; i += 512) barw[i] = 0u;
      if (threadIdx.x < 4) ((LAS unsigned*)(lds + MISC_OFF))[threadIdx.x] = 0u;
      asm volatile("s_waitcnt vmcnt(0)" ::: "memory"); __syncthreads();
      grid.sync();
      __builtin_amdgcn_fence(__ATOMIC_ACQUIRE, "agent"); asm volatile("s_waitcnt vmcnt(0)" ::: "memory");
      xbar = xcd_barrier_post(barw, (volatile LAS unsigned*)(lds + MISC_OFF)); }

#ifdef NANFILL
    { FRESH(); v4u q = {0xffffffffu, 0xffffffffu, 0xffffffffu, 0xffffffffu};
      for (size_t i = (size_t)bx * 512 + tid; i < WS_END / 16; i += (size_t)G * 512) ((v4u*)ws)[i] = q;
      for (size_t i = (size_t)bx * 512 + tid; i < (size_t)M * D / 4; i += (size_t)G * 512) ((v4u*)X)[i] = q;
      for (int i = tid; i < LDS_BYTES / 4; i += 512) ((LAS unsigned*)lds)[i] = 0xffffffffu; }
    GSYNC();
#endif
    for (int dup = 0; dup < 1 + DUP_P0; ++dup)
    if (ph_lo == 0) {
        FRESH();
        LAS float* scr = (LAS float*)(lds + wid * 16384);
        constexpr int I_GU = (D / 64) * (2 * DFF / 32), I_D = (DFF / 64) * (D / 32), I_G = (D / 64) * (D / 32), I_P = (PLE / 64) * (D / 32), I_IN0 = (D / 64) * (EVEN_IN / 32), I_IN1 = (D / 64) * (FOX_INP / 32);
        constexpr int NITEMS = 4 * I_GU + 4 * I_D + 2 * I_G + 2 * I_P + I_IN0 + I_IN1 + 2 * I_G;
        for (int it = gw; it < NITEMS; it += NGW) {
            int r = it;
#define MAT(cnt, W_, K_, N_, NP_, WT_, G_, MODE_) if (r < (cnt)) { conv_item((W_), (K_), (N_), (NP_), (bf16*)(WT_), (G_), (MODE_), scr, r, lane); continue; } r -= (cnt);
            MAT(I_GU, INP(3), D, 2 * DFF, 2 * DFF, ws + WS_WGU, INP(2), 1)
            MAT(I_GU, INP(7), D, 2 * DFF, 2 * DFF, ws + WS_WGU + 11 * MiB, INP(6), 1)
            MAT(I_GU, INP(3) + (size_t)D * 2 * DFF, D, 2 * DFF, 2 * DFF, ws + WS_WGU + 22 * MiB, INP(2) + D, 1)
            MAT(I_GU, INP(7) + (size_t)D * 2 * DFF, D, 2 * DFF, 2 * DFF, ws + WS_WGU + 33 * MiB, INP(6) + D, 1)
            MAT(I_D, INP(4), DFF, D, D, ws + WS_WD, nullptr, 0)
            MAT(I_D, INP(8), DFF, D, D, ws + WS_WD + (size_t)D * DFF * 2, nullptr, 0)
            MAT(I_D, INP(4) + (size_t)D * DFF, DFF, D, D, ws + WS_WD + (size_t)D * DFF * 4, nullptr, 0)
            MAT(I_D, INP(8) + (size_t)D * DFF, DFF, D, D, ws + WS_WD + (size_t)D * DFF * 6, nullptr, 0)
            MAT(I_G, INP(10), D, D, D, ws + WS_WG, INP(9), 0)
            MAT(I_G, INP(10) + (size_t)D * D, D, D, D, ws + WS_WG + 2 * MiB, INP(9) + D, 0)
            MAT(I_P, INP(11), PLE, D, D, ws + WS_WP, nullptr, 0)
            MAT(I_P, INP(11) + (size_t)PLE * D, PLE, D, D, ws + WS_WP + (size_t)PLE * D * 2, nullptr, 0)
            MAT(I_IN0, INP(12), D, EVEN_IN, EVEN_IN, ws + WS_WIN0, INP(5), 0)
            MAT(I_IN1, INP(26), D, FOX_IN, FOX_INP, ws + WS_WIN1, INP(5) + D, 0)
            MAT(I_G, INP(13), D, D, D, ws + WS_WOUT0, nullptr, 0)
            MAT(I_G, INP(28), D, D, D, ws + WS_WOUT1, nullptr, 0)
#undef MAT
        }
        const float* x_in = INP(0);
        for (int m = gw; m < M; m += NGW) { const f32x4* xr = (const f32x4*)(x_in + (size_t)m * D) + lane; f32x4 v[4]; float s = 0.f;
#pragma unroll
            for (int j = 0; j < 4; ++j) { v[j] = xr[64 * j]; s += (v[j][0] * v[j][0] + v[j][1] * v[j][1]) + (v[j][2] * v[j][2] + v[j][3] * v[j][3]); }
            s = wave_sum(s); if (lane < 16) ssq[(size_t)m * 16 + lane] = (lane == 0) ? s : 0.f;
            v2u* o = (v2u*)(XB + (size_t)m * D) + lane;
#pragma unroll
            for (int j = 0; j < 4; ++j) { v2u w; w.x = pk2(v[j][0], v[j][1]); w.y = pk2(v[j][2], v[j][3]); o[64 * j] = w; } }
        const float* g2 = INP(20);
        for (int i = bx * 512 + tid; i < 8192; i += G * 512) { const int ln = i & 63, ks = (i >> 6) & 7, nb = (i >> 9) & 1, hh = i >> 10; float f[8];
#pragma unroll
            for (int j = 0; j < 8; ++j) f[j] = g2[(size_t)(16 * ks + 8 * (ln >> 5) + j) * 512 + hh * 64 + 32 * nb + (ln & 31)];
            ((bf16x8*)(ws + WS_G2F))[i] = pack8(f); }
    }
    if (ph_lo == 0 && ph_hi > 1) GSYNC();

#define GEMM(EpiT, Aptr, Bptr, Nn, Kk, Eobj) do { pg8::Gemm g_{(const pg8::bf16_t*)(Aptr), (const pg8::bf16_t*)(Bptr), M, (Nn), (Kk)}; pg8::StaticOrder S_; S_.init(M, (Nn), G, bx); \
        pg8::gemm_phase<EpiT, pg8::StaticOrder, true, true>(lds, g_, S_, (Eobj), tid); } while (0)
#pragma unroll 1
    for (int L = 0; L < 2; ++L) {
#pragma unroll 1
        for (int st = 0; st < 9; ++st) {
            const int ph = 1 + 9 * L + st; if (ph < ph_lo || ph >= ph_hi) continue;
            switch (st) {
            case 0: case 6: {
#if PHM & 1
                FRESH();
                for (int dup = 0; dup < 1 + DUP_GU; ++dup) {
                const int f = (st == 6); pg8::EpiGU E{H, ssq + (size_t)((f ? 2 : 0) & 1) * M * 16};
                GEMM(pg8::EpiGU, (L == 1 && st == 0) ? Y : XB, ws + WS_WGU + (size_t)(L * 2 + f) * 11 * MiB, 2 * DFF, D, E);
                __syncthreads(); }
#endif
            } break;
            case 1: case 5: case 7: {
#if PHM & 2
                FRESH();
                const bf16* A; const bf16* Bt; int K; float alpha; float* so;
                if (st == 5) { A = (L == 0) ? Y : Qb; Bt = (const bf16*)(ws + (L == 0 ? WS_WOUT0 : WS_WOUT1)); K = D; alpha = 1.f; so = ssq; }
                else { const int f = (st == 7); A = H; Bt = (const bf16*)(ws + WS_WD + (size_t)(L * 2 + f) * D * DFF * 2); K = DFF; alpha = 0.5f; so = ssq + (size_t)M * 16; }
                pg8::EpiRes E{(L == 0 && st == 1) ? INP(0) : (const float*)X, X, XB, so, alpha};
                GEMM(pg8::EpiRes, A, Bt, D, K, E);
                if (st == 7) {
                    const f32x4* ps = (const f32x4*)(INP(1) + (size_t)L * M * PLE);
                    for (int i = bx * 512 + tid; i < M * PLE / 8; i += G * 512) { const f32x4 u0 = ps[2 * i], u1 = ps[2 * i + 1]; v4u w; w.x = pk2(u0[0], u0[1]); w.y = pk2(u0[2], u0[3]); w.z = pk2(u1[0], u1[1]); w.w = pk2(u1[2], u1[3]); ((v4u*)PB)[i] = w; }
                }
#endif
            } break;
            case 2: {
#if PHM & 4
                FRESH();
                pg8::EpiStore E{Qb, L ? D : EVEN_IN, ssq + (size_t)M * 16, QSCALE, L ? 4 : 2, L ? 4 : 1000, (size_t)M * D, -1, LF, INP(27)};
                for (int dup = 0; dup < 1 + DUP_INPROJ; ++dup) { GEMM(pg8::EpiStore, XB, ws + (L ? WS_WIN1 : WS_WIN0), L ? 3 * D : EVEN_IN, D, E); __syncthreads(); }
                if (L == 1) fox_gate_pass(XB, (const bf16*)(ws + WS_WIN1) + (size_t)3 * D * D, ssq + (size_t)M * 16, INP(27), LF, gw, NGW, lane);
#endif
            } break;
            case 3: {
                if (L == 0) {
#if PHM & 8
                    { FRESH();
#pragma unroll 1
                    for (int dup = 0; dup < 1 + DUP_SWA; ++dup)
                    for (int u = bx; u < 256; u += G) swa_unit(u, PROJ, Y, INP(14), lds, tid, lane, wid); }
#endif
#if PHM & 16
                    { FRESH();
#pragma unroll 1
                    for (int dup = 0; dup < 1 + DUP_SCAN; ++dup)
                    for (int u = bx; u < 256; u += G) rwkv_scan_unit(u, PROJ, YRAW, C3, INP(15), INP(16), INP(17), INP(18), INP(19), INP(21), INP(22), INP(23), lds, lane, wid); }
#endif
                } else {
#if PHM & 32
                    FRESH();
                    const int vcu = (G % 8 == 0) ? (bx % 8) * (G / 8) + bx / 8 : bx;
#pragma unroll 1
                    for (int v = vcu; v < 256; v += G)
#pragma unroll 1
                        for (int i = 0; i < 4; ++i) { int tid2 = tid; asm volatile("" : "+v"(tid2)); const int lane2 = tid2 & 63, wid2 = __builtin_amdgcn_readfirstlane(tid2 >> 6); const int s = v & 3, bh = v >> 2, qb = (i == 0) ? s : (i == 1) ? 7 - s : (i == 2) ? 8 + s : 15 - s;
                            if (i == 0) fox_prefix(LF + (size_t)(bh >> 4) * SEQ * 16 + (bh & 15), (LAS float*)(lds + 98304), (LAS float*)(lds + 131072), tid2, lane2, wid2);
                            attn_body::attn_unit<60>(bh >> 4, bh & 15, qb, (const attn_body::bf16*)Qb, (const attn_body::bf16*)Kb, (const attn_body::bf16*)Vb, (attn_body::bf16*)Qb, (char*)lds_raw, (attn_body::lds_fptr)(lds + 98304), tid2); }
#endif
                }
            } break;
            case 4: {
#if PHM & 64
                if (L == 0) { FRESH();
#pragma unroll 1
                    for (int dup = 0; dup < 1 + DUP_POST; ++dup)
                    for (int t = bx; t < M / 32; t += G) rwkv_post_unit(t, PROJ, YRAW, C3, Y, INP(15), (const bf16*)(ws + WS_G2F), INP(24), INP(25), lane, wid); }
#endif
            } break;
            case 8: {
#if PHM & 128
                FRESH();
#pragma unroll 1
                for (int mode = 0; mode < 2; ++mode) {
                    pg8::EpiPle E{mode, X, (L == 0) ? Y : (bf16*)nullptr, PP, ssq + (size_t)M * 16, ssq};
                    GEMM(pg8::EpiPle, mode ? XB : PB, mode ? ws + WS_WG + (size_t)L * 2 * MiB : ws + WS_WP + (size_t)L * PLE * D * 2, D, mode ? D : PLE, E);
                    __syncthreads();
                }
#endif
            } break;
            }
            if (!(L == 1 && st == 4) && ph + 1 < ph_hi) { GSYNC(); for (int dup = 0; dup < DUP_SYNC; ++dup) GSYNC(); }
        }
    }
#undef GEMM
    if (ph_hi == 20) { FRESH(); const float* fg = INP(29); const float* s8 = ssq;
        for (int m = gw; m < M; m += NGW) { f32x4* xr = (f32x4*)(X + (size_t)m * D) + lane; const float rs = pg8::rstd_of(s8, m);
#pragma unroll
            for (int j = 0; j < 4; ++j) { const f32x4 gv = ((const f32x4*)fg)[lane + 64 * j]; xr[64 * j] = xr[64 * j] * rs * gv; } } }
}

extern "C" void kernel_launch(void* const* d_in, const int* in_sizes, int n_in, void* d_out, int out_size, void* d_ws, size_t ws_size, hipStream_t stream) {
    static int grid = 0;
    if (grid == 0) {
        if (n_in != 30 || out_size != M * D || ws_size < WS_END) { fprintf(stderr, "kernel_launch: unexpected shapes (n_in %d out %d ws %zu)\n", n_in, out_size, ws_size); grid = -1; return; }
        int dev = 0, cus = 0, per_cu = 0;
        if (hipGetDevice(&dev) != hipSuccess || hipDeviceGetAttribute(&cus, hipDeviceAttributeMultiprocessorCount, dev) != hipSuccess) { grid = -1; return; }
        if (hipFuncSetAttribute((const void*)fwd_megakernel, hipFuncAttributeMaxDynamicSharedMemorySize, LDS_BYTES) != hipSuccess) { fprintf(stderr, "kernel_launch: hipFuncSetAttribute failed\n"); grid = -1; return; }
        if (hipOccupancyMaxActiveBlocksPerMultiprocessor(&per_cu, (const void*)fwd_megakernel, 512, LDS_BYTES) != hipSuccess || per_cu < 1) { fprintf(stderr, "kernel_launch: occupancy query failed (%d)\n", per_cu); (void)hipGetLastError(); grid = -1; return; }
        grid = cus * per_cu;
        if (grid > 256) grid = 256;
    }
    if (grid < 0) return;
    Args a{};
    for (int i = 0; i < 30; ++i) a.in[i] = (const float*)d_in[i];
    a.out = (float*)d_out; a.ws = (unsigned char*)d_ws;
#ifndef N_LAUNCH_PER_PHASE
    a.ph_lo = 0; a.ph_hi = 20;
    { void* args[] = {&a};
      hipError_t e = hipLaunchCooperativeKernel((const void*)fwd_megakernel, dim3(grid), dim3(512), args, LDS_BYTES, stream);
      if (e != hipSuccess) fprintf(stderr, "cooperative launch failed: %s (grid %d)\n", hipGetErrorString(e), grid); }
#else
    for (int ph = 0; ph < 20; ++ph) { if (ph == 14) continue; a.ph_lo = ph; a.ph_hi = ph + 1; void* args[] = {&a};
      hipError_t e = hipLaunchCooperativeKernel((const void*)fwd_megakernel, dim3(grid), dim3(512), args, LDS_BYTES, stream);
      if (e != hipSuccess) { fprintf(stderr, "cooperative launch failed: %s (grid %d)\n", hipGetErrorString(e), grid); break; } }
#endif
}
```

```cpp
#include <hip/hip_runtime.h>
#include <hip/hip_cooperative_groups.h>
#include <hip/hip_bf16.h>
#include <cstdio>
#include <cstdint>
#include <cmath>
namespace cg = cooperative_groups;
#ifndef PHM
#define PHM 255
#endif
namespace pg8 {
#define PG8_LAS __attribute__((address_space(3)))
typedef unsigned short bf16_t;
typedef short bf16x8 __attribute__((ext_vector_type(8)));
typedef float f32x4 __attribute__((ext_vector_type(4)));
typedef unsigned u32x4 __attribute__((ext_vector_type(4)));
constexpr int BM = 256, BK = 64, HALF = 128, HTB = HALF * BK * 2  , STAGE_BYTES = 8 * HTB, NXCD = 8, WGM = 8;

__host__ __device__ __forceinline__ int lds_byte(int r, int c) { const int st = (r >> 4) * 2 + (c >> 5), rr = r & 15, cc = c & 31, ob = rr * 64 + cc * 2; return st * 1024 + (ob ^ (((ob >> 9) & 1) << 5)); }
__host__ __device__ __forceinline__ void stage_rc(int b, int& R, int& C) { const int st = b / 1024, sb = b % 1024, swz = sb ^ (((sb >> 9) & 1) << 5); R = (st >> 1) * 16 + swz / 64; C = (st & 1) * 32 + (swz % 64) / 2; }
__host__ __device__ __forceinline__ int perm32(int rho) { const int n = rho >> 4, i = rho & 15; return 8 * (i >> 2) + 4 * n + (i & 3); }

struct Unit { int pm, pn; };
struct Gemm { const bf16_t* A; const bf16_t* Bt; int M, N, K; };

struct StaticOrder {
    int nM, nN, nwg, G, c;
    __host__ __device__ void init(int M, int N, int G_, int c_) { nM = M / BM; nN = N / BM; nwg = nM * nN; G = G_; c = c_; }
    __host__ __device__ bool next(int i, Unit& u) const {
        const long L = (long)i * G + c; if (L >= nwg) return false;
        int wgid = (int)L; { const int q = nwg / NXCD, r = nwg % NXCD, xcd = wgid % NXCD, off = wgid / NXCD; wgid = (xcd < r ? xcd * (q + 1) : r * (q + 1) + (xcd - r) * q) + off; }
        const int nig = WGM * nN, gid = wgid / nig, fm = gid * WGM, gsz = (nM - fm) < WGM ? (nM - fm) : WGM;
        u.pm = fm + ((wgid % nig) % gsz); u.pn = (wgid % nig) / gsz; return true;
    }
    __device__ __forceinline__ void a_ready(const Unit&) const {}
    __device__ __forceinline__ void done(const Unit&) const {}
};

typedef float f32x2_c __attribute__((ext_vector_type(2))); typedef __bf16 bf16x2_c __attribute__((ext_vector_type(2)));
__device__ __forceinline__ unsigned cvt_pk_bf16(float lo, float hi) { f32x2_c v = {lo, hi}; bf16x2_c b = __builtin_convertvector(v, bf16x2_c); return __builtin_bit_cast(unsigned, b); }
typedef float f32x2 __attribute__((ext_vector_type(2)));
constexpr float NORM_EPS = 1e-6f;
__device__ __forceinline__ float ssq_sum(const float* ssq, int row) { const f32x4* p = (const f32x4*)(ssq + (size_t)row * 16); const f32x4 a = p[0], b = p[1], c = p[2], d = p[3];
    return ((a[0] + a[1]) + (a[2] + a[3])) + ((b[0] + b[1]) + (b[2] + b[3])) + (((c[0] + c[1]) + (c[2] + c[3])) + ((d[0] + d[1]) + (d[2] + d[3]))); }
__device__ __forceinline__ float rstd_of(const float* ssq, int row) { return rsqrtf(ssq_sum(ssq, row) * (1.0f / 1024.0f) + NORM_EPS); }
__device__ __forceinline__ float sigm(float x) { return __builtin_amdgcn_rcpf(1.0f + __expf(-x)); }
struct EpiGU { static constexpr bool PERM = true, AFTER_DRAIN = false;
    bf16_t* H; const float* ssq;
    __device__ __forceinline__ void operator()(const f32x4 (&acc)[2][2][4][2], const Unit& u, int wr, int wc, int fr, int fq) const {
        int row0 = u.pm * BM + wr * 64 + fr; asm volatile("" : "+v"(row0)); const int col0 = u.pn * 128 + wc * 32 + 8 * fq;
#pragma unroll
        for (int ai = 0; ai < 2; ++ai)
#pragma unroll
            for (int m = 0; m < 4; ++m) { const int row = row0 + ai * HALF + m * 16; const float rs = rstd_of(ssq, row);
                const float nk = -1.4426950408889634f * rs, rs2 = rs * rs; u32x4 w;
#pragma unroll
                for (int n = 0; n < 2; ++n) { const f32x4 ag = acc[ai][0][m][n], au = acc[ai][1][m][n]; const f32x4 t = ag * nk; f32x4 d;
                    d[0] = __builtin_amdgcn_exp2f(t[0]); d[1] = __builtin_amdgcn_exp2f(t[1]); d[2] = __builtin_amdgcn_exp2f(t[2]); d[3] = __builtin_amdgcn_exp2f(t[3]);
                    d = d + 1.0f; f32x4 r; r[0] = __builtin_amdgcn_rcpf(d[0]); r[1] = __builtin_amdgcn_rcpf(d[1]); r[2] = __builtin_amdgcn_rcpf(d[2]); r[3] = __builtin_amdgcn_rcpf(d[3]);
                    const f32x4 hv = (ag * au) * (r * rs2);
                    if (n == 0) { w.x = cvt_pk_bf16(hv[0], hv[1]); w.y = cvt_pk_bf16(hv[2], hv[3]); } else { w.z = cvt_pk_bf16(hv[0], hv[1]); w.w = cvt_pk_bf16(hv[2], hv[3]); } }
                *(u32x4*)(H + (size_t)row * 2816 + col0) = w; }
    }
};
struct EpiRes { static constexpr bool PERM = true, AFTER_DRAIN = false;
    const float* base; float* X; bf16_t* XB; float* ssq_out; float alpha;
    __device__ __forceinline__ void operator()(const f32x4 (&acc)[2][2][4][2], const Unit& u, int wr, int wc, int fr, int fq) const {
        int row0 = u.pm * BM + wr * 64 + fr; asm volatile("" : "+v"(row0)); const int col0 = u.pn * BM + wc * 32 + 8 * fq;
#pragma unroll
        for (int ai = 0; ai < 2; ++ai)
#pragma unroll
            for (int m = 0; m < 4; ++m) { const int row = row0 + ai * HALF + m * 16; float part = 0.f;
#pragma unroll
                for (int bj = 0; bj < 2; ++bj) { const size_t off = (size_t)row * 1024 + col0 + bj * HALF;
                    const f32x4 b0 = *(const f32x4*)(base + off), b1 = *(const f32x4*)(base + off + 4);
                    const f32x4 v0 = b0 + acc[ai][bj][m][0] * alpha, v1 = b1 + acc[ai][bj][m][1] * alpha;
                    *(f32x4*)(X + off) = v0; *(f32x4*)(X + off + 4) = v1;
                    u32x4 w; w.x = cvt_pk_bf16(v0[0], v0[1]); w.y = cvt_pk_bf16(v0[2], v0[3]); w.z = cvt_pk_bf16(v1[0], v1[1]); w.w = cvt_pk_bf16(v1[2], v1[3]);
                    *(u32x4*)(XB + off) = w;
                    part += (v0[0] * v0[0] + v0[1] * v0[1]) + (v0[2] * v0[2] + v0[3] * v0[3]) + (v1[0] * v1[0] + v1[1] * v1[1]) + (v1[2] * v1[2] + v1[3] * v1[3]); }
                part += __shfl_xor(part, 16); part += __shfl_xor(part, 32);
                if (fq == 0) ssq_out[(size_t)row * 16 + u.pn * 4 + wc] = part; }
    }
};
struct EpiPle { static constexpr bool PERM = true, AFTER_DRAIN = false;
    int mode; float* X; bf16_t* XB; bf16_t* PP; const float* ssq_in; float* ssq_out;
    __device__ __forceinline__ void operator()(const f32x4 (&acc)[2][2][4][2], const Unit& u, int wr, int wc, int fr, int fq) const {
        int row0 = u.pm * BM + wr * 64 + fr; asm volatile("" : "+v"(row0)); const int col0 = u.pn * BM + wc * 32 + 8 * fq;
#pragma unroll
        for (int ai = 0; ai < 2; ++ai)
#pragma unroll
            for (int m = 0; m < 4; ++m) { const int row = row0 + ai * HALF + m * 16; float part = 0.f; const float rs = mode ? rstd_of(ssq_in, row) : 1.f;
#pragma unroll
                for (int bj = 0; bj < 2; ++bj) { const size_t off = (size_t)row * 1024 + col0 + bj * HALF;
                    if (mode == 0) { const f32x4 v0 = acc[ai][bj][m][0], v1 = acc[ai][bj][m][1];
                        u32x4 w; w.x = cvt_pk_bf16(v0[0], v0[1]); w.y = cvt_pk_bf16(v0[2], v0[3]); w.z = cvt_pk_bf16(v1[0], v1[1]); w.w = cvt_pk_bf16(v1[2], v1[3]);
                        *(u32x4*)(PP + off) = w;
                    } else {
                        const u32x4 pw = *(const u32x4*)(PP + off);
                        const f32x4 p0 = {__uint_as_float(pw.x << 16), __uint_as_float(pw.x & 0xffff0000u), __uint_as_float(pw.y << 16), __uint_as_float(pw.y & 0xffff0000u)};
                        const f32x4 p1 = {__uint_as_float(pw.z << 16), __uint_as_float(pw.z & 0xffff0000u), __uint_as_float(pw.w << 16), __uint_as_float(pw.w & 0xffff0000u)};
                        const f32x4 b0 = *(const f32x4*)(X + off), b1 = *(const f32x4*)(X + off + 4);
                        const f32x4 a0 = acc[ai][bj][m][0] * rs, a1 = acc[ai][bj][m][1] * rs;
                        f32x4 v0, v1;
#pragma unroll
                        for (int j = 0; j < 4; ++j) { v0[j] = b0[j] + sigm(a0[j]) * p0[j]; v1[j] = b1[j] + sigm(a1[j]) * p1[j]; }
                        *(f32x4*)(X + off) = v0; *(f32x4*)(X + off + 4) = v1;
                        u32x4 w; w.x = cvt_pk_bf16(v0[0], v0[1]); w.y = cvt_pk_bf16(v0[2], v0[3]); w.z = cvt_pk_bf16(v1[0], v1[1]); w.w = cvt_pk_bf16(v1[2], v1[3]);
                        if (XB) *(u32x4*)(XB + off) = w;
                        part += (v0[0] * v0[0] + v0[1] * v0[1]) + (v0[2] * v0[2] + v0[3] * v0[3]) + (v1[0] * v1[0] + v1[1] * v1[1]) + (v1[2] * v1[2] + v1[3] * v1[3]); } }
                if (mode) { part += __shfl_xor(part, 16); part += __shfl_xor(part, 32); if (fq == 0) ssq_out[(size_t)row * 16 + u.pn * 4 + wc] = part; } }
    }
};
struct EpiStore { static constexpr bool PERM = true, AFTER_DRAIN = false;
    bf16_t* O; int ldc; const float* ssq; float scale0; int scale_tiles; int split_tiles; size_t split_stride; int lf_tile; float* LF; const float* bfv;
    __device__ __forceinline__ void operator()(const f32x4 (&acc)[2][2][4][2], const Unit& u, int wr, int wc, int fr, int fq) const {
        int row0 = u.pm * BM + wr * 64 + fr; asm volatile("" : "+v"(row0));
        if (u.pn == lf_tile) {
            if (wc == 0 && fq < 2) {
#pragma unroll
                for (int ai = 0; ai < 2; ++ai)
#pragma unroll
                    for (int m = 0; m < 4; ++m) { const int row = row0 + ai * HALF + m * 16; const float rs = rstd_of(ssq, row);
#pragma unroll
                        for (int n = 0; n < 2; ++n) { f32x4 o;
#pragma unroll
                            for (int j = 0; j < 4; ++j) { const float z = fmaxf(acc[ai][0][m][n][j] * rs + bfv[8 * fq + 4 * n + j], -80.f), e = __expf(-z);
                                o[j] = (e < 0.01f) ? -(e - 0.5f * e * e + e * e * e * (1.f / 3.f)) : -__logf(1.f + e); }
                            *(f32x4*)(LF + (size_t)row * 16 + 8 * fq + 4 * n) = o; } }
            }
            return;
        }
        const int t = u.pn / split_tiles, ct = u.pn - t * split_tiles;
        bf16_t* base = O + (size_t)t * split_stride; const float sc = (u.pn < scale_tiles) ? scale0 : 1.f;
        const int col0 = ct * BM + wc * 32 + 8 * fq;
#pragma unroll
        for (int ai = 0; ai < 2; ++ai)
#pragma unroll
            for (int m = 0; m < 4; ++m) { const int row = row0 + ai * HALF + m * 16; const float rs = rstd_of(ssq, row) * sc;
#pragma unroll
                for (int bj = 0; bj < 2; ++bj) { const f32x4 v0 = acc[ai][bj][m][0] * rs, v1 = acc[ai][bj][m][1] * rs;
                    u32x4 w; w.x = cvt_pk_bf16(v0[0], v0[1]); w.y = cvt_pk_bf16(v0[2], v0[3]); w.z = cvt_pk_bf16(v1[0], v1[1]); w.w = cvt_pk_bf16(v1[2], v1[3]);
                    *(u32x4*)(base + (size_t)row * ldc + col0 + bj * HALF) = w; } }
    }
};

template <class Epi, class Sched, bool ALIGN_EPI = false, bool SP2 = false>
__device__ __forceinline__ void gemm_phase(PG8_LAS unsigned char* lds, const Gemm g, const Sched& S, const Epi& E, const int tid) {
    const int wid = __builtin_amdgcn_readfirstlane(tid >> 6), lane = tid & 63, wr = wid >> 2, wc = wid & 3, fr = lane & 15, fq = lane >> 4;
    const int K = g.K, nt = K / BK;
    unsigned voffA[2], voffB[2];
#pragma unroll
    for (int i = 0; i < 2; ++i) { int R, C; stage_rc(tid * 16 + i * 8192, R, C); const int Rb = Epi::PERM ? ((R & ~31) + perm32(R & 31)) : R;
        voffA[i] = (unsigned)(R * K + C) * 2u; voffB[i] = (unsigned)(Rb * K + C) * 2u; }
    const size_t kstep = (size_t)(BK * 2);
    const size_t hstep = (size_t)HALF * K * 2;
    const size_t tstep = 2 * hstep;
    const unsigned ldsw = (unsigned)wid * 1024u;
    const int aoff = lds_byte(wr * 64 + fr, fq * 8), boff = lds_byte(wc * 32 + fr, fq * 8);
#define PG8_SA(b, h) (((b) * 2 + (h)) * HTB)
#define PG8_SB(b, h) ((4 + (b) * 2 + (h)) * HTB)
#define PG8_STAGE(bufoff, gbase, voff) do { _Pragma("unroll") for (int _i = 0; _i < 2; ++_i) \
        __builtin_amdgcn_global_load_lds((const unsigned*)((const char*)(gbase) + (voff)[_i]), (PG8_LAS unsigned*)(lds + (bufoff) + ldsw + _i * 8192), 16, 0, 0); } while (0)
#define PG8_LDA(dst, b, h) do { _Pragma("unroll") for (int m = 0; m < 4; ++m) _Pragma("unroll") for (int k = 0; k < 2; ++k) dst[m][k] = *(const PG8_LAS bf16x8*)(lds + PG8_SA(b, h) + aoff + m * 2048 + k * 1024); } while (0)
#define PG8_LDB(dst, b, h) do { _Pragma("unroll") for (int n = 0; n < 2; ++n) _Pragma("unroll") for (int k = 0; k < 2; ++k) dst[n][k] = *(const PG8_LAS bf16x8*)(lds + PG8_SB(b, h) + boff + n * 2048 + k * 1024); } while (0)
#define PG8_MMA(ai, bj, At, Bt) do { __builtin_amdgcn_s_setprio(1); _Pragma("unroll") for (int m = 0; m < 4; ++m) _Pragma("unroll") for (int n = 0; n < 2; ++n) _Pragma("unroll") for (int k = 0; k < 2; ++k) \
        acc[ai][bj][m][n] = __builtin_amdgcn_mfma_f32_16x16x32_bf16(Bt[n][k], At[m][k], acc[ai][bj][m][n], 0, 0, 0); __builtin_amdgcn_s_setprio(0); } while (0)
#define PG8_WAIT_V(n) asm volatile("s_waitcnt vmcnt(" #n ")" ::: "memory")
#define PG8_WAIT_L(n) asm volatile("s_waitcnt lgkmcnt(" #n ")" ::: "memory")
#define PG8_BAR __builtin_amdgcn_s_barrier()
#define PG8_SCHED __builtin_amdgcn_sched_barrier(0)
    Unit cur, nxt; int ui = 0;
    if (!S.next(0, cur)) return;
    f32x4 acc[2][2][4][2];
#pragma unroll
    for (int a = 0; a < 2; ++a)
#pragma unroll
        for (int b = 0; b < 2; ++b)
#pragma unroll
            for (int m = 0; m < 4; ++m)
#pragma unroll
                for (int n = 0; n < 2; ++n) acc[a][b][m][n] = (f32x4){0.f, 0.f, 0.f, 0.f};
    bf16x8 At[4][2], B0[2][2], B1[2][2];
    const char* cA = (const char*)g.A + (size_t)cur.pm * tstep; const char* cB = (const char*)g.Bt + (size_t)cur.pn * tstep;
    S.a_ready(cur);
    if constexpr (SP2) {
        PG8_STAGE(PG8_SB(0, 0), cB, voffB); PG8_STAGE(PG8_SB(0, 1), cB + hstep, voffB); PG8_STAGE(PG8_SA(0, 0), cA, voffA); PG8_STAGE(PG8_SA(0, 1), cA + hstep, voffA);
        if (wr == 1) PG8_BAR;
        PG8_WAIT_V(2); PG8_BAR;
        PG8_STAGE(PG8_SB(1, 0), cB + kstep, voffB); PG8_STAGE(PG8_SA(1, 0), cA + kstep, voffA); PG8_STAGE(PG8_SB(1, 1), cB + hstep + kstep, voffB);
        PG8_WAIT_V(6); PG8_BAR;
    } else {
        PG8_STAGE(PG8_SB(0, 0), cB, voffB); PG8_STAGE(PG8_SA(0, 0), cA, voffA); PG8_STAGE(PG8_SB(0, 1), cB + hstep, voffB); PG8_STAGE(PG8_SA(0, 1), cA + hstep, voffA);
        if (wr == 1) PG8_BAR;
        PG8_WAIT_V(4); PG8_BAR;
        PG8_STAGE(PG8_SB(1, 0), cB + kstep, voffB); PG8_STAGE(PG8_SA(1, 0), cA + kstep, voffA); PG8_STAGE(PG8_SB(1, 1), cB + hstep + kstep, voffB);
        PG8_WAIT_V(6); PG8_BAR;
    }
    for (;;) {
        const bool has_next = S.next(ui + 1, nxt);
        const char* nA = has_next ? (const char*)g.A + (size_t)nxt.pm * tstep : cA; const char* nB = has_next ? (const char*)g.Bt + (size_t)nxt.pn * tstep : cB;
        for (int t = 0; t < nt; t += 2) {
            const bool last = (t == nt - 2);
            const char* a1 = cA + (size_t)(t + 1) * kstep;
            const char* a2 = last ? nA : cA + (size_t)(t + 2) * kstep; const char* b2 = last ? nB : cB + (size_t)(t + 2) * kstep;
            const char* a3 = a2 + kstep; const char* b3 = b2 + kstep;
            if (last && has_next) S.a_ready(nxt);
            if constexpr (SP2) {
            PG8_LDB(B0, 0, 0); PG8_LDB(B1, 0, 1); PG8_SCHED; PG8_LDA(At, 0, 0); PG8_STAGE(PG8_SA(1, 1), a1 + hstep, voffA);
            PG8_WAIT_V(8); PG8_WAIT_L(0); PG8_BAR; PG8_MMA(0, 0, At, B0); PG8_MMA(0, 1, At, B1); PG8_BAR; PG8_SCHED;
            PG8_LDA(At, 0, 1); PG8_STAGE(PG8_SB(0, 0), b2, voffB); PG8_STAGE(PG8_SB(0, 1), b2 + hstep, voffB); PG8_STAGE(PG8_SA(0, 0), a2, voffA);
            PG8_WAIT_V(8); PG8_WAIT_L(0); PG8_BAR; PG8_MMA(1, 0, At, B0); PG8_MMA(1, 1, At, B1); PG8_BAR; PG8_SCHED;
            PG8_LDB(B0, 1, 0); PG8_LDB(B1, 1, 1); PG8_SCHED; PG8_LDA(At, 1, 0); PG8_STAGE(PG8_SA(0, 1), a2 + hstep, voffA);
            PG8_WAIT_V(8); PG8_WAIT_L(0); PG8_BAR; PG8_MMA(0, 0, At, B0); PG8_MMA(0, 1, At, B1); PG8_BAR; PG8_SCHED;
            PG8_LDA(At, 1, 1); PG8_STAGE(PG8_SB(1, 0), b3, voffB); PG8_STAGE(PG8_SB(1, 1), b3 + hstep, voffB); PG8_STAGE(PG8_SA(1, 0), a3, voffA);
            PG8_WAIT_V(8); PG8_WAIT_L(0); PG8_BAR; PG8_MMA(1, 0, At, B0); PG8_MMA(1, 1, At, B1); PG8_BAR; PG8_SCHED;
            } else {
            PG8_LDB(B0, 0, 0); PG8_SCHED; PG8_LDA(At, 0, 0); PG8_STAGE(PG8_SA(1, 1), a1 + hstep, voffA);
            PG8_WAIT_L(8); PG8_BAR; PG8_WAIT_L(0); PG8_MMA(0, 0, At, B0); PG8_BAR; PG8_SCHED;
            PG8_LDB(B1, 0, 1); PG8_STAGE(PG8_SB(0, 0), b2, voffB);
            PG8_BAR; PG8_WAIT_L(0); PG8_MMA(0, 1, At, B1); PG8_BAR;
            PG8_LDA(At, 0, 1); PG8_STAGE(PG8_SA(0, 0), a2, voffA);
            PG8_BAR; PG8_WAIT_L(0); PG8_MMA(1, 0, At, B0); PG8_BAR; PG8_SCHED;
            PG8_STAGE(PG8_SB(0, 1), b2 + hstep, voffB);
            PG8_WAIT_V(6); PG8_BAR; PG8_MMA(1, 1, At, B1); PG8_BAR;
            PG8_LDB(B0, 1, 0); PG8_SCHED; PG8_LDA(At, 1, 0); PG8_STAGE(PG8_SA(0, 1), a2 + hstep, voffA);
            PG8_WAIT_L(8); PG8_BAR; PG8_WAIT_L(0); PG8_MMA(0, 0, At, B0); PG8_BAR; PG8_SCHED;
            PG8_LDB(B1, 1, 1); PG8_STAGE(PG8_SB(1, 0), b3, voffB);
            PG8_BAR; PG8_WAIT_L(0); PG8_MMA(0, 1, At, B1); PG8_BAR;
            PG8_LDA(At, 1, 1); PG8_STAGE(PG8_SA(1, 0), a3, voffA);
            PG8_BAR; PG8_WAIT_L(0); PG8_MMA(1, 0, At, B0); PG8_BAR; PG8_SCHED;
            PG8_STAGE(PG8_SB(1, 1), b3 + hstep, voffB);
            PG8_WAIT_V(6); PG8_BAR; PG8_MMA(1, 1, At, B1); PG8_BAR;
            }
        }
        if constexpr (ALIGN_EPI) { if (wr == 0) PG8_BAR; }
        if constexpr (!Epi::AFTER_DRAIN) { E(acc, cur, wr, wc, fr, fq); S.done(cur); }
        if (!has_next) break;
#pragma unroll
        for (int a = 0; a < 2; ++a)
#pragma unroll
            for (int b = 0; b < 2; ++b)
#pragma unroll
                for (int m = 0; m < 4; ++m)
#pragma unroll
                    for (int n = 0; n < 2; ++n) acc[a][b][m][n] = (f32x4){0.f, 0.f, 0.f, 0.f};
        cur = nxt; cA = nA; cB = nB; ++ui;
        if constexpr (ALIGN_EPI) { if (wr == 1) PG8_BAR; }
    }
    PG8_WAIT_V(0);
    if constexpr (!ALIGN_EPI) { if (wr == 0) PG8_BAR; }
    PG8_BAR;
    if constexpr (Epi::AFTER_DRAIN) { E.fused(acc, cur, wr, wc, fr, fq, lds, wid, lane); S.done(cur); }
#undef PG8_SA
#undef PG8_SB
#undef PG8_STAGE
#undef PG8_LDA
#undef PG8_LDB
#undef PG8_MMA
#undef PG8_WAIT_V
#undef PG8_WAIT_L
#undef PG8_BAR
#undef PG8_SCHED
}
}
#include <hip/hip_bf16.h>
#include <cmath>
namespace attn_body {
using bf16=__hip_bfloat16;
using bf16x8=__attribute__((ext_vector_type(8)))short;
using s16x4=__attribute__((ext_vector_type(4)))short;
using f32x16=__attribute__((ext_vector_type(16)))float;
using u32x4=__attribute__((ext_vector_type(4)))unsigned;
constexpr int BATCH=4,NHEAD=16,SEQ=4096,D=64,DM=NHEAD*D;
constexpr int NW=8,QBLK=32,QB=QBLK*NW,KVBLK=64,NQB=SEQ/QB;
constexpr int ATTN_PITCH=DM, ATTN_UNIT_ROWS=QB;
__device__ __forceinline__ int crow(int r,int hi){return (r&3)+8*(r>>2)+4*hi;}
#define SBAR() __builtin_amdgcn_sched_barrier(0)
__device__ __forceinline__ void cmask(f32x16&p0,f32x16&p1,int jb,int qrel,int hi){
  const float NEG=-INFINITY; int kb=64*jb+4*hi;
  #pragma unroll
  for(int r=0;r<16;++r){int kv=kb+(r&3)+8*(r>>2); if(kv>qrel)p0[r]=NEG; if(kv+32>qrel)p1[r]=NEG;}
}

constexpr int NSLOT=3, SLOTB=8192;
constexpr int LDS_K=0, LDS_V=NSLOT*SLOTB, LDS_WS=2*NSLOT*SLOTB, LDS_OST=LDS_WS+NW*64*4, LDS_BYTES=LDS_OST+NW*4096;
constexpr float C2=0.125f*1.4426950408889634f;
__device__ __forceinline__ void glds16(const void*gsrc,unsigned lds_dst){unsigned keep;
  asm volatile("s_mov_b32 %0, m0\n\ts_mov_b32 m0, %2\n\ts_nop 0\n\tglobal_load_lds_dwordx4 %1, off\n\ts_mov_b32 m0, %0":"=&s"(keep):"v"(gsrc),"s"(lds_dst):"memory");}
__device__ __forceinline__ float max3f(float a,float b,float c){float r;asm("v_max3_f32 %0, %1, %2, %3":"=v"(r):"v"(a),"v"(b),"v"(c));return r;}
__device__ __forceinline__ float max2f(float a,float b){float r;asm("v_max_f32_e32 %0, %1, %2":"=v"(r):"v"(a),"v"(b));return r;}
__device__ __forceinline__ float fadd_s(float a,float b){float r;asm("v_add_f32_e32 %0, %1, %2":"=v"(r):"v"(a),"v"(b));return r;}
__device__ __forceinline__ float fsub_s(float a,float b){float r;asm("v_sub_f32_e32 %0, %1, %2":"=v"(r):"v"(a),"v"(b));return r;}
typedef float f32x2_t __attribute__((ext_vector_type(2))); typedef __bf16 bf16x2_t __attribute__((ext_vector_type(2)));
__device__ __forceinline__ unsigned cvtpk_s(float lo,float hi){f32x2_t v={lo,hi};bf16x2_t b=__builtin_convertvector(v,bf16x2_t);return __builtin_bit_cast(unsigned,b);}
#define WAIT_BAR(N) asm volatile("s_waitcnt vmcnt(" #N ") lgkmcnt(0)\n\ts_barrier":::"memory")

__device__ __forceinline__ void qkt(f32x16&p0,f32x16&p1,const char*Kslot,const bf16x8*qr,int r32,int hi){
  const char*kb=Kslot+hi*1024+r32*16;
  #pragma unroll
  for(int d0=0;d0<4;++d0){
    const bf16x8 b0=*reinterpret_cast<const bf16x8*>(kb+d0*2048);
    const bf16x8 b1=*reinterpret_cast<const bf16x8*>(kb+d0*2048+512);
    {p0=__builtin_amdgcn_mfma_f32_32x32x16_bf16(b0,qr[d0],p0,0,0,0);p1=__builtin_amdgcn_mfma_f32_32x32x16_bf16(b1,qr[d0],p1,0,0,0);}}
}
typedef __attribute__((address_space(3))) const char* lds_cptr;
typedef short v4i16_t __attribute__((ext_vector_type(4)));
__device__ __forceinline__ void kload8(bf16x8*kf,lds_cptr kp){
  kf[0]=*(const __attribute__((address_space(3))) bf16x8*)(kp);      kf[1]=*(const __attribute__((address_space(3))) bf16x8*)(kp+512);
  kf[2]=*(const __attribute__((address_space(3))) bf16x8*)(kp+2048); kf[3]=*(const __attribute__((address_space(3))) bf16x8*)(kp+2560);
  kf[4]=*(const __attribute__((address_space(3))) bf16x8*)(kp+4096); kf[5]=*(const __attribute__((address_space(3))) bf16x8*)(kp+4608);
  kf[6]=*(const __attribute__((address_space(3))) bf16x8*)(kp+6144); kf[7]=*(const __attribute__((address_space(3))) bf16x8*)(kp+6656);
}
__device__ __forceinline__ void kload2(bf16x8*kf,lds_cptr kp,int j){ kf[2*j]=*(const __attribute__((address_space(3))) bf16x8*)(kp+j*2048); kf[2*j+1]=*(const __attribute__((address_space(3))) bf16x8*)(kp+j*2048+512); }
__device__ __forceinline__ s16x4 vtr(lds_cptr p){ return __builtin_bit_cast(s16x4,__builtin_amdgcn_ds_read_tr16_b64_v4i16((__attribute__((address_space(3))) v4i16_t*)p)); }
__device__ __forceinline__ float rowmax(const f32x16&p0,const f32x16&p1){
  float a=max3f(p0[0],p0[1],p1[0]),b=max3f(p0[2],p0[3],p1[1]);a=max3f(a,p1[2],p1[3]);
  #pragma unroll
  for(int r=4;r<16;r+=4){a=max3f(a,p0[r],p0[r+1]);b=max3f(b,p0[r+2],p0[r+3]);a=max3f(a,p1[r],p1[r+1]);b=max3f(b,p1[r+2],p1[r+3]);}
  const float m=max2f(a,b);
  auto rr=__builtin_amdgcn_permlane32_swap(__float_as_uint(m),__float_as_uint(m),false,false);
  return max2f(__uint_as_float(rr[0]),__uint_as_float(rr[1]));
}
__device__ __forceinline__ void pv(f32x16*o,int vb,bf16x8 pa0,bf16x8 pa1,bf16x8 pa2,bf16x8 pa3){
  #pragma unroll
  for(int d0=0;d0<2;++d0){s16x4 lo[4],hi[4];
    #pragma unroll
    for(int ks=0;ks<4;++ks){
      asm volatile("ds_read_b64_tr_b16 %0,%1 offset:%c2":"=&v"(lo[ks]):"v"(vb),"i"(d0*4096+ks*1024):"memory");
      asm volatile("ds_read_b64_tr_b16 %0,%1 offset:%c2":"=&v"(hi[ks]):"v"(vb),"i"(d0*4096+ks*1024+512):"memory");}
    asm volatile("s_waitcnt lgkmcnt(0)":::"memory");SBAR();
    #define PK(k) (bf16x8){lo[k][0],lo[k][1],lo[k][2],lo[k][3],hi[k][0],hi[k][1],hi[k][2],hi[k][3]}
    o[d0]=__builtin_amdgcn_mfma_f32_32x32x16_bf16(pa0,PK(0),o[d0],0,0,0);
    o[d0]=__builtin_amdgcn_mfma_f32_32x32x16_bf16(pa1,PK(1),o[d0],0,0,0);
    o[d0]=__builtin_amdgcn_mfma_f32_32x32x16_bf16(pa2,PK(2),o[d0],0,0,0);
    o[d0]=__builtin_amdgcn_mfma_f32_32x32x16_bf16(pa3,PK(3),o[d0],0,0,0);
    #undef PK
  }
}

#ifndef ATTN_STORE16
#define ATTN_STORE16(p,v) (*(u32x4*)(p)=(v))
#endif
typedef float f32x4b __attribute__((ext_vector_type(4)));
typedef __attribute__((address_space(3))) const float* lds_fptr;
typedef __attribute__((address_space(3))) const f32x4b* lds_f4ptr;
template<int THRL> __device__ __forceinline__ void attn_unit(int b,int h,int qb,const bf16*Q,const bf16*__restrict__ K,const bf16*__restrict__ V,bf16*O,char*shm,lds_fptr cs,const int tid){
  const int lane=tid&63,r32=lane&31,hi=lane>>5; const int wid=__builtin_amdgcn_readfirstlane(tid>>6);
  const long rowbase=(long)b*SEQ; const int q0=qb*QB;
  const bf16*Qw=Q+(rowbase+q0+wid*QBLK)*DM+h*D;
  const bf16*Kh=K+rowbase*DM+h*D,*Vh=V+rowbase*DM+h*D;
  const unsigned lds0=(unsigned)(uintptr_t)shm;
  float*wsf=(float*)(shm+LDS_WS)+wid*64;
  const bf16*ksrc=Kh+(long)lane*DM+wid*8;
  const bf16*vsrc=Vh+(long)(16*(wid&3)+(lane>>2))*DM+(wid>>2)*32+(lane&3)*8;
  const unsigned kdst=lds0+LDS_K+wid*1024, vdst=lds0+LDS_V+wid*1024;
  #define DMA_K(t,slot) glds16(ksrc+(long)(t)*KVBLK*DM,(unsigned)__builtin_amdgcn_readfirstlane(kdst+(slot)))
  #define DMA_V(t,slot) glds16(vsrc+(long)(t)*KVBLK*DM,(unsigned)__builtin_amdgcn_readfirstlane(vdst+(slot)))
  const int vb0=(int)(lds0+LDS_V)+((lane>>4)&1)*32+(lane&3)*8+(4*hi+((lane&15)>>2))*64;
  const char*Kbase=shm+LDS_K; bf16x8 kf[8];
  const lds_cptr shm3=(lds_cptr)shm; const lds_cptr kp0=shm3+LDS_K+hi*1024+r32*16; const lds_cptr vp0=shm3+LDS_V+((lane>>4)&1)*32+(lane&3)*8+(4*hi+((lane&15)>>2))*64;
  const int NT=(q0+QB)/KVBLK;
  DMA_K(0,0);DMA_V(0,0);DMA_K(1,SLOTB);
  bf16x8 qr[4];
  #pragma unroll
  for(int d0=0;d0<4;++d0)qr[d0]=*reinterpret_cast<const bf16x8*>(&Qw[(long)r32*DM+d0*16+hi*8]);
  const int qrel=wid*QBLK+r32;
  typedef __attribute__((address_space(3))) const unsigned long long* lds_u64p; typedef unsigned u32x2b __attribute__((ext_vector_type(2)));
  const lds_u64p ctr=(lds_u64p)cs;
  float ci2; { const unsigned long long w_=ctr[q0+qrel]; ci2=__uint_as_float((unsigned)w_<<16)+__uint_as_float((unsigned)w_&0xffff0000u)+__uint_as_float((unsigned)(w_>>32)<<16); }
  float mhat=0.f,l_reg=0.f;f32x16 o[2];o[0]=f32x16{};o[1]=f32x16{};float nm=ci2; bf16x8 bnm;
  #define MKBNM() do{ const unsigned h1_=cvtpk_s(nm,0.f)&0xffffu; const float r1_=nm-__uint_as_float(h1_<<16); const unsigned h2_=cvtpk_s(r1_,0.f)&0xffffu; const float r2_=r1_-__uint_as_float(h2_<<16); const unsigned h3_=cvtpk_s(r2_,0.f)&0xffffu; \
    u32x4 b_; b_.x=hi?0u:0xBF80BF80u; b_.y=hi?0u:(0xBF80u|(h1_<<16)); b_.z=hi?0u:(h2_|(h3_<<16)); b_.w=0u; bnm=__builtin_bit_cast(bf16x8,b_); }while(0)
  MKBNM();
  #define CINIT(P0,P1,t) do{ const unsigned long long w0_=ctr[64*(t)+r32], w1_=ctr[64*(t)+32+r32]; \
    u32x4 a0_; a0_.x=(unsigned)w0_; a0_.y=(unsigned)(w0_>>32)|0x3F800000u; a0_.z=0x3F803F80u; a0_.w=0u; u32x4 a1_; a1_.x=(unsigned)w1_; a1_.y=(unsigned)(w1_>>32)|0x3F800000u; a1_.z=0x3F803F80u; a1_.w=0u; \
    P0=__builtin_amdgcn_mfma_f32_32x32x16_bf16(__builtin_bit_cast(bf16x8,a0_),bnm,f32x16{},0,0,0); P1=__builtin_amdgcn_mfma_f32_32x32x16_bf16(__builtin_bit_cast(bf16x8,a1_),bnm,f32x16{},0,0,0); }while(0)
  #define CMASK(P0,P1,t) do{int jb_=(t)-(NT-4); if(jb_>=0)cmask(P0,P1,jb_,qrel,hi);}while(0)
  bool resc=false;
  #define START(P0,P1) do{ const float rm=rowmax(P0,P1); resc=false; \
    { const float dl=rm; mhat=fadd_s(mhat,dl); \
      _Pragma("unroll") for(int r=0;r<16;++r){P0[r]=fsub_s(P0[r],dl);P1[r]=fsub_s(P1[r],dl);} \
      nm=ci2-mhat; MKBNM(); } \
    _Pragma("unroll") for(int r=0;r<16;++r)P0[r]=__builtin_amdgcn_exp2f(P0[r]); }while(0)
  #define RESC() do{ if(resc){ asm volatile("s_waitcnt lgkmcnt(0)":::"memory"); \
      _Pragma("unroll") for(int d_=0;d_<2;++d_) _Pragma("unroll") for(int r=0;r<16;++r)o[d_][r]*=wsf[crow(r,hi)]; } }while(0)
  f32x16 pA0,pA1,pB0,pB1;
  int sl_prev=0,sl_cur=0,sl_next=SLOTB;
  #define ROT() do{sl_prev=sl_cur;sl_cur=sl_next;sl_next=(sl_next==(NSLOT-1)*SLOTB)?0:sl_next+SLOTB;}while(0)
  DMA_K(2,2*SLOTB);
  WAIT_BAR(3);
  CINIT(pA0,pA1,0);qkt(pA0,pA1,Kbase,qr,r32,hi);asm volatile("s_nop 15\n\ts_nop 7":"+v"(pA0),"+v"(pA1));CMASK(pA0,pA1,0);
  START(pA0,pA1);
  _Pragma("unroll") for(int r=0;r<16;++r)pA1[r]=__builtin_amdgcn_exp2f(pA1[r]);
  WAIT_BAR(0);
  DMA_K(3,0);DMA_V(1,SLOTB);
  ROT();
  kload8(kf,kp0+sl_cur);
  WAIT_BAR(2);
  s16x4 vlo[8],vhi[8]; u32x4 pw0,pw1,pw2,pw3;
  #define PKW(P,B) cvtpk_s(P[B],P[B+1])
  #define PAF(k) __builtin_bit_cast(bf16x8,pw##k)
  #define VFR(i) (bf16x8){vlo[i][0],vlo[i][1],vlo[i][2],vlo[i][3],vhi[i][0],vhi[i][1],vhi[i][2],vhi[i][3]}
  #define PIN(x) asm volatile("":"+v"(x))
  #define MX3(a,b,c) __builtin_fmaxf(__builtin_fmaxf((a),(b)),(c))
  #define GAPA(MF,A0,A1,A2,A3,W0,W1,PW) do{ MF; sacc+=A0; sacc+=A1; sacc+=A2; sacc+=A3; PIN(sacc); W0; W1; PIN(PW); SBAR(); }while(0)
  #define EX(v) __builtin_amdgcn_exp2f(v)
  #define GAPB(MF,X,B) do{ MF; X[B]=EX(X[B]); X[B+1]=EX(X[B+1]); X[B+2]=EX(X[B+2]); X[B+3]=EX(X[B+3]); PIN(X); SBAR(); }while(0)
  #define VRD(i) do{ vlo[i]=vtr(vp_+(((i)>>2)*4096+((i)&3)*1024)); vhi[i]=vtr(vp_+(((i)>>2)*4096+((i)&3)*1024+512)); }while(0)
  #define KRD(G,j) do{ if(G){ kload2(kf,kp0+sl_next,j); SBAR(); } }while(0)
  #define STEP(C0,C1,P0,P1,t,GK,GV,GL) do{ SBAR(); \
    const lds_cptr vp_=vp0+sl_prev; CINIT(C0,C1,t); SBAR(); \
    VRD(0); SBAR(); float sacc=(P0[0]+P0[1]); \
    GAPA(C0=__builtin_amdgcn_mfma_f32_32x32x16_bf16(kf[0],qr[0],C0,0,0,0), P0[2],P0[3],P0[4],P0[5],     pw0[0]=PKW(P0,0), pw0[1]=PKW(P0,2), pw0); \
    VRD(4); SBAR(); GAPA(C1=__builtin_amdgcn_mfma_f32_32x32x16_bf16(kf[1],qr[0],C1,0,0,0), P0[6],P0[7],P0[8],P0[9],     pw0[2]=PKW(P0,4), pw0[3]=PKW(P0,6), pw0); \
    VRD(1); SBAR(); GAPA(C0=__builtin_amdgcn_mfma_f32_32x32x16_bf16(kf[2],qr[1],C0,0,0,0),   P0[10],P0[11],P0[12],P0[13], pw1[0]=PKW(P0,8), pw1[1]=PKW(P0,10), pw1); \
    VRD(5); SBAR(); GAPA(C1=__builtin_amdgcn_mfma_f32_32x32x16_bf16(kf[3],qr[1],C1,0,0,0),   P0[14],P0[15],P1[0],P1[1],   pw1[2]=PKW(P0,12),pw1[3]=PKW(P0,14), pw1); \
    VRD(2); SBAR(); GAPA(C0=__builtin_amdgcn_mfma_f32_32x32x16_bf16(kf[4],qr[2],C0,0,0,0),   P1[2],P1[3],P1[4],P1[5],     pw2[0]=PKW(P1,0), pw2[1]=PKW(P1,2), pw2); \
    VRD(6); SBAR(); GAPA(C1=__builtin_amdgcn_mfma_f32_32x32x16_bf16(kf[5],qr[2],C1,0,0,0),   P1[6],P1[7],P1[8],P1[9],     pw2[2]=PKW(P1,4), pw2[3]=PKW(P1,6), pw2); \
    VRD(3); SBAR(); GAPA(C0=__builtin_amdgcn_mfma_f32_32x32x16_bf16(kf[6],qr[3],C0,0,0,0),   P1[10],P1[11],P1[12],P1[13], pw3[0]=PKW(P1,8), pw3[1]=PKW(P1,10), pw3); \
    VRD(7); SBAR(); GAPA(C1=__builtin_amdgcn_mfma_f32_32x32x16_bf16(kf[7],qr[3],C1,0,0,0),   P1[14],P1[15],0.f,0.f,       pw3[2]=PKW(P1,12),pw3[3]=PKW(P1,14), pw3); \
    l_reg+=sacc; \
    if(GK){DMA_K((t)+3,sl_cur);} if(GV){DMA_V((t)+1,sl_next);} \
    CMASK(C0,C1,t); \
    { float a=MX3(C0[0],C0[1],C1[0]),b=MX3(C0[2],C0[3],C1[1]); a=MX3(a,C1[2],C1[3]); \
      _Pragma("unroll") for(int r=4;r<16;r+=4){a=MX3(a,C0[r],C0[r+1]);b=MX3(b,C0[r+2],C0[r+3]);a=MX3(a,C1[r],C1[r+1]);b=MX3(b,C1[r+2],C1[r+3]);} \
      float rm=__builtin_fmaxf(a,b); { auto rr=__builtin_amdgcn_permlane32_swap(__float_as_uint(rm),__float_as_uint(rm),false,false); rm=__builtin_fmaxf(__uint_as_float(rr[0]),__uint_as_float(rr[1])); } \
      resc=false; \
      if(__builtin_expect(__any(rm>(float)THRL),0)){ const float dl=__builtin_fmaxf(rm,0.f); mhat+=dl; \
        _Pragma("unroll") for(int r=0;r<16;++r){C0[r]-=dl;C1[r]-=dl;} \
        nm=ci2-mhat; MKBNM(); \
        const float f=__builtin_amdgcn_exp2f(-dl); l_reg*=f; if(hi==0)wsf[r32]=f; resc=true; } } \
    SBAR(); \
    GAPB(o[0]=__builtin_amdgcn_mfma_f32_32x32x16_bf16(PAF(0),VFR(0),o[0],0,0,0), C0,0); \
    GAPB(o[1]=__builtin_amdgcn_mfma_f32_32x32x16_bf16(PAF(0),VFR(4),o[1],0,0,0), C0,4); \
    KRD(GL,0); GAPB(o[0]=__builtin_amdgcn_mfma_f32_32x32x16_bf16(PAF(1),VFR(1),o[0],0,0,0), C0,8); \
    KRD(GL,1); GAPB(o[1]=__builtin_amdgcn_mfma_f32_32x32x16_bf16(PAF(1),VFR(5),o[1],0,0,0), C0,12); \
    KRD(GL,2); GAPB(o[0]=__builtin_amdgcn_mfma_f32_32x32x16_bf16(PAF(2),VFR(2),o[0],0,0,0), C1,0); \
    KRD(GL,3); GAPB(o[1]=__builtin_amdgcn_mfma_f32_32x32x16_bf16(PAF(2),VFR(6),o[1],0,0,0), C1,4); \
    GAPB(o[0]=__builtin_amdgcn_mfma_f32_32x32x16_bf16(PAF(3),VFR(3),o[0],0,0,0), C1,8); \
    GAPB(o[1]=__builtin_amdgcn_mfma_f32_32x32x16_bf16(PAF(3),VFR(7),o[1],0,0,0), C1,12); \
    }while(0)
  int t=1;
  #undef CMASK
  #define CMASK(P0,P1,t) do{}while(0)
  for(;t+5<NT;t+=2){
    STEP(pB0,pB1,pA0,pA1,t,true,true,true);     WAIT_BAR(2); RESC(); ROT();
    STEP(pA0,pA1,pB0,pB1,t+1,true,true,true);   WAIT_BAR(2); RESC(); ROT();
  }
  #undef CMASK
  #define CMASK(P0,P1,t) do{int jb_=(t)-(NT-4); if(jb_>=0)cmask(P0,P1,jb_,qrel,hi);}while(0)
  #define ENDW(tt) do{ if((tt)+3<NT){WAIT_BAR(2);} else if((tt)+2<NT){WAIT_BAR(1);} else {WAIT_BAR(0);} }while(0)
  for(;t+1<NT;t+=2){
    STEP(pB0,pB1,pA0,pA1,t,(t+3<NT),(t+1<NT),(t+1<NT));       ENDW(t);   RESC(); ROT();
    STEP(pA0,pA1,pB0,pB1,t+1,(t+4<NT),(t+2<NT),(t+2<NT));     ENDW(t+1); RESC(); ROT();
  }
  STEP(pB0,pB1,pA0,pA1,NT-1,false,false,false); RESC();
  { float sacc=pB0[0]+pB0[1]; _Pragma("unroll") for(int r=2;r<16;++r)sacc+=pB0[r]; _Pragma("unroll") for(int r=0;r<16;++r)sacc+=pB1[r]; l_reg+=sacc;
    pw0=(u32x4){PKW(pB0,0),PKW(pB0,2),PKW(pB0,4),PKW(pB0,6)};pw1=(u32x4){PKW(pB0,8),PKW(pB0,10),PKW(pB0,12),PKW(pB0,14)};pw2=(u32x4){PKW(pB1,0),PKW(pB1,2),PKW(pB1,4),PKW(pB1,6)};pw3=(u32x4){PKW(pB1,8),PKW(pB1,10),PKW(pB1,12),PKW(pB1,14)};
    SBAR(); pv(o,vb0+sl_cur,PAF(0),PAF(1),PAF(2),PAF(3)); }
  #undef PKW
  #undef PAF
  #undef VFR
  #undef PIN
  #undef MX3
  #undef GAPA
  #undef GAPB
  #undef EX
  #undef VRD
  #undef KRD
  #undef STEP
  #undef ENDW
  {auto rr=__builtin_amdgcn_permlane32_swap(__float_as_uint(l_reg),__float_as_uint(l_reg),false,false);l_reg=__uint_as_float(rr[0])+__uint_as_float(rr[1]);}
  if(hi==0)wsf[32+r32]=l_reg;asm volatile("s_waitcnt lgkmcnt(0)":::"memory");
  float rli[16];
  #pragma unroll
  for(int r=0;r<16;++r)rli[r]=__builtin_amdgcn_rcpf(wsf[32+crow(r,hi)]);
  bf16*Ow=O+(rowbase+q0+wid*QBLK)*DM+h*D;
  { bf16*stg=(bf16*)(shm+LDS_OST)+wid*2048;
    #pragma unroll
    for(int r=0;r<16;++r){const int orow=crow(r,hi);
      #pragma unroll
      for(int d0=0;d0<2;++d0)stg[orow*64+d0*32+r32]=__float2bfloat16(o[d0][r]*rli[r]);}
    asm volatile("s_waitcnt lgkmcnt(0)":::"memory");
    #pragma unroll
    for(int i=0;i<4;++i){const int row=i*8+(lane>>3),ch=lane&7; const u32x4 v=*(const u32x4*)(stg+row*64+ch*8); ATTN_STORE16(Ow+(long)row*DM+ch*8,v);} }
  asm volatile("s_waitcnt lgkmcnt(0)\n\ts_barrier":::"memory");
  #undef DMA_K
  #undef DMA_V
  #undef CINIT
  #undef MKBNM
  #undef CMASK
  #undef START
  #undef RESC
  #undef ROT
}
constexpr int ATTN_LDS_BYTES=LDS_BYTES;
struct AttnTensors { const bf16* Q; const bf16* K; const bf16* V; bf16* O; };
struct AttnUnit { int bh; int qb; };
struct StaticOrder {
  int vcu;
  __device__ __forceinline__ explicit StaticOrder(int grid,int block):vcu((block%8)*(grid/8)+block/8){}
  __device__ __forceinline__ bool next(int i,AttnUnit&u)const{ if(i>=4)return false; const int s=vcu&3; u.bh=vcu>>2; u.qb=(i==0)?s:(i==1)?7-s:(i==2)?8+s:15-s; return true; }
  __device__ __forceinline__ void a_ready(const AttnUnit&)const{}
  __device__ __forceinline__ void done(const AttnUnit&)const{}
};
#undef SBAR
#undef WAIT_BAR
}
#define LAS __attribute__((address_space(3)))
typedef unsigned short bf16;
typedef unsigned v4u __attribute__((ext_vector_type(4)));
typedef unsigned v2u __attribute__((ext_vector_type(2)));
typedef float f32x4 __attribute__((ext_vector_type(4)));
typedef float f32x16 __attribute__((ext_vector_type(16)));
typedef short bf16x8 __attribute__((ext_vector_type(8)));
typedef float f32x2s __attribute__((ext_vector_type(2)));

constexpr int NBATCH = 4, SEQ = 4096, M = NBATCH * SEQ, D = 1024, DFF = 2816, PLE = 256;
constexpr int EVEN_IN = 2560, FOX_IN = 3088, FOX_INP = 3328;
constexpr float LOG2E = 1.4426950408889634f;
constexpr float QSCALE = 0.125f * LOG2E;
constexpr float GN_EPS = 64e-5f;
constexpr size_t MiB = 1u << 20;
constexpr size_t WS_SSQ = 0;
constexpr size_t WS_C3 = 1 * MiB;
constexpr size_t WS_LF = 2 * MiB;
constexpr size_t WS_G2F = 3 * MiB;
constexpr size_t WS_WGU = 4 * MiB;
constexpr size_t WS_WD = 48 * MiB;
constexpr size_t WS_WG = 70 * MiB;
constexpr size_t WS_WP = 74 * MiB;
constexpr size_t WS_WIN0 = 75 * MiB, WS_WOUT0 = 80 * MiB, WS_WIN1 = 82 * MiB, WS_WOUT1 = 89 * MiB;
constexpr size_t WS_XB = 91 * MiB;
constexpr size_t WS_Y = 123 * MiB;
constexpr size_t WS_BIG = 155 * MiB;
constexpr size_t WS_PB = 243 * MiB;
constexpr size_t WS_SSQP = 251 * MiB;
constexpr size_t WS_END = 253 * MiB;
constexpr size_t WS_BAR = 0;
constexpr int LDS_BYTES = 147456, MISC_OFF = 147456 - 64;

#define LDS_WAIT() asm volatile("s_waitcnt lgkmcnt(0)" ::: "memory")
__device__ __forceinline__ unsigned pk2(float lo, float hi) { return pg8::cvt_pk_bf16(lo, hi); }
__device__ __forceinline__ float bflo(unsigned w) { return __uint_as_float(w << 16); }
__device__ __forceinline__ float bfhi(unsigned w) { return __uint_as_float(w & 0xffff0000u); }
__device__ __forceinline__ float bf2f(bf16 h) { return __uint_as_float((unsigned)h << 16); }
__device__ __forceinline__ float wave_sum(float v) {
#pragma unroll
    for (int o = 1; o < 64; o <<= 1) v += __shfl_xor(v, o);
    return v;
}
__device__ __forceinline__ int crow(int r, int hi) { return (r & 3) + 8 * (r >> 2) + 4 * hi; }
template <int CTRL> __device__ __forceinline__ float dpp_f(float x) { return __int_as_float(__builtin_amdgcn_update_dpp(0, __float_as_int(x), CTRL, 0xf, 0xf, true)); }
__device__ __forceinline__ float red16(float x) { x += dpp_f<0xB1>(x); x += dpp_f<0x4E>(x); x += dpp_f<0x141>(x); x += dpp_f<0x140>(x); return x; }
__device__ __forceinline__ float red8(float x) { x += dpp_f<0xB1>(x); x += dpp_f<0x4E>(x); x += dpp_f<0x141>(x); return x; }
__device__ __forceinline__ void unpack8(const v4u w, float (&f)[8]) { f[0] = bflo(w.x); f[1] = bfhi(w.x); f[2] = bflo(w.y); f[3] = bfhi(w.y); f[4] = bflo(w.z); f[5] = bfhi(w.z); f[6] = bflo(w.w); f[7] = bfhi(w.w); }
__device__ __forceinline__ bf16x8 pack8(const float (&f)[8]) { v4u w; w.x = pk2(f[0], f[1]); w.y = pk2(f[2], f[3]); w.z = pk2(f[4], f[5]); w.w = pk2(f[6], f[7]); return __builtin_bit_cast(bf16x8, w); }

__device__ __forceinline__ void conv_item(const float* W, int K, int N, int NP, bf16* WT, const float* gain, int mode, LAS float* scr, int item, int lane) {
    const int nblk = NP / 32, kb = item / nblk, nb = item - kb * nblk, k0 = 64 * kb, n0 = 32 * nb;
    int orow0 = n0;
    if (mode == 1) orow0 = (n0 < DFF) ? (n0 / 128) * 256 + (n0 % 128) : ((n0 - DFF) / 128) * 256 + 128 + ((n0 - DFF) % 128);
    const int nq = 4 * (lane & 7); const bool inb = (n0 + nq) < N;
#pragma unroll
    for (int i = 0; i < 8; ++i) { const int kk = 8 * i + (lane >> 3); f32x4 v = {0.f, 0.f, 0.f, 0.f}; if (inb) v = *(const f32x4*)(W + (size_t)(k0 + kk) * N + n0 + nq);
        if (gain) v = v * gain[k0 + kk];
        LAS float* d = scr + kk * 33 + nq; d[0] = v[0]; d[1] = v[1]; d[2] = v[2]; d[3] = v[3]; }
    LDS_WAIT(); asm volatile("" ::: "memory");
    const int c = lane & 7;
#pragma unroll
    for (int j = 0; j < 4; ++j) { const int nn = (lane >> 3) + 8 * j; const LAS float* s = scr + (8 * c) * 33 + nn;
        v4u o; o.x = pk2(s[0 * 33], s[1 * 33]); o.y = pk2(s[2 * 33], s[3 * 33]); o.z = pk2(s[4 * 33], s[5 * 33]); o.w = pk2(s[6 * 33], s[7 * 33]);
        *(v4u*)(WT + (size_t)(orow0 + nn) * K + k0 + 8 * c) = o; }
    LDS_WAIT(); asm volatile("" ::: "memory");
}

constexpr int VTP = 264;
__device__ __forceinline__ void swa_unit(int unit, const bf16* PROJ, bf16* Y, const float* sinks, LAS unsigned char* lds, int tid, int lane, int wid) {
    const int b = unit >> 6, kvh = (unit >> 5) & 1, qblk = unit & 31, q0 = qblk * 128; const size_t rb = (size_t)b * SEQ;
    asm volatile("" : "+s"(PROJ), "+s"(Y));
    LAS bf16* VT = (LAS bf16*)lds;
    for (int c = tid; c < 2048; c += 512) { const int kvl = c >> 3, ch = c & 7, tok = q0 - 128 + kvl; v4u v = {0u, 0u, 0u, 0u};
        if (tok >= 0) v = *(const v4u*)(PROJ + (rb + tok) * EVEN_IN + 640 + kvh * 64 + ch * 8);
        LAS bf16* d = VT + (ch * 8) * VTP + kvl;
        d[0 * VTP] = (bf16)(v.x & 0xffffu); d[1 * VTP] = (bf16)(v.x >> 16); d[2 * VTP] = (bf16)(v.y & 0xffffu); d[3 * VTP] = (bf16)(v.y >> 16);
        d[4 * VTP] = (bf16)(v.z & 0xffffu); d[5 * VTP] = (bf16)(v.z >> 16); d[6 * VTP] = (bf16)(v.w & 0xffffu); d[7 * VTP] = (bf16)(v.w >> 16); }
    __syncthreads();
    const int g = wid >> 1, qh = wid & 1, hq = kvh * 4 + g;
    const float slope2 = exp2f(-(float)(hq + 1)) * LOG2E, sink2 = sinks[hq] * LOG2E;
#pragma unroll 1
    for (int sb = 0; sb < 2; ++sb) {
        int r32 = lane & 31, hi = lane >> 5; asm volatile("" : "+v"(r32), "+v"(hi));
        const int qs = q0 + 64 * qh + 32 * sb;
        bf16x8 qf[4];
#pragma unroll
        for (int ks = 0; ks < 4; ++ks) qf[ks] = *(const bf16x8*)(PROJ + (rb + qs + r32) * EVEN_IN + hq * 64 + 16 * ks + 8 * hi);
        f32x16 sc[5];
#pragma unroll
        for (int kt = 0; kt < 5; ++kt) { int tk = qs - 128 + 32 * kt + r32; tk = tk < 0 ? 0 : tk; sc[kt] = f32x16{};
#pragma unroll
            for (int ks = 0; ks < 4; ++ks) { const bf16x8 kf = *(const bf16x8*)(PROJ + (rb + tk) * EVEN_IN + 512 + kvh * 64 + 16 * ks + 8 * hi);
                sc[kt] = __builtin_amdgcn_mfma_f32_32x32x16_bf16(kf, qf[ks], sc[kt], 0, 0, 0); } }
        const int db = r32 + 128 - 4 * hi, kmin = 128 - qs - 4 * hi; const float ab = -slope2 * (float)db;
        float mx = sink2;
#pragma unroll
        for (int kt = 0; kt < 5; ++kt)
#pragma unroll
            for (int r = 0; r < 16; ++r) { const int kc = 32 * kt + (r & 3) + 8 * (r >> 2), dist = db - kc; const bool ok = ((unsigned)dist < 128u) && (kmin <= kc);
                const float s = ok ? fmaf(slope2, (float)kc, sc[kt][r] + ab) : -INFINITY; sc[kt][r] = s; mx = fmaxf(mx, s); }
        mx = fmaxf(mx, __shfl_xor(mx, 32));
        float l = 0.f;
#pragma unroll
        for (int kt = 0; kt < 5; ++kt)
#pragma unroll
            for (int r = 0; r < 16; ++r) { const float p = exp2f(sc[kt][r] - mx); sc[kt][r] = p; l += p; }
        l += __shfl_xor(l, 32); l += exp2f(sink2 - mx);
        const float rl = 1.0f / l;
        f32x16 o[2]; o[0] = f32x16{}; o[1] = f32x16{};
        const int kvl0 = 64 * qh + 32 * sb;
#pragma unroll
        for (int kt = 0; kt < 5; ++kt)
#pragma unroll
            for (int s2 = 0; s2 < 2; ++s2) { v4u pw; pw.x = pk2(sc[kt][8 * s2 + 0], sc[kt][8 * s2 + 1]); pw.y = pk2(sc[kt][8 * s2 + 2], sc[kt][8 * s2 + 3]); pw.z = pk2(sc[kt][8 * s2 + 4], sc[kt][8 * s2 + 5]); pw.w = pk2(sc[kt][8 * s2 + 6], sc[kt][8 * s2 + 7]);
                const bf16x8 pa = __builtin_bit_cast(bf16x8, pw);
#pragma unroll
                for (int db = 0; db < 2; ++db) { const LAS bf16* vp = VT + (32 * db + r32) * VTP + kvl0 + 32 * kt + 16 * s2 + 4 * hi;
                    const v2u lo = *(const LAS v2u*)vp, hh = *(const LAS v2u*)(vp + 8); v4u vw; vw.x = lo.x; vw.y = lo.y; vw.z = hh.x; vw.w = hh.y;
                    o[db] = __builtin_amdgcn_mfma_f32_32x32x16_bf16(pa, __builtin_bit_cast(bf16x8, vw), o[db], 0, 0, 0); } }
#pragma unroll
        for (int r = 0; r < 16; ++r) { const int qq = crow(r, hi); const float sc1 = __shfl(rl, qq);
            bf16* yp = Y + (rb + qs + qq) * 1024 + hq * 64 + r32;
            yp[0] = (bf16)(pk2(o[0][r] * sc1, 0.f) & 0xffffu); yp[32] = (bf16)(pk2(o[1][r] * sc1, 0.f) & 0xffffu); }
    }
    __syncthreads();
}
typedef unsigned v4u_unused_;
#define XB_TMO      128
#define XB_XCNT(j)  (256  + 64 * (j))
#define XB_XSUB(j)  (1280 + 64 * (j))
#define XB_XGEN(j)  (2304 + 64 * (j))
#define XB_TOP      3328
#define XB_TOPGEN   3392
#define XCD_BAR_WORDS 3456
#define XB_SPIN_CAP (1u << 18)

__device__ __forceinline__ unsigned xb_ld(unsigned* p)              { return __hip_atomic_load(p, __ATOMIC_RELAXED, __HIP_MEMORY_SCOPE_AGENT); }
__device__ __forceinline__ unsigned xb_add(unsigned* p, unsigned v) { return __hip_atomic_fetch_add(p, v, __ATOMIC_RELAXED, __HIP_MEMORY_SCOPE_AGENT); }
__device__ __forceinline__ unsigned xb_xcc_id() { return (unsigned)__builtin_amdgcn_s_getreg((3 << 11) | 20) & 0xFu; }
#define XB_SPIN(cond, bar) do { unsigned _sp = 0; while (cond) { __builtin_amdgcn_s_sleep(1); \
    if ((++_sp & 255u) == 0u) { if (xb_ld(&(bar)[XB_TMO])) break; if (_sp > XB_SPIN_CAP) { atomicAdd(&(bar)[XB_TMO], 1u); break; } } } } while (0)

struct XcdBarrier {
    unsigned* bar; unsigned x;
    volatile LAS unsigned* st;
};

__device__ __forceinline__ XcdBarrier xcd_barrier_post(unsigned* bar, volatile LAS unsigned* st) {
    XcdBarrier b; b.bar = bar; b.x = xb_xcc_id(); b.st = st;
    if (threadIdx.x == 0) (void)xb_add(&bar[XB_XCNT(b.x)], 1u);
    return b;
}
__device__ __forceinline__ void xcd_barrier_complete(unsigned* bar, unsigned x, unsigned& nloc, unsigned& nx) {
    const unsigned G = gridDim.x * gridDim.y * gridDim.z;
    unsigned sum, cnt, mine, sp = 0u;
    for (;;) {
        sum = 0u; cnt = 0u; mine = 0u;
#pragma unroll
        for (unsigned j = 0; j < 16; ++j) { const unsigned c = xb_ld(&bar[XB_XCNT(j)]); sum += c; cnt += (c > 0u) ? 1u : 0u; mine = (j == x) ? c : mine; }
        if (sum == G) break;
        __builtin_amdgcn_s_sleep(1);
        if ((++sp & 255u) == 0u) { if (xb_ld(&bar[XB_TMO])) break; if (sp > XB_SPIN_CAP) { atomicAdd(&bar[XB_TMO], 1u); break; } }
    }
    nloc = mine > 0u ? mine : 1u; nx = cnt > 0u ? cnt : 1u;
}

__device__ __forceinline__ void xcd_barrier(const XcdBarrier& b) {
    asm volatile("s_waitcnt vmcnt(0)" ::: "memory");
    __syncthreads();
    if (threadIdx.x == 0) {
        unsigned* bar = b.bar;
        __builtin_amdgcn_s_waitcnt(0);
        unsigned nloc = b.st[0], nx = b.st[1];
        if (nloc == 0u) { xcd_barrier_complete(bar, b.x, nloc, nx); b.st[0] = nloc; b.st[1] = nx; }
        const unsigned old = xb_add(&bar[XB_XSUB(b.x)], 1u);
        const unsigned gen = old / nloc;
        if (old + 1u == (gen + 1u) * nloc) {
            __builtin_amdgcn_fence(__ATOMIC_RELEASE, "agent");
            asm volatile("s_waitcnt vmcnt(0)" ::: "memory");
            const unsigned og = xb_add(&bar[XB_TOP], 1u);
            const unsigned tg = og / nx;
            if (og + 1u == (tg + 1u) * nx) xb_add(&bar[XB_TOPGEN], 1u);
            else XB_SPIN(xb_ld(&bar[XB_TOPGEN]) == tg, bar);
            __builtin_amdgcn_fence(__ATOMIC_ACQUIRE, "agent");
            xb_add(&bar[XB_XGEN(b.x)], 1u);
            asm volatile("s_waitcnt vmcnt(0)" ::: "memory");
        } else {
            XB_SPIN(xb_ld(&bar[XB_XGEN(b.x)]) == gen, bar);
            __builtin_amdgcn_fence(__ATOMIC_ACQUIRE, "agent");
            asm volatile("s_waitcnt vmcnt(0)" ::: "memory");
        }
    }
    __syncthreads();
}
constexpr int TC = 32, SBS = 340, LBS = 68;
constexpr int SBS_UNUSED_ = 336;
constexpr int RW_SBUF = 0, RW_SBUF_BYTES = TC * SBS * 4, RW_LW = 2 * RW_SBUF_BYTES, RW_LA = RW_LW + 2 * TC * LBS * 4, RW_EC = RW_LA + 2 * TC * LBS * 4, RW_BF = RW_EC + 2560;
__device__ __forceinline__ void rwkv_scan_unit(int unit, const bf16* PROJ, float* YRAW, float* C3, const float* mu, const float* w0, const float* w2, const float* a0, const float* a2,
                                               const float* k_k, const float* k_a, const float* r_k, LAS unsigned char* lds, const int lane, int wid) {
    const int role = (wid < 2) ? 0 : ((wid == 2 || wid == 3) ? 2 : 1), lw = wid - 2, ew = wid - 4;
    const int b = unit >> 6, h = (unit >> 3) & 7, rg = unit & 7; const size_t rb = (size_t)b * SEQ;
    const int r32 = lane & 31, hi = lane >> 5;
    constexpr int NCH = SEQ / TC;
    if (role == 2) {
        const int colx = 768 + ((lw == 0) ? 1536 : 1600); const float* Wl = (lw == 0) ? w2 : a2;
#pragma unroll
        for (int nb = 0; nb < 2; ++nb)
#pragma unroll
            for (int ks = 0; ks < 4; ++ks) { float f[8];
#pragma unroll
                for (int i = 0; i < 8; ++i) f[i] = Wl[(size_t)(16 * ks + 8 * hi + i) * 512 + h * 64 + 32 * nb + r32];
                *(LAS bf16x8*)(lds + RW_BF + (((lw * 2 + nb) * 4 + ks) * 64 + lane) * 16) = pack8(f); }
        ((LAS float*)(lds + RW_EC))[512 + lw * 64 + lane] = mu[colx - 768 + lane];
        v4u lcw[4], lpw[4];
#define LORA_LOAD(itn) do { const int tl_ = (itn) * TC + r32; const bf16* p_ = PROJ + (rb + tl_) * EVEN_IN + colx + 8 * hi; _Pragma("unroll") for (int ks = 0; ks < 4; ++ks) { lcw[ks] = *(const v4u*)(p_ + 16 * ks); \
            lpw[ks] = (v4u){0u, 0u, 0u, 0u}; if (tl_ > 0) lpw[ks] = *(const v4u*)(p_ - EVEN_IN + 16 * ks); } } while (0)
        LORA_LOAD(0);
#pragma unroll 1
        for (int it = 0; it < NCH + 2; ++it) {
            if (it < NCH) { bf16x8 afr[4];
#pragma unroll
                for (int ks = 0; ks < 4; ++ks) { float c[8], p[8]; unpack8(lcw[ks], c); unpack8(lpw[ks], p);
                    const LAS float* mq = (const LAS float*)(lds + RW_EC) + 512 + lw * 64 + 16 * ks + 8 * hi; const f32x4 m0 = *(const LAS f32x4*)mq, m1 = *(const LAS f32x4*)(mq + 4);
#pragma unroll
                    for (int i = 0; i < 8; ++i) { float x = c[i] + (p[i] - c[i]) * (i < 4 ? m0[i] : m1[i - 4]); if (lw == 0) x = 1.f - 2.f * __builtin_amdgcn_rcpf(1.f + __expf(2.f * x)); c[i] = x; }
                    afr[ks] = pack8(c); }
                if (it + 1 < NCH) LORA_LOAD(it + 1);
                LAS float* LB = (LAS float*)(lds + ((lw == 0) ? RW_LW : RW_LA)) + (it & 1) * (TC * LBS);
#pragma unroll
                for (int nb = 0; nb < 2; ++nb) { f32x16 acc = f32x16{};
#pragma unroll
                    for (int ks = 0; ks < 4; ++ks) acc = __builtin_amdgcn_mfma_f32_32x32x16_bf16(afr[ks], *(const LAS bf16x8*)(lds + RW_BF + (((lw * 2 + nb) * 4 + ks) * 64 + lane) * 16), acc, 0, 0, 0);
#pragma unroll
                    for (int r = 0; r < 16; ++r) LB[crow(r, hi) * LBS + 32 * nb + r32] = acc[r]; } }
            asm volatile("s_waitcnt lgkmcnt(0)\n\ts_barrier" ::: "memory");
        }
#undef LORA_LOAD
    } else if (role == 1) {
        const int el = ew * 64 + lane, s = el >> 3, g = el & 7;
        float ecc[8][8];
        { const int chn = h * 64 + 8 * g;
#pragma unroll
          for (int i = 0; i < 8; ++i) { ecc[0][i] = mu[chn + i]; ecc[1][i] = mu[512 + chn + i]; ecc[2][i] = mu[1024 + chn + i]; ecc[3][i] = w0[chn + i]; ecc[4][i] = a0[chn + i]; ecc[5][i] = k_k[chn + i]; ecc[6][i] = k_a[chn + i]; ecc[7][i] = r_k[chn + i]; } }
        v4u ecr, eck, ecv, epr, epk, epv;
#define ELEM_LOAD(cn) do { const int tl_ = (cn) * TC + s; const bf16* p_ = PROJ + (rb + tl_) * EVEN_IN + 768 + h * 64 + 8 * g; \
            ecr = *(const v4u*)p_; eck = *(const v4u*)(p_ + 512); ecv = *(const v4u*)(p_ + 1024); epr = (v4u){0u, 0u, 0u, 0u}; epk = epr; epv = epr; \
            if (tl_ > 0) { epr = *(const v4u*)(p_ - EVEN_IN); epk = *(const v4u*)(p_ - EVEN_IN + 512); epv = *(const v4u*)(p_ - EVEN_IN + 1024); } } while (0)
        ELEM_LOAD(0);
#pragma unroll 1
        for (int it = 0; it < NCH + 2; ++it) {
            const int c = it - 1;
            if (c >= 0 && c < NCH) { const size_t row = rb + c * TC + s;
                const LAS float* LW = (const LAS float*)(lds + RW_LW) + (c & 1) * (TC * LBS) + s * LBS + 8 * g; const LAS float* LA = (const LAS float*)(lds + RW_LA) + (c & 1) * (TC * LBS) + s * LBS + 8 * g;
                LAS float* sp = (LAS float*)(lds + RW_SBUF + (c & 1) * RW_SBUF_BYTES) + s * SBS;
                float ec[8];
#define LDEC(arr) do { _Pragma("unroll") for (int i_ = 0; i_ < 8; ++i_) ec[i_] = ecc[arr][i_]; } while (0)
                float r[8], k[8], v[8], t[8];
                unpack8(ecr, r); unpack8(epr, t); LDEC(0);
#pragma unroll
                for (int i = 0; i < 8; ++i) r[i] += (t[i] - r[i]) * ec[i];
                unpack8(eck, k); unpack8(epk, t); LDEC(1);
#pragma unroll
                for (int i = 0; i < 8; ++i) k[i] += (t[i] - k[i]) * ec[i];
                unpack8(ecv, v); unpack8(epv, t); LDEC(2);
#pragma unroll
                for (int i = 0; i < 8; ++i) v[i] += (t[i] - v[i]) * ec[i];
                if (c + 1 < NCH) ELEM_LOAD(c + 1);
                const f32x4 dw0 = *(const LAS f32x4*)LW, dw1 = *(const LAS f32x4*)(LW + 4), da0 = *(const LAS f32x4*)LA, da1 = *(const LAS f32x4*)(LA + 4);
                float w[8], a[8], kk[8], kp[8]; float n2 = 0.f;
#pragma unroll
                for (int i = 0; i < 8; ++i) w[i] = i < 4 ? dw0[i] : dw1[i - 4];
                LDEC(3);
#pragma unroll
                for (int i = 0; i < 8; ++i) w[i] = __expf(-0.60653065971f * pg8::sigm(ec[i] + w[i]));
                LDEC(4);
#pragma unroll
                for (int i = 0; i < 8; ++i) a[i] = pg8::sigm(ec[i] + (i < 4 ? da0[i] : da1[i - 4]));
                LDEC(5);
#pragma unroll
                for (int i = 0; i < 8; ++i) { kk[i] = k[i] * ec[i]; n2 += kk[i] * kk[i]; }
                LDEC(6);
#pragma unroll
                for (int i = 0; i < 8; ++i) kp[i] = k[i] * (1.f + (a[i] - 1.f) * ec[i]);
                LDEC(7);
                n2 = red8(n2); const float inv = __builtin_amdgcn_rsqf(fmaxf(n2, 1e-24f));
                float c1 = 0.f, c2 = 0.f, c3 = 0.f;
#pragma unroll
                for (int i = 0; i < 8; ++i) { kk[i] *= inv; t[i] = kk[i] * a[i]; c1 += t[i] * r[i]; c2 += kp[i] * r[i]; c3 += r[i] * kp[i] * ec[i]; }
#undef LDEC
                c1 = red8(c1); c2 = red8(c2); c3 = red8(c3);
                *(LAS f32x4*)(sp + 8 * g) = (f32x4){kk[0], kk[1], kk[2], kk[3]}; *(LAS f32x4*)(sp + 8 * g + 4) = (f32x4){kk[4], kk[5], kk[6], kk[7]};
                *(LAS f32x4*)(sp + 64 + 8 * g) = (f32x4){w[0] * r[0], w[1] * r[1], w[2] * r[2], w[3] * r[3]}; *(LAS f32x4*)(sp + 64 + 8 * g + 4) = (f32x4){w[4] * r[4], w[5] * r[5], w[6] * r[6], w[7] * r[7]};
                *(LAS f32x4*)(sp + 128 + 8 * g) = (f32x4){w[0], w[1], w[2], w[3]}; *(LAS f32x4*)(sp + 128 + 8 * g + 4) = (f32x4){w[4], w[5], w[6], w[7]};
                *(LAS f32x4*)(sp + 192 + 8 * g) = (f32x4){t[0], t[1], t[2], t[3]}; *(LAS f32x4*)(sp + 192 + 8 * g + 4) = (f32x4){t[4], t[5], t[6], t[7]};
                *(LAS f32x4*)(sp + 256 + 8 * g) = (f32x4){kp[0], kp[1], kp[2], kp[3]}; *(LAS f32x4*)(sp + 256 + 8 * g + 4) = (f32x4){kp[4], kp[5], kp[6], kp[7]};
                if (g == rg) { *(LAS f32x4*)(sp + 320) = (f32x4){v[0], v[1], v[2], v[3]}; *(LAS f32x4*)(sp + 324) = (f32x4){v[4], v[5], v[6], v[7]}; }
                if (g == 0) { sp[328] = c1; sp[329] = c2; if (rg == 0) C3[row * 8 + h] = c3; } }
            asm volatile("s_waitcnt lgkmcnt(0)\n\ts_barrier" ::: "memory");
        }
#undef ELEM_LOAD
    } else {
        const int rowl = 4 * (wid & 1) + (lane >> 4), cgp = lane & 15;
        f32x2s S01 = {0.f, 0.f}, S23 = {0.f, 0.f};
#pragma unroll 1
        for (int it = 0; it < NCH + 2; ++it) {
            const int c = it - 2;
            if (c >= 0) { const LAS float* SBF = (const LAS float*)(lds + RW_SBUF + (c & 1) * RW_SBUF_BYTES);
                float* yp = YRAW + (rb + (size_t)c * TC) * 512 + h * 64 + 8 * rg + rowl;
                __builtin_amdgcn_s_setprio(3);
                f32x4 kkA, wrA, wA, kaA, kpA, kkB, wrB, wB, kaB, kpB; float viA, viB; float pkeep = 0.f, qkeep = 0.f;
#define LDREC(X, s_) do { const LAS float* sp_ = SBF + (s_) * SBS; kk##X = *(const LAS f32x4*)(sp_ + 4 * cgp); wr##X = *(const LAS f32x4*)(sp_ + 64 + 4 * cgp); w##X = *(const LAS f32x4*)(sp_ + 128 + 4 * cgp); \
                    ka##X = *(const LAS f32x4*)(sp_ + 192 + 4 * cgp); kp##X = *(const LAS f32x4*)(sp_ + 256 + 4 * cgp); vi##X = sp_[320 + rowl]; } while (0)
#define LO2(v) __builtin_shufflevector(v, v, 0, 1)
#define HI2(v) __builtin_shufflevector(v, v, 2, 3)
#define STEPREC(X, s_) do { f32x2s pp = S01 * LO2(kk##X); pp = S23 * HI2(kk##X) + pp; f32x2s qq = S01 * LO2(wr##X); qq = S23 * HI2(wr##X) + qq; float p = pp[0] + pp[1], q = qq[0] + qq[1]; \
                    const f32x2s vv_ = {vi##X, vi##X}; const f32x2s u01_ = S01 * LO2(w##X) + LO2(kp##X) * vv_, u23_ = S23 * HI2(w##X) + HI2(kp##X) * vv_;     \
                    p += dpp_f<0xB1>(p); q += dpp_f<0xB1>(q); p += dpp_f<0x4E>(p); q += dpp_f<0x4E>(q); p += dpp_f<0x141>(p); q += dpp_f<0x141>(q); p += dpp_f<0x140>(p); q += dpp_f<0x140>(q); \
                    const f32x2s pv_ = {p, p}; \
                    S01 = u01_ - LO2(ka##X) * pv_; S23 = u23_ - HI2(ka##X) * pv_; \
                    pkeep = (((s_) & 15) == cgp) ? p : pkeep; qkeep = (((s_) & 15) == cgp) ? q : qkeep;     \
                    if (((s_) & 15) == 15) { const LAS float* sy_ = SBF + ((s_) - 15 + cgp) * SBS; const f32x2s cy_ = *(const LAS f32x2s*)(sy_ + 328); \
                        yp[(size_t)((s_) - 15 + cgp) * 512] = qkeep - pkeep * cy_[0] + sy_[320 + rowl] * cy_[1]; } } while (0)
                LDREC(A, 0);
#pragma unroll
                for (int s = 0; s < TC; s += 2) {
 LDREC(B, s + 1); STEPREC(A, s); LDREC(A, s + 2); STEPREC(B, s + 1); }
#undef LDREC
#undef STEPREC
#undef LO2
#undef HI2
                __builtin_amdgcn_s_setprio(0); }
            asm volatile("s_waitcnt lgkmcnt(0)\n\ts_barrier" ::: "memory");
        }
    }
    __syncthreads();
}

__device__ __forceinline__ void rwkv_post_unit(int tile, const bf16* PROJ, const float* YRAW, const float* C3, bf16* Y, const float* mu, const bf16* g2f, const float* ln_w, const float* ln_b, int lane, int wid) {
    asm volatile("" : "+s"(PROJ), "+s"(mu), "+s"(g2f), "+s"(YRAW));
    const int h = wid, r32 = lane & 31, hi = lane >> 5; const int tok0 = tile * 32; const bool first = (tok0 & (SEQ - 1)) == 0;
    bf16x8 afr[8];
    { const int tk = tok0 + r32; const bool hp = !(first && r32 == 0); v4u cwv[8], pwv[8];
      const __attribute__((address_space(1))) bf16* pg = (const __attribute__((address_space(1))) bf16*)(PROJ + (size_t)tk * EVEN_IN + 768 + 1664 + 8 * hi);
#pragma unroll
        for (int ks = 0; ks < 8; ++ks) { cwv[ks] = *(const __attribute__((address_space(1))) v4u*)(pg + 16 * ks); pwv[ks] = (v4u){0u, 0u, 0u, 0u};
            if (hp) pwv[ks] = *(const __attribute__((address_space(1))) v4u*)(pg - EVEN_IN + 16 * ks); }
#pragma unroll
        for (int ks = 0; ks < 8; ++ks) { float c[8], p[8]; unpack8(cwv[ks], c); unpack8(pwv[ks], p);
            const f32x4 m0 = *(const f32x4*)(mu + 1664 + 16 * ks + 8 * hi), m1 = *(const f32x4*)(mu + 1664 + 16 * ks + 8 * hi + 4);
#pragma unroll
            for (int i = 0; i < 8; ++i) c[i] = pg8::sigm(c[i] + (p[i] - c[i]) * (i < 4 ? m0[i] : m1[i - 4]));
            afr[ks] = pack8(c); } }
    f32x16 gt[2];
#pragma unroll
    for (int nb = 0; nb < 2; ++nb) { gt[nb] = f32x16{};
#pragma unroll
        for (int ks = 0; ks < 8; ++ks) { const bf16x8 bf = *(const bf16x8*)(g2f + ((size_t)((h * 2 + nb) * 8 + ks) * 64 + lane) * 8);
            gt[nb] = __builtin_amdgcn_mfma_f32_32x32x16_bf16(afr[ks], bf, gt[nb], 0, 0, 0); } }
    typedef const __attribute__((address_space(1))) float* gfp; typedef const __attribute__((address_space(1))) unsigned short* gup;
    const int ch0 = h * 64 + r32; const float lw0 = ln_w[ch0], lw1 = ln_w[ch0 + 32], lb0 = ln_b[ch0], lb1 = ln_b[ch0 + 32], mv0 = mu[1024 + ch0], mv1 = mu[1024 + ch0 + 32];
    float y0[16], y1[16], c3v[16]; unsigned vc[16], vp[16];
#pragma unroll
    for (int r = 0; r < 16; ++r) { const int tk = tok0 + crow(r, hi); gfp yp = (gfp)(YRAW + (size_t)tk * 512 + ch0); y0[r] = yp[0]; y1[r] = yp[32]; c3v[r] = ((gfp)C3)[(size_t)tk * 8 + h];
        gup vq = (gup)(PROJ + (size_t)tk * EVEN_IN + 768 + 1024 + ch0); vc[r] = (unsigned)vq[0] | ((unsigned)vq[32] << 16); vp[r] = 0u;
        if ((tk & (SEQ - 1)) != 0) vp[r] = (unsigned)vq[-EVEN_IN] | ((unsigned)vq[32 - EVEN_IN] << 16); }
#pragma unroll
    for (int r = 0; r < 16; ++r) { const int tk = tok0 + crow(r, hi);
        float s = y0[r] + y1[r]; s = red16(s); s += __shfl_xor(s, 16);
        const float mean = s * (1.f / 64.f), d0 = y0[r] - mean, d1 = y1[r] - mean; float q = d0 * d0 + d1 * d1; q = red16(q); q += __shfl_xor(q, 16);
        const float rstd = rsqrtf(q * (1.f / 64.f) + GN_EPS);
        const float cv0 = bflo(vc[r]), cv1 = bfhi(vc[r]), pv0 = bflo(vp[r]), pv1 = bfhi(vp[r]);
        const float v0 = cv0 + (pv0 - cv0) * mv0, v1 = cv1 + (pv1 - cv1) * mv1;
        const float o0 = (d0 * rstd * lw0 + lb0 + c3v[r] * v0) * gt[0][r], o1 = (d1 * rstd * lw1 + lb1 + c3v[r] * v1) * gt[1][r];
        bf16* op = Y + (size_t)tk * 1024 + 512 + ch0; op[0] = (bf16)(pk2(o0, 0.f) & 0xffffu); op[32] = (bf16)(pk2(o1, 0.f) & 0xffffu); }
}

__device__ __forceinline__ void fox_gate_pass(const bf16* XB, const bf16* Wf, const float* ssqv, const float* bfv, float* LF, int gw, int NGW, int lane) {
    typedef float f32x4g __attribute__((ext_vector_type(4)));
    const int fr = lane & 15, fq = lane >> 4;
    for (int t = gw; t < M / 16; t += NGW) {
        const bf16* ap = XB + (size_t)(t * 16 + fr) * D + 8 * fq; const bf16* bp = Wf + (size_t)fr * D + 8 * fq;
        f32x4g acc = {0.f, 0.f, 0.f, 0.f};
#pragma unroll 8
        for (int ks = 0; ks < D / 32; ++ks) acc = __builtin_amdgcn_mfma_f32_16x16x32_bf16(*(const bf16x8*)(ap + 32 * ks), *(const bf16x8*)(bp + 32 * ks), acc, 0, 0, 0);
        const float bn = bfv[fr];
#pragma unroll
        for (int j = 0; j < 4; ++j) { const int row = t * 16 + 4 * fq + j; const float z = fmaxf(acc[j] * pg8::rstd_of(ssqv, row) + bn, -80.f), e = __expf(-z);
            LF[(size_t)row * 16 + fr] = (e < 0.01f) ? -(e - 0.5f * e * e + e * e * e * (1.f / 3.f)) : -__logf(1.f + e); }
    }
}

__device__ __forceinline__ void fox_prefix(const float* LFbh, LAS float* cs, LAS float* wtot, int tid, int lane, int wid) {
    const float* lp = LFbh + (size_t)tid * 128;
    float s[8]; s[0] = lp[0]; s[1] = s[0] + lp[16]; s[2] = s[1] + lp[32]; s[3] = s[2] + lp[48]; s[4] = s[3] + lp[64]; s[5] = s[4] + lp[80]; s[6] = s[5] + lp[96]; s[7] = s[6] + lp[112];
    float incl = s[7];
#pragma unroll
    for (int o = 1; o < 64; o <<= 1) { const float t = __shfl_up(incl, o); if (lane >= o) incl += t; }
    if (lane == 63) wtot[wid] = incl;
    __syncthreads();
    float base = incl - s[7];
    for (int w = 0; w < wid; ++w) base += wtot[w];
#pragma unroll
    for (int i = 0; i < 8; ++i) { const float v = (base + s[i]) * LOG2E;
        const unsigned h1 = pk2(v, 0.f) & 0xffffu; const float r1 = v - __uint_as_float(h1 << 16); const unsigned h2 = pk2(r1, 0.f) & 0xffffu; const float r2 = r1 - __uint_as_float(h2 << 16); const unsigned h3 = pk2(r2, 0.f) & 0xffffu;
        ((LAS v2u*)cs)[8 * tid + i] = (v2u){h1 | (h2 << 16), h3}; }
    __syncthreads();
}
struct Args { const float* in[30]; float* out; unsigned char* ws; int ph_lo, ph_hi; };
#define AS4 __attribute__((address_space(4)))
#ifndef DUP_SWA
#define DUP_SWA 0
#endif
#ifndef DUP_SCAN
#define DUP_SCAN 0
#endif
#ifndef DUP_POST
#define DUP_POST 0
#endif
#ifndef DUP_GU
#define DUP_GU 0
#endif
#ifndef DUP_INPROJ
#define DUP_INPROJ 0
#endif
#ifndef DUP_P0
#define DUP_P0 0
#endif
#ifndef DUP_SYNC
#define DUP_SYNC 0
#endif
#define INP(i) (*(const float* const AS4*)(kp + 8 * (i)))
#define GSYNC() xcd_barrier(xbar)
#define FRESH() const AS4 char* kp = kp0; asm volatile("" : "+s"(kp)); unsigned char* ws = *(unsigned char* const AS4*)(kp + 248); float* X = *(float* const AS4*)(kp + 240); \
    int tid = threadIdx.x; asm volatile("" : "+v"(tid)); const int lane = tid & 63, wid = __builtin_amdgcn_readfirstlane(tid >> 6); \
    const int gw = bx * 8 + wid, NGW = G * 8; \
    float* ssq = (float*)(ws + WS_SSQP); float* C3 = (float*)(ws + WS_C3); float* LF = (float*)(ws + WS_LF); \
    bf16* XB = (bf16*)(ws + WS_XB); float* YRAW = (float*)(ws + WS_XB); bf16* Y = (bf16*)(ws + WS_Y); \
    bf16* H = (bf16*)(ws + WS_BIG); bf16* PROJ = (bf16*)(ws + WS_BIG); bf16* PP = (bf16*)(ws + WS_BIG); bf16* PB = (bf16*)(ws + WS_PB); \
    bf16* Qb = (bf16*)(ws + WS_BIG); bf16* Kb = Qb + (size_t)M * D; bf16* Vb = Kb + (size_t)M * D; \
    (void)X; (void)lane; (void)wid; (void)gw; (void)NGW; (void)ssq; (void)C3; (void)LF; (void)XB; (void)YRAW; (void)Y; (void)H; (void)PROJ; (void)PP; (void)PB; (void)Qb; (void)Kb; (void)Vb
__global__ void __launch_bounds__(512, 2) fwd_megakernel(Args a_unused) {
    extern __shared__ __attribute__((aligned(16))) unsigned char lds_raw[];
    cg::grid_group grid = cg::this_grid();
    LAS unsigned char* lds = (LAS unsigned char*)lds_raw;
    const int G = gridDim.x, bx = blockIdx.x;
    const AS4 char* kp0 = (const AS4 char*)__builtin_amdgcn_kernarg_segment_ptr();
    const int ph_lo = *(const int AS4*)(kp0 + 256), ph_hi = *(const int AS4*)(kp0 + 260);
    XcdBarrier xbar;
    { unsigned* barw = (unsigned*)(*(unsigned char* const AS4*)(kp0 + 248) + WS_BAR);
      if (bx == 0) for (int i = threadIdx.x; i < XCD_BAR_WORDS; i += 512) barw[i] = 0u;
      if (threadIdx.x < 4) ((LAS unsigned*)(lds + MISC_OFF))[threadIdx.x] = 0u;
      asm volatile("s_waitcnt vmcnt(0)" ::: "memory"); __syncthreads();
      grid.sync();
      __builtin_amdgcn_fence(__ATOMIC_ACQUIRE, "agent"); asm volatile("s_waitcnt vmcnt(0)" ::: "memory");
      xbar = xcd_barrier_post(barw, (volatile LAS unsigned*)(lds + MISC_OFF)); }

#ifdef NANFILL
    { FRESH(); v4u q = {0xffffffffu, 0xffffffffu, 0xffffffffu, 0xffffffffu};
      for (size_t i = (size_t)bx * 512 + tid; i < WS_END / 16; i += (size_t)G * 512) ((v4u*)ws)[i] = q;
      for (size_t i = (size_t)bx * 512 + tid; i < (size_t)M * D / 4; i += (size_t)G * 512) ((v4u*)X)[i] = q;
      for (int i = tid; i < LDS_BYTES / 4; i += 512) ((LAS unsigned*)lds)[i] = 0xffffffffu; }
    GSYNC();
#endif
    for (int dup = 0; dup < 1 + DUP_P0; ++dup)
    if (ph_lo == 0) {
        FRESH();
        LAS float* scr = (LAS float*)(lds + wid * 16384);
        constexpr int I_GU = (D / 64) * (2 * DFF / 32), I_D = (DFF / 64) * (D / 32), I_G = (D / 64) * (D / 32), I_P = (PLE / 64) * (D / 32), I_IN0 = (D / 64) * (EVEN_IN / 32), I_IN1 = (D / 64) * (FOX_INP / 32);
        constexpr int NITEMS = 4 * I_GU + 4 * I_D + 2 * I_G + 2 * I_P + I_IN0 + I_IN1 + 2 * I_G;
        for (int it = gw; it < NITEMS; it += NGW) {
            int r = it;
#define MAT(cnt, W_, K_, N_, NP_, WT_, G_, MODE_) if (r < (cnt)) { conv_item((W_), (K_), (N_), (NP_), (bf16*)(WT_), (G_), (MODE_), scr, r, lane); continue; } r -= (cnt);
            MAT(I_GU, INP(3), D, 2 * DFF, 2 * DFF, ws + WS_WGU, INP(2), 1)
            MAT(I_GU, INP(7), D, 2 * DFF, 2 * DFF, ws + WS_WGU + 11 * MiB, INP(6), 1)
            MAT(I_GU, INP(3) + (size_t)D * 2 * DFF, D, 2 * DFF, 2 * DFF, ws + WS_WGU + 22 * MiB, INP(2) + D, 1)
            MAT(I_GU, INP(7) + (size_t)D * 2 * DFF, D, 2 * DFF, 2 * DFF, ws + WS_WGU + 33 * MiB, INP(6) + D, 1)
            MAT(I_D, INP(4), DFF, D, D, ws + WS_WD, nullptr, 0)
            MAT(I_D, INP(8), DFF, D, D, ws + WS_WD + (size_t)D * DFF * 2, nullptr, 0)
            MAT(I_D, INP(4) + (size_t)D * DFF, DFF, D, D, ws + WS_WD + (size_t)D * DFF * 4, nullptr, 0)
            MAT(I_D, INP(8) + (size_t)D * DFF, DFF, D, D, ws + WS_WD + (size_t)D * DFF * 6, nullptr, 0)
            MAT(I_G, INP(10), D, D, D, ws + WS_WG, INP(9), 0)
            MAT(I_G, INP(10) + (size_t)D * D, D, D, D, ws + WS_WG + 2 * MiB, INP(9) + D, 0)
            MAT(I_P, INP(11), PLE, D, D, ws + WS_WP, nullptr, 0)
            MAT(I_P, INP(11) + (size_t)PLE * D, PLE, D, D, ws + WS_WP + (size_t)PLE * D * 2, nullptr, 0)
            MAT(I_IN0, INP(12), D, EVEN_IN, EVEN_IN, ws + WS_WIN0, INP(5), 0)
            MAT(I_IN1, INP(26), D, FOX_IN, FOX_INP, ws + WS_WIN1, INP(5) + D, 0)
            MAT(I_G, INP(13), D, D, D, ws + WS_WOUT0, nullptr, 0)
            MAT(I_G, INP(28), D, D, D, ws + WS_WOUT1, nullptr, 0)
#undef MAT
        }
        const float* x_in = INP(0);
        for (int m = gw; m < M; m += NGW) { const f32x4* xr = (const f32x4*)(x_in + (size_t)m * D) + lane; f32x4 v[4]; float s = 0.f;
#pragma unroll
            for (int j = 0; j < 4; ++j) { v[j] = xr[64 * j]; s += (v[j][0] * v[j][0] + v[j][1] * v[j][1]) + (v[j][2] * v[j][2] + v[j][3] * v[j][3]); }
            s = wave_sum(s); if (lane < 16) ssq[(size_t)m * 16 + lane] = (lane == 0) ? s : 0.f;
            v2u* o = (v2u*)(XB + (size_t)m * D) + lane;
#pragma unroll
            for (int j = 0; j < 4; ++j) { v2u w; w.x = pk2(v[j][0], v[j][1]); w.y = pk2(v[j][2], v[j][3]); o[64 * j] = w; } }
        const float* g2 = INP(20);
        for (int i = bx * 512 + tid; i < 8192; i += G * 512) { const int ln = i & 63, ks = (i >> 6) & 7, nb = (i >> 9) & 1, hh = i >> 10; float f[8];
#pragma unroll
            for (int j = 0; j < 8; ++j) f[j] = g2[(size_t)(16 * ks + 8 * (ln >> 5) + j) * 512 + hh * 64 + 32 * nb + (ln & 31)];
            ((bf16x8*)(ws + WS_G2F))[i] = pack8(f); }
    }
    if (ph_lo == 0 && ph_hi > 1) GSYNC();

#define GEMM(EpiT, Aptr, Bptr, Nn, Kk, Eobj) do { pg8::Gemm g_{(const pg8::bf16_t*)(Aptr), (const pg8::bf16_t*)(Bptr), M, (Nn), (Kk)}; pg8::StaticOrder S_; S_.init(M, (Nn), G, bx); \
        pg8::gemm_phase<EpiT, pg8::StaticOrder, true, true>(lds, g_, S_, (Eobj), tid); } while (0)
#pragma unroll 1
    for (int L = 0; L < 2; ++L) {
#pragma unroll 1
        for (int st = 0; st < 9; ++st) {
            const int ph = 1 + 9 * L + st; if (ph < ph_lo || ph >= ph_hi) continue;
            switch (st) {
            case 0: case 6: {
#if PHM & 1
                FRESH();
                for (int dup = 0; dup < 1 + DUP_GU; ++dup) {
                const int f = (st == 6); pg8::EpiGU E{H, ssq + (size_t)((f ? 2 : 0) & 1) * M * 16};
                GEMM(pg8::EpiGU, (L == 1 && st == 0) ? Y : XB, ws + WS_WGU + (size_t)(L * 2 + f) * 11 * MiB, 2 * DFF, D, E);
                __syncthreads(); }
#endif
            } break;
            case 1: case 5: case 7: {
#if PHM & 2
                FRESH();
                const bf16* A; const bf16* Bt; int K; float alpha; float* so;
                if (st == 5) { A = (L == 0) ? Y : Qb; Bt = (const bf16*)(ws + (L == 0 ? WS_WOUT0 : WS_WOUT1)); K = D; alpha = 1.f; so = ssq; }
                else { const int f = (st == 7); A = H; Bt = (const bf16*)(ws + WS_WD + (size_t)(L * 2 + f) * D * DFF * 2); K = DFF; alpha = 0.5f; so = ssq + (size_t)M * 16; }
                pg8::EpiRes E{(L == 0 && st == 1) ? INP(0) : (const float*)X, X, XB, so, alpha};
                GEMM(pg8::EpiRes, A, Bt, D, K, E);
                if (st == 7) {
                    const f32x4* ps = (const f32x4*)(INP(1) + (size_t)L * M * PLE);
                    for (int i = bx * 512 + tid; i < M * PLE / 8; i += G * 512) { const f32x4 u0 = ps[2 * i], u1 = ps[2 * i + 1]; v4u w; w.x = pk2(u0[0], u0[1]); w.y = pk2(u0[2], u0[3]); w.z = pk2(u1[0], u1[1]); w.w = pk2(u1[2], u1[3]); ((v4u*)PB)[i] = w; }
                }
#endif
            } break;
            case 2: {
#if PHM & 4
                FRESH();
                pg8::EpiStore E{Qb, L ? D : EVEN_IN, ssq + (size_t)M * 16, QSCALE, L ? 4 : 2, L ? 4 : 1000, (size_t)M * D, -1, LF, INP(27)};
                for (int dup = 0; dup < 1 + DUP_INPROJ; ++dup) { GEMM(pg8::EpiStore, XB, ws + (L ? WS_WIN1 : WS_WIN0), L ? 3 * D : EVEN_IN, D, E); __syncthreads(); }
                if (L == 1) fox_gate_pass(XB, (const bf16*)(ws + WS_WIN1) + (size_t)3 * D * D, ssq + (size_t)M * 16, INP(27), LF, gw, NGW, lane);
#endif
            } break;
            case 3: {
                if (L == 0) {
#if PHM & 8
                    { FRESH();
#pragma unroll 1
                    for (int dup = 0; dup < 1 + DUP_SWA; ++dup)
                    for (int u = bx; u < 256; u += G) swa_unit(u, PROJ, Y, INP(14), lds, tid, lane, wid); }
#endif
#if PHM & 16
                    { FRESH();
#pragma unroll 1
                    for (int dup = 0; dup < 1 + DUP_SCAN; ++dup)
                    for (int u = bx; u < 256; u += G) rwkv_scan_unit(u, PROJ, YRAW, C3, INP(15), INP(16), INP(17), INP(18), INP(19), INP(21), INP(22), INP(23), lds, lane, wid); }
#endif
                } else {
#if PHM & 32
                    FRESH();
                    const int vcu = (G % 8 == 0) ? (bx % 8) * (G / 8) + bx / 8 : bx;
#pragma unroll 1
                    for (int v = vcu; v < 256; v += G)
#pragma unroll 1
                        for (int i = 0; i < 4; ++i) { int tid2 = tid; asm volatile("" : "+v"(tid2)); const int lane2 = tid2 & 63, wid2 = __builtin_amdgcn_readfirstlane(tid2 >> 6); const int s = v & 3, bh = v >> 2, qb = (i == 0) ? s : (i == 1) ? 7 - s : (i == 2) ? 8 + s : 15 - s;
                            if (i == 0) fox_prefix(LF + (size_t)(bh >> 4) * SEQ * 16 + (bh & 15), (LAS float*)(lds + 98304), (LAS float*)(lds + 131072), tid2, lane2, wid2);
                            attn_body::attn_unit<60>(bh >> 4, bh & 15, qb, (const attn_body::bf16*)Qb, (const attn_body::bf16*)Kb, (const attn_body::bf16*)Vb, (attn_body::bf16*)Qb, (char*)lds_raw, (attn_body::lds_fptr)(lds + 98304), tid2); }
#endif
                }
            } break;
            case 4: {
#if PHM & 64
                if (L == 0) { FRESH();
#pragma unroll 1
                    for (int dup = 0; dup < 1 + DUP_POST; ++dup)
                    for (int t = bx; t < M / 32; t += G) rwkv_post_unit(t, PROJ, YRAW, C3, Y, INP(15), (const bf16*)(ws + WS_G2F), INP(24), INP(25), lane, wid); }
#endif
            } break;
            case 8: {
#if PHM & 128
                FRESH();
#pragma unroll 1
                for (int mode = 0; mode < 2; ++mode) {
                    pg8::EpiPle E{mode, X, (L == 0) ? Y : (bf16*)nullptr, PP, ssq + (size_t)M * 16, ssq};
                    GEMM(pg8::EpiPle, mode ? XB : PB, mode ? ws + WS_WG + (size_t)L * 2 * MiB : ws + WS_WP + (size_t)L * PLE * D * 2, D, mode ? D : PLE, E);
                    __syncthreads();
                }
#endif
            } break;
            }
            if (!(L == 1 && st == 4) && ph + 1 < ph_hi) { GSYNC(); for (int dup = 0; dup < DUP_SYNC; ++dup) GSYNC(); }
        }
    }
#undef GEMM
    if (ph_hi == 20) { FRESH(); const float* fg = INP(29); const float* s8 = ssq;
        for (int m = gw; m < M; m += NGW) { f32x4* xr = (f32x4*)(X + (size_t)m * D) + lane; const float rs = pg8::rstd_of(s8, m);
#pragma unroll
            for (int j = 0; j < 4; ++j) { const f32x4 gv = ((const f32x4*)fg)[lane + 64 * j]; xr[64 * j] = xr[64 * j] * rs * gv; } } }
}

extern "C" void kernel_launch(void* const* d_in, const int* in_sizes, int n_in, void* d_out, int out_size, void* d_ws, size_t ws_size, hipStream_t stream) {
    static int grid = 0;
    if (grid == 0) {
        if (n_in != 30 || out_size != M * D || ws_size < WS_END) { fprintf(stderr, "kernel_launch: unexpected shapes (n_in %d out %d ws %zu)\n", n_in, out_size, ws_size); grid = -1; return; }
        int dev = 0, cus = 0, per_cu = 0;
        if (hipGetDevice(&dev) != hipSuccess || hipDeviceGetAttribute(&cus, hipDeviceAttributeMultiprocessorCount, dev) != hipSuccess) { grid = -1; return; }
        if (hipFuncSetAttribute((const void*)fwd_megakernel, hipFuncAttributeMaxDynamicSharedMemorySize, LDS_BYTES) != hipSuccess) { fprintf(stderr, "kernel_launch: hipFuncSetAttribute failed\n"); grid = -1; return; }
        if (hipOccupancyMaxActiveBlocksPerMultiprocessor(&per_cu, (const void*)fwd_megakernel, 512, LDS_BYTES) != hipSuccess || per_cu < 1) { fprintf(stderr, "kernel_launch: occupancy query failed (%d)\n", per_cu); (void)hipGetLastError(); grid = -1; return; }
        grid = cus * per_cu;
        if (grid > 256) grid = 256;
    }
    if (grid < 0) return;
    Args a{};
    for (int i = 0; i < 30; ++i) a.in[i] = (const float*)d_in[i];
    a.out = (float*)d_out; a.ws = (unsigned char*)d_ws;
#ifndef N_LAUNCH_PER_PHASE
    a.ph_lo = 0; a.ph_hi = 20;
    { void* args[] = {&a};
      hipError_t e = hipLaunchCooperativeKernel((const void*)fwd_megakernel, dim3(grid), dim3(512), args, LDS_BYTES, stream);
      if (e != hipSuccess) fprintf(stderr, "cooperative launch failed: %s (grid %d)\n", hipGetErrorString(e), grid); }
#else
    for (int ph = 0; ph < 20; ++ph) { if (ph == 14) continue; a.ph_lo = ph; a.ph_hi = ph + 1; void* args[] = {&a};
      hipError_t e = hipLaunchCooperativeKernel((const void*)fwd_megakernel, dim3(grid), dim3(512), args, LDS_BYTES, stream);
      if (e != hipSuccess) { fprintf(stderr, "cooperative launch failed: %s (grid %d)\n", hipGetErrorString(e), grid); break; } }
#endif
}
```

```cpp
#include <hip/hip_runtime.h>
#include <hip/hip_cooperative_groups.h>
#include <hip/hip_bf16.h>
#include <cstdio>
#include <cstdint>
#include <cmath>
namespace cg = cooperative_groups;
#ifndef PHM
#define PHM 255
#endif
namespace pg8 {
#define PG8_LAS __attribute__((address_space(3)))
typedef unsigned short bf16_t;
typedef short bf16x8 __attribute__((ext_vector_type(8)));
typedef float f32x4 __attribute__((ext_vector_type(4)));
typedef unsigned u32x4 __attribute__((ext_vector_type(4)));
constexpr int BM = 256, BK = 64, HALF = 128, HTB = HALF * BK * 2  , STAGE_BYTES = 8 * HTB, NXCD = 8, WGM = 8;

__host__ __device__ __forceinline__ int lds_byte(int r, int c) { const int st = (r >> 4) * 2 + (c >> 5), rr = r & 15, cc = c & 31, ob = rr * 64 + cc * 2; return st * 1024 + (ob ^ (((ob >> 9) & 1) << 5)); }
__host__ __device__ __forceinline__ void stage_rc(int b, int& R, int& C) { const int st = b / 1024, sb = b % 1024, swz = sb ^ (((sb >> 9) & 1) << 5); R = (st >> 1) * 16 + swz / 64; C = (st & 1) * 32 + (swz % 64) / 2; }
__host__ __device__ __forceinline__ int perm32(int rho) { const int n = rho >> 4, i = rho & 15; return 8 * (i >> 2) + 4 * n + (i & 3); }

struct Unit { int pm, pn; };
struct Gemm { const bf16_t* A; const bf16_t* Bt; int M, N, K; };

struct StaticOrder {
    int nM, nN, nwg, G, c;
    __host__ __device__ void init(int M, int N, int G_, int c_) { nM = M / BM; nN = N / BM; nwg = nM * nN; G = G_; c = c_; }
    __host__ __device__ bool next(int i, Unit& u) const {
        const long L = (long)i * G + c; if (L >= nwg) return false;
        int wgid = (int)L; { const int q = nwg / NXCD, r = nwg % NXCD, xcd = wgid % NXCD, off = wgid / NXCD; wgid = (xcd < r ? xcd * (q + 1) : r * (q + 1) + (xcd - r) * q) + off; }
        const int nig = WGM * nN, gid = wgid / nig, fm = gid * WGM, gsz = (nM - fm) < WGM ? (nM - fm) : WGM;
        u.pm = fm + ((wgid % nig) % gsz); u.pn = (wgid % nig) / gsz; return true;
    }
    __device__ __forceinline__ void a_ready(const Unit&) const {}
    __device__ __forceinline__ void done(const Unit&) const {}
};

typedef float f32x2_c __attribute__((ext_vector_type(2))); typedef __bf16 bf16x2_c __attribute__((ext_vector_type(2)));
__device__ __forceinline__ unsigned cvt_pk_bf16(float lo, float hi) { f32x2_c v = {lo, hi}; bf16x2_c b = __builtin_convertvector(v, bf16x2_c); return __builtin_bit_cast(unsigned, b); }
typedef float f32x2 __attribute__((ext_vector_type(2)));
constexpr float NORM_EPS = 1e-6f;
__device__ __forceinline__ float ssq_sum(const float* ssq, int row) { const f32x4* p = (const f32x4*)(ssq + (size_t)row * 16); const f32x4 a = p[0], b = p[1], c = p[2], d = p[3];
    return ((a[0] + a[1]) + (a[2] + a[3])) + ((b[0] + b[1]) + (b[2] + b[3])) + (((c[0] + c[1]) + (c[2] + c[3])) + ((d[0] + d[1]) + (d[2] + d[3]))); }
__device__ __forceinline__ float rstd_of(const float* ssq, int row) { return rsqrtf(ssq_sum(ssq, row) * (1.0f / 1024.0f) + NORM_EPS); }
__device__ __forceinline__ void rstd8(const float* ssq, int row0, int fr, int fq, float (&rs)[2][4]) {
    const int i0 = 2 * fq, i1 = 2 * fq + 1;
    const float m0 = rstd_of(ssq, row0 + (i0 >> 2) * HALF + (i0 & 3) * 16), m1 = rstd_of(ssq, row0 + (i1 >> 2) * HALF + (i1 & 3) * 16);
#pragma unroll
    for (int ai = 0; ai < 2; ++ai)
#pragma unroll
        for (int m = 0; m < 4; ++m) { const int idx = ai * 4 + m; rs[ai][m] = __shfl((idx & 1) ? m1 : m0, (idx >> 1) * 16 + fr); }
}
__device__ __forceinline__ float sigm(float x) { return __builtin_amdgcn_rcpf(1.0f + __expf(-x)); }
struct EpiGU { static constexpr bool PERM = true, AFTER_DRAIN = false;
    bf16_t* H; const float* ssq;
    __device__ __forceinline__ void operator()(const f32x4 (&acc)[2][2][4][2], const Unit& u, int wr, int wc, int fr, int fq) const {
        int row0 = u.pm * BM + wr * 64 + fr; asm volatile("" : "+v"(row0)); const int col0 = u.pn * 128 + wc * 32 + 8 * fq; float rsv[2][4]; rstd8(ssq, row0, fr, fq, rsv);
#pragma unroll
        for (int ai = 0; ai < 2; ++ai)
#pragma unroll
            for (int m = 0; m < 4; ++m) { const int row = row0 + ai * HALF + m * 16; const float rs = rsv[ai][m];
                const float nk = -1.4426950408889634f * rs, rs2 = rs * rs; u32x4 w;
#pragma unroll
                for (int n = 0; n < 2; ++n) { const f32x4 ag = acc[ai][0][m][n], au = acc[ai][1][m][n]; const f32x4 t = ag * nk; f32x4 d;
                    d[0] = __builtin_amdgcn_exp2f(t[0]); d[1] = __builtin_amdgcn_exp2f(t[1]); d[2] = __builtin_amdgcn_exp2f(t[2]); d[3] = __builtin_amdgcn_exp2f(t[3]);
                    d = d + 1.0f; f32x4 r; r[0] = __builtin_amdgcn_rcpf(d[0]); r[1] = __builtin_amdgcn_rcpf(d[1]); r[2] = __builtin_amdgcn_rcpf(d[2]); r[3] = __builtin_amdgcn_rcpf(d[3]);
                    const f32x4 hv = (ag * au) * (r * rs2);
                    if (n == 0) { w.x = cvt_pk_bf16(hv[0], hv[1]); w.y = cvt_pk_bf16(hv[2], hv[3]); } else { w.z = cvt_pk_bf16(hv[0], hv[1]); w.w = cvt_pk_bf16(hv[2], hv[3]); } }
                *(u32x4*)(H + (size_t)row * 2816 + col0) = w; }
    }
};
struct EpiRes { static constexpr bool PERM = true, AFTER_DRAIN = false;
    const float* base; float* X; bf16_t* XB; float* ssq_out; float alpha;
    __device__ __forceinline__ void operator()(const f32x4 (&acc)[2][2][4][2], const Unit& u, int wr, int wc, int fr, int fq) const {
        int row0 = u.pm * BM + wr * 64 + fr; asm volatile("" : "+v"(row0)); const int col0 = u.pn * BM + wc * 32 + 8 * fq;
#pragma unroll
        for (int ai = 0; ai < 2; ++ai)
#pragma unroll
            for (int m = 0; m < 4; ++m) { const int row = row0 + ai * HALF + m * 16; float part = 0.f;
#pragma unroll
                for (int bj = 0; bj < 2; ++bj) { const size_t off = (size_t)row * 1024 + col0 + bj * HALF;
                    const f32x4 b0 = *(const f32x4*)(base + off), b1 = *(const f32x4*)(base + off + 4);
                    const f32x4 v0 = b0 + acc[ai][bj][m][0] * alpha, v1 = b1 + acc[ai][bj][m][1] * alpha;
                    *(f32x4*)(X + off) = v0; *(f32x4*)(X + off + 4) = v1;
                    u32x4 w; w.x = cvt_pk_bf16(v0[0], v0[1]); w.y = cvt_pk_bf16(v0[2], v0[3]); w.z = cvt_pk_bf16(v1[0], v1[1]); w.w = cvt_pk_bf16(v1[2], v1[3]);
                    *(u32x4*)(XB + off) = w;
                    part += (v0[0] * v0[0] + v0[1] * v0[1]) + (v0[2] * v0[2] + v0[3] * v0[3]) + (v1[0] * v1[0] + v1[1] * v1[1]) + (v1[2] * v1[2] + v1[3] * v1[3]); }
                part += __shfl_xor(part, 16); part += __shfl_xor(part, 32);
                if (fq == 0) ssq_out[(size_t)row * 16 + u.pn * 4 + wc] = part; }
    }
};
struct EpiPle { static constexpr bool PERM = true, AFTER_DRAIN = false;
    int mode; float* X; bf16_t* XB; bf16_t* PP; const float* ssq_in; float* ssq_out;
    __device__ __forceinline__ void operator()(const f32x4 (&acc)[2][2][4][2], const Unit& u, int wr, int wc, int fr, int fq) const {
        int row0 = u.pm * BM + wr * 64 + fr; asm volatile("" : "+v"(row0)); const int col0 = u.pn * BM + wc * 32 + 8 * fq;
#pragma unroll
        for (int ai = 0; ai < 2; ++ai)
#pragma unroll
            for (int m = 0; m < 4; ++m) { const int row = row0 + ai * HALF + m * 16; float part = 0.f; const float rs = mode ? rstd_of(ssq_in, row) : 1.f;
#pragma unroll
                for (int bj = 0; bj < 2; ++bj) { const size_t off = (size_t)row * 1024 + col0 + bj * HALF;
                    if (mode == 0) { const f32x4 v0 = acc[ai][bj][m][0], v1 = acc[ai][bj][m][1];
                        u32x4 w; w.x = cvt_pk_bf16(v0[0], v0[1]); w.y = cvt_pk_bf16(v0[2], v0[3]); w.z = cvt_pk_bf16(v1[0], v1[1]); w.w = cvt_pk_bf16(v1[2], v1[3]);
                        *(u32x4*)(PP + off) = w;
                    } else {
                        const u32x4 pw = *(const u32x4*)(PP + off);
                        const f32x4 p0 = {__uint_as_float(pw.x << 16), __uint_as_float(pw.x & 0xffff0000u), __uint_as_float(pw.y << 16), __uint_as_float(pw.y & 0xffff0000u)};
                        const f32x4 p1 = {__uint_as_float(pw.z << 16), __uint_as_float(pw.z & 0xffff0000u), __uint_as_float(pw.w << 16), __uint_as_float(pw.w & 0xffff0000u)};
                        const f32x4 b0 = *(const f32x4*)(X + off), b1 = *(const f32x4*)(X + off + 4);
                        const f32x4 a0 = acc[ai][bj][m][0] * rs, a1 = acc[ai][bj][m][1] * rs;
                        f32x4 v0, v1;
#pragma unroll
                        for (int j = 0; j < 4; ++j) { v0[j] = b0[j] + sigm(a0[j]) * p0[j]; v1[j] = b1[j] + sigm(a1[j]) * p1[j]; }
                        *(f32x4*)(X + off) = v0; *(f32x4*)(X + off + 4) = v1;
                        u32x4 w; w.x = cvt_pk_bf16(v0[0], v0[1]); w.y = cvt_pk_bf16(v0[2], v0[3]); w.z = cvt_pk_bf16(v1[0], v1[1]); w.w = cvt_pk_bf16(v1[2], v1[3]);
                        if (XB) *(u32x4*)(XB + off) = w;
                        part += (v0[0] * v0[0] + v0[1] * v0[1]) + (v0[2] * v0[2] + v0[3] * v0[3]) + (v1[0] * v1[0] + v1[1] * v1[1]) + (v1[2] * v1[2] + v1[3] * v1[3]); } }
                if (mode) { part += __shfl_xor(part, 16); part += __shfl_xor(part, 32); if (fq == 0) ssq_out[(size_t)row * 16 + u.pn * 4 + wc] = part; } }
    }
};
struct EpiStore { static constexpr bool PERM = true, AFTER_DRAIN = false;
    bf16_t* O; int ldc; const float* ssq; float scale0; int scale_tiles; int split_tiles; size_t split_stride; int lf_tile; float* LF; const float* bfv;
    __device__ __forceinline__ void operator()(const f32x4 (&acc)[2][2][4][2], const Unit& u, int wr, int wc, int fr, int fq) const {
        int row0 = u.pm * BM + wr * 64 + fr; asm volatile("" : "+v"(row0));
        if (u.pn == lf_tile) {
            if (wc == 0 && fq < 2) {
#pragma unroll
                for (int ai = 0; ai < 2; ++ai)
#pragma unroll
                    for (int m = 0; m < 4; ++m) { const int row = row0 + ai * HALF + m * 16; const float rs = rstd_of(ssq, row);
#pragma unroll
                        for (int n = 0; n < 2; ++n) { f32x4 o;
#pragma unroll
                            for (int j = 0; j < 4; ++j) { const float z = fmaxf(acc[ai][0][m][n][j] * rs + bfv[8 * fq + 4 * n + j], -80.f), e = __expf(-z);
                                o[j] = (e < 0.01f) ? -(e - 0.5f * e * e + e * e * e * (1.f / 3.f)) : -__logf(1.f + e); }
                            *(f32x4*)(LF + (size_t)row * 16 + 8 * fq + 4 * n) = o; } }
            }
            return;
        }
        const int t = u.pn / split_tiles, ct = u.pn - t * split_tiles;
        bf16_t* base = O + (size_t)t * split_stride; const float sc = (u.pn < scale_tiles) ? scale0 : 1.f;
        const int col0 = ct * BM + wc * 32 + 8 * fq; float rsv[2][4]; rstd8(ssq, row0, fr, fq, rsv);
#pragma unroll
        for (int ai = 0; ai < 2; ++ai)
#pragma unroll
            for (int m = 0; m < 4; ++m) { const int row = row0 + ai * HALF + m * 16; const float rs = rsv[ai][m] * sc;
#pragma unroll
                for (int bj = 0; bj < 2; ++bj) { const f32x4 v0 = acc[ai][bj][m][0] * rs, v1 = acc[ai][bj][m][1] * rs;
                    u32x4 w; w.x = cvt_pk_bf16(v0[0], v0[1]); w.y = cvt_pk_bf16(v0[2], v0[3]); w.z = cvt_pk_bf16(v1[0], v1[1]); w.w = cvt_pk_bf16(v1[2], v1[3]);
                    *(u32x4*)(base + (size_t)row * ldc + col0 + bj * HALF) = w; } }
    }
};

template <class Epi, class Sched, bool ALIGN_EPI = false, bool SP2 = false>
__device__ __forceinline__ void gemm_phase(PG8_LAS unsigned char* lds, const Gemm g, const Sched& S, const Epi& E, const int tid) {
    const int wid = __builtin_amdgcn_readfirstlane(tid >> 6), lane = tid & 63, wr = wid >> 2, wc = wid & 3, fr = lane & 15, fq = lane >> 4;
    const int K = g.K, nt = K / BK;
    unsigned voffA[2], voffB[2];
#pragma unroll
    for (int i = 0; i < 2; ++i) { int R, C; stage_rc(tid * 16 + i * 8192, R, C); const int Rb = Epi::PERM ? ((R & ~31) + perm32(R & 31)) : R;
        voffA[i] = (unsigned)(R * K + C) * 2u; voffB[i] = (unsigned)(Rb * K + C) * 2u; }
    const size_t kstep = (size_t)(BK * 2);
    const size_t hstep = (size_t)HALF * K * 2;
    const size_t tstep = 2 * hstep;
    const unsigned ldsw = (unsigned)wid * 1024u;
    const int aoff = lds_byte(wr * 64 + fr, fq * 8), boff = lds_byte(wc * 32 + fr, fq * 8);
#define PG8_SA(b, h) (((b) * 2 + (h)) * HTB)
#define PG8_SB(b, h) ((4 + (b) * 2 + (h)) * HTB)
#define PG8_STAGE(bufoff, gbase, voff) do { _Pragma("unroll") for (int _i = 0; _i < 2; ++_i) \
        __builtin_amdgcn_global_load_lds((const unsigned*)((const char*)(gbase) + (voff)[_i]), (PG8_LAS unsigned*)(lds + (bufoff) + ldsw + _i * 8192), 16, 0, 0); } while (0)
#define PG8_LDA(dst, b, h) do { _Pragma("unroll") for (int m = 0; m < 4; ++m) _Pragma("unroll") for (int k = 0; k < 2; ++k) dst[m][k] = *(const PG8_LAS bf16x8*)(lds + PG8_SA(b, h) + aoff + m * 2048 + k * 1024); } while (0)
#define PG8_LDB(dst, b, h) do { _Pragma("unroll") for (int n = 0; n < 2; ++n) _Pragma("unroll") for (int k = 0; k < 2; ++k) dst[n][k] = *(const PG8_LAS bf16x8*)(lds + PG8_SB(b, h) + boff + n * 2048 + k * 1024); } while (0)
#define PG8_MMA(ai, bj, At, Bt) do { __builtin_amdgcn_s_setprio(1); _Pragma("unroll") for (int m = 0; m < 4; ++m) _Pragma("unroll") for (int n = 0; n < 2; ++n) _Pragma("unroll") for (int k = 0; k < 2; ++k) \
        acc[ai][bj][m][n] = __builtin_amdgcn_mfma_f32_16x16x32_bf16(Bt[n][k], At[m][k], acc[ai][bj][m][n], 0, 0, 0); __builtin_amdgcn_s_setprio(0); } while (0)
#define PG8_WAIT_V(n) asm volatile("s_waitcnt vmcnt(" #n ")" ::: "memory")
#define PG8_WAIT_L(n) asm volatile("s_waitcnt lgkmcnt(" #n ")" ::: "memory")
#define PG8_BAR __builtin_amdgcn_s_barrier()
#define PG8_SCHED __builtin_amdgcn_sched_barrier(0)
    Unit cur, nxt; int ui = 0;
    if (!S.next(0, cur)) return;
    f32x4 acc[2][2][4][2];
#pragma unroll
    for (int a = 0; a < 2; ++a)
#pragma unroll
        for (int b = 0; b < 2; ++b)
#pragma unroll
            for (int m = 0; m < 4; ++m)
#pragma unroll
                for (int n = 0; n < 2; ++n) acc[a][b][m][n] = (f32x4){0.f, 0.f, 0.f, 0.f};
    bf16x8 At[4][2], B0[2][2], B1[2][2];
    const char* cA = (const char*)g.A + (size_t)cur.pm * tstep; const char* cB = (const char*)g.Bt + (size_t)cur.pn * tstep;
    S.a_ready(cur);
    if constexpr (SP2) {
        PG8_STAGE(PG8_SB(0, 0), cB, voffB); PG8_STAGE(PG8_SB(0, 1), cB + hstep, voffB); PG8_STAGE(PG8_SA(0, 0), cA, voffA); PG8_STAGE(PG8_SA(0, 1), cA + hstep, voffA);
        if (wr == 1) PG8_BAR;
        PG8_WAIT_V(2); PG8_BAR;
        PG8_STAGE(PG8_SB(1, 0), cB + kstep, voffB); PG8_STAGE(PG8_SA(1, 0), cA + kstep, voffA); PG8_STAGE(PG8_SB(1, 1), cB + hstep + kstep, voffB);
        PG8_WAIT_V(6); PG8_BAR;
    } else {
        PG8_STAGE(PG8_SB(0, 0), cB, voffB); PG8_STAGE(PG8_SA(0, 0), cA, voffA); PG8_STAGE(PG8_SB(0, 1), cB + hstep, voffB); PG8_STAGE(PG8_SA(0, 1), cA + hstep, voffA);
        if (wr == 1) PG8_BAR;
        PG8_WAIT_V(4); PG8_BAR;
        PG8_STAGE(PG8_SB(1, 0), cB + kstep, voffB); PG8_STAGE(PG8_SA(1, 0), cA + kstep, voffA); PG8_STAGE(PG8_SB(1, 1), cB + hstep + kstep, voffB);
        PG8_WAIT_V(6); PG8_BAR;
    }
    for (;;) {
        const bool has_next = S.next(ui + 1, nxt);
        const char* nA = has_next ? (const char*)g.A + (size_t)nxt.pm * tstep : cA; const char* nB = has_next ? (const char*)g.Bt + (size_t)nxt.pn * tstep : cB;
        for (int t = 0; t < nt; t += 2) {
            const bool last = (t == nt - 2);
            const char* a1 = cA + (size_t)(t + 1) * kstep;
            const char* a2 = last ? nA : cA + (size_t)(t + 2) * kstep; const char* b2 = last ? nB : cB + (size_t)(t + 2) * kstep;
            const char* a3 = a2 + kstep; const char* b3 = b2 + kstep;
            if (last && has_next) S.a_ready(nxt);
            if constexpr (SP2) {
            PG8_LDB(B0, 0, 0); PG8_LDB(B1, 0, 1); PG8_SCHED; PG8_LDA(At, 0, 0); PG8_STAGE(PG8_SA(1, 1), a1 + hstep, voffA);
            PG8_WAIT_V(8); PG8_WAIT_L(0); PG8_BAR; PG8_MMA(0, 0, At, B0); PG8_MMA(0, 1, At, B1); PG8_BAR; PG8_SCHED;
            PG8_LDA(At, 0, 1); PG8_STAGE(PG8_SB(0, 0), b2, voffB); PG8_STAGE(PG8_SB(0, 1), b2 + hstep, voffB); PG8_STAGE(PG8_SA(0, 0), a2, voffA);
            PG8_WAIT_V(8); PG8_WAIT_L(0); PG8_BAR; PG8_MMA(1, 0, At, B0); PG8_MMA(1, 1, At, B1); PG8_BAR; PG8_SCHED;
            PG8_LDB(B0, 1, 0); PG8_LDB(B1, 1, 1); PG8_SCHED; PG8_LDA(At, 1, 0); PG8_STAGE(PG8_SA(0, 1), a2 + hstep, voffA);
            PG8_WAIT_V(8); PG8_WAIT_L(0); PG8_BAR; PG8_MMA(0, 0, At, B0); PG8_MMA(0, 1, At, B1); PG8_BAR; PG8_SCHED;
            PG8_LDA(At, 1, 1); PG8_STAGE(PG8_SB(1, 0), b3, voffB); PG8_STAGE(PG8_SB(1, 1), b3 + hstep, voffB); PG8_STAGE(PG8_SA(1, 0), a3, voffA);
            PG8_WAIT_V(8); PG8_WAIT_L(0); PG8_BAR; PG8_MMA(1, 0, At, B0); PG8_MMA(1, 1, At, B1); PG8_BAR; PG8_SCHED;
            } else {
            PG8_LDB(B0, 0, 0); PG8_SCHED; PG8_LDA(At, 0, 0); PG8_STAGE(PG8_SA(1, 1), a1 + hstep, voffA);
            PG8_WAIT_L(8); PG8_BAR; PG8_WAIT_L(0); PG8_MMA(0, 0, At, B0); PG8_BAR; PG8_SCHED;
            PG8_LDB(B1, 0, 1); PG8_STAGE(PG8_SB(0, 0), b2, voffB);
            PG8_BAR; PG8_WAIT_L(0); PG8_MMA(0, 1, At, B1); PG8_BAR;
            PG8_LDA(At, 0, 1); PG8_STAGE(PG8_SA(0, 0), a2, voffA);
            PG8_BAR; PG8_WAIT_L(0); PG8_MMA(1, 0, At, B0); PG8_BAR; PG8_SCHED;
            PG8_STAGE(PG8_SB(0, 1), b2 + hstep, voffB);
            PG8_WAIT_V(6); PG8_BAR; PG8_MMA(1, 1, At, B1); PG8_BAR;
            PG8_LDB(B0, 1, 0); PG8_SCHED; PG8_LDA(At, 1, 0); PG8_STAGE(PG8_SA(0, 1), a2 + hstep, voffA);
            PG8_WAIT_L(8); PG8_BAR; PG8_WAIT_L(0); PG8_MMA(0, 0, At, B0); PG8_BAR; PG8_SCHED;
            PG8_LDB(B1, 1, 1); PG8_STAGE(PG8_SB(1, 0), b3, voffB);
            PG8_BAR; PG8_WAIT_L(0); PG8_MMA(0, 1, At, B1); PG8_BAR;
            PG8_LDA(At, 1, 1); PG8_STAGE(PG8_SA(1, 0), a3, voffA);
            PG8_BAR; PG8_WAIT_L(0); PG8_MMA(1, 0, At, B0); PG8_BAR; PG8_SCHED;
            PG8_STAGE(PG8_SB(1, 1), b3 + hstep, voffB);
            PG8_WAIT_V(6); PG8_BAR; PG8_MMA(1, 1, At, B1); PG8_BAR;
            }
        }
        if constexpr (ALIGN_EPI) { if (wr == 0) PG8_BAR; }
        if constexpr (!Epi::AFTER_DRAIN) { E(acc, cur, wr, wc, fr, fq); S.done(cur); }
        if (!has_next) break;
#pragma unroll
        for (int a = 0; a < 2; ++a)
#pragma unroll
            for (int b = 0; b < 2; ++b)
#pragma unroll
                for (int m = 0; m < 4; ++m)
#pragma unroll
                    for (int n = 0; n < 2; ++n) acc[a][b][m][n] = (f32x4){0.f, 0.f, 0.f, 0.f};
        cur = nxt; cA = nA; cB = nB; ++ui;
        if constexpr (ALIGN_EPI) { if (wr == 1) PG8_BAR; }
    }
    PG8_WAIT_V(0);
    if constexpr (!ALIGN_EPI) { if (wr == 0) PG8_BAR; }
    PG8_BAR;
    if constexpr (Epi::AFTER_DRAIN) { E.fused(acc, cur, wr, wc, fr, fq, lds, wid, lane); S.done(cur); }
#undef PG8_SA
#undef PG8_SB
#undef PG8_STAGE
#undef PG8_LDA
#undef PG8_LDB
#undef PG8_MMA
#undef PG8_WAIT_V
#undef PG8_WAIT_L
#undef PG8_BAR
#undef PG8_SCHED
}
}
#include <hip/hip_bf16.h>
#include <cmath>
namespace attn_body {
using bf16=__hip_bfloat16;
using bf16x8=__attribute__((ext_vector_type(8)))short;
using s16x4=__attribute__((ext_vector_type(4)))short;
using f32x16=__attribute__((ext_vector_type(16)))float;
using u32x4=__attribute__((ext_vector_type(4)))unsigned;
constexpr int BATCH=4,NHEAD=16,SEQ=4096,D=64,DM=NHEAD*D;
constexpr int NW=8,QBLK=32,QB=QBLK*NW,KVBLK=64,NQB=SEQ/QB;
constexpr int ATTN_PITCH=DM, ATTN_UNIT_ROWS=QB;
__device__ __forceinline__ int crow(int r,int hi){return (r&3)+8*(r>>2)+4*hi;}
#define SBAR() __builtin_amdgcn_sched_barrier(0)
__device__ __forceinline__ void cmask(f32x16&p0,f32x16&p1,int jb,int qrel,int hi){
  const float NEG=-INFINITY; int kb=64*jb+4*hi;
  #pragma unroll
  for(int r=0;r<16;++r){int kv=kb+(r&3)+8*(r>>2); if(kv>qrel)p0[r]=NEG; if(kv+32>qrel)p1[r]=NEG;}
}

constexpr int NSLOT=3, SLOTB=8192;
constexpr int LDS_K=0, LDS_V=NSLOT*SLOTB, LDS_WS=2*NSLOT*SLOTB, LDS_OST=LDS_WS+NW*64*4, LDS_BYTES=LDS_OST+NW*4096;
constexpr float C2=0.125f*1.4426950408889634f;
__device__ __forceinline__ void glds16(const void*gsrc,unsigned lds_dst){unsigned keep;
  asm volatile("s_mov_b32 %0, m0\n\ts_mov_b32 m0, %2\n\ts_nop 0\n\tglobal_load_lds_dwordx4 %1, off\n\ts_mov_b32 m0, %0":"=&s"(keep):"v"(gsrc),"s"(lds_dst):"memory");}
__device__ __forceinline__ float max3f(float a,float b,float c){float r;asm("v_max3_f32 %0, %1, %2, %3":"=v"(r):"v"(a),"v"(b),"v"(c));return r;}
__device__ __forceinline__ float max2f(float a,float b){float r;asm("v_max_f32_e32 %0, %1, %2":"=v"(r):"v"(a),"v"(b));return r;}
__device__ __forceinline__ float fadd_s(float a,float b){float r;asm("v_add_f32_e32 %0, %1, %2":"=v"(r):"v"(a),"v"(b));return r;}
__device__ __forceinline__ float fsub_s(float a,float b){float r;asm("v_sub_f32_e32 %0, %1, %2":"=v"(r):"v"(a),"v"(b));return r;}
typedef float f32x2_t __attribute__((ext_vector_type(2))); typedef __bf16 bf16x2_t __attribute__((ext_vector_type(2)));
__device__ __forceinline__ unsigned cvtpk_s(float lo,float hi){f32x2_t v={lo,hi};bf16x2_t b=__builtin_convertvector(v,bf16x2_t);return __builtin_bit_cast(unsigned,b);}
#define WAIT_BAR(N) asm volatile("s_waitcnt vmcnt(" #N ") lgkmcnt(0)\n\ts_barrier":::"memory")

__device__ __forceinline__ void qkt(f32x16&p0,f32x16&p1,const char*Kslot,const bf16x8*qr,int r32,int hi){
  const char*kb=Kslot+hi*1024+r32*16;
  #pragma unroll
  for(int d0=0;d0<4;++d0){
    const bf16x8 b0=*reinterpret_cast<const bf16x8*>(kb+d0*2048);
    const bf16x8 b1=*reinterpret_cast<const bf16x8*>(kb+d0*2048+512);
    {p0=__builtin_amdgcn_mfma_f32_32x32x16_bf16(b0,qr[d0],p0,0,0,0);p1=__builtin_amdgcn_mfma_f32_32x32x16_bf16(b1,qr[d0],p1,0,0,0);}}
}
typedef __attribute__((address_space(3))) const char* lds_cptr;
typedef short v4i16_t __attribute__((ext_vector_type(4)));
__device__ __forceinline__ void kload8(bf16x8*kf,lds_cptr kp){
  kf[0]=*(const __attribute__((address_space(3))) bf16x8*)(kp);      kf[1]=*(const __attribute__((address_space(3))) bf16x8*)(kp+512);
  kf[2]=*(const __attribute__((address_space(3))) bf16x8*)(kp+2048); kf[3]=*(const __attribute__((address_space(3))) bf16x8*)(kp+2560);
  kf[4]=*(const __attribute__((address_space(3))) bf16x8*)(kp+4096); kf[5]=*(const __attribute__((address_space(3))) bf16x8*)(kp+4608);
  kf[6]=*(const __attribute__((address_space(3))) bf16x8*)(kp+6144); kf[7]=*(const __attribute__((address_space(3))) bf16x8*)(kp+6656);
}
__device__ __forceinline__ void kload2(bf16x8*kf,lds_cptr kp,int j){ kf[2*j]=*(const __attribute__((address_space(3))) bf16x8*)(kp+j*2048); kf[2*j+1]=*(const __attribute__((address_space(3))) bf16x8*)(kp+j*2048+512); }
__device__ __forceinline__ s16x4 vtr(lds_cptr p){ return __builtin_bit_cast(s16x4,__builtin_amdgcn_ds_read_tr16_b64_v4i16((__attribute__((address_space(3))) v4i16_t*)p)); }
__device__ __forceinline__ float rowmax(const f32x16&p0,const f32x16&p1){
  float a=max3f(p0[0],p0[1],p1[0]),b=max3f(p0[2],p0[3],p1[1]);a=max3f(a,p1[2],p1[3]);
  #pragma unroll
  for(int r=4;r<16;r+=4){a=max3f(a,p0[r],p0[r+1]);b=max3f(b,p0[r+2],p0[r+3]);a=max3f(a,p1[r],p1[r+1]);b=max3f(b,p1[r+2],p1[r+3]);}
  const float m=max2f(a,b);
  auto rr=__builtin_amdgcn_permlane32_swap(__float_as_uint(m),__float_as_uint(m),false,false);
  return max2f(__uint_as_float(rr[0]),__uint_as_float(rr[1]));
}
__device__ __forceinline__ void pv(f32x16*o,int vb,bf16x8 pa0,bf16x8 pa1,bf16x8 pa2,bf16x8 pa3){
  #pragma unroll
  for(int d0=0;d0<2;++d0){s16x4 lo[4],hi[4];
    #pragma unroll
    for(int ks=0;ks<4;++ks){
      asm volatile("ds_read_b64_tr_b16 %0,%1 offset:%c2":"=&v"(lo[ks]):"v"(vb),"i"(d0*4096+ks*1024):"memory");
      asm volatile("ds_read_b64_tr_b16 %0,%1 offset:%c2":"=&v"(hi[ks]):"v"(vb),"i"(d0*4096+ks*1024+512):"memory");}
    asm volatile("s_waitcnt lgkmcnt(0)":::"memory");SBAR();
    #define PK(k) (bf16x8){lo[k][0],lo[k][1],lo[k][2],lo[k][3],hi[k][0],hi[k][1],hi[k][2],hi[k][3]}
    o[d0]=__builtin_amdgcn_mfma_f32_32x32x16_bf16(pa0,PK(0),o[d0],0,0,0);
    o[d0]=__builtin_amdgcn_mfma_f32_32x32x16_bf16(pa1,PK(1),o[d0],0,0,0);
    o[d0]=__builtin_amdgcn_mfma_f32_32x32x16_bf16(pa2,PK(2),o[d0],0,0,0);
    o[d0]=__builtin_amdgcn_mfma_f32_32x32x16_bf16(pa3,PK(3),o[d0],0,0,0);
    #undef PK
  }
}

#ifndef ATTN_STORE16
#define ATTN_STORE16(p,v) (*(u32x4*)(p)=(v))
#endif
typedef float f32x4b __attribute__((ext_vector_type(4)));
typedef __attribute__((address_space(3))) const float* lds_fptr;
typedef __attribute__((address_space(3))) const f32x4b* lds_f4ptr;
template<int THRL> __device__ __forceinline__ void attn_unit(int b,int h,int qb,const bf16*Q,const bf16*__restrict__ K,const bf16*__restrict__ V,bf16*O,char*shm,lds_fptr cs,const int tid){
  const int lane=tid&63,r32=lane&31,hi=lane>>5; const int wid=__builtin_amdgcn_readfirstlane(tid>>6);
  const long rowbase=(long)b*SEQ; const int q0=qb*QB;
  const bf16*Qw=Q+(rowbase+q0+wid*QBLK)*DM+h*D;
  const bf16*Kh=K+rowbase*DM+h*D,*Vh=V+rowbase*DM+h*D;
  const unsigned lds0=(unsigned)(uintptr_t)shm;
  float*wsf=(float*)(shm+LDS_WS)+wid*64;
  const bf16*ksrc=Kh+(long)lane*DM+wid*8;
  const bf16*vsrc=Vh+(long)(16*(wid&3)+(lane>>2))*DM+(wid>>2)*32+(lane&3)*8;
  const unsigned kdst=lds0+LDS_K+wid*1024, vdst=lds0+LDS_V+wid*1024;
  #define DMA_K(t,slot) glds16(ksrc+(long)(t)*KVBLK*DM,(unsigned)__builtin_amdgcn_readfirstlane(kdst+(slot)))
  #define DMA_V(t,slot) glds16(vsrc+(long)(t)*KVBLK*DM,(unsigned)__builtin_amdgcn_readfirstlane(vdst+(slot)))
  const int vb0=(int)(lds0+LDS_V)+((lane>>4)&1)*32+(lane&3)*8+(4*hi+((lane&15)>>2))*64;
  const char*Kbase=shm+LDS_K; bf16x8 kf[8];
  const lds_cptr shm3=(lds_cptr)shm; const lds_cptr kp0=shm3+LDS_K+hi*1024+r32*16; const lds_cptr vp0=shm3+LDS_V+((lane>>4)&1)*32+(lane&3)*8+(4*hi+((lane&15)>>2))*64;
  const int NT=(q0+QB)/KVBLK;
  DMA_K(0,0);DMA_V(0,0);DMA_K(1,SLOTB);
  bf16x8 qr[4];
  #pragma unroll
  for(int d0=0;d0<4;++d0)qr[d0]=*reinterpret_cast<const bf16x8*>(&Qw[(long)r32*DM+d0*16+hi*8]);
  const int qrel=wid*QBLK+r32;
  typedef __attribute__((address_space(3))) const unsigned long long* lds_u64p; typedef unsigned u32x2b __attribute__((ext_vector_type(2)));
  const lds_u64p ctr=(lds_u64p)cs;
  float ci2; { const unsigned long long w_=ctr[q0+qrel]; ci2=__uint_as_float((unsigned)w_<<16)+__uint_as_float((unsigned)w_&0xffff0000u)+__uint_as_float((unsigned)(w_>>32)<<16); }
  float mhat=0.f,l_reg=0.f;f32x16 o[2];o[0]=f32x16{};o[1]=f32x16{};float nm=ci2; bf16x8 bnm;
  #define MKBNM() do{ const unsigned h1_=cvtpk_s(nm,0.f)&0xffffu; const float r1_=nm-__uint_as_float(h1_<<16); const unsigned h2_=cvtpk_s(r1_,0.f)&0xffffu; const float r2_=r1_-__uint_as_float(h2_<<16); const unsigned h3_=cvtpk_s(r2_,0.f)&0xffffu; \
    u32x4 b_; b_.x=hi?0u:0xBF80BF80u; b_.y=hi?0u:(0xBF80u|(h1_<<16)); b_.z=hi?0u:(h2_|(h3_<<16)); b_.w=0u; bnm=__builtin_bit_cast(bf16x8,b_); }while(0)
  MKBNM();
  #define CINIT(P0,P1,t) do{ const unsigned long long w0_=ctr[64*(t)+r32], w1_=ctr[64*(t)+32+r32]; \
    u32x4 a0_; a0_.x=(unsigned)w0_; a0_.y=(unsigned)(w0_>>32)|0x3F800000u; a0_.z=0x3F803F80u; a0_.w=0u; u32x4 a1_; a1_.x=(unsigned)w1_; a1_.y=(unsigned)(w1_>>32)|0x3F800000u; a1_.z=0x3F803F80u; a1_.w=0u; \
    P0=__builtin_amdgcn_mfma_f32_32x32x16_bf16(__builtin_bit_cast(bf16x8,a0_),bnm,f32x16{},0,0,0); P1=__builtin_amdgcn_mfma_f32_32x32x16_bf16(__builtin_bit_cast(bf16x8,a1_),bnm,f32x16{},0,0,0); }while(0)
  #define CMASK(P0,P1,t) do{int jb_=(t)-(NT-4); if(jb_>=0)cmask(P0,P1,jb_,qrel,hi);}while(0)
  bool resc=false;
  #define START(P0,P1) do{ const float rm=rowmax(P0,P1); resc=false; \
    { const float dl=rm; mhat=fadd_s(mhat,dl); \
      _Pragma("unroll") for(int r=0;r<16;++r){P0[r]=fsub_s(P0[r],dl);P1[r]=fsub_s(P1[r],dl);} \
      nm=ci2-mhat; MKBNM(); } \
    _Pragma("unroll") for(int r=0;r<16;++r)P0[r]=__builtin_amdgcn_exp2f(P0[r]); }while(0)
  #define RESC() do{ if(resc){ asm volatile("s_waitcnt lgkmcnt(0)":::"memory"); \
      _Pragma("unroll") for(int d_=0;d_<2;++d_) _Pragma("unroll") for(int r=0;r<16;++r)o[d_][r]*=wsf[crow(r,hi)]; } }while(0)
  f32x16 pA0,pA1,pB0,pB1;
  int sl_prev=0,sl_cur=0,sl_next=SLOTB;
  #define ROT() do{sl_prev=sl_cur;sl_cur=sl_next;sl_next=(sl_next==(NSLOT-1)*SLOTB)?0:sl_next+SLOTB;}while(0)
  DMA_K(2,2*SLOTB);
  WAIT_BAR(3);
  CINIT(pA0,pA1,0);qkt(pA0,pA1,Kbase,qr,r32,hi);asm volatile("s_nop 15\n\ts_nop 7":"+v"(pA0),"+v"(pA1));CMASK(pA0,pA1,0);
  START(pA0,pA1);
  _Pragma("unroll") for(int r=0;r<16;++r)pA1[r]=__builtin_amdgcn_exp2f(pA1[r]);
  WAIT_BAR(0);
  DMA_K(3,0);DMA_V(1,SLOTB);
  ROT();
  kload8(kf,kp0+sl_cur);
  WAIT_BAR(2);
  s16x4 vlo[8],vhi[8]; u32x4 pw0,pw1,pw2,pw3;
  #define PKW(P,B) cvtpk_s(P[B],P[B+1])
  #define PAF(k) __builtin_bit_cast(bf16x8,pw##k)
  #define VFR(i) (bf16x8){vlo[i][0],vlo[i][1],vlo[i][2],vlo[i][3],vhi[i][0],vhi[i][1],vhi[i][2],vhi[i][3]}
  #define PIN(x) asm volatile("":"+v"(x))
  #define MX3(a,b,c) __builtin_fmaxf(__builtin_fmaxf((a),(b)),(c))
  #define GAPA(MF,A0,A1,A2,A3,W0,W1,PW) do{ MF; sacc+=A0; sacc+=A1; sacc+=A2; sacc+=A3; PIN(sacc); W0; W1; PIN(PW); SBAR(); }while(0)
  #define EX(v) __builtin_amdgcn_exp2f(v)
  #define GAPB(MF,X,B) do{ MF; X[B]=EX(X[B]); X[B+1]=EX(X[B+1]); X[B+2]=EX(X[B+2]); X[B+3]=EX(X[B+3]); PIN(X); SBAR(); }while(0)
  #define VRD(i) do{ vlo[i]=vtr(vp_+(((i)>>2)*4096+((i)&3)*1024)); vhi[i]=vtr(vp_+(((i)>>2)*4096+((i)&3)*1024+512)); }while(0)
  #define KRD(G,j) do{ if(G){ kload2(kf,kp0+sl_next,j); SBAR(); } }while(0)
  #define STEP(C0,C1,P0,P1,t,GK,GV,GL) do{ SBAR(); \
    const lds_cptr vp_=vp0+sl_prev; CINIT(C0,C1,t); SBAR(); \
    VRD(0); SBAR(); float sacc=(P0[0]+P0[1]); \
    GAPA(C0=__builtin_amdgcn_mfma_f32_32x32x16_bf16(kf[0],qr[0],C0,0,0,0), P0[2],P0[3],P0[4],P0[5],     pw0[0]=PKW(P0,0), pw0[1]=PKW(P0,2), pw0); \
    VRD(4); SBAR(); GAPA(C1=__builtin_amdgcn_mfma_f32_32x32x16_bf16(kf[1],qr[0],C1,0,0,0), P0[6],P0[7],P0[8],P0[9],     pw0[2]=PKW(P0,4), pw0[3]=PKW(P0,6), pw0); \
    VRD(1); SBAR(); GAPA(C0=__builtin_amdgcn_mfma_f32_32x32x16_bf16(kf[2],qr[1],C0,0,0,0),   P0[10],P0[11],P0[12],P0[13], pw1[0]=PKW(P0,8), pw1[1]=PKW(P0,10), pw1); \
    VRD(5); SBAR(); GAPA(C1=__builtin_amdgcn_mfma_f32_32x32x16_bf16(kf[3],qr[1],C1,0,0,0),   P0[14],P0[15],P1[0],P1[1],   pw1[2]=PKW(P0,12),pw1[3]=PKW(P0,14), pw1); \
    VRD(2); SBAR(); GAPA(C0=__builtin_amdgcn_mfma_f32_32x32x16_bf16(kf[4],qr[2],C0,0,0,0),   P1[2],P1[3],P1[4],P1[5],     pw2[0]=PKW(P1,0), pw2[1]=PKW(P1,2), pw2); \
    VRD(6); SBAR(); GAPA(C1=__builtin_amdgcn_mfma_f32_32x32x16_bf16(kf[5],qr[2],C1,0,0,0),   P1[6],P1[7],P1[8],P1[9],     pw2[2]=PKW(P1,4), pw2[3]=PKW(P1,6), pw2); \
    VRD(3); SBAR(); GAPA(C0=__builtin_amdgcn_mfma_f32_32x32x16_bf16(kf[6],qr[3],C0,0,0,0),   P1[10],P1[11],P1[12],P1[13], pw3[0]=PKW(P1,8), pw3[1]=PKW(P1,10), pw3); \
    VRD(7); SBAR(); GAPA(C1=__builtin_amdgcn_mfma_f32_32x32x16_bf16(kf[7],qr[3],C1,0,0,0),   P1[14],P1[15],0.f,0.f,       pw3[2]=PKW(P1,12),pw3[3]=PKW(P1,14), pw3); \
    l_reg+=sacc; \
    if(GK){DMA_K((t)+3,sl_cur);} if(GV){DMA_V((t)+1,sl_next);} \
    CMASK(C0,C1,t); \
    { float a=MX3(C0[0],C0[1],C1[0]),b=MX3(C0[2],C0[3],C1[1]); a=MX3(a,C1[2],C1[3]); \
      _Pragma("unroll") for(int r=4;r<16;r+=4){a=MX3(a,C0[r],C0[r+1]);b=MX3(b,C0[r+2],C0[r+3]);a=MX3(a,C1[r],C1[r+1]);b=MX3(b,C1[r+2],C1[r+3]);} \
      float rm=__builtin_fmaxf(a,b); { auto rr=__builtin_amdgcn_permlane32_swap(__float_as_uint(rm),__float_as_uint(rm),false,false); rm=__builtin_fmaxf(__uint_as_float(rr[0]),__uint_as_float(rr[1])); } \
      resc=false; \
      if(__builtin_expect(__any(rm>(float)THRL),0)){ const float dl=__builtin_fmaxf(rm,0.f); mhat+=dl; \
        _Pragma("unroll") for(int r=0;r<16;++r){C0[r]-=dl;C1[r]-=dl;} \
        nm=ci2-mhat; MKBNM(); \
        const float f=__builtin_amdgcn_exp2f(-dl); l_reg*=f; if(hi==0)wsf[r32]=f; resc=true; } } \
    SBAR(); \
    GAPB(o[0]=__builtin_amdgcn_mfma_f32_32x32x16_bf16(PAF(0),VFR(0),o[0],0,0,0), C0,0); \
    GAPB(o[1]=__builtin_amdgcn_mfma_f32_32x32x16_bf16(PAF(0),VFR(4),o[1],0,0,0), C0,4); \
    KRD(GL,0); GAPB(o[0]=__builtin_amdgcn_mfma_f32_32x32x16_bf16(PAF(1),VFR(1),o[0],0,0,0), C0,8); \
    KRD(GL,1); GAPB(o[1]=__builtin_amdgcn_mfma_f32_32x32x16_bf16(PAF(1),VFR(5),o[1],0,0,0), C0,12); \
    KRD(GL,2); GAPB(o[0]=__builtin_amdgcn_mfma_f32_32x32x16_bf16(PAF(2),VFR(2),o[0],0,0,0), C1,0); \
    KRD(GL,3); GAPB(o[1]=__builtin_amdgcn_mfma_f32_32x32x16_bf16(PAF(2),VFR(6),o[1],0,0,0), C1,4); \
    GAPB(o[0]=__builtin_amdgcn_mfma_f32_32x32x16_bf16(PAF(3),VFR(3),o[0],0,0,0), C1,8); \
    GAPB(o[1]=__builtin_amdgcn_mfma_f32_32x32x16_bf16(PAF(3),VFR(7),o[1],0,0,0), C1,12); \
    }while(0)
  int t=1;
  #undef CMASK
  #define CMASK(P0,P1,t) do{}while(0)
  for(;t+5<NT;t+=2){
    STEP(pB0,pB1,pA0,pA1,t,true,true,true);     WAIT_BAR(2); RESC(); ROT();
    STEP(pA0,pA1,pB0,pB1,t+1,true,true,true);   WAIT_BAR(2); RESC(); ROT();
  }
  #undef CMASK
  #define CMASK(P0,P1,t) do{int jb_=(t)-(NT-4); if(jb_>=0)cmask(P0,P1,jb_,qrel,hi);}while(0)
  #define ENDW(tt) do{ if((tt)+3<NT){WAIT_BAR(2);} else if((tt)+2<NT){WAIT_BAR(1);} else {WAIT_BAR(0);} }while(0)
  for(;t+1<NT;t+=2){
    STEP(pB0,pB1,pA0,pA1,t,(t+3<NT),(t+1<NT),(t+1<NT));       ENDW(t);   RESC(); ROT();
    STEP(pA0,pA1,pB0,pB1,t+1,(t+4<NT),(t+2<NT),(t+2<NT));     ENDW(t+1); RESC(); ROT();
  }
  STEP(pB0,pB1,pA0,pA1,NT-1,false,false,false); RESC();
  { float sacc=pB0[0]+pB0[1]; _Pragma("unroll") for(int r=2;r<16;++r)sacc+=pB0[r]; _Pragma("unroll") for(int r=0;r<16;++r)sacc+=pB1[r]; l_reg+=sacc;
    pw0=(u32x4){PKW(pB0,0),PKW(pB0,2),PKW(pB0,4),PKW(pB0,6)};pw1=(u32x4){PKW(pB0,8),PKW(pB0,10),PKW(pB0,12),PKW(pB0,14)};pw2=(u32x4){PKW(pB1,0),PKW(pB1,2),PKW(pB1,4),PKW(pB1,6)};pw3=(u32x4){PKW(pB1,8),PKW(pB1,10),PKW(pB1,12),PKW(pB1,14)};
    SBAR(); pv(o,vb0+sl_cur,PAF(0),PAF(1),PAF(2),PAF(3)); }
  #undef PKW
  #undef PAF
  #undef VFR
  #undef PIN
  #undef MX3
  #undef GAPA
  #undef GAPB
  #undef EX
  #undef VRD
  #undef KRD
  #undef STEP
  #undef ENDW
  {auto rr=__builtin_amdgcn_permlane32_swap(__float_as_uint(l_reg),__float_as_uint(l_reg),false,false);l_reg=__uint_as_float(rr[0])+__uint_as_float(rr[1]);}
  if(hi==0)wsf[32+r32]=l_reg;asm volatile("s_waitcnt lgkmcnt(0)":::"memory");
  float rli[16];
  #pragma unroll
  for(int r=0;r<16;++r)rli[r]=__builtin_amdgcn_rcpf(wsf[32+crow(r,hi)]);
  bf16*Ow=O+(rowbase+q0+wid*QBLK)*DM+h*D;
  { bf16*stg=(bf16*)(shm+LDS_OST)+wid*2048;
    #pragma unroll
    for(int r=0;r<16;++r){const int orow=crow(r,hi);
      #pragma unroll
      for(int d0=0;d0<2;++d0)stg[orow*64+d0*32+r32]=__float2bfloat16(o[d0][r]*rli[r]);}
    asm volatile("s_waitcnt lgkmcnt(0)":::"memory");
    #pragma unroll
    for(int i=0;i<4;++i){const int row=i*8+(lane>>3),ch=lane&7; const u32x4 v=*(const u32x4*)(stg+row*64+ch*8); ATTN_STORE16(Ow+(long)row*DM+ch*8,v);} }
  asm volatile("s_waitcnt lgkmcnt(0)\n\ts_barrier":::"memory");
  #undef DMA_K
  #undef DMA_V
  #undef CINIT
  #undef MKBNM
  #undef CMASK
  #undef START
  #undef RESC
  #undef ROT
}
constexpr int ATTN_LDS_BYTES=LDS_BYTES;
struct AttnTensors { const bf16* Q; const bf16* K; const bf16* V; bf16* O; };
struct AttnUnit { int bh; int qb; };
struct StaticOrder {
  int vcu;
  __device__ __forceinline__ explicit StaticOrder(int grid,int block):vcu((block%8)*(grid/8)+block/8){}
  __device__ __forceinline__ bool next(int i,AttnUnit&u)const{ if(i>=4)return false; const int s=vcu&3; u.bh=vcu>>2; u.qb=(i==0)?s:(i==1)?7-s:(i==2)?8+s:15-s; return true; }
  __device__ __forceinline__ void a_ready(const AttnUnit&)const{}
  __device__ __forceinline__ void done(const AttnUnit&)const{}
};
#undef SBAR
#undef WAIT_BAR
}
#define LAS __attribute__((address_space(3)))
typedef unsigned short bf16;
typedef unsigned v4u __attribute__((ext_vector_type(4)));
typedef unsigned v2u __attribute__((ext_vector_type(2)));
typedef float f32x4 __attribute__((ext_vector_type(4)));
typedef float f32x16 __attribute__((ext_vector_type(16)));
typedef short bf16x8 __attribute__((ext_vector_type(8)));
typedef float f32x2s __attribute__((ext_vector_type(2)));

constexpr int NBATCH = 4, SEQ = 4096, M = NBATCH * SEQ, D = 1024, DFF = 2816, PLE = 256;
constexpr int EVEN_IN = 2560, FOX_IN = 3088, FOX_INP = 3328;
constexpr float LOG2E = 1.4426950408889634f;
constexpr float QSCALE = 0.125f * LOG2E;
constexpr float GN_EPS = 64e-5f;
constexpr size_t MiB = 1u << 20;
constexpr size_t WS_SSQ = 0;
constexpr size_t WS_C3 = 1 * MiB;
constexpr size_t WS_LF = 2 * MiB;
constexpr size_t WS_G2F = 3 * MiB;
constexpr size_t WS_WGU = 4 * MiB;
constexpr size_t WS_WD = 48 * MiB;
constexpr size_t WS_WG = 70 * MiB;
constexpr size_t WS_WP = 74 * MiB;
constexpr size_t WS_WIN0 = 75 * MiB, WS_WOUT0 = 80 * MiB, WS_WIN1 = 82 * MiB, WS_WOUT1 = 89 * MiB;
constexpr size_t WS_XB = 91 * MiB;
constexpr size_t WS_Y = 123 * MiB;
constexpr size_t WS_BIG = 155 * MiB;
constexpr size_t WS_PB = 243 * MiB;
constexpr size_t WS_SSQP = 251 * MiB;
constexpr size_t WS_END = 253 * MiB;
constexpr size_t WS_BAR = 0;
constexpr int LDS_BYTES = 147456, MISC_OFF = 147456 - 64;

#define LDS_WAIT() asm volatile("s_waitcnt lgkmcnt(0)" ::: "memory")
__device__ __forceinline__ unsigned pk2(float lo, float hi) { return pg8::cvt_pk_bf16(lo, hi); }
__device__ __forceinline__ float bflo(unsigned w) { return __uint_as_float(w << 16); }
__device__ __forceinline__ float bfhi(unsigned w) { return __uint_as_float(w & 0xffff0000u); }
__device__ __forceinline__ float bf2f(bf16 h) { return __uint_as_float((unsigned)h << 16); }
__device__ __forceinline__ float wave_sum(float v) {
#pragma unroll
    for (int o = 1; o < 64; o <<= 1) v += __shfl_xor(v, o);
    return v;
}
__device__ __forceinline__ int crow(int r, int hi) { return (r & 3) + 8 * (r >> 2) + 4 * hi; }
template <int CTRL> __device__ __forceinline__ float dpp_f(float x) { return __int_as_float(__builtin_amdgcn_update_dpp(0, __float_as_int(x), CTRL, 0xf, 0xf, true)); }
__device__ __forceinline__ float red16(float x) { x += dpp_f<0xB1>(x); x += dpp_f<0x4E>(x); x += dpp_f<0x141>(x); x += dpp_f<0x140>(x); return x; }
__device__ __forceinline__ float red8(float x) { x += dpp_f<0xB1>(x); x += dpp_f<0x4E>(x); x += dpp_f<0x141>(x); return x; }
__device__ __forceinline__ void unpack8(const v4u w, float (&f)[8]) { f[0] = bflo(w.x); f[1] = bfhi(w.x); f[2] = bflo(w.y); f[3] = bfhi(w.y); f[4] = bflo(w.z); f[5] = bfhi(w.z); f[6] = bflo(w.w); f[7] = bfhi(w.w); }
__device__ __forceinline__ bf16x8 pack8(const float (&f)[8]) { v4u w; w.x = pk2(f[0], f[1]); w.y = pk2(f[2], f[3]); w.z = pk2(f[4], f[5]); w.w = pk2(f[6], f[7]); return __builtin_bit_cast(bf16x8, w); }

__device__ __forceinline__ void conv_item(const float* W, int K, int N, int NP, bf16* WT, const float* gain, int mode, LAS float* scr, int item, int lane) {
    const int nblk = NP / 32, kb = item / nblk, nb = item - kb * nblk, k0 = 64 * kb, n0 = 32 * nb;
    int orow0 = n0;
    if (mode == 1) orow0 = (n0 < DFF) ? (n0 / 128) * 256 + (n0 % 128) : ((n0 - DFF) / 128) * 256 + 128 + ((n0 - DFF) % 128);
    const int nq = 4 * (lane & 7); const bool inb = (n0 + nq) < N;
#pragma unroll
    for (int i = 0; i < 8; ++i) { const int kk = 8 * i + (lane >> 3); f32x4 v = {0.f, 0.f, 0.f, 0.f}; if (inb) v = *(const f32x4*)(W + (size_t)(k0 + kk) * N + n0 + nq);
        if (gain) v = v * gain[k0 + kk];
        LAS float* d = scr + kk * 33 + nq; d[0] = v[0]; d[1] = v[1]; d[2] = v[2]; d[3] = v[3]; }
    LDS_WAIT(); asm volatile("" ::: "memory");
    const int c = lane & 7;
#pragma unroll
    for (int j = 0; j < 4; ++j) { const int nn = (lane >> 3) + 8 * j; const LAS float* s = scr + (8 * c) * 33 + nn;
        v4u o; o.x = pk2(s[0 * 33], s[1 * 33]); o.y = pk2(s[2 * 33], s[3 * 33]); o.z = pk2(s[4 * 33], s[5 * 33]); o.w = pk2(s[6 * 33], s[7 * 33]);
        *(v4u*)(WT + (size_t)(orow0 + nn) * K + k0 + 8 * c) = o; }
    LDS_WAIT(); asm volatile("" ::: "memory");
}

constexpr int VTP = 264;
__device__ __forceinline__ void swa_unit(int unit, const bf16* PROJ, bf16* Y, const float* sinks, LAS unsigned char* lds, int tid, int lane, int wid) {
    const int b = unit >> 6, kvh = (unit >> 5) & 1, qblk = unit & 31, q0 = qblk * 128; const size_t rb = (size_t)b * SEQ;
    asm volatile("" : "+s"(PROJ), "+s"(Y));
    LAS bf16* VT = (LAS bf16*)lds;
    for (int c = tid; c < 2048; c += 512) { const int kvl = c >> 3, ch = c & 7, tok = q0 - 128 + kvl; v4u v = {0u, 0u, 0u, 0u};
        if (tok >= 0) v = *(const v4u*)(PROJ + (rb + tok) * EVEN_IN + 640 + kvh * 64 + ch * 8);
        LAS bf16* d = VT + (ch * 8) * VTP + kvl;
        d[0 * VTP] = (bf16)(v.x & 0xffffu); d[1 * VTP] = (bf16)(v.x >> 16); d[2 * VTP] = (bf16)(v.y & 0xffffu); d[3 * VTP] = (bf16)(v.y >> 16);
        d[4 * VTP] = (bf16)(v.z & 0xffffu); d[5 * VTP] = (bf16)(v.z >> 16); d[6 * VTP] = (bf16)(v.w & 0xffffu); d[7 * VTP] = (bf16)(v.w >> 16); }
    __syncthreads();
    const int g = wid >> 1, qh = wid & 1, hq = kvh * 4 + g;
    const float slope2 = exp2f(-(float)(hq + 1)) * LOG2E, sink2 = sinks[hq] * LOG2E;
#pragma unroll 1
    for (int sb = 0; sb < 2; ++sb) {
        int r32 = lane & 31, hi = lane >> 5; asm volatile("" : "+v"(r32), "+v"(hi));
        const int qs = q0 + 64 * qh + 32 * sb;
        bf16x8 qf[4];
#pragma unroll
        for (int ks = 0; ks < 4; ++ks) qf[ks] = *(const bf16x8*)(PROJ + (rb + qs + r32) * EVEN_IN + hq * 64 + 16 * ks + 8 * hi);
        f32x16 sc[5];
#pragma unroll
        for (int kt = 0; kt < 5; ++kt) { int tk = qs - 128 + 32 * kt + r32; tk = tk < 0 ? 0 : tk; sc[kt] = f32x16{};
#pragma unroll
            for (int ks = 0; ks < 4; ++ks) { const bf16x8 kf = *(const bf16x8*)(PROJ + (rb + tk) * EVEN_IN + 512 + kvh * 64 + 16 * ks + 8 * hi);
                sc[kt] = __builtin_amdgcn_mfma_f32_32x32x16_bf16(kf, qf[ks], sc[kt], 0, 0, 0); } }
        const int db = r32 + 128 - 4 * hi, kmin = 128 - qs - 4 * hi; const float ab = -slope2 * (float)db;
        float mx = sink2;
#pragma unroll
        for (int kt = 0; kt < 5; ++kt)
#pragma unroll
            for (int r = 0; r < 16; ++r) { const int kc = 32 * kt + (r & 3) + 8 * (r >> 2), dist = db - kc; const bool ok = ((unsigned)dist < 128u) && (kmin <= kc);
                const float s = ok ? fmaf(slope2, (float)kc, sc[kt][r] + ab) : -INFINITY; sc[kt][r] = s; mx = fmaxf(mx, s); }
        mx = fmaxf(mx, __shfl_xor(mx, 32));
        float l = 0.f;
#pragma unroll
        for (int kt = 0; kt < 5; ++kt)
#pragma unroll
            for (int r = 0; r < 16; ++r) { const float p = exp2f(sc[kt][r] - mx); sc[kt][r] = p; l += p; }
        l += __shfl_xor(l, 32); l += exp2f(sink2 - mx);
        const float rl = 1.0f / l;
        f32x16 o[2]; o[0] = f32x16{}; o[1] = f32x16{};
        const int kvl0 = 64 * qh + 32 * sb;
#pragma unroll
        for (int kt = 0; kt < 5; ++kt)
#pragma unroll
            for (int s2 = 0; s2 < 2; ++s2) { v4u pw; pw.x = pk2(sc[kt][8 * s2 + 0], sc[kt][8 * s2 + 1]); pw.y = pk2(sc[kt][8 * s2 + 2], sc[kt][8 * s2 + 3]); pw.z = pk2(sc[kt][8 * s2 + 4], sc[kt][8 * s2 + 5]); pw.w = pk2(sc[kt][8 * s2 + 6], sc[kt][8 * s2 + 7]);
                const bf16x8 pa = __builtin_bit_cast(bf16x8, pw);
#pragma unroll
                for (int db = 0; db < 2; ++db) { const LAS bf16* vp = VT + (32 * db + r32) * VTP + kvl0 + 32 * kt + 16 * s2 + 4 * hi;
                    const v2u lo = *(const LAS v2u*)vp, hh = *(const LAS v2u*)(vp + 8); v4u vw; vw.x = lo.x; vw.y = lo.y; vw.z = hh.x; vw.w = hh.y;
                    o[db] = __builtin_amdgcn_mfma_f32_32x32x16_bf16(pa, __builtin_bit_cast(bf16x8, vw), o[db], 0, 0, 0); } }
#pragma unroll
        for (int r = 0; r < 16; ++r) { const int qq = crow(r, hi); const float sc1 = __shfl(rl, qq);
            bf16* yp = Y + (rb + qs + qq) * 1024 + hq * 64 + r32;
            yp[0] = (bf16)(pk2(o[0][r] * sc1, 0.f) & 0xffffu); yp[32] = (bf16)(pk2(o[1][r] * sc1, 0.f) & 0xffffu); }
    }
    __syncthreads();
}
typedef unsigned v4u_unused_;
#define XB_TMO      128
#define XB_XCNT(j)  (256  + 64 * (j))
#define XB_XSUB(j)  (1280 + 64 * (j))
#define XB_XGEN(j)  (2304 + 64 * (j))
#define XB_TOP      3328
#define XB_TOPGEN   3392
#define XCD_BAR_WORDS 3456
#define XB_SPIN_CAP (1u << 18)

__device__ __forceinline__ unsigned xb_ld(unsigned* p)              { return __hip_atomic_load(p, __ATOMIC_RELAXED, __HIP_MEMORY_SCOPE_AGENT); }
__device__ __forceinline__ unsigned xb_add(unsigned* p, unsigned v) { return __hip_atomic_fetch_add(p, v, __ATOMIC_RELAXED, __HIP_MEMORY_SCOPE_AGENT); }
__device__ __forceinline__ unsigned xb_xcc_id() { return (unsigned)__builtin_amdgcn_s_getreg((3 << 11) | 20) & 0xFu; }
#define XB_SPIN(cond, bar) do { unsigned _sp = 0; while (cond) { __builtin_amdgcn_s_sleep(1); \
    if ((++_sp & 255u) == 0u) { if (xb_ld(&(bar)[XB_TMO])) break; if (_sp > XB_SPIN_CAP) { atomicAdd(&(bar)[XB_TMO], 1u); break; } } } } while (0)

struct XcdBarrier {
    unsigned* bar; unsigned x;
    volatile LAS unsigned* st;
};

__device__ __forceinline__ XcdBarrier xcd_barrier_post(unsigned* bar, volatile LAS unsigned* st) {
    XcdBarrier b; b.bar = bar; b.x = xb_xcc_id(); b.st = st;
    if (threadIdx.x == 0) (void)xb_add(&bar[XB_XCNT(b.x)], 1u);
    return b;
}
__device__ __forceinline__ void xcd_barrier_complete(unsigned* bar, unsigned x, unsigned& nloc, unsigned& nx) {
    const unsigned G = gridDim.x * gridDim.y * gridDim.z;
    unsigned sum, cnt, mine, sp = 0u;
    for (;;) {
        sum = 0u; cnt = 0u; mine = 0u;
#pragma unroll
        for (unsigned j = 0; j < 16; ++j) { const unsigned c = xb_ld(&bar[XB_XCNT(j)]); sum += c; cnt += (c > 0u) ? 1u : 0u; mine = (j == x) ? c : mine; }
        if (sum == G) break;
        __builtin_amdgcn_s_sleep(1);
        if ((++sp & 255u) == 0u) { if (xb_ld(&bar[XB_TMO])) break; if (sp > XB_SPIN_CAP) { atomicAdd(&bar[XB_TMO], 1u); break; } }
    }
    nloc = mine > 0u ? mine : 1u; nx = cnt > 0u ? cnt : 1u;
}

__device__ __forceinline__ void xcd_barrier(const XcdBarrier& b) {
    asm volatile("s_waitcnt vmcnt(0)" ::: "memory");
    __syncthreads();
    if (threadIdx.x == 0) {
        unsigned* bar = b.bar;
        __builtin_amdgcn_s_waitcnt(0);
        unsigned nloc = b.st[0], nx = b.st[1];
        if (nloc == 0u) { xcd_barrier_complete(bar, b.x, nloc, nx); b.st[0] = nloc; b.st[1] = nx; }
        const unsigned old = xb_add(&bar[XB_XSUB(b.x)], 1u);
        const unsigned gen = old / nloc;
        if (old + 1u == (gen + 1u) * nloc) {
            __builtin_amdgcn_fence(__ATOMIC_RELEASE, "agent");
            asm volatile("s_waitcnt vmcnt(0)" ::: "memory");
            const unsigned og = xb_add(&bar[XB_TOP], 1u);
            const unsigned tg = og / nx;
            if (og + 1u == (tg + 1u) * nx) xb_add(&bar[XB_TOPGEN], 1u);
            else XB_SPIN(xb_ld(&bar[XB_TOPGEN]) == tg, bar);
            __builtin_amdgcn_fence(__ATOMIC_ACQUIRE, "agent");
            xb_add(&bar[XB_XGEN(b.x)], 1u);
            asm volatile("s_waitcnt vmcnt(0)" ::: "memory");
        } else {
            XB_SPIN(xb_ld(&bar[XB_XGEN(b.x)]) == gen, bar);
            __builtin_amdgcn_fence(__ATOMIC_ACQUIRE, "agent");
            asm volatile("s_waitcnt vmcnt(0)" ::: "memory");
        }
    }
    __syncthreads();
}
constexpr int TC = 32, SBS = 340, LBS = 68;
constexpr int SBS_UNUSED_ = 336;
constexpr int RW_SBUF = 0, RW_SBUF_BYTES = TC * SBS * 4, RW_LW = 2 * RW_SBUF_BYTES, RW_LA = RW_LW + 2 * TC * LBS * 4, RW_EC = RW_LA + 2 * TC * LBS * 4, RW_BF = RW_EC + 2560;
__device__ __forceinline__ void rwkv_scan_unit(int unit, const bf16* PROJ, float* YRAW, float* C3, const float* mu, const float* w0, const float* w2, const float* a0, const float* a2,
                                               const float* k_k, const float* k_a, const float* r_k, LAS unsigned char* lds, const int lane, int wid) {
    const int role = (wid < 2) ? 0 : ((wid == 2 || wid == 3) ? 2 : 1), lw = wid - 2, ew = wid - 4;
    const int b = unit >> 6, h = (unit >> 3) & 7, rg = unit & 7; const size_t rb = (size_t)b * SEQ;
    const int r32 = lane & 31, hi = lane >> 5;
    constexpr int NCH = SEQ / TC;
    if (role == 2) {
        const int colx = 768 + ((lw == 0) ? 1536 : 1600); const float* Wl = (lw == 0) ? w2 : a2;
#pragma unroll
        for (int nb = 0; nb < 2; ++nb)
#pragma unroll
            for (int ks = 0; ks < 4; ++ks) { float f[8];
#pragma unroll
                for (int i = 0; i < 8; ++i) f[i] = Wl[(size_t)(16 * ks + 8 * hi + i) * 512 + h * 64 + 32 * nb + r32];
                *(LAS bf16x8*)(lds + RW_BF + (((lw * 2 + nb) * 4 + ks) * 64 + lane) * 16) = pack8(f); }
        ((LAS float*)(lds + RW_EC))[512 + lw * 64 + lane] = mu[colx - 768 + lane];
        v4u lcw[4], lpw[4];
#define LORA_LOAD(itn) do { const int tl_ = (itn) * TC + r32; const bf16* p_ = PROJ + (rb + tl_) * EVEN_IN + colx + 8 * hi; _Pragma("unroll") for (int ks = 0; ks < 4; ++ks) { lcw[ks] = *(const v4u*)(p_ + 16 * ks); \
            lpw[ks] = (v4u){0u, 0u, 0u, 0u}; if (tl_ > 0) lpw[ks] = *(const v4u*)(p_ - EVEN_IN + 16 * ks); } } while (0)
        LORA_LOAD(0);
#pragma unroll 1
        for (int it = 0; it < NCH + 2; ++it) {
            if (it < NCH) { bf16x8 afr[4];
#pragma unroll
                for (int ks = 0; ks < 4; ++ks) { float c[8], p[8]; unpack8(lcw[ks], c); unpack8(lpw[ks], p);
                    const LAS float* mq = (const LAS float*)(lds + RW_EC) + 512 + lw * 64 + 16 * ks + 8 * hi; const f32x4 m0 = *(const LAS f32x4*)mq, m1 = *(const LAS f32x4*)(mq + 4);
#pragma unroll
                    for (int i = 0; i < 8; ++i) { float x = c[i] + (p[i] - c[i]) * (i < 4 ? m0[i] : m1[i - 4]); if (lw == 0) x = 1.f - 2.f * __builtin_amdgcn_rcpf(1.f + __expf(2.f * x)); c[i] = x; }
                    afr[ks] = pack8(c); }
                if (it + 1 < NCH) LORA_LOAD(it + 1);
                LAS float* LB = (LAS float*)(lds + ((lw == 0) ? RW_LW : RW_LA)) + (it & 1) * (TC * LBS);
#pragma unroll
                for (int nb = 0; nb < 2; ++nb) { f32x16 acc = f32x16{};
#pragma unroll
                    for (int ks = 0; ks < 4; ++ks) acc = __builtin_amdgcn_mfma_f32_32x32x16_bf16(afr[ks], *(const LAS bf16x8*)(lds + RW_BF + (((lw * 2 + nb) * 4 + ks) * 64 + lane) * 16), acc, 0, 0, 0);
#pragma unroll
                    for (int r = 0; r < 16; ++r) LB[crow(r, hi) * LBS + 32 * nb + r32] = acc[r]; } }
            asm volatile("s_waitcnt lgkmcnt(0)\n\ts_barrier" ::: "memory");
        }
#undef LORA_LOAD
    } else if (role == 1) {
        const int el = ew * 64 + lane, s = el >> 3, g = el & 7;
        float ecc[8][8];
        { const int chn = h * 64 + 8 * g;
#pragma unroll
          for (int i = 0; i < 8; ++i) { ecc[0][i] = mu[chn + i]; ecc[1][i] = mu[512 + chn + i]; ecc[2][i] = mu[1024 + chn + i]; ecc[3][i] = w0[chn + i]; ecc[4][i] = a0[chn + i]; ecc[5][i] = k_k[chn + i]; ecc[6][i] = k_a[chn + i]; ecc[7][i] = r_k[chn + i]; } }
        v4u ecr, eck, ecv, epr, epk, epv;
#define ELEM_LOAD(cn) do { const int tl_ = (cn) * TC + s; const bf16* p_ = PROJ + (rb + tl_) * EVEN_IN + 768 + h * 64 + 8 * g; \
            ecr = *(const v4u*)p_; eck = *(const v4u*)(p_ + 512); ecv = *(const v4u*)(p_ + 1024); epr = (v4u){0u, 0u, 0u, 0u}; epk = epr; epv = epr; \
            if (tl_ > 0) { epr = *(const v4u*)(p_ - EVEN_IN); epk = *(const v4u*)(p_ - EVEN_IN + 512); epv = *(const v4u*)(p_ - EVEN_IN + 1024); } } while (0)
        ELEM_LOAD(0);
#pragma unroll 1
        for (int it = 0; it < NCH + 2; ++it) {
            const int c = it - 1;
            if (c >= 0 && c < NCH) { const size_t row = rb + c * TC + s;
                const LAS float* LW = (const LAS float*)(lds + RW_LW) + (c & 1) * (TC * LBS) + s * LBS + 8 * g; const LAS float* LA = (const LAS float*)(lds + RW_LA) + (c & 1) * (TC * LBS) + s * LBS + 8 * g;
                LAS float* sp = (LAS float*)(lds + RW_SBUF + (c & 1) * RW_SBUF_BYTES) + s * SBS;
                float ec[8];
#define LDEC(arr) do { _Pragma("unroll") for (int i_ = 0; i_ < 8; ++i_) ec[i_] = ecc[arr][i_]; } while (0)
                float r[8], k[8], v[8], t[8];
                unpack8(ecr, r); unpack8(epr, t); LDEC(0);
#pragma unroll
                for (int i = 0; i < 8; ++i) r[i] += (t[i] - r[i]) * ec[i];
                unpack8(eck, k); unpack8(epk, t); LDEC(1);
#pragma unroll
                for (int i = 0; i < 8; ++i) k[i] += (t[i] - k[i]) * ec[i];
                unpack8(ecv, v); unpack8(epv, t); LDEC(2);
#pragma unroll
                for (int i = 0; i < 8; ++i) v[i] += (t[i] - v[i]) * ec[i];
                if (c + 1 < NCH) ELEM_LOAD(c + 1);
                const f32x4 dw0 = *(const LAS f32x4*)LW, dw1 = *(const LAS f32x4*)(LW + 4), da0 = *(const LAS f32x4*)LA, da1 = *(const LAS f32x4*)(LA + 4);
                float w[8], a[8], kk[8], kp[8]; float n2 = 0.f;
#pragma unroll
                for (int i = 0; i < 8; ++i) w[i] = i < 4 ? dw0[i] : dw1[i - 4];
                LDEC(3);
#pragma unroll
                for (int i = 0; i < 8; ++i) w[i] = __expf(-0.60653065971f * pg8::sigm(ec[i] + w[i]));
                LDEC(4);
#pragma unroll
                for (int i = 0; i < 8; ++i) a[i] = pg8::sigm(ec[i] + (i < 4 ? da0[i] : da1[i - 4]));
                LDEC(5);
#pragma unroll
                for (int i = 0; i < 8; ++i) { kk[i] = k[i] * ec[i]; n2 += kk[i] * kk[i]; }
                LDEC(6);
#pragma unroll
                for (int i = 0; i < 8; ++i) kp[i] = k[i] * (1.f + (a[i] - 1.f) * ec[i]);
                LDEC(7);
                n2 = red8(n2); const float inv = __builtin_amdgcn_rsqf(fmaxf(n2, 1e-24f));
                float c1 = 0.f, c2 = 0.f, c3 = 0.f;
#pragma unroll
                for (int i = 0; i < 8; ++i) { kk[i] *= inv; t[i] = kk[i] * a[i]; c1 += t[i] * r[i]; c2 += kp[i] * r[i]; c3 += r[i] * kp[i] * ec[i]; }
#undef LDEC
                c1 = red8(c1); c2 = red8(c2); c3 = red8(c3);
                *(LAS f32x4*)(sp + 8 * g) = (f32x4){kk[0], kk[1], kk[2], kk[3]}; *(LAS f32x4*)(sp + 8 * g + 4) = (f32x4){kk[4], kk[5], kk[6], kk[7]};
                *(LAS f32x4*)(sp + 64 + 8 * g) = (f32x4){w[0] * r[0], w[1] * r[1], w[2] * r[2], w[3] * r[3]}; *(LAS f32x4*)(sp + 64 + 8 * g + 4) = (f32x4){w[4] * r[4], w[5] * r[5], w[6] * r[6], w[7] * r[7]};
                *(LAS f32x4*)(sp + 128 + 8 * g) = (f32x4){w[0], w[1], w[2], w[3]}; *(LAS f32x4*)(sp + 128 + 8 * g + 4) = (f32x4){w[4], w[5], w[6], w[7]};
                *(LAS f32x4*)(sp + 192 + 8 * g) = (f32x4){t[0], t[1], t[2], t[3]}; *(LAS f32x4*)(sp + 192 + 8 * g + 4) = (f32x4){t[4], t[5], t[6], t[7]};
                *(LAS f32x4*)(sp + 256 + 8 * g) = (f32x4){kp[0], kp[1], kp[2], kp[3]}; *(LAS f32x4*)(sp + 256 + 8 * g + 4) = (f32x4){kp[4], kp[5], kp[6], kp[7]};
                if (g == rg) { *(LAS f32x4*)(sp + 320) = (f32x4){v[0], v[1], v[2], v[3]}; *(LAS f32x4*)(sp + 324) = (f32x4){v[4], v[5], v[6], v[7]}; }
                if (g == 0) { sp[328] = c1; sp[329] = c2; if (rg == 0) C3[row * 8 + h] = c3; } }
            asm volatile("s_waitcnt lgkmcnt(0)\n\ts_barrier" ::: "memory");
        }
#undef ELEM_LOAD
    } else {
        const int rowl = 4 * (wid & 1) + (lane >> 4), cgp = lane & 15;
        f32x2s S01 = {0.f, 0.f}, S23 = {0.f, 0.f};
#pragma unroll 1
        for (int it = 0; it < NCH + 2; ++it) {
            const int c = it - 2;
            if (c >= 0) { const LAS float* SBF = (const LAS float*)(lds + RW_SBUF + (c & 1) * RW_SBUF_BYTES);
                float* yp = YRAW + (rb + (size_t)c * TC) * 512 + h * 64 + 8 * rg + rowl;
                __builtin_amdgcn_s_setprio(3);
                f32x4 kkA, wrA, wA, kaA, kpA, kkB, wrB, wB, kaB, kpB; float viA, viB; float pkeep = 0.f, qkeep = 0.f;
#define LDREC(X, s_) do { const LAS float* sp_ = SBF + (s_) * SBS; kk##X = *(const LAS f32x4*)(sp_ + 4 * cgp); wr##X = *(const LAS f32x4*)(sp_ + 64 + 4 * cgp); w##X = *(const LAS f32x4*)(sp_ + 128 + 4 * cgp); \
                    ka##X = *(const LAS f32x4*)(sp_ + 192 + 4 * cgp); kp##X = *(const LAS f32x4*)(sp_ + 256 + 4 * cgp); vi##X = sp_[320 + rowl]; } while (0)
#define LO2(v) __builtin_shufflevector(v, v, 0, 1)
#define HI2(v) __builtin_shufflevector(v, v, 2, 3)
#define STEPREC(X, s_) do { f32x2s pp = S01 * LO2(kk##X); pp = S23 * HI2(kk##X) + pp; f32x2s qq = S01 * LO2(wr##X); qq = S23 * HI2(wr##X) + qq; float p = pp[0] + pp[1], q = qq[0] + qq[1]; \
                    const f32x2s vv_ = {vi##X, vi##X}; const f32x2s u01_ = S01 * LO2(w##X) + LO2(kp##X) * vv_, u23_ = S23 * HI2(w##X) + HI2(kp##X) * vv_;     \
                    p += dpp_f<0xB1>(p); q += dpp_f<0xB1>(q); p += dpp_f<0x4E>(p); q += dpp_f<0x4E>(q); p += dpp_f<0x141>(p); q += dpp_f<0x141>(q); p += dpp_f<0x140>(p); q += dpp_f<0x140>(q); \
                    const f32x2s pv_ = {p, p}; \
                    S01 = u01_ - LO2(ka##X) * pv_; S23 = u23_ - HI2(ka##X) * pv_; \
                    pkeep = (((s_) & 15) == cgp) ? p : pkeep; qkeep = (((s_) & 15) == cgp) ? q : qkeep;     \
                    if (((s_) & 15) == 15) { const LAS float* sy_ = SBF + ((s_) - 15 + cgp) * SBS; const f32x2s cy_ = *(const LAS f32x2s*)(sy_ + 328); \
                        yp[(size_t)((s_) - 15 + cgp) * 512] = qkeep - pkeep * cy_[0] + sy_[320 + rowl] * cy_[1]; } } while (0)
                LDREC(A, 0);
#pragma unroll
                for (int s = 0; s < TC; s += 2) {
 LDREC(B, s + 1); STEPREC(A, s); LDREC(A, s + 2); STEPREC(B, s + 1); }
#undef LDREC
#undef STEPREC
#undef LO2
#undef HI2
                __builtin_amdgcn_s_setprio(0); }
            asm volatile("s_waitcnt lgkmcnt(0)\n\ts_barrier" ::: "memory");
        }
    }
    __syncthreads();
}

__device__ __forceinline__ void rwkv_post_unit(int tile, const bf16* PROJ, const float* YRAW, const float* C3, bf16* Y, const float* mu, const bf16* g2f, const float* ln_w, const float* ln_b, int lane, int wid) {
    asm volatile("" : "+s"(PROJ), "+s"(mu), "+s"(g2f), "+s"(YRAW));
    const int h = wid, r32 = lane & 31, hi = lane >> 5; const int tok0 = tile * 32; const bool first = (tok0 & (SEQ - 1)) == 0;
    bf16x8 afr[8];
    { const int tk = tok0 + r32; const bool hp = !(first && r32 == 0); v4u cwv[8], pwv[8];
      const __attribute__((address_space(1))) bf16* pg = (const __attribute__((address_space(1))) bf16*)(PROJ + (size_t)tk * EVEN_IN + 768 + 1664 + 8 * hi);
#pragma unroll
        for (int ks = 0; ks < 8; ++ks) { cwv[ks] = *(const __attribute__((address_space(1))) v4u*)(pg + 16 * ks); pwv[ks] = (v4u){0u, 0u, 0u, 0u};
            if (hp) pwv[ks] = *(const __attribute__((address_space(1))) v4u*)(pg - EVEN_IN + 16 * ks); }
#pragma unroll
        for (int ks = 0; ks < 8; ++ks) { float c[8], p[8]; unpack8(cwv[ks], c); unpack8(pwv[ks], p);
            const f32x4 m0 = *(const f32x4*)(mu + 1664 + 16 * ks + 8 * hi), m1 = *(const f32x4*)(mu + 1664 + 16 * ks + 8 * hi + 4);
#pragma unroll
            for (int i = 0; i < 8; ++i) c[i] = pg8::sigm(c[i] + (p[i] - c[i]) * (i < 4 ? m0[i] : m1[i - 4]));
            afr[ks] = pack8(c); } }
    f32x16 gt[2];
#pragma unroll
    for (int nb = 0; nb < 2; ++nb) { gt[nb] = f32x16{};
#pragma unroll
        for (int ks = 0; ks < 8; ++ks) { const bf16x8 bf = *(const bf16x8*)(g2f + ((size_t)((h * 2 + nb) * 8 + ks) * 64 + lane) * 8);
            gt[nb] = __builtin_amdgcn_mfma_f32_32x32x16_bf16(afr[ks], bf, gt[nb], 0, 0, 0); } }
    typedef const __attribute__((address_space(1))) float* gfp; typedef const __attribute__((address_space(1))) unsigned short* gup;
    const int ch0 = h * 64 + r32; const float lw0 = ln_w[ch0], lw1 = ln_w[ch0 + 32], lb0 = ln_b[ch0], lb1 = ln_b[ch0 + 32], mv0 = mu[1024 + ch0], mv1 = mu[1024 + ch0 + 32];
    float y0[16], y1[16], c3v[16]; unsigned vc[16], vp[16];
#pragma unroll
    for (int r = 0; r < 16; ++r) { const int tk = tok0 + crow(r, hi); gfp yp = (gfp)(YRAW + (size_t)tk * 512 + ch0); y0[r] = yp[0]; y1[r] = yp[32]; c3v[r] = ((gfp)C3)[(size_t)tk * 8 + h];
        gup vq = (gup)(PROJ + (size_t)tk * EVEN_IN + 768 + 1024 + ch0); vc[r] = (unsigned)vq[0] | ((unsigned)vq[32] << 16); vp[r] = 0u;
        if ((tk & (SEQ - 1)) != 0) vp[r] = (unsigned)vq[-EVEN_IN] | ((unsigned)vq[32 - EVEN_IN] << 16); }
#pragma unroll
    for (int r = 0; r < 16; ++r) { const int tk = tok0 + crow(r, hi);
        float s = y0[r] + y1[r]; s = red16(s); s += __shfl_xor(s, 16);
        const float mean = s * (1.f / 64.f), d0 = y0[r] - mean, d1 = y1[r] - mean; float q = d0 * d0 + d1 * d1; q = red16(q); q += __shfl_xor(q, 16);
        const float rstd = rsqrtf(q * (1.f / 64.f) + GN_EPS);
        const float cv0 = bflo(vc[r]), cv1 = bfhi(vc[r]), pv0 = bflo(vp[r]), pv1 = bfhi(vp[r]);
        const float v0 = cv0 + (pv0 - cv0) * mv0, v1 = cv1 + (pv1 - cv1) * mv1;
        const float o0 = (d0 * rstd * lw0 + lb0 + c3v[r] * v0) * gt[0][r], o1 = (d1 * rstd * lw1 + lb1 + c3v[r] * v1) * gt[1][r];
        bf16* op = Y + (size_t)tk * 1024 + 512 + ch0; op[0] = (bf16)(pk2(o0, 0.f) & 0xffffu); op[32] = (bf16)(pk2(o1, 0.f) & 0xffffu); }
}

__device__ __forceinline__ void fox_gate_pass(const bf16* XB, const bf16* Wf, const float* ssqv, const float* bfv, float* LF, int gw, int NGW, int lane) {
    typedef float f32x4g __attribute__((ext_vector_type(4)));
    const int fr = lane & 15, fq = lane >> 4;
    for (int t = gw; t < M / 16; t += NGW) {
        const bf16* ap = XB + (size_t)(t * 16 + fr) * D + 8 * fq; const bf16* bp = Wf + (size_t)fr * D + 8 * fq;
        f32x4g acc = {0.f, 0.f, 0.f, 0.f};
#pragma unroll 8
        for (int ks = 0; ks < D / 32; ++ks) acc = __builtin_amdgcn_mfma_f32_16x16x32_bf16(*(const bf16x8*)(ap + 32 * ks), *(const bf16x8*)(bp + 32 * ks), acc, 0, 0, 0);
        const float bn = bfv[fr];
#pragma unroll
        for (int j = 0; j < 4; ++j) { const int row = t * 16 + 4 * fq + j; const float z = fmaxf(acc[j] * pg8::rstd_of(ssqv, row) + bn, -80.f), e = __expf(-z);
            LF[(size_t)row * 16 + fr] = (e < 0.01f) ? -(e - 0.5f * e * e + e * e * e * (1.f / 3.f)) : -__logf(1.f + e); }
    }
}

__device__ __forceinline__ void fox_prefix(const float* LFbh, LAS float* cs, LAS float* wtot, int tid, int lane, int wid) {
    const float* lp = LFbh + (size_t)tid * 128;
    float s[8]; s[0] = lp[0]; s[1] = s[0] + lp[16]; s[2] = s[1] + lp[32]; s[3] = s[2] + lp[48]; s[4] = s[3] + lp[64]; s[5] = s[4] + lp[80]; s[6] = s[5] + lp[96]; s[7] = s[6] + lp[112];
    float incl = s[7];
#pragma unroll
    for (int o = 1; o < 64; o <<= 1) { const float t = __shfl_up(incl, o); if (lane >= o) incl += t; }
    if (lane == 63) wtot[wid] = incl;
    __syncthreads();
    float base = incl - s[7];
    for (int w = 0; w < wid; ++w) base += wtot[w];
#pragma unroll
    for (int i = 0; i < 8; ++i) { const float v = (base + s[i]) * LOG2E;
        const unsigned h1 = pk2(v, 0.f) & 0xffffu; const float r1 = v - __uint_as_float(h1 << 16); const unsigned h2 = pk2(r1, 0.f) & 0xffffu; const float r2 = r1 - __uint_as_float(h2 << 16); const unsigned h3 = pk2(r2, 0.f) & 0xffffu;
        ((LAS v2u*)cs)[8 * tid + i] = (v2u){h1 | (h2 << 16), h3}; }
    __syncthreads();
}
struct Args { const float* in[30]; float* out; unsigned char* ws; int ph_lo, ph_hi; };
#define AS4 __attribute__((address_space(4)))
#ifndef DUP_SWA
#define DUP_SWA 0
#endif
#ifndef DUP_SCAN
#define DUP_SCAN 0
#endif
#ifndef DUP_POST
#define DUP_POST 0
#endif
#ifndef DUP_GU
#define DUP_GU 0
#endif
#ifndef DUP_INPROJ
#define DUP_INPROJ 0
#endif
#ifndef DUP_P0
#define DUP_P0 0
#endif
#ifndef DUP_SYNC
#define DUP_SYNC 0
#endif
#define INP(i) (*(const float* const AS4*)(kp + 8 * (i)))
#define GSYNC() xcd_barrier(xbar)
#define FRESH() const AS4 char* kp = kp0; asm volatile("" : "+s"(kp)); unsigned char* ws = *(unsigned char* const AS4*)(kp + 248); float* X = *(float* const AS4*)(kp + 240); \
    int tid = threadIdx.x; asm volatile("" : "+v"(tid)); const int lane = tid & 63, wid = __builtin_amdgcn_readfirstlane(tid >> 6); \
    const int gw = bx * 8 + wid, NGW = G * 8; \
    float* ssq = (float*)(ws + WS_SSQP); float* C3 = (float*)(ws + WS_C3); float* LF = (float*)(ws + WS_LF); \
    bf16* XB = (bf16*)(ws + WS_XB); float* YRAW = (float*)(ws + WS_XB); bf16* Y = (bf16*)(ws + WS_Y); \
    bf16* H = (bf16*)(ws + WS_BIG); bf16* PROJ = (bf16*)(ws + WS_BIG); bf16* PP = (bf16*)(ws + WS_BIG); bf16* PB = (bf16*)(ws + WS_PB); \
    bf16* Qb = (bf16*)(ws + WS_BIG); bf16* Kb = Qb + (size_t)M * D; bf16* Vb = Kb + (size_t)M * D; \
    (void)X; (void)lane; (void)wid; (void)gw; (void)NGW; (void)ssq; (void)C3; (void)LF; (void)XB; (void)YRAW; (void)Y; (void)H; (void)PROJ; (void)PP; (void)PB; (void)Qb; (void)Kb; (void)Vb
__global__ void __launch_bounds__(512, 2) fwd_megakernel(Args a_unused) {
    extern __shared__ __attribute__((aligned(16))) unsigned char lds_raw[];
    cg::grid_group grid = cg::this_grid();
    LAS unsigned char* lds = (LAS unsigned char*)lds_raw;
    const int G = gridDim.x, bx = blockIdx.x;
    const AS4 char* kp0 = (const AS4 char*)__builtin_amdgcn_kernarg_segment_ptr();
    const int ph_lo = *(const int AS4*)(kp0 + 256), ph_hi = *(const int AS4*)(kp0 + 260);
    XcdBarrier xbar;
    { unsigned* barw = (unsigned*)(*(unsigned char* const AS4*)(kp0 + 248) + WS_BAR);
      if (bx == 0) for (int i = threadIdx.x; i < XCD_BAR_WORDS; i += 512) barw[i] = 0u;
      if (threadIdx.x < 4) ((LAS unsigned*)(lds + MISC_OFF))[threadIdx.x] = 0u;
      asm volatile("s_waitcnt vmcnt(0)" ::: "memory"); __syncthreads();
      grid.sync();
      __builtin_amdgcn_fence(__ATOMIC_ACQUIRE, "agent"); asm volatile("s_waitcnt vmcnt(0)" ::: "memory");
      xbar = xcd_barrier_post(barw, (volatile LAS unsigned*)(lds + MISC_OFF)); }

#ifdef NANFILL
    { FRESH(); v4u q = {0xffffffffu, 0xffffffffu, 0xffffffffu, 0xffffffffu};
      for (size_t i = (size_t)bx * 512 + tid; i < WS_END / 16; i += (size_t)G * 512) ((v4u*)ws)[i] = q;
      for (size_t i = (size_t)bx * 512 + tid; i < (size_t)M * D / 4; i += (size_t)G * 512) ((v4u*)X)[i] = q;
      for (int i = tid; i < LDS_BYTES / 4; i += 512) ((LAS unsigned*)lds)[i] = 0xffffffffu; }
    GSYNC();
#endif
    for (int dup = 0; dup < 1 + DUP_P0; ++dup)
    if (ph_lo == 0) {
        FRESH();
        LAS float* scr = (LAS float*)(lds + wid * 16384);
        constexpr int I_GU = (D / 64) * (2 * DFF / 32), I_D = (DFF / 64) * (D / 32), I_G = (D / 64) * (D / 32), I_P = (PLE / 64) * (D / 32), I_IN0 = (D / 64) * (EVEN_IN / 32), I_IN1 = (D / 64) * (FOX_INP / 32);
        constexpr int NITEMS = 4 * I_GU + 4 * I_D + 2 * I_G + 2 * I_P + I_IN0 + I_IN1 + 2 * I_G;
        for (int it = gw; it < NITEMS; it += NGW) {
            int r = it;
#define MAT(cnt, W_, K_, N_, NP_, WT_, G_, MODE_) if (r < (cnt)) { conv_item((W_), (K_), (N_), (NP_), (bf16*)(WT_), (G_), (MODE_), scr, r, lane); continue; } r -= (cnt);
            MAT(I_GU, INP(3), D, 2 * DFF, 2 * DFF, ws + WS_WGU, INP(2), 1)
            MAT(I_GU, INP(7), D, 2 * DFF, 2 * DFF, ws + WS_WGU + 11 * MiB, INP(6), 1)
            MAT(I_GU, INP(3) + (size_t)D * 2 * DFF, D, 2 * DFF, 2 * DFF, ws + WS_WGU + 22 * MiB, INP(2) + D, 1)
            MAT(I_GU, INP(7) + (size_t)D * 2 * DFF, D, 2 * DFF, 2 * DFF, ws + WS_WGU + 33 * MiB, INP(6) + D, 1)
            MAT(I_D, INP(4), DFF, D, D, ws + WS_WD, nullptr, 0)
            MAT(I_D, INP(8), DFF, D, D, ws + WS_WD + (size_t)D * DFF * 2, nullptr, 0)
            MAT(I_D, INP(4) + (size_t)D * DFF, DFF, D, D, ws + WS_WD + (size_t)D * DFF * 4, nullptr, 0)
            MAT(I_D, INP(8) + (size_t)D * DFF, DFF, D, D, ws + WS_WD + (size_t)D * DFF * 6, nullptr, 0)
            MAT(I_G, INP(10), D, D, D, ws + WS_WG, INP(9), 0)
            MAT(I_G, INP(10) + (size_t)D * D, D, D, D, ws + WS_WG + 2 * MiB, INP(9) + D, 0)
            MAT(I_P, INP(11), PLE, D, D, ws + WS_WP, nullptr, 0)
            MAT(I_P, INP(11) + (size_t)PLE * D, PLE, D, D, ws + WS_WP + (size_t)PLE * D * 2, nullptr, 0)
            MAT(I_IN0, INP(12), D, EVEN_IN, EVEN_IN, ws + WS_WIN0, INP(5), 0)
            MAT(I_IN1, INP(26), D, FOX_IN, FOX_INP, ws + WS_WIN1, INP(5) + D, 0)
            MAT(I_G, INP(13), D, D, D, ws + WS_WOUT0, nullptr, 0)
            MAT(I_G, INP(28), D, D, D, ws + WS_WOUT1, nullptr, 0)
#undef MAT
        }
        const float* x_in = INP(0);
        for (int m = gw; m < M; m += NGW) { const f32x4* xr = (const f32x4*)(x_in + (size_t)m * D) + lane; f32x4 v[4]; float s = 0.f;
#pragma unroll
            for (int j = 0; j < 4; ++j) { v[j] = xr[64 * j]; s += (v[j][0] * v[j][0] + v[j][1] * v[j][1]) + (v[j][2] * v[j][2] + v[j][3] * v[j][3]); }
            s = wave_sum(s); if (lane < 16) ssq[(size_t)m * 16 + lane] = (lane == 0) ? s : 0.f;
            v2u* o = (v2u*)(XB + (size_t)m * D) + lane;
#pragma unroll
            for (int j = 0; j < 4; ++j) { v2u w; w.x = pk2(v[j][0], v[j][1]); w.y = pk2(v[j][2], v[j][3]); o[64 * j] = w; } }
        const float* g2 = INP(20);
        for (int i = bx * 512 + tid; i < 8192; i += G * 512) { const int ln = i & 63, ks = (i >> 6) & 7, nb = (i >> 9) & 1, hh = i >> 10; float f[8];
#pragma unroll
            for (int j = 0; j < 8; ++j) f[j] = g2[(size_t)(16 * ks + 8 * (ln >> 5) + j) * 512 + hh * 64 + 32 * nb + (ln & 31)];
            ((bf16x8*)(ws + WS_G2F))[i] = pack8(f); }
    }
    if (ph_lo == 0 && ph_hi > 1) GSYNC();

#define GEMM(EpiT, Aptr, Bptr, Nn, Kk, Eobj) do { pg8::Gemm g_{(const pg8::bf16_t*)(Aptr), (const pg8::bf16_t*)(Bptr), M, (Nn), (Kk)}; pg8::StaticOrder S_; S_.init(M, (Nn), G, bx); \
        pg8::gemm_phase<EpiT, pg8::StaticOrder, true, true>(lds, g_, S_, (Eobj), tid); } while (0)
#pragma unroll 1
    for (int L = 0; L < 2; ++L) {
#pragma unroll 1
        for (int st = 0; st < 9; ++st) {
            const int ph = 1 + 9 * L + st; if (ph < ph_lo || ph >= ph_hi) continue;
            switch (st) {
            case 0: case 6: {
#if PHM & 1
                FRESH();
                for (int dup = 0; dup < 1 + DUP_GU; ++dup) {
                const int f = (st == 6); pg8::EpiGU E{H, ssq + (size_t)((f ? 2 : 0) & 1) * M * 16};
                GEMM(pg8::EpiGU, (L == 1 && st == 0) ? Y : XB, ws + WS_WGU + (size_t)(L * 2 + f) * 11 * MiB, 2 * DFF, D, E);
                __syncthreads(); }
#endif
            } break;
            case 1: case 5: case 7: {
#if PHM & 2
                FRESH();
                const bf16* A; const bf16* Bt; int K; float alpha; float* so;
                if (st == 5) { A = (L == 0) ? Y : Qb; Bt = (const bf16*)(ws + (L == 0 ? WS_WOUT0 : WS_WOUT1)); K = D; alpha = 1.f; so = ssq; }
                else { const int f = (st == 7); A = H; Bt = (const bf16*)(ws + WS_WD + (size_t)(L * 2 + f) * D * DFF * 2); K = DFF; alpha = 0.5f; so = ssq + (size_t)M * 16; }
                pg8::EpiRes E{(L == 0 && st == 1) ? INP(0) : (const float*)X, X, XB, so, alpha};
                GEMM(pg8::EpiRes, A, Bt, D, K, E);
                if (st == 7) {
                    const f32x4* ps = (const f32x4*)(INP(1) + (size_t)L * M * PLE);
                    for (int i = bx * 512 + tid; i < M * PLE / 8; i += G * 512) { const f32x4 u0 = ps[2 * i], u1 = ps[2 * i + 1]; v4u w; w.x = pk2(u0[0], u0[1]); w.y = pk2(u0[2], u0[3]); w.z = pk2(u1[0], u1[1]); w.w = pk2(u1[2], u1[3]); ((v4u*)PB)[i] = w; }
                }
#endif
            } break;
            case 2: {
#if PHM & 4
                FRESH();
                pg8::EpiStore E{Qb, L ? D : EVEN_IN, ssq + (size_t)M * 16, QSCALE, L ? 4 : 2, L ? 4 : 1000, (size_t)M * D, -1, LF, INP(27)};
                for (int dup = 0; dup < 1 + DUP_INPROJ; ++dup) { GEMM(pg8::EpiStore, XB, ws + (L ? WS_WIN1 : WS_WIN0), L ? 3 * D : EVEN_IN, D, E); __syncthreads(); }
                if (L == 1) fox_gate_pass(XB, (const bf16*)(ws + WS_WIN1) + (size_t)3 * D * D, ssq + (size_t)M * 16, INP(27), LF, gw, NGW, lane);
#endif
            } break;
            case 3: {
                if (L == 0) {
#if PHM & 8
                    { FRESH();
#pragma unroll 1
                    for (int dup = 0; dup < 1 + DUP_SWA; ++dup)
                    for (int u = bx; u < 256; u += G) swa_unit(u, PROJ, Y, INP(14), lds, tid, lane, wid); }
#endif
#if PHM & 16
                    { FRESH();
#pragma unroll 1
                    for (int dup = 0; dup < 1 + DUP_SCAN; ++dup)
                    for (int u = bx; u < 256; u += G) rwkv_scan_unit(u, PROJ, YRAW, C3, INP(15), INP(16), INP(17), INP(18), INP(19), INP(21), INP(22), INP(23), lds, lane, wid); }
#endif
                } else {
#if PHM & 32
                    FRESH();
                    const int vcu = (G % 8 == 0) ? (bx % 8) * (G / 8) + bx / 8 : bx;
#pragma unroll 1
                    for (int v = vcu; v < 256; v += G)
#pragma unroll 1
                        for (int i = 0; i < 4; ++i) { int tid2 = tid; asm volatile("" : "+v"(tid2)); const int lane2 = tid2 & 63, wid2 = __builtin_amdgcn_readfirstlane(tid2 >> 6); const int s = v & 3, bh = v >> 2, qb = (i == 0) ? s : (i == 1) ? 7 - s : (i == 2) ? 8 + s : 15 - s;
                            if (i == 0) fox_prefix(LF + (size_t)(bh >> 4) * SEQ * 16 + (bh & 15), (LAS float*)(lds + 98304), (LAS float*)(lds + 131072), tid2, lane2, wid2);
                            attn_body::attn_unit<60>(bh >> 4, bh & 15, qb, (const attn_body::bf16*)Qb, (const attn_body::bf16*)Kb, (const attn_body::bf16*)Vb, (attn_body::bf16*)Qb, (char*)lds_raw, (attn_body::lds_fptr)(lds + 98304), tid2); }
#endif
                }
            } break;
            case 4: {
#if PHM & 64
                if (L == 0) { FRESH();
#pragma unroll 1
                    for (int dup = 0; dup < 1 + DUP_POST; ++dup)
                    for (int t = bx; t < M / 32; t += G) rwkv_post_unit(t, PROJ, YRAW, C3, Y, INP(15), (const bf16*)(ws + WS_G2F), INP(24), INP(25), lane, wid); }
#endif
            } break;
            case 8: {
#if PHM & 128
                FRESH();
#pragma unroll 1
                for (int mode = 0; mode < 2; ++mode) {
                    pg8::EpiPle E{mode, X, (L == 0) ? Y : (bf16*)nullptr, PP, ssq + (size_t)M * 16, ssq};
                    GEMM(pg8::EpiPle, mode ? XB : PB, mode ? ws + WS_WG + (size_t)L * 2 * MiB : ws + WS_WP + (size_t)L * PLE * D * 2, D, mode ? D : PLE, E);
                    __syncthreads();
                }
#endif
            } break;
            }
            if (!(L == 1 && st == 4) && ph + 1 < ph_hi) { GSYNC(); for (int dup = 0; dup < DUP_SYNC; ++dup) GSYNC(); }
        }
    }
#undef GEMM
    if (ph_hi == 20) { FRESH(); const float* fg = INP(29); const float* s8 = ssq;
        for (int m = gw; m < M; m += NGW) { f32x4* xr = (f32x4*)(X + (size_t)m * D) + lane; const float rs = pg8::rstd_of(s8, m);
#pragma unroll
            for (int j = 0; j < 4; ++j) { const f32x4 gv = ((const f32x4*)fg)[lane + 64 * j]; xr[64 * j] = xr[64 * j] * rs * gv; } } }
}

extern "C" void kernel_launch(void* const* d_in, const int* in_sizes, int n_in, void* d_out, int out_size, void* d_ws, size_t ws_size, hipStream_t stream) {
    static int grid = 0;
    if (grid == 0) {
        if (n_in != 30 || out_size != M * D || ws_size < WS_END) { fprintf(stderr, "kernel_launch: unexpected shapes (n_in %d out %d ws %zu)\n", n_in, out_size, ws_size); grid = -1; return; }
        int dev = 0, cus = 0, per_cu = 0;
        if (hipGetDevice(&dev) != hipSuccess || hipDeviceGetAttribute(&cus, hipDeviceAttributeMultiprocessorCount, dev) != hipSuccess) { grid = -1; return; }
        if (hipFuncSetAttribute((const void*)fwd_megakernel, hipFuncAttributeMaxDynamicSharedMemorySize, LDS_BYTES) != hipSuccess) { fprintf(stderr, "kernel_launch: hipFuncSetAttribute failed\n"); grid = -1; return; }
        if (hipOccupancyMaxActiveBlocksPerMultiprocessor(&per_cu, (const void*)fwd_megakernel, 512, LDS_BYTES) != hipSuccess || per_cu < 1) { fprintf(stderr, "kernel_launch: occupancy query failed (%d)\n", per_cu); (void)hipGetLastError(); grid = -1; return; }
        grid = cus * per_cu;
        if (grid > 256) grid = 256;
    }
    if (grid < 0) return;
    Args a{};
    for (int i = 0; i < 30; ++i) a.in[i] = (const float*)d_in[i];
    a.out = (float*)d_out; a.ws = (unsigned char*)d_ws;
#ifndef N_LAUNCH_PER_PHASE
    a.ph_lo = 0; a.ph_hi = 20;
    { void* args[] = {&a};
      hipError_t e = hipLaunchCooperativeKernel((const void*)fwd_megakernel, dim3(grid), dim3(512), args, LDS_BYTES, stream);
      if (e != hipSuccess) fprintf(stderr, "cooperative launch failed: %s (grid %d)\n", hipGetErrorString(e), grid); }
#else
    for (int ph = 0; ph < 20; ++ph) { if (ph == 14) continue; a.ph_lo = ph; a.ph_hi = ph + 1; void* args[] = {&a};
      hipError_t e = hipLaunchCooperativeKernel((const void*)fwd_megakernel, dim3(grid), dim3(512), args, LDS_BYTES, stream);
      if (e != hipSuccess) { fprintf(stderr, "cooperative launch failed: %s (grid %d)\n", hipGetErrorString(e), grid); break; } }
#endif
}
```

```cpp
#include <hip/hip_runtime.h>
#include <hip/hip_cooperative_groups.h>
#include <hip/hip_bf16.h>
#include <cstdio>
#include <cstdint>
#include <cmath>
namespace cg = cooperative_groups;
#ifndef PHM
#define PHM 255
#endif
namespace pg8 {
#define PG8_LAS __attribute__((address_space(3)))
typedef unsigned short bf16_t;
typedef short bf16x8 __attribute__((ext_vector_type(8)));
typedef float f32x4 __attribute__((ext_vector_type(4)));
typedef unsigned u32x4 __attribute__((ext_vector_type(4)));
constexpr int BM = 256, BK = 64, HALF = 128, HTB = HALF * BK * 2  , STAGE_BYTES = 8 * HTB, NXCD = 8, WGM = 8;

__host__ __device__ __forceinline__ int lds_byte(int r, int c) { const int st = (r >> 4) * 2 + (c >> 5), rr = r & 15, cc = c & 31, ob = rr * 64 + cc * 2; return st * 1024 + (ob ^ (((ob >> 9) & 1) << 5)); }
__host__ __device__ __forceinline__ void stage_rc(int b, int& R, int& C) { const int st = b / 1024, sb = b % 1024, swz = sb ^ (((sb >> 9) & 1) << 5); R = (st >> 1) * 16 + swz / 64; C = (st & 1) * 32 + (swz % 64) / 2; }
__host__ __device__ __forceinline__ int perm32(int rho) { const int n = rho >> 4, i = rho & 15; return 8 * (i >> 2) + 4 * n + (i & 3); }

struct Unit { int pm, pn; };
struct Gemm { const bf16_t* A; const bf16_t* Bt; int M, N, K; };

struct StaticOrder {
    int nM, nN, nwg, G, c;
    __host__ __device__ void init(int M, int N, int G_, int c_) { nM = M / BM; nN = N / BM; nwg = nM * nN; G = G_; c = c_; }
    __host__ __device__ bool next(int i, Unit& u) const {
        const long L = (long)i * G + c; if (L >= nwg) return false;
        int wgid = (int)L; { const int q = nwg / NXCD, r = nwg % NXCD, xcd = wgid % NXCD, off = wgid / NXCD; wgid = (xcd < r ? xcd * (q + 1) : r * (q + 1) + (xcd - r) * q) + off; }
        const int nig = WGM * nN, gid = wgid / nig, fm = gid * WGM, gsz = (nM - fm) < WGM ? (nM - fm) : WGM;
        u.pm = fm + ((wgid % nig) % gsz); u.pn = (wgid % nig) / gsz; return true;
    }
    __device__ __forceinline__ void a_ready(const Unit&) const {}
    __device__ __forceinline__ void done(const Unit&) const {}
};

typedef float f32x2_c __attribute__((ext_vector_type(2))); typedef __bf16 bf16x2_c __attribute__((ext_vector_type(2)));
__device__ __forceinline__ unsigned cvt_pk_bf16(float lo, float hi) { f32x2_c v = {lo, hi}; bf16x2_c b = __builtin_convertvector(v, bf16x2_c); return __builtin_bit_cast(unsigned, b); }
typedef float f32x2 __attribute__((ext_vector_type(2)));
constexpr float NORM_EPS = 1e-6f;
__device__ __forceinline__ float ssq_sum(const float* ssq, int row) { const f32x4* p = (const f32x4*)(ssq + (size_t)row * 16); const f32x4 a = p[0], b = p[1], c = p[2], d = p[3];
    return ((a[0] + a[1]) + (a[2] + a[3])) + ((b[0] + b[1]) + (b[2] + b[3])) + (((c[0] + c[1]) + (c[2] + c[3])) + ((d[0] + d[1]) + (d[2] + d[3]))); }
__device__ __forceinline__ float rstd_of(const float* ssq, int row) { return rsqrtf(ssq_sum(ssq, row) * (1.0f / 1024.0f) + NORM_EPS); }
__device__ __forceinline__ void rstd8(const float* ssq, int row0, int fr, int fq, float (&rs)[2][4]) {
    const int i0 = 2 * fq, i1 = 2 * fq + 1;
    const float m0 = rstd_of(ssq, row0 + (i0 >> 2) * HALF + (i0 & 3) * 16), m1 = rstd_of(ssq, row0 + (i1 >> 2) * HALF + (i1 & 3) * 16);
#pragma unroll
    for (int ai = 0; ai < 2; ++ai)
#pragma unroll
        for (int m = 0; m < 4; ++m) { const int idx = ai * 4 + m; rs[ai][m] = __shfl((idx & 1) ? m1 : m0, (idx >> 1) * 16 + fr); }
}
__device__ __forceinline__ float sigm(float x) { return __builtin_amdgcn_rcpf(1.0f + __expf(-x)); }
struct EpiGU { static constexpr bool PERM = true, AFTER_DRAIN = false;
    bf16_t* H; const float* ssq;
    __device__ __forceinline__ void operator()(const f32x4 (&acc)[2][2][4][2], const Unit& u, int wr, int wc, int fr, int fq) const {
        int row0 = u.pm * BM + wr * 64 + fr; asm volatile("" : "+v"(row0)); const int col0 = u.pn * 128 + wc * 32 + 8 * fq; float rsv[2][4]; rstd8(ssq, row0, fr, fq, rsv);
#pragma unroll
        for (int ai = 0; ai < 2; ++ai)
#pragma unroll
            for (int m = 0; m < 4; ++m) { const int row = row0 + ai * HALF + m * 16; const float rs = rsv[ai][m];
                const float nk = -1.4426950408889634f * rs, rs2 = rs * rs; u32x4 w;
#pragma unroll
                for (int n = 0; n < 2; ++n) { const f32x4 ag = acc[ai][0][m][n], au = acc[ai][1][m][n]; const f32x4 t = ag * nk; f32x4 d;
                    d[0] = __builtin_amdgcn_exp2f(t[0]); d[1] = __builtin_amdgcn_exp2f(t[1]); d[2] = __builtin_amdgcn_exp2f(t[2]); d[3] = __builtin_amdgcn_exp2f(t[3]);
                    d = d + 1.0f; f32x4 r; r[0] = __builtin_amdgcn_rcpf(d[0]); r[1] = __builtin_amdgcn_rcpf(d[1]); r[2] = __builtin_amdgcn_rcpf(d[2]); r[3] = __builtin_amdgcn_rcpf(d[3]);
                    const f32x4 hv = (ag * au) * (r * rs2);
                    if (n == 0) { w.x = cvt_pk_bf16(hv[0], hv[1]); w.y = cvt_pk_bf16(hv[2], hv[3]); } else { w.z = cvt_pk_bf16(hv[0], hv[1]); w.w = cvt_pk_bf16(hv[2], hv[3]); } }
                *(u32x4*)(H + (size_t)row * 2816 + col0) = w; }
    }
};
struct EpiRes { static constexpr bool PERM = true, AFTER_DRAIN = false;
    const float* base; float* X; bf16_t* XB; float* ssq_out; float alpha;
    __device__ __forceinline__ void operator()(const f32x4 (&acc)[2][2][4][2], const Unit& u, int wr, int wc, int fr, int fq) const {
        int row0 = u.pm * BM + wr * 64 + fr; asm volatile("" : "+v"(row0)); const int col0 = u.pn * BM + wc * 32 + 8 * fq;
#pragma unroll
        for (int ai = 0; ai < 2; ++ai) {
            f32x4 bb[4][2][2];
#pragma unroll
            for (int m = 0; m < 4; ++m)
#pragma unroll
                for (int bj = 0; bj < 2; ++bj) { const size_t off = (size_t)(row0 + ai * HALF + m * 16) * 1024 + col0 + bj * HALF; bb[m][bj][0] = *(const f32x4*)(base + off); bb[m][bj][1] = *(const f32x4*)(base + off + 4); }
#pragma unroll
            for (int m = 0; m < 4; ++m) { const int row = row0 + ai * HALF + m * 16; float part = 0.f;
#pragma unroll
                for (int bj = 0; bj < 2; ++bj) { const size_t off = (size_t)row * 1024 + col0 + bj * HALF;
                    const f32x4 v0 = bb[m][bj][0] + acc[ai][bj][m][0] * alpha, v1 = bb[m][bj][1] + acc[ai][bj][m][1] * alpha;
                    *(f32x4*)(X + off) = v0; *(f32x4*)(X + off + 4) = v1;
                    u32x4 w; w.x = cvt_pk_bf16(v0[0], v0[1]); w.y = cvt_pk_bf16(v0[2], v0[3]); w.z = cvt_pk_bf16(v1[0], v1[1]); w.w = cvt_pk_bf16(v1[2], v1[3]);
                    *(u32x4*)(XB + off) = w;
                    part += (v0[0] * v0[0] + v0[1] * v0[1]) + (v0[2] * v0[2] + v0[3] * v0[3]) + (v1[0] * v1[0] + v1[1] * v1[1]) + (v1[2] * v1[2] + v1[3] * v1[3]); }
                part += __shfl_xor(part, 16); part += __shfl_xor(part, 32);
                if (fq == 0) ssq_out[(size_t)row * 16 + u.pn * 4 + wc] = part; } }
    }
};
struct EpiPle { static constexpr bool PERM = true, AFTER_DRAIN = false;
    int mode; float* X; bf16_t* XB; bf16_t* PP; const float* ssq_in; float* ssq_out;
    __device__ __forceinline__ void operator()(const f32x4 (&acc)[2][2][4][2], const Unit& u, int wr, int wc, int fr, int fq) const {
        int row0 = u.pm * BM + wr * 64 + fr; asm volatile("" : "+v"(row0)); const int col0 = u.pn * BM + wc * 32 + 8 * fq;
        if (mode == 0) {
#pragma unroll
            for (int ai = 0; ai < 2; ++ai)
#pragma unroll
                for (int m = 0; m < 4; ++m)
#pragma unroll
                    for (int bj = 0; bj < 2; ++bj) { const size_t off = (size_t)(row0 + ai * HALF + m * 16) * 1024 + col0 + bj * HALF; const f32x4 v0 = acc[ai][bj][m][0], v1 = acc[ai][bj][m][1];
                        u32x4 w; w.x = cvt_pk_bf16(v0[0], v0[1]); w.y = cvt_pk_bf16(v0[2], v0[3]); w.z = cvt_pk_bf16(v1[0], v1[1]); w.w = cvt_pk_bf16(v1[2], v1[3]);
                        *(u32x4*)(PP + off) = w; }
            return;
        }
        float rsv[2][4]; rstd8(ssq_in, row0, fr, fq, rsv);
#pragma unroll
        for (int ai = 0; ai < 2; ++ai)
#pragma unroll
            for (int mp = 0; mp < 2; ++mp) {
                u32x4 pw[2][2]; f32x4 xb[2][2][2];
#pragma unroll
                for (int mm = 0; mm < 2; ++mm)
#pragma unroll
                    for (int bj = 0; bj < 2; ++bj) { const size_t off = (size_t)(row0 + ai * HALF + (2 * mp + mm) * 16) * 1024 + col0 + bj * HALF;
                        pw[mm][bj] = *(const u32x4*)(PP + off); xb[mm][bj][0] = *(const f32x4*)(X + off); xb[mm][bj][1] = *(const f32x4*)(X + off + 4); }
#pragma unroll
                for (int mm = 0; mm < 2; ++mm) { const int m = 2 * mp + mm; const int row = row0 + ai * HALF + m * 16; float part = 0.f; const float rs = rsv[ai][m];
#pragma unroll
                    for (int bj = 0; bj < 2; ++bj) { const size_t off = (size_t)row * 1024 + col0 + bj * HALF; const u32x4 pq = pw[mm][bj];
                        const f32x4 p0 = {__uint_as_float(pq.x << 16), __uint_as_float(pq.x & 0xffff0000u), __uint_as_float(pq.y << 16), __uint_as_float(pq.y & 0xffff0000u)};
                        const f32x4 p1 = {__uint_as_float(pq.z << 16), __uint_as_float(pq.z & 0xffff0000u), __uint_as_float(pq.w << 16), __uint_as_float(pq.w & 0xffff0000u)};
                        const f32x4 a0 = acc[ai][bj][m][0] * rs, a1 = acc[ai][bj][m][1] * rs;
                        f32x4 v0, v1;
#pragma unroll
                        for (int j = 0; j < 4; ++j) { v0[j] = xb[mm][bj][0][j] + sigm(a0[j]) * p0[j]; v1[j] = xb[mm][bj][1][j] + sigm(a1[j]) * p1[j]; }
                        *(f32x4*)(X + off) = v0; *(f32x4*)(X + off + 4) = v1;
                        u32x4 w; w.x = cvt_pk_bf16(v0[0], v0[1]); w.y = cvt_pk_bf16(v0[2], v0[3]); w.z = cvt_pk_bf16(v1[0], v1[1]); w.w = cvt_pk_bf16(v1[2], v1[3]);
                        if (XB) *(u32x4*)(XB + off) = w;
                        part += (v0[0] * v0[0] + v0[1] * v0[1]) + (v0[2] * v0[2] + v0[3] * v0[3]) + (v1[0] * v1[0] + v1[1] * v1[1]) + (v1[2] * v1[2] + v1[3] * v1[3]); }
                    part += __shfl_xor(part, 16); part += __shfl_xor(part, 32); if (fq == 0) ssq_out[(size_t)row * 16 + u.pn * 4 + wc] = part; } }
    }
};
struct EpiStore { static constexpr bool PERM = true, AFTER_DRAIN = false;
    bf16_t* O; int ldc; const float* ssq; float scale0; int scale_tiles; int split_tiles; size_t split_stride; int lf_tile; float* LF; const float* bfv;
    __device__ __forceinline__ void operator()(const f32x4 (&acc)[2][2][4][2], const Unit& u, int wr, int wc, int fr, int fq) const {
        int row0 = u.pm * BM + wr * 64 + fr; asm volatile("" : "+v"(row0));
        if (u.pn == lf_tile) {
            if (wc == 0 && fq < 2) {
#pragma unroll
                for (int ai = 0; ai < 2; ++ai)
#pragma unroll
                    for (int m = 0; m < 4; ++m) { const int row = row0 + ai * HALF + m * 16; const float rs = rstd_of(ssq, row);
#pragma unroll
                        for (int n = 0; n < 2; ++n) { f32x4 o;
#pragma unroll
                            for (int j = 0; j < 4; ++j) { const float z = fmaxf(acc[ai][0][m][n][j] * rs + bfv[8 * fq + 4 * n + j], -80.f), e = __expf(-z);
                                o[j] = (e < 0.01f) ? -(e - 0.5f * e * e + e * e * e * (1.f / 3.f)) : -__logf(1.f + e); }
                            *(f32x4*)(LF + (size_t)row * 16 + 8 * fq + 4 * n) = o; } }
            }
            return;
        }
        const int t = u.pn / split_tiles, ct = u.pn - t * split_tiles;
        bf16_t* base = O + (size_t)t * split_stride; const float sc = (u.pn < scale_tiles) ? scale0 : 1.f;
        const int col0 = ct * BM + wc * 32 + 8 * fq; float rsv[2][4]; rstd8(ssq, row0, fr, fq, rsv);
#pragma unroll
        for (int ai = 0; ai < 2; ++ai)
#pragma unroll
            for (int m = 0; m < 4; ++m) { const int row = row0 + ai * HALF + m * 16; const float rs = rsv[ai][m] * sc;
#pragma unroll
                for (int bj = 0; bj < 2; ++bj) { const f32x4 v0 = acc[ai][bj][m][0] * rs, v1 = acc[ai][bj][m][1] * rs;
                    u32x4 w; w.x = cvt_pk_bf16(v0[0], v0[1]); w.y = cvt_pk_bf16(v0[2], v0[3]); w.z = cvt_pk_bf16(v1[0], v1[1]); w.w = cvt_pk_bf16(v1[2], v1[3]);
                    *(u32x4*)(base + (size_t)row * ldc + col0 + bj * HALF) = w; } }
    }
};

template <class Epi, class Sched, bool ALIGN_EPI = false, bool SP2 = false>
__device__ __forceinline__ void gemm_phase(PG8_LAS unsigned char* lds, const Gemm g, const Sched& S, const Epi& E, const int tid) {
    const int wid = __builtin_amdgcn_readfirstlane(tid >> 6), lane = tid & 63, wr = wid >> 2, wc = wid & 3, fr = lane & 15, fq = lane >> 4;
    const int K = g.K, nt = K / BK;
    unsigned voffA[2], voffB[2];
#pragma unroll
    for (int i = 0; i < 2; ++i) { int R, C; stage_rc(tid * 16 + i * 8192, R, C); const int Rb = Epi::PERM ? ((R & ~31) + perm32(R & 31)) : R;
        voffA[i] = (unsigned)(R * K + C) * 2u; voffB[i] = (unsigned)(Rb * K + C) * 2u; }
    const size_t kstep = (size_t)(BK * 2);
    const size_t hstep = (size_t)HALF * K * 2;
    const size_t tstep = 2 * hstep;
    const unsigned ldsw = (unsigned)wid * 1024u;
    const int aoff = lds_byte(wr * 64 + fr, fq * 8), boff = lds_byte(wc * 32 + fr, fq * 8);
#define PG8_SA(b, h) (((b) * 2 + (h)) * HTB)
#define PG8_SB(b, h) ((4 + (b) * 2 + (h)) * HTB)
#define PG8_STAGE(bufoff, gbase, voff) do { _Pragma("unroll") for (int _i = 0; _i < 2; ++_i) \
        __builtin_amdgcn_global_load_lds((const unsigned*)((const char*)(gbase) + (voff)[_i]), (PG8_LAS unsigned*)(lds + (bufoff) + ldsw + _i * 8192), 16, 0, 0); } while (0)
#define PG8_LDA(dst, b, h) do { _Pragma("unroll") for (int m = 0; m < 4; ++m) _Pragma("unroll") for (int k = 0; k < 2; ++k) dst[m][k] = *(const PG8_LAS bf16x8*)(lds + PG8_SA(b, h) + aoff + m * 2048 + k * 1024); } while (0)
#define PG8_LDB(dst, b, h) do { _Pragma("unroll") for (int n = 0; n < 2; ++n) _Pragma("unroll") for (int k = 0; k < 2; ++k) dst[n][k] = *(const PG8_LAS bf16x8*)(lds + PG8_SB(b, h) + boff + n * 2048 + k * 1024); } while (0)
#define PG8_MMA(ai, bj, At, Bt) do { __builtin_amdgcn_s_setprio(1); _Pragma("unroll") for (int m = 0; m < 4; ++m) _Pragma("unroll") for (int n = 0; n < 2; ++n) _Pragma("unroll") for (int k = 0; k < 2; ++k) \
        acc[ai][bj][m][n] = __builtin_amdgcn_mfma_f32_16x16x32_bf16(Bt[n][k], At[m][k], acc[ai][bj][m][n], 0, 0, 0); __builtin_amdgcn_s_setprio(0); } while (0)
#define PG8_WAIT_V(n) asm volatile("s_waitcnt vmcnt(" #n ")" ::: "memory")
#define PG8_WAIT_L(n) asm volatile("s_waitcnt lgkmcnt(" #n ")" ::: "memory")
#define PG8_BAR __builtin_amdgcn_s_barrier()
#define PG8_SCHED __builtin_amdgcn_sched_barrier(0)
    Unit cur, nxt; int ui = 0;
    if (!S.next(0, cur)) return;
    f32x4 acc[2][2][4][2];
#pragma unroll
    for (int a = 0; a < 2; ++a)
#pragma unroll
        for (int b = 0; b < 2; ++b)
#pragma unroll
            for (int m = 0; m < 4; ++m)
#pragma unroll
                for (int n = 0; n < 2; ++n) acc[a][b][m][n] = (f32x4){0.f, 0.f, 0.f, 0.f};
    bf16x8 At[4][2], B0[2][2], B1[2][2];
    const char* cA = (const char*)g.A + (size_t)cur.pm * tstep; const char* cB = (const char*)g.Bt + (size_t)cur.pn * tstep;
    S.a_ready(cur);
    if constexpr (SP2) {
        PG8_STAGE(PG8_SB(0, 0), cB, voffB); PG8_STAGE(PG8_SB(0, 1), cB + hstep, voffB); PG8_STAGE(PG8_SA(0, 0), cA, voffA); PG8_STAGE(PG8_SA(0, 1), cA + hstep, voffA);
        if (wr == 1) PG8_BAR;
        PG8_WAIT_V(2); PG8_BAR;
        PG8_STAGE(PG8_SB(1, 0), cB + kstep, voffB); PG8_STAGE(PG8_SA(1, 0), cA + kstep, voffA); PG8_STAGE(PG8_SB(1, 1), cB + hstep + kstep, voffB);
        PG8_WAIT_V(6); PG8_BAR;
    } else {
        PG8_STAGE(PG8_SB(0, 0), cB, voffB); PG8_STAGE(PG8_SA(0, 0), cA, voffA); PG8_STAGE(PG8_SB(0, 1), cB + hstep, voffB); PG8_STAGE(PG8_SA(0, 1), cA + hstep, voffA);
        if (wr == 1) PG8_BAR;
        PG8_WAIT_V(4); PG8_BAR;
        PG8_STAGE(PG8_SB(1, 0), cB + kstep, voffB); PG8_STAGE(PG8_SA(1, 0), cA + kstep, voffA); PG8_STAGE(PG8_SB(1, 1), cB + hstep + kstep, voffB);
        PG8_WAIT_V(6); PG8_BAR;
    }
    for (;;) {
        const bool has_next = S.next(ui + 1, nxt);
        const char* nA = has_next ? (const char*)g.A + (size_t)nxt.pm * tstep : cA; const char* nB = has_next ? (const char*)g.Bt + (size_t)nxt.pn * tstep : cB;
        for (int t = 0; t < nt; t += 2) {
            const bool last = (t == nt - 2);
            const char* a1 = cA + (size_t)(t + 1) * kstep;
            const char* a2 = last ? nA : cA + (size_t)(t + 2) * kstep; const char* b2 = last ? nB : cB + (size_t)(t + 2) * kstep;
            const char* a3 = a2 + kstep; const char* b3 = b2 + kstep;
            if (last && has_next) S.a_ready(nxt);
            if constexpr (SP2) {
            PG8_LDB(B0, 0, 0); PG8_LDB(B1, 0, 1); PG8_SCHED; PG8_LDA(At, 0, 0); PG8_STAGE(PG8_SA(1, 1), a1 + hstep, voffA);
            PG8_WAIT_V(8); PG8_WAIT_L(0); PG8_BAR; PG8_MMA(0, 0, At, B0); PG8_MMA(0, 1, At, B1); PG8_BAR; PG8_SCHED;
            PG8_LDA(At, 0, 1); PG8_STAGE(PG8_SB(0, 0), b2, voffB); PG8_STAGE(PG8_SB(0, 1), b2 + hstep, voffB); PG8_STAGE(PG8_SA(0, 0), a2, voffA);
            PG8_WAIT_V(8); PG8_WAIT_L(0); PG8_BAR; PG8_MMA(1, 0, At, B0); PG8_MMA(1, 1, At, B1); PG8_BAR; PG8_SCHED;
            PG8_LDB(B0, 1, 0); PG8_LDB(B1, 1, 1); PG8_SCHED; PG8_LDA(At, 1, 0); PG8_STAGE(PG8_SA(0, 1), a2 + hstep, voffA);
            PG8_WAIT_V(8); PG8_WAIT_L(0); PG8_BAR; PG8_MMA(0, 0, At, B0); PG8_MMA(0, 1, At, B1); PG8_BAR; PG8_SCHED;
            PG8_LDA(At, 1, 1); PG8_STAGE(PG8_SB(1, 0), b3, voffB); PG8_STAGE(PG8_SB(1, 1), b3 + hstep, voffB); PG8_STAGE(PG8_SA(1, 0), a3, voffA);
            PG8_WAIT_V(8); PG8_WAIT_L(0); PG8_BAR; PG8_MMA(1, 0, At, B0); PG8_MMA(1, 1, At, B1); PG8_BAR; PG8_SCHED;
            } else {
            PG8_LDB(B0, 0, 0); PG8_SCHED; PG8_LDA(At, 0, 0); PG8_STAGE(PG8_SA(1, 1), a1 + hstep, voffA);
            PG8_WAIT_L(8); PG8_BAR; PG8_WAIT_L(0); PG8_MMA(0, 0, At, B0); PG8_BAR; PG8_SCHED;
            PG8_LDB(B1, 0, 1); PG8_STAGE(PG8_SB(0, 0), b2, voffB);
            PG8_BAR; PG8_WAIT_L(0); PG8_MMA(0, 1, At, B1); PG8_BAR;
            PG8_LDA(At, 0, 1); PG8_STAGE(PG8_SA(0, 0), a2, voffA);
            PG8_BAR; PG8_WAIT_L(0); PG8_MMA(1, 0, At, B0); PG8_BAR; PG8_SCHED;
            PG8_STAGE(PG8_SB(0, 1), b2 + hstep, voffB);
            PG8_WAIT_V(6); PG8_BAR; PG8_MMA(1, 1, At, B1); PG8_BAR;
            PG8_LDB(B0, 1, 0); PG8_SCHED; PG8_LDA(At, 1, 0); PG8_STAGE(PG8_SA(0, 1), a2 + hstep, voffA);
            PG8_WAIT_L(8); PG8_BAR; PG8_WAIT_L(0); PG8_MMA(0, 0, At, B0); PG8_BAR; PG8_SCHED;
            PG8_LDB(B1, 1, 1); PG8_STAGE(PG8_SB(1, 0), b3, voffB);
            PG8_BAR; PG8_WAIT_L(0); PG8_MMA(0, 1, At, B1); PG8_BAR;
            PG8_LDA(At, 1, 1); PG8_STAGE(PG8_SA(1, 0), a3, voffA);
            PG8_BAR; PG8_WAIT_L(0); PG8_MMA(1, 0, At, B0); PG8_BAR; PG8_SCHED;
            PG8_STAGE(PG8_SB(1, 1), b3 + hstep, voffB);
            PG8_WAIT_V(6); PG8_BAR; PG8_MMA(1, 1, At, B1); PG8_BAR;
            }
        }
        if constexpr (ALIGN_EPI) { if (wr == 0) PG8_BAR; }
        if constexpr (!Epi::AFTER_DRAIN) { E(acc, cur, wr, wc, fr, fq); S.done(cur); }
        if (!has_next) break;
#pragma unroll
        for (int a = 0; a < 2; ++a)
#pragma unroll
            for (int b = 0; b < 2; ++b)
#pragma unroll
                for (int m = 0; m < 4; ++m)
#pragma unroll
                    for (int n = 0; n < 2; ++n) acc[a][b][m][n] = (f32x4){0.f, 0.f, 0.f, 0.f};
        cur = nxt; cA = nA; cB = nB; ++ui;
        if constexpr (ALIGN_EPI) { if (wr == 1) PG8_BAR; }
    }
    PG8_WAIT_V(0);
    if constexpr (!ALIGN_EPI) { if (wr == 0) PG8_BAR; }
    PG8_BAR;
    if constexpr (Epi::AFTER_DRAIN) { E.fused(acc, cur, wr, wc, fr, fq, lds, wid, lane); S.done(cur); }
#undef PG8_SA
#undef PG8_SB
#undef PG8_STAGE
#undef PG8_LDA
#undef PG8_LDB
#undef PG8_MMA
#undef PG8_WAIT_V
#undef PG8_WAIT_L
#undef PG8_BAR
#undef PG8_SCHED
}
}
#include <hip/hip_bf16.h>
#include <cmath>
namespace attn_body {
using bf16=__hip_bfloat16;
using bf16x8=__attribute__((ext_vector_type(8)))short;
using s16x4=__attribute__((ext_vector_type(4)))short;
using f32x16=__attribute__((ext_vector_type(16)))float;
using u32x4=__attribute__((ext_vector_type(4)))unsigned;
constexpr int BATCH=4,NHEAD=16,SEQ=4096,D=64,DM=NHEAD*D;
constexpr int NW=8,QBLK=32,QB=QBLK*NW,KVBLK=64,NQB=SEQ/QB;
constexpr int ATTN_PITCH=DM, ATTN_UNIT_ROWS=QB;
__device__ __forceinline__ int crow(int r,int hi){return (r&3)+8*(r>>2)+4*hi;}
#define SBAR() __builtin_amdgcn_sched_barrier(0)
__device__ __forceinline__ void cmask(f32x16&p0,f32x16&p1,int jb,int qrel,int hi){
  const float NEG=-INFINITY; int kb=64*jb+4*hi;
  #pragma unroll
  for(int r=0;r<16;++r){int kv=kb+(r&3)+8*(r>>2); if(kv>qrel)p0[r]=NEG; if(kv+32>qrel)p1[r]=NEG;}
}

constexpr int NSLOT=3, SLOTB=8192;
constexpr int LDS_K=0, LDS_V=NSLOT*SLOTB, LDS_WS=2*NSLOT*SLOTB, LDS_OST=LDS_WS+NW*64*4, LDS_BYTES=LDS_OST+NW*4096;
constexpr float C2=0.125f*1.4426950408889634f;
__device__ __forceinline__ void glds16(const void*gsrc,unsigned lds_dst){unsigned keep;
  asm volatile("s_mov_b32 %0, m0\n\ts_mov_b32 m0, %2\n\ts_nop 0\n\tglobal_load_lds_dwordx4 %1, off\n\ts_mov_b32 m0, %0":"=&s"(keep):"v"(gsrc),"s"(lds_dst):"memory");}
__device__ __forceinline__ float max3f(float a,float b,float c){float r;asm("v_max3_f32 %0, %1, %2, %3":"=v"(r):"v"(a),"v"(b),"v"(c));return r;}
__device__ __forceinline__ float max2f(float a,float b){float r;asm("v_max_f32_e32 %0, %1, %2":"=v"(r):"v"(a),"v"(b));return r;}
__device__ __forceinline__ float fadd_s(float a,float b){float r;asm("v_add_f32_e32 %0, %1, %2":"=v"(r):"v"(a),"v"(b));return r;}
__device__ __forceinline__ float fsub_s(float a,float b){float r;asm("v_sub_f32_e32 %0, %1, %2":"=v"(r):"v"(a),"v"(b));return r;}
typedef float f32x2_t __attribute__((ext_vector_type(2))); typedef __bf16 bf16x2_t __attribute__((ext_vector_type(2)));
__device__ __forceinline__ unsigned cvtpk_s(float lo,float hi){f32x2_t v={lo,hi};bf16x2_t b=__builtin_convertvector(v,bf16x2_t);return __builtin_bit_cast(unsigned,b);}
#define WAIT_BAR(N) asm volatile("s_waitcnt vmcnt(" #N ") lgkmcnt(0)\n\ts_barrier":::"memory")

__device__ __forceinline__ void qkt(f32x16&p0,f32x16&p1,const char*Kslot,const bf16x8*qr,int r32,int hi){
  const char*kb=Kslot+hi*1024+r32*16;
  #pragma unroll
  for(int d0=0;d0<4;++d0){
    const bf16x8 b0=*reinterpret_cast<const bf16x8*>(kb+d0*2048);
    const bf16x8 b1=*reinterpret_cast<const bf16x8*>(kb+d0*2048+512);
    {p0=__builtin_amdgcn_mfma_f32_32x32x16_bf16(b0,qr[d0],p0,0,0,0);p1=__builtin_amdgcn_mfma_f32_32x32x16_bf16(b1,qr[d0],p1,0,0,0);}}
}
typedef __attribute__((address_space(3))) const char* lds_cptr;
typedef short v4i16_t __attribute__((ext_vector_type(4)));
__device__ __forceinline__ void kload8(bf16x8*kf,lds_cptr kp){
  kf[0]=*(const __attribute__((address_space(3))) bf16x8*)(kp);      kf[1]=*(const __attribute__((address_space(3))) bf16x8*)(kp+512);
  kf[2]=*(const __attribute__((address_space(3))) bf16x8*)(kp+2048); kf[3]=*(const __attribute__((address_space(3))) bf16x8*)(kp+2560);
  kf[4]=*(const __attribute__((address_space(3))) bf16x8*)(kp+4096); kf[5]=*(const __attribute__((address_space(3))) bf16x8*)(kp+4608);
  kf[6]=*(const __attribute__((address_space(3))) bf16x8*)(kp+6144); kf[7]=*(const __attribute__((address_space(3))) bf16x8*)(kp+6656);
}
__device__ __forceinline__ void kload2(bf16x8*kf,lds_cptr kp,int j){ kf[2*j]=*(const __attribute__((address_space(3))) bf16x8*)(kp+j*2048); kf[2*j+1]=*(const __attribute__((address_space(3))) bf16x8*)(kp+j*2048+512); }
__device__ __forceinline__ s16x4 vtr(lds_cptr p){ return __builtin_bit_cast(s16x4,__builtin_amdgcn_ds_read_tr16_b64_v4i16((__attribute__((address_space(3))) v4i16_t*)p)); }
__device__ __forceinline__ float rowmax(const f32x16&p0,const f32x16&p1){
  float a=max3f(p0[0],p0[1],p1[0]),b=max3f(p0[2],p0[3],p1[1]);a=max3f(a,p1[2],p1[3]);
  #pragma unroll
  for(int r=4;r<16;r+=4){a=max3f(a,p0[r],p0[r+1]);b=max3f(b,p0[r+2],p0[r+3]);a=max3f(a,p1[r],p1[r+1]);b=max3f(b,p1[r+2],p1[r+3]);}
  const float m=max2f(a,b);
  auto rr=__builtin_amdgcn_permlane32_swap(__float_as_uint(m),__float_as_uint(m),false,false);
  return max2f(__uint_as_float(rr[0]),__uint_as_float(rr[1]));
}
__device__ __forceinline__ void pv(f32x16*o,int vb,bf16x8 pa0,bf16x8 pa1,bf16x8 pa2,bf16x8 pa3){
  #pragma unroll
  for(int d0=0;d0<2;++d0){s16x4 lo[4],hi[4];
    #pragma unroll
    for(int ks=0;ks<4;++ks){
      asm volatile("ds_read_b64_tr_b16 %0,%1 offset:%c2":"=&v"(lo[ks]):"v"(vb),"i"(d0*4096+ks*1024):"memory");
      asm volatile("ds_read_b64_tr_b16 %0,%1 offset:%c2":"=&v"(hi[ks]):"v"(vb),"i"(d0*4096+ks*1024+512):"memory");}
    asm volatile("s_waitcnt lgkmcnt(0)":::"memory");SBAR();
    #define PK(k) (bf16x8){lo[k][0],lo[k][1],lo[k][2],lo[k][3],hi[k][0],hi[k][1],hi[k][2],hi[k][3]}
    o[d0]=__builtin_amdgcn_mfma_f32_32x32x16_bf16(pa0,PK(0),o[d0],0,0,0);
    o[d0]=__builtin_amdgcn_mfma_f32_32x32x16_bf16(pa1,PK(1),o[d0],0,0,0);
    o[d0]=__builtin_amdgcn_mfma_f32_32x32x16_bf16(pa2,PK(2),o[d0],0,0,0);
    o[d0]=__builtin_amdgcn_mfma_f32_32x32x16_bf16(pa3,PK(3),o[d0],0,0,0);
    #undef PK
  }
}

#ifndef ATTN_STORE16
#define ATTN_STORE16(p,v) (*(u32x4*)(p)=(v))
#endif
typedef float f32x4b __attribute__((ext_vector_type(4)));
typedef __attribute__((address_space(3))) const float* lds_fptr;
typedef __attribute__((address_space(3))) const f32x4b* lds_f4ptr;
template<int THRL> __device__ __forceinline__ void attn_unit(int b,int h,int qb,const bf16*Q,const bf16*__restrict__ K,const bf16*__restrict__ V,bf16*O,char*shm,lds_fptr cs,const int tid){
  const int lane=tid&63,r32=lane&31,hi=lane>>5; const int wid=__builtin_amdgcn_readfirstlane(tid>>6);
  const long rowbase=(long)b*SEQ; const int q0=qb*QB;
  const bf16*Qw=Q+(rowbase+q0+wid*QBLK)*DM+h*D;
  const bf16*Kh=K+rowbase*DM+h*D,*Vh=V+rowbase*DM+h*D;
  const unsigned lds0=(unsigned)(uintptr_t)shm;
  float*wsf=(float*)(shm+LDS_WS)+wid*64;
  const bf16*ksrc=Kh+(long)lane*DM+wid*8;
  const bf16*vsrc=Vh+(long)(16*(wid&3)+(lane>>2))*DM+(wid>>2)*32+(lane&3)*8;
  const unsigned kdst=lds0+LDS_K+wid*1024, vdst=lds0+LDS_V+wid*1024;
  #define DMA_K(t,slot) glds16(ksrc+(long)(t)*KVBLK*DM,(unsigned)__builtin_amdgcn_readfirstlane(kdst+(slot)))
  #define DMA_V(t,slot) glds16(vsrc+(long)(t)*KVBLK*DM,(unsigned)__builtin_amdgcn_readfirstlane(vdst+(slot)))
  const int vb0=(int)(lds0+LDS_V)+((lane>>4)&1)*32+(lane&3)*8+(4*hi+((lane&15)>>2))*64;
  const char*Kbase=shm+LDS_K; bf16x8 kf[8];
  const lds_cptr shm3=(lds_cptr)shm; const lds_cptr kp0=shm3+LDS_K+hi*1024+r32*16; const lds_cptr vp0=shm3+LDS_V+((lane>>4)&1)*32+(lane&3)*8+(4*hi+((lane&15)>>2))*64;
  const int NT=(q0+QB)/KVBLK;
  DMA_K(0,0);DMA_V(0,0);DMA_K(1,SLOTB);
  bf16x8 qr[4];
  #pragma unroll
  for(int d0=0;d0<4;++d0)qr[d0]=*reinterpret_cast<const bf16x8*>(&Qw[(long)r32*DM+d0*16+hi*8]);
  const int qrel=wid*QBLK+r32;
  typedef __attribute__((address_space(3))) const unsigned long long* lds_u64p; typedef unsigned u32x2b __attribute__((ext_vector_type(2)));
  const lds_u64p ctr=(lds_u64p)cs;
  float ci2; { const unsigned long long w_=ctr[q0+qrel]; ci2=__uint_as_float((unsigned)w_<<16)+__uint_as_float((unsigned)w_&0xffff0000u)+__uint_as_float((unsigned)(w_>>32)<<16); }
  float mhat=0.f,l_reg=0.f;f32x16 o[2];o[0]=f32x16{};o[1]=f32x16{};float nm=ci2; bf16x8 bnm;
  #define MKBNM() do{ const unsigned h1_=cvtpk_s(nm,0.f)&0xffffu; const float r1_=nm-__uint_as_float(h1_<<16); const unsigned h2_=cvtpk_s(r1_,0.f)&0xffffu; const float r2_=r1_-__uint_as_float(h2_<<16); const unsigned h3_=cvtpk_s(r2_,0.f)&0xffffu; \
    u32x4 b_; b_.x=hi?0u:0xBF80BF80u; b_.y=hi?0u:(0xBF80u|(h1_<<16)); b_.z=hi?0u:(h2_|(h3_<<16)); b_.w=0u; bnm=__builtin_bit_cast(bf16x8,b_); }while(0)
  MKBNM();
  #define CINIT(P0,P1,t) do{ const unsigned long long w0_=ctr[64*(t)+r32], w1_=ctr[64*(t)+32+r32]; \
    u32x4 a0_; a0_.x=(unsigned)w0_; a0_.y=(unsigned)(w0_>>32)|0x3F800000u; a0_.z=0x3F803F80u; a0_.w=0u; u32x4 a1_; a1_.x=(unsigned)w1_; a1_.y=(unsigned)(w1_>>32)|0x3F800000u; a1_.z=0x3F803F80u; a1_.w=0u; \
    P0=__builtin_amdgcn_mfma_f32_32x32x16_bf16(__builtin_bit_cast(bf16x8,a0_),bnm,f32x16{},0,0,0); P1=__builtin_amdgcn_mfma_f32_32x32x16_bf16(__builtin_bit_cast(bf16x8,a1_),bnm,f32x16{},0,0,0); }while(0)
  #define CMASK(P0,P1,t) do{int jb_=(t)-(NT-4); if(jb_>=0)cmask(P0,P1,jb_,qrel,hi);}while(0)
  bool resc=false;
  #define START(P0,P1) do{ const float rm=rowmax(P0,P1); resc=false; \
    { const float dl=rm; mhat=fadd_s(mhat,dl); \
      _Pragma("unroll") for(int r=0;r<16;++r){P0[r]=fsub_s(P0[r],dl);P1[r]=fsub_s(P1[r],dl);} \
      nm=ci2-mhat; MKBNM(); } \
    _Pragma("unroll") for(int r=0;r<16;++r)P0[r]=__builtin_amdgcn_exp2f(P0[r]); }while(0)
  #define RESC() do{ if(resc){ asm volatile("s_waitcnt lgkmcnt(0)":::"memory"); \
      _Pragma("unroll") for(int d_=0;d_<2;++d_) _Pragma("unroll") for(int r=0;r<16;++r)o[d_][r]*=wsf[crow(r,hi)]; } }while(0)
  f32x16 pA0,pA1,pB0,pB1;
  int sl_prev=0,sl_cur=0,sl_next=SLOTB;
  #define ROT() do{sl_prev=sl_cur;sl_cur=sl_next;sl_next=(sl_next==(NSLOT-1)*SLOTB)?0:sl_next+SLOTB;}while(0)
  DMA_K(2,2*SLOTB);
  WAIT_BAR(3);
  CINIT(pA0,pA1,0);qkt(pA0,pA1,Kbase,qr,r32,hi);asm volatile("s_nop 15\n\ts_nop 7":"+v"(pA0),"+v"(pA1));CMASK(pA0,pA1,0);
  START(pA0,pA1);
  _Pragma("unroll") for(int r=0;r<16;++r)pA1[r]=__builtin_amdgcn_exp2f(pA1[r]);
  WAIT_BAR(0);
  DMA_K(3,0);DMA_V(1,SLOTB);
  ROT();
  kload8(kf,kp0+sl_cur);
  WAIT_BAR(2);
  s16x4 vlo[8],vhi[8]; u32x4 pw0,pw1,pw2,pw3;
  #define PKW(P,B) cvtpk_s(P[B],P[B+1])
  #define PAF(k) __builtin_bit_cast(bf16x8,pw##k)
  #define VFR(i) (bf16x8){vlo[i][0],vlo[i][1],vlo[i][2],vlo[i][3],vhi[i][0],vhi[i][1],vhi[i][2],vhi[i][3]}
  #define PIN(x) asm volatile("":"+v"(x))
  #define MX3(a,b,c) __builtin_fmaxf(__builtin_fmaxf((a),(b)),(c))
  #define GAPA(MF,A0,A1,A2,A3,W0,W1,PW) do{ MF; sacc+=A0; sacc+=A1; sacc+=A2; sacc+=A3; PIN(sacc); W0; W1; PIN(PW); SBAR(); }while(0)
  #define EX(v) __builtin_amdgcn_exp2f(v)
  #define GAPB(MF,X,B) do{ MF; X[B]=EX(X[B]); X[B+1]=EX(X[B+1]); X[B+2]=EX(X[B+2]); X[B+3]=EX(X[B+3]); PIN(X); SBAR(); }while(0)
  #define VRD(i) do{ vlo[i]=vtr(vp_+(((i)>>2)*4096+((i)&3)*1024)); vhi[i]=vtr(vp_+(((i)>>2)*4096+((i)&3)*1024+512)); }while(0)
  #define KRD(G,j) do{ if(G){ kload2(kf,kp0+sl_next,j); SBAR(); } }while(0)
  #define STEP(C0,C1,P0,P1,t,GK,GV,GL) do{ SBAR(); \
    const lds_cptr vp_=vp0+sl_prev; CINIT(C0,C1,t); SBAR(); \
    VRD(0); SBAR(); float sacc=(P0[0]+P0[1]); \
    GAPA(C0=__builtin_amdgcn_mfma_f32_32x32x16_bf16(kf[0],qr[0],C0,0,0,0), P0[2],P0[3],P0[4],P0[5],     pw0[0]=PKW(P0,0), pw0[1]=PKW(P0,2), pw0); \
    VRD(4); SBAR(); GAPA(C1=__builtin_amdgcn_mfma_f32_32x32x16_bf16(kf[1],qr[0],C1,0,0,0), P0[6],P0[7],P0[8],P0[9],     pw0[2]=PKW(P0,4), pw0[3]=PKW(P0,6), pw0); \
    VRD(1); SBAR(); GAPA(C0=__builtin_amdgcn_mfma_f32_32x32x16_bf16(kf[2],qr[1],C0,0,0,0),   P0[10],P0[11],P0[12],P0[13], pw1[0]=PKW(P0,8), pw1[1]=PKW(P0,10), pw1); \
    VRD(5); SBAR(); GAPA(C1=__builtin_amdgcn_mfma_f32_32x32x16_bf16(kf[3],qr[1],C1,0,0,0),   P0[14],P0[15],P1[0],P1[1],   pw1[2]=PKW(P0,12),pw1[3]=PKW(P0,14), pw1); \
    VRD(2); SBAR(); GAPA(C0=__builtin_amdgcn_mfma_f32_32x32x16_bf16(kf[4],qr[2],C0,0,0,0),   P1[2],P1[3],P1[4],P1[5],     pw2[0]=PKW(P1,0), pw2[1]=PKW(P1,2), pw2); \
    VRD(6); SBAR(); GAPA(C1=__builtin_amdgcn_mfma_f32_32x32x16_bf16(kf[5],qr[2],C1,0,0,0),   P1[6],P1[7],P1[8],P1[9],     pw2[2]=PKW(P1,4), pw2[3]=PKW(P1,6), pw2); \
    VRD(3); SBAR(); GAPA(C0=__builtin_amdgcn_mfma_f32_32x32x16_bf16(kf[6],qr[3],C0,0,0,0),   P1[10],P1[11],P1[12],P1[13], pw3[0]=PKW(P1,8), pw3[1]=PKW(P1,10), pw3); \
    VRD(7); SBAR(); GAPA(C1=__builtin_amdgcn_mfma_f32_32x32x16_bf16(kf[7],qr[3],C1,0,0,0),   P1[14],P1[15],0.f,0.f,       pw3[2]=PKW(P1,12),pw3[3]=PKW(P1,14), pw3); \
    l_reg+=sacc; \
    if(GK){DMA_K((t)+3,sl_cur);} if(GV){DMA_V((t)+1,sl_next);} \
    CMASK(C0,C1,t); \
    { float a=MX3(C0[0],C0[1],C1[0]),b=MX3(C0[2],C0[3],C1[1]); a=MX3(a,C1[2],C1[3]); \
      _Pragma("unroll") for(int r=4;r<16;r+=4){a=MX3(a,C0[r],C0[r+1]);b=MX3(b,C0[r+2],C0[r+3]);a=MX3(a,C1[r],C1[r+1]);b=MX3(b,C1[r+2],C1[r+3]);} \
      float rm=__builtin_fmaxf(a,b); { auto rr=__builtin_amdgcn_permlane32_swap(__float_as_uint(rm),__float_as_uint(rm),false,false); rm=__builtin_fmaxf(__uint_as_float(rr[0]),__uint_as_float(rr[1])); } \
      resc=false; \
      if(__builtin_expect(__any(rm>(float)THRL),0)){ const float dl=__builtin_fmaxf(rm,0.f); mhat+=dl; \
        _Pragma("unroll") for(int r=0;r<16;++r){C0[r]-=dl;C1[r]-=dl;} \
        nm=ci2-mhat; MKBNM(); \
        const float f=__builtin_amdgcn_exp2f(-dl); l_reg*=f; if(hi==0)wsf[r32]=f; resc=true; } } \
    SBAR(); \
    GAPB(o[0]=__builtin_amdgcn_mfma_f32_32x32x16_bf16(PAF(0),VFR(0),o[0],0,0,0), C0,0); \
    GAPB(o[1]=__builtin_amdgcn_mfma_f32_32x32x16_bf16(PAF(0),VFR(4),o[1],0,0,0), C0,4); \
    KRD(GL,0); GAPB(o[0]=__builtin_amdgcn_mfma_f32_32x32x16_bf16(PAF(1),VFR(1),o[0],0,0,0), C0,8); \
    KRD(GL,1); GAPB(o[1]=__builtin_amdgcn_mfma_f32_32x32x16_bf16(PAF(1),VFR(5),o[1],0,0,0), C0,12); \
    KRD(GL,2); GAPB(o[0]=__builtin_amdgcn_mfma_f32_32x32x16_bf16(PAF(2),VFR(2),o[0],0,0,0), C1,0); \
    KRD(GL,3); GAPB(o[1]=__builtin_amdgcn_mfma_f32_32x32x16_bf16(PAF(2),VFR(6),o[1],0,0,0), C1,4); \
    GAPB(o[0]=__builtin_amdgcn_mfma_f32_32x32x16_bf16(PAF(3),VFR(3),o[0],0,0,0), C1,8); \
    GAPB(o[1]=__builtin_amdgcn_mfma_f32_32x32x16_bf16(PAF(3),VFR(7),o[1],0,0,0), C1,12); \
    }while(0)
  int t=1;
  #undef CMASK
  #define CMASK(P0,P1,t) do{}while(0)
  for(;t+5<NT;t+=2){
    STEP(pB0,pB1,pA0,pA1,t,true,true,true);     WAIT_BAR(2); RESC(); ROT();
    STEP(pA0,pA1,pB0,pB1,t+1,true,true,true);   WAIT_BAR(2); RESC(); ROT();
  }
  #undef CMASK
  #define CMASK(P0,P1,t) do{int jb_=(t)-(NT-4); if(jb_>=0)cmask(P0,P1,jb_,qrel,hi);}while(0)
  #define ENDW(tt) do{ if((tt)+3<NT){WAIT_BAR(2);} else if((tt)+2<NT){WAIT_BAR(1);} else {WAIT_BAR(0);} }while(0)
  for(;t+1<NT;t+=2){
    STEP(pB0,pB1,pA0,pA1,t,(t+3<NT),(t+1<NT),(t+1<NT));       ENDW(t);   RESC(); ROT();
    STEP(pA0,pA1,pB0,pB1,t+1,(t+4<NT),(t+2<NT),(t+2<NT));     ENDW(t+1); RESC(); ROT();
  }
  STEP(pB0,pB1,pA0,pA1,NT-1,false,false,false); RESC();
  { float sacc=pB0[0]+pB0[1]; _Pragma("unroll") for(int r=2;r<16;++r)sacc+=pB0[r]; _Pragma("unroll") for(int r=0;r<16;++r)sacc+=pB1[r]; l_reg+=sacc;
    pw0=(u32x4){PKW(pB0,0),PKW(pB0,2),PKW(pB0,4),PKW(pB0,6)};pw1=(u32x4){PKW(pB0,8),PKW(pB0,10),PKW(pB0,12),PKW(pB0,14)};pw2=(u32x4){PKW(pB1,0),PKW(pB1,2),PKW(pB1,4),PKW(pB1,6)};pw3=(u32x4){PKW(pB1,8),PKW(pB1,10),PKW(pB1,12),PKW(pB1,14)};
    SBAR(); pv(o,vb0+sl_cur,PAF(0),PAF(1),PAF(2),PAF(3)); }
  #undef PKW
  #undef PAF
  #undef VFR
  #undef PIN
  #undef MX3
  #undef GAPA
  #undef GAPB
  #undef EX
  #undef VRD
  #undef KRD
  #undef STEP
  #undef ENDW
  {auto rr=__builtin_amdgcn_permlane32_swap(__float_as_uint(l_reg),__float_as_uint(l_reg),false,false);l_reg=__uint_as_float(rr[0])+__uint_as_float(rr[1]);}
  if(hi==0)wsf[32+r32]=l_reg;asm volatile("s_waitcnt lgkmcnt(0)":::"memory");
  float rli[16];
  #pragma unroll
  for(int r=0;r<16;++r)rli[r]=__builtin_amdgcn_rcpf(wsf[32+crow(r,hi)]);
  bf16*Ow=O+(rowbase+q0+wid*QBLK)*DM+h*D;
  { bf16*stg=(bf16*)(shm+LDS_OST)+wid*2048;
    #pragma unroll
    for(int r=0;r<16;++r){const int orow=crow(r,hi);
      #pragma unroll
      for(int d0=0;d0<2;++d0)stg[orow*64+d0*32+r32]=__float2bfloat16(o[d0][r]*rli[r]);}
    asm volatile("s_waitcnt lgkmcnt(0)":::"memory");
    #pragma unroll
    for(int i=0;i<4;++i){const int row=i*8+(lane>>3),ch=lane&7; const u32x4 v=*(const u32x4*)(stg+row*64+ch*8); ATTN_STORE16(Ow+(long)row*DM+ch*8,v);} }
  asm volatile("s_waitcnt lgkmcnt(0)\n\ts_barrier":::"memory");
  #undef DMA_K
  #undef DMA_V
  #undef CINIT
  #undef MKBNM
  #undef CMASK
  #undef START
  #undef RESC
  #undef ROT
}
constexpr int ATTN_LDS_BYTES=LDS_BYTES;
struct AttnTensors { const bf16* Q; const bf16* K; const bf16* V; bf16* O; };
struct AttnUnit { int bh; int qb; };
struct StaticOrder {
  int vcu;
  __device__ __forceinline__ explicit StaticOrder(int grid,int block):vcu((block%8)*(grid/8)+block/8){}
  __device__ __forceinline__ bool next(int i,AttnUnit&u)const{ if(i>=4)return false; const int s=vcu&3; u.bh=vcu>>2; u.qb=(i==0)?s:(i==1)?7-s:(i==2)?8+s:15-s; return true; }
  __device__ __forceinline__ void a_ready(const AttnUnit&)const{}
  __device__ __forceinline__ void done(const AttnUnit&)const{}
};
#undef SBAR
#undef WAIT_BAR
}
#define LAS __attribute__((address_space(3)))
typedef unsigned short bf16;
typedef unsigned v4u __attribute__((ext_vector_type(4)));
typedef unsigned v2u __attribute__((ext_vector_type(2)));
typedef float f32x4 __attribute__((ext_vector_type(4)));
typedef float f32x16 __attribute__((ext_vector_type(16)));
typedef short bf16x8 __attribute__((ext_vector_type(8)));
typedef float f32x2s __attribute__((ext_vector_type(2)));

constexpr int NBATCH = 4, SEQ = 4096, M = NBATCH * SEQ, D = 1024, DFF = 2816, PLE = 256;
constexpr int EVEN_IN = 2560, FOX_IN = 3088, FOX_INP = 3328;
constexpr float LOG2E = 1.4426950408889634f;
constexpr float QSCALE = 0.125f * LOG2E;
constexpr float GN_EPS = 64e-5f;
constexpr size_t MiB = 1u << 20;
constexpr size_t WS_SSQ = 0;
constexpr size_t WS_C3 = 1 * MiB;
constexpr size_t WS_LF = 2 * MiB;
constexpr size_t WS_G2F = 3 * MiB;
constexpr size_t WS_WGU = 4 * MiB;
constexpr size_t WS_WD = 48 * MiB;
constexpr size_t WS_WG = 70 * MiB;
constexpr size_t WS_WP = 74 * MiB;
constexpr size_t WS_WIN0 = 75 * MiB, WS_WOUT0 = 80 * MiB, WS_WIN1 = 82 * MiB, WS_WOUT1 = 89 * MiB;
constexpr size_t WS_XB = 91 * MiB;
constexpr size_t WS_Y = 123 * MiB;
constexpr size_t WS_BIG = 155 * MiB;
constexpr size_t WS_PB = 243 * MiB;
constexpr size_t WS_SSQP = 251 * MiB;
constexpr size_t WS_END = 253 * MiB;
constexpr size_t WS_BAR = 0;
constexpr int LDS_BYTES = 147456, MISC_OFF = 147456 - 64;

#define LDS_WAIT() asm volatile("s_waitcnt lgkmcnt(0)" ::: "memory")
__device__ __forceinline__ unsigned pk2(float lo, float hi) { return pg8::cvt_pk_bf16(lo, hi); }
__device__ __forceinline__ float bflo(unsigned w) { return __uint_as_float(w << 16); }
__device__ __forceinline__ float bfhi(unsigned w) { return __uint_as_float(w & 0xffff0000u); }
__device__ __forceinline__ float bf2f(bf16 h) { return __uint_as_float((unsigned)h << 16); }
__device__ __forceinline__ float wave_sum(float v) {
#pragma unroll
    for (int o = 1; o < 64; o <<= 1) v += __shfl_xor(v, o);
    return v;
}
__device__ __forceinline__ int crow(int r, int hi) { return (r & 3) + 8 * (r >> 2) + 4 * hi; }
template <int CTRL> __device__ __forceinline__ float dpp_f(float x) { return __int_as_float(__builtin_amdgcn_update_dpp(0, __float_as_int(x), CTRL, 0xf, 0xf, true)); }
__device__ __forceinline__ float red16(float x) { x += dpp_f<0xB1>(x); x += dpp_f<0x4E>(x); x += dpp_f<0x141>(x); x += dpp_f<0x140>(x); return x; }
__device__ __forceinline__ float red8(float x) { x += dpp_f<0xB1>(x); x += dpp_f<0x4E>(x); x += dpp_f<0x141>(x); return x; }
__device__ __forceinline__ void unpack8(const v4u w, float (&f)[8]) { f[0] = bflo(w.x); f[1] = bfhi(w.x); f[2] = bflo(w.y); f[3] = bfhi(w.y); f[4] = bflo(w.z); f[5] = bfhi(w.z); f[6] = bflo(w.w); f[7] = bfhi(w.w); }
__device__ __forceinline__ bf16x8 pack8(const float (&f)[8]) { v4u w; w.x = pk2(f[0], f[1]); w.y = pk2(f[2], f[3]); w.z = pk2(f[4], f[5]); w.w = pk2(f[6], f[7]); return __builtin_bit_cast(bf16x8, w); }

__device__ __forceinline__ void conv_item(const float* W, int K, int N, int NP, bf16* WT, const float* gain, int mode, LAS float* scr, int item, int lane) {
    const int nblk = NP / 32, kb = item / nblk, nb = item - kb * nblk, k0 = 64 * kb, n0 = 32 * nb;
    int orow0 = n0;
    if (mode == 1) orow0 = (n0 < DFF) ? (n0 / 128) * 256 + (n0 % 128) : ((n0 - DFF) / 128) * 256 + 128 + ((n0 - DFF) % 128);
    const int nq = 4 * (lane & 7); const bool inb = (n0 + nq) < N;
#pragma unroll
    for (int i = 0; i < 8; ++i) { const int kk = 8 * i + (lane >> 3); f32x4 v = {0.f, 0.f, 0.f, 0.f}; if (inb) v = *(const f32x4*)(W + (size_t)(k0 + kk) * N + n0 + nq);
        if (gain) v = v * gain[k0 + kk];
        LAS float* d = scr + kk * 33 + nq; d[0] = v[0]; d[1] = v[1]; d[2] = v[2]; d[3] = v[3]; }
    LDS_WAIT(); asm volatile("" ::: "memory");
    const int c = lane & 7;
#pragma unroll
    for (int j = 0; j < 4; ++j) { const int nn = (lane >> 3) + 8 * j; const LAS float* s = scr + (8 * c) * 33 + nn;
        v4u o; o.x = pk2(s[0 * 33], s[1 * 33]); o.y = pk2(s[2 * 33], s[3 * 33]); o.z = pk2(s[4 * 33], s[5 * 33]); o.w = pk2(s[6 * 33], s[7 * 33]);
        *(v4u*)(WT + (size_t)(orow0 + nn) * K + k0 + 8 * c) = o; }
    LDS_WAIT(); asm volatile("" ::: "memory");
}

constexpr int VTP = 264;
__device__ __forceinline__ void swa_unit(int unit, const bf16* PROJ, bf16* Y, const float* sinks, LAS unsigned char* lds, int tid, int lane, int wid) {
    const int b = unit >> 6, kvh = (unit >> 5) & 1, qblk = unit & 31, q0 = qblk * 128; const size_t rb = (size_t)b * SEQ;
    asm volatile("" : "+s"(PROJ), "+s"(Y));
    LAS bf16* VT = (LAS bf16*)lds;
    for (int c = tid; c < 2048; c += 512) { const int kvl = c >> 3, ch = c & 7, tok = q0 - 128 + kvl; v4u v = {0u, 0u, 0u, 0u};
        if (tok >= 0) v = *(const v4u*)(PROJ + (rb + tok) * EVEN_IN + 640 + kvh * 64 + ch * 8);
        LAS bf16* d = VT + (ch * 8) * VTP + kvl;
        d[0 * VTP] = (bf16)(v.x & 0xffffu); d[1 * VTP] = (bf16)(v.x >> 16); d[2 * VTP] = (bf16)(v.y & 0xffffu); d[3 * VTP] = (bf16)(v.y >> 16);
        d[4 * VTP] = (bf16)(v.z & 0xffffu); d[5 * VTP] = (bf16)(v.z >> 16); d[6 * VTP] = (bf16)(v.w & 0xffffu); d[7 * VTP] = (bf16)(v.w >> 16); }
    __syncthreads();
    const int g = wid >> 1, qh = wid & 1, hq = kvh * 4 + g;
    const float slope2 = exp2f(-(float)(hq + 1)) * LOG2E, sink2 = sinks[hq] * LOG2E;
#pragma unroll 1
    for (int sb = 0; sb < 2; ++sb) {
        int r32 = lane & 31, hi = lane >> 5; asm volatile("" : "+v"(r32), "+v"(hi));
        const int qs = q0 + 64 * qh + 32 * sb;
        bf16x8 qf[4];
#pragma unroll
        for (int ks = 0; ks < 4; ++ks) qf[ks] = *(const bf16x8*)(PROJ + (rb + qs + r32) * EVEN_IN + hq * 64 + 16 * ks + 8 * hi);
        f32x16 sc[5];
#pragma unroll
        for (int kt = 0; kt < 5; ++kt) { int tk = qs - 128 + 32 * kt + r32; tk = tk < 0 ? 0 : tk; sc[kt] = f32x16{};
#pragma unroll
            for (int ks = 0; ks < 4; ++ks) { const bf16x8 kf = *(const bf16x8*)(PROJ + (rb + tk) * EVEN_IN + 512 + kvh * 64 + 16 * ks + 8 * hi);
                sc[kt] = __builtin_amdgcn_mfma_f32_32x32x16_bf16(kf, qf[ks], sc[kt], 0, 0, 0); } }
        const int db = r32 + 128 - 4 * hi, kmin = 128 - qs - 4 * hi; const float ab = -slope2 * (float)db;
        float mx = sink2;
#pragma unroll
        for (int kt = 0; kt < 5; ++kt)
#pragma unroll
            for (int r = 0; r < 16; ++r) { const int kc = 32 * kt + (r & 3) + 8 * (r >> 2), dist = db - kc; const bool ok = ((unsigned)dist < 128u) && (kmin <= kc);
                const float s = ok ? fmaf(slope2, (float)kc, sc[kt][r] + ab) : -INFINITY; sc[kt][r] = s; mx = fmaxf(mx, s); }
        mx = fmaxf(mx, __shfl_xor(mx, 32));
        float l = 0.f;
#pragma unroll
        for (int kt = 0; kt < 5; ++kt)
#pragma unroll
            for (int r = 0; r < 16; ++r) { const float p = exp2f(sc[kt][r] - mx); sc[kt][r] = p; l += p; }
        l += __shfl_xor(l, 32); l += exp2f(sink2 - mx);
        const float rl = 1.0f / l;
        f32x16 o[2]; o[0] = f32x16{}; o[1] = f32x16{};
        const int kvl0 = 64 * qh + 32 * sb;
#pragma unroll
        for (int kt = 0; kt < 5; ++kt)
#pragma unroll
            for (int s2 = 0; s2 < 2; ++s2) { v4u pw; pw.x = pk2(sc[kt][8 * s2 + 0], sc[kt][8 * s2 + 1]); pw.y = pk2(sc[kt][8 * s2 + 2], sc[kt][8 * s2 + 3]); pw.z = pk2(sc[kt][8 * s2 + 4], sc[kt][8 * s2 + 5]); pw.w = pk2(sc[kt][8 * s2 + 6], sc[kt][8 * s2 + 7]);
                const bf16x8 pa = __builtin_bit_cast(bf16x8, pw);
#pragma unroll
                for (int db = 0; db < 2; ++db) { const LAS bf16* vp = VT + (32 * db + r32) * VTP + kvl0 + 32 * kt + 16 * s2 + 4 * hi;
                    const v2u lo = *(const LAS v2u*)vp, hh = *(const LAS v2u*)(vp + 8); v4u vw; vw.x = lo.x; vw.y = lo.y; vw.z = hh.x; vw.w = hh.y;
                    o[db] = __builtin_amdgcn_mfma_f32_32x32x16_bf16(pa, __builtin_bit_cast(bf16x8, vw), o[db], 0, 0, 0); } }
#pragma unroll
        for (int r = 0; r < 16; ++r) { const int qq = crow(r, hi); const float sc1 = __shfl(rl, qq);
            bf16* yp = Y + (rb + qs + qq) * 1024 + hq * 64 + r32;
            yp[0] = (bf16)(pk2(o[0][r] * sc1, 0.f) & 0xffffu); yp[32] = (bf16)(pk2(o[1][r] * sc1, 0.f) & 0xffffu); }
    }
    __syncthreads();
}
typedef unsigned v4u_unused_;
#define XB_TMO      128
#define XB_XCNT(j)  (256  + 64 * (j))
#define XB_XSUB(j)  (1280 + 64 * (j))
#define XB_XGEN(j)  (2304 + 64 * (j))
#define XB_TOP      3328
#define XB_TOPGEN   3392
#define XCD_BAR_WORDS 3456
#define XB_SPIN_CAP (1u << 18)

__device__ __forceinline__ unsigned xb_ld(unsigned* p)              { return __hip_atomic_load(p, __ATOMIC_RELAXED, __HIP_MEMORY_SCOPE_AGENT); }
__device__ __forceinline__ unsigned xb_add(unsigned* p, unsigned v) { return __hip_atomic_fetch_add(p, v, __ATOMIC_RELAXED, __HIP_MEMORY_SCOPE_AGENT); }
__device__ __forceinline__ unsigned xb_xcc_id() { return (unsigned)__builtin_amdgcn_s_getreg((3 << 11) | 20) & 0xFu; }
#define XB_SPIN(cond, bar) do { unsigned _sp = 0; while (cond) { __builtin_amdgcn_s_sleep(1); \
    if ((++_sp & 255u) == 0u) { if (xb_ld(&(bar)[XB_TMO])) break; if (_sp > XB_SPIN_CAP) { atomicAdd(&(bar)[XB_TMO], 1u); break; } } } } while (0)

struct XcdBarrier {
    unsigned* bar; unsigned x;
    volatile LAS unsigned* st;
};

__device__ __forceinline__ XcdBarrier xcd_barrier_post(unsigned* bar, volatile LAS unsigned* st) {
    XcdBarrier b; b.bar = bar; b.x = xb_xcc_id(); b.st = st;
    if (threadIdx.x == 0) (void)xb_add(&bar[XB_XCNT(b.x)], 1u);
    return b;
}
__device__ __forceinline__ void xcd_barrier_complete(unsigned* bar, unsigned x, unsigned& nloc, unsigned& nx) {
    const unsigned G = gridDim.x * gridDim.y * gridDim.z;
    unsigned sum, cnt, mine, sp = 0u;
    for (;;) {
        sum = 0u; cnt = 0u; mine = 0u;
#pragma unroll
        for (unsigned j = 0; j < 16; ++j) { const unsigned c = xb_ld(&bar[XB_XCNT(j)]); sum += c; cnt += (c > 0u) ? 1u : 0u; mine = (j == x) ? c : mine; }
        if (sum == G) break;
        __builtin_amdgcn_s_sleep(1);
        if ((++sp & 255u) == 0u) { if (xb_ld(&bar[XB_TMO])) break; if (sp > XB_SPIN_CAP) { atomicAdd(&bar[XB_TMO], 1u); break; } }
    }
    nloc = mine > 0u ? mine : 1u; nx = cnt > 0u ? cnt : 1u;
}

__device__ __forceinline__ void xcd_barrier(const XcdBarrier& b) {
    asm volatile("s_waitcnt vmcnt(0)" ::: "memory");
    __syncthreads();
    if (threadIdx.x == 0) {
        unsigned* bar = b.bar;
        __builtin_amdgcn_s_waitcnt(0);
        unsigned nloc = b.st[0], nx = b.st[1];
        if (nloc == 0u) { xcd_barrier_complete(bar, b.x, nloc, nx); b.st[0] = nloc; b.st[1] = nx; }
        const unsigned old = xb_add(&bar[XB_XSUB(b.x)], 1u);
        const unsigned gen = old / nloc;
        if (old + 1u == (gen + 1u) * nloc) {
            __builtin_amdgcn_fence(__ATOMIC_RELEASE, "agent");
            asm volatile("s_waitcnt vmcnt(0)" ::: "memory");
            const unsigned og = xb_add(&bar[XB_TOP], 1u);
            const unsigned tg = og / nx;
            if (og + 1u == (tg + 1u) * nx) xb_add(&bar[XB_TOPGEN], 1u);
            else XB_SPIN(xb_ld(&bar[XB_TOPGEN]) == tg, bar);
            __builtin_amdgcn_fence(__ATOMIC_ACQUIRE, "agent");
            xb_add(&bar[XB_XGEN(b.x)], 1u);
            asm volatile("s_waitcnt vmcnt(0)" ::: "memory");
        } else {
            XB_SPIN(xb_ld(&bar[XB_XGEN(b.x)]) == gen, bar);
            __builtin_amdgcn_fence(__ATOMIC_ACQUIRE, "agent");
            asm volatile("s_waitcnt vmcnt(0)" ::: "memory");
        }
    }
    __syncthreads();
}
constexpr int TC = 32, SBS = 340, LBS = 68;
constexpr int SBS_UNUSED_ = 336;
constexpr int RW_SBUF = 0, RW_SBUF_BYTES = TC * SBS * 4, RW_LW = 2 * RW_SBUF_BYTES, RW_LA = RW_LW + 2 * TC * LBS * 4, RW_EC = RW_LA + 2 * TC * LBS * 4, RW_BF = RW_EC + 2560;
__device__ __forceinline__ void rwkv_scan_unit(int unit, const bf16* PROJ, float* YRAW, float* C3, const float* mu, const float* w0, const float* w2, const float* a0, const float* a2,
                                               const float* k_k, const float* k_a, const float* r_k, LAS unsigned char* lds, const int lane, int wid) {
    const int role = (wid < 2) ? 0 : ((wid == 2 || wid == 3) ? 2 : 1), lw = wid - 2, ew = wid - 4;
    const int b = unit >> 6, h = (unit >> 3) & 7, rg = unit & 7; const size_t rb = (size_t)b * SEQ;
    const int r32 = lane & 31, hi = lane >> 5;
    constexpr int NCH = SEQ / TC;
    if (role == 2) {
        const int colx = 768 + ((lw == 0) ? 1536 : 1600); const float* Wl = (lw == 0) ? w2 : a2;
#pragma unroll
        for (int nb = 0; nb < 2; ++nb)
#pragma unroll
            for (int ks = 0; ks < 4; ++ks) { float f[8];
#pragma unroll
                for (int i = 0; i < 8; ++i) f[i] = Wl[(size_t)(16 * ks + 8 * hi + i) * 512 + h * 64 + 32 * nb + r32];
                *(LAS bf16x8*)(lds + RW_BF + (((lw * 2 + nb) * 4 + ks) * 64 + lane) * 16) = pack8(f); }
        ((LAS float*)(lds + RW_EC))[512 + lw * 64 + lane] = mu[colx - 768 + lane];
        v4u lcw[4], lpw[4];
#define LORA_LOAD(itn) do { const int tl_ = (itn) * TC + r32; const bf16* p_ = PROJ + (rb + tl_) * EVEN_IN + colx + 8 * hi; _Pragma("unroll") for (int ks = 0; ks < 4; ++ks) { lcw[ks] = *(const v4u*)(p_ + 16 * ks); \
            lpw[ks] = (v4u){0u, 0u, 0u, 0u}; if (tl_ > 0) lpw[ks] = *(const v4u*)(p_ - EVEN_IN + 16 * ks); } } while (0)
        LORA_LOAD(0);
#pragma unroll 1
        for (int it = 0; it < NCH + 2; ++it) {
            if (it < NCH) { bf16x8 afr[4];
#pragma unroll
                for (int ks = 0; ks < 4; ++ks) { float c[8], p[8]; unpack8(lcw[ks], c); unpack8(lpw[ks], p);
                    const LAS float* mq = (const LAS float*)(lds + RW_EC) + 512 + lw * 64 + 16 * ks + 8 * hi; const f32x4 m0 = *(const LAS f32x4*)mq, m1 = *(const LAS f32x4*)(mq + 4);
#pragma unroll
                    for (int i = 0; i < 8; ++i) { float x = c[i] + (p[i] - c[i]) * (i < 4 ? m0[i] : m1[i - 4]); if (lw == 0) x = 1.f - 2.f * __builtin_amdgcn_rcpf(1.f + __expf(2.f * x)); c[i] = x; }
                    afr[ks] = pack8(c); }
                if (it + 1 < NCH) LORA_LOAD(it + 1);
                LAS float* LB = (LAS float*)(lds + ((lw == 0) ? RW_LW : RW_LA)) + (it & 1) * (TC * LBS);
#pragma unroll
                for (int nb = 0; nb < 2; ++nb) { f32x16 acc = f32x16{};
#pragma unroll
                    for (int ks = 0; ks < 4; ++ks) acc = __builtin_amdgcn_mfma_f32_32x32x16_bf16(afr[ks], *(const LAS bf16x8*)(lds + RW_BF + (((lw * 2 + nb) * 4 + ks) * 64 + lane) * 16), acc, 0, 0, 0);
#pragma unroll
                    for (int r = 0; r < 16; ++r) LB[crow(r, hi) * LBS + 32 * nb + r32] = acc[r]; } }
            asm volatile("s_waitcnt lgkmcnt(0)\n\ts_barrier" ::: "memory");
        }
#undef LORA_LOAD
    } else if (role == 1) {
        const int el = ew * 64 + lane, s = el >> 3, g = el & 7;
        float ecc[8][8];
        { const int chn = h * 64 + 8 * g;
#pragma unroll
          for (int i = 0; i < 8; ++i) { ecc[0][i] = mu[chn + i]; ecc[1][i] = mu[512 + chn + i]; ecc[2][i] = mu[1024 + chn + i]; ecc[3][i] = w0[chn + i]; ecc[4][i] = a0[chn + i]; ecc[5][i] = k_k[chn + i]; ecc[6][i] = k_a[chn + i]; ecc[7][i] = r_k[chn + i]; } }
        v4u ecr, eck, ecv, epr, epk, epv;
#define ELEM_LOAD(cn) do { const int tl_ = (cn) * TC + s; const bf16* p_ = PROJ + (rb + tl_) * EVEN_IN + 768 + h * 64 + 8 * g; \
            ecr = *(const v4u*)p_; eck = *(const v4u*)(p_ + 512); ecv = *(const v4u*)(p_ + 1024); epr = (v4u){0u, 0u, 0u, 0u}; epk = epr; epv = epr; \
            if (tl_ > 0) { epr = *(const v4u*)(p_ - EVEN_IN); epk = *(const v4u*)(p_ - EVEN_IN + 512); epv = *(const v4u*)(p_ - EVEN_IN + 1024); } } while (0)
        ELEM_LOAD(0);
#pragma unroll 1
        for (int it = 0; it < NCH + 2; ++it) {
            const int c = it - 1;
            if (c >= 0 && c < NCH) { const size_t row = rb + c * TC + s;
                const LAS float* LW = (const LAS float*)(lds + RW_LW) + (c & 1) * (TC * LBS) + s * LBS + 8 * g; const LAS float* LA = (const LAS float*)(lds + RW_LA) + (c & 1) * (TC * LBS) + s * LBS + 8 * g;
                LAS float* sp = (LAS float*)(lds + RW_SBUF + (c & 1) * RW_SBUF_BYTES) + s * SBS;
                float ec[8];
#define LDEC(arr) do { _Pragma("unroll") for (int i_ = 0; i_ < 8; ++i_) ec[i_] = ecc[arr][i_]; } while (0)
                float r[8], k[8], v[8], t[8];
                unpack8(ecr, r); unpack8(epr, t); LDEC(0);
#pragma unroll
                for (int i = 0; i < 8; ++i) r[i] += (t[i] - r[i]) * ec[i];
                unpack8(eck, k); unpack8(epk, t); LDEC(1);
#pragma unroll
                for (int i = 0; i < 8; ++i) k[i] += (t[i] - k[i]) * ec[i];
                unpack8(ecv, v); unpack8(epv, t); LDEC(2);
#pragma unroll
                for (int i = 0; i < 8; ++i) v[i] += (t[i] - v[i]) * ec[i];
                if (c + 1 < NCH) ELEM_LOAD(c + 1);
                const f32x4 dw0 = *(const LAS f32x4*)LW, dw1 = *(const LAS f32x4*)(LW + 4), da0 = *(const LAS f32x4*)LA, da1 = *(const LAS f32x4*)(LA + 4);
                float w[8], a[8], kk[8], kp[8]; float n2 = 0.f;
#pragma unroll
                for (int i = 0; i < 8; ++i) w[i] = i < 4 ? dw0[i] : dw1[i - 4];
                LDEC(3);
#pragma unroll
                for (int i = 0; i < 8; ++i) w[i] = __expf(-0.60653065971f * pg8::sigm(ec[i] + w[i]));
                LDEC(4);
#pragma unroll
                for (int i = 0; i < 8; ++i) a[i] = pg8::sigm(ec[i] + (i < 4 ? da0[i] : da1[i - 4]));
                LDEC(5);
#pragma unroll
                for (int i = 0; i < 8; ++i) { kk[i] = k[i] * ec[i]; n2 += kk[i] * kk[i]; }
                LDEC(6);
#pragma unroll
                for (int i = 0; i < 8; ++i) kp[i] = k[i] * (1.f + (a[i] - 1.f) * ec[i]);
                LDEC(7);
                n2 = red8(n2); const float inv = __builtin_amdgcn_rsqf(fmaxf(n2, 1e-24f));
                float c1 = 0.f, c2 = 0.f, c3 = 0.f;
#pragma unroll
                for (int i = 0; i < 8; ++i) { kk[i] *= inv; t[i] = kk[i] * a[i]; c1 += t[i] * r[i]; c2 += kp[i] * r[i]; c3 += r[i] * kp[i] * ec[i]; }
#undef LDEC
                c1 = red8(c1); c2 = red8(c2); c3 = red8(c3);
                *(LAS f32x4*)(sp + 8 * g) = (f32x4){kk[0], kk[1], kk[2], kk[3]}; *(LAS f32x4*)(sp + 8 * g + 4) = (f32x4){kk[4], kk[5], kk[6], kk[7]};
                *(LAS f32x4*)(sp + 64 + 8 * g) = (f32x4){w[0] * r[0], w[1] * r[1], w[2] * r[2], w[3] * r[3]}; *(LAS f32x4*)(sp + 64 + 8 * g + 4) = (f32x4){w[4] * r[4], w[5] * r[5], w[6] * r[6], w[7] * r[7]};
                *(LAS f32x4*)(sp + 128 + 8 * g) = (f32x4){w[0], w[1], w[2], w[3]}; *(LAS f32x4*)(sp + 128 + 8 * g + 4) = (f32x4){w[4], w[5], w[6], w[7]};
                *(LAS f32x4*)(sp + 192 + 8 * g) = (f32x4){t[0], t[1], t[2], t[3]}; *(LAS f32x4*)(sp + 192 + 8 * g + 4) = (f32x4){t[4], t[5], t[6], t[7]};
                *(LAS f32x4*)(sp + 256 + 8 * g) = (f32x4){kp[0], kp[1], kp[2], kp[3]}; *(LAS f32x4*)(sp + 256 + 8 * g + 4) = (f32x4){kp[4], kp[5], kp[6], kp[7]};
                if (g == rg) { *(LAS f32x4*)(sp + 320) = (f32x4){v[0], v[1], v[2], v[3]}; *(LAS f32x4*)(sp + 324) = (f32x4){v[4], v[5], v[6], v[7]}; }
                if (g == 0) { sp[328] = c1; sp[329] = c2; if (rg == 0) C3[row * 8 + h] = c3; } }
            asm volatile("s_waitcnt lgkmcnt(0)\n\ts_barrier" ::: "memory");
        }
#undef ELEM_LOAD
    } else {
        const int rowl = 4 * (wid & 1) + (lane >> 4), cgp = lane & 15;
        f32x2s S01 = {0.f, 0.f}, S23 = {0.f, 0.f};
#pragma unroll 1
        for (int it = 0; it < NCH + 2; ++it) {
            const int c = it - 2;
            if (c >= 0) { const LAS float* SBF = (const LAS float*)(lds + RW_SBUF + (c & 1) * RW_SBUF_BYTES);
                float* yp = YRAW + (rb + (size_t)c * TC) * 512 + h * 64 + 8 * rg + rowl;
                __builtin_amdgcn_s_setprio(3);
                f32x4 kkA, wrA, wA, kaA, kpA, kkB, wrB, wB, kaB, kpB; float viA, viB; float pkeep = 0.f, qkeep = 0.f;
#define LDREC(X, s_) do { const LAS float* sp_ = SBF + (s_) * SBS; kk##X = *(const LAS f32x4*)(sp_ + 4 * cgp); wr##X = *(const LAS f32x4*)(sp_ + 64 + 4 * cgp); w##X = *(const LAS f32x4*)(sp_ + 128 + 4 * cgp); \
                    ka##X = *(const LAS f32x4*)(sp_ + 192 + 4 * cgp); kp##X = *(const LAS f32x4*)(sp_ + 256 + 4 * cgp); vi##X = sp_[320 + rowl]; } while (0)
#define LO2(v) __builtin_shufflevector(v, v, 0, 1)
#define HI2(v) __builtin_shufflevector(v, v, 2, 3)
#define STEPREC(X, s_) do { f32x2s pp = S01 * LO2(kk##X); pp = S23 * HI2(kk##X) + pp; f32x2s qq = S01 * LO2(wr##X); qq = S23 * HI2(wr##X) + qq; float p = pp[0] + pp[1], q = qq[0] + qq[1]; \
                    const f32x2s vv_ = {vi##X, vi##X}; const f32x2s u01_ = S01 * LO2(w##X) + LO2(kp##X) * vv_, u23_ = S23 * HI2(w##X) + HI2(kp##X) * vv_;     \
                    p += dpp_f<0xB1>(p); q += dpp_f<0xB1>(q); p += dpp_f<0x4E>(p); q += dpp_f<0x4E>(q); p += dpp_f<0x141>(p); q += dpp_f<0x141>(q); p += dpp_f<0x140>(p); q += dpp_f<0x140>(q); \
                    const f32x2s pv_ = {p, p}; \
                    S01 = u01_ - LO2(ka##X) * pv_; S23 = u23_ - HI2(ka##X) * pv_; \
                    pkeep = (((s_) & 15) == cgp) ? p : pkeep; qkeep = (((s_) & 15) == cgp) ? q : qkeep;     \
                    if (((s_) & 15) == 15) { const LAS float* sy_ = SBF + ((s_) - 15 + cgp) * SBS; const f32x2s cy_ = *(const LAS f32x2s*)(sy_ + 328); \
                        yp[(size_t)((s_) - 15 + cgp) * 512] = qkeep - pkeep * cy_[0] + sy_[320 + rowl] * cy_[1]; } } while (0)
                LDREC(A, 0);
#pragma unroll
                for (int s = 0; s < TC; s += 2) {
 LDREC(B, s + 1); STEPREC(A, s); LDREC(A, s + 2); STEPREC(B, s + 1); }
#undef LDREC
#undef STEPREC
#undef LO2
#undef HI2
                __builtin_amdgcn_s_setprio(0); }
            asm volatile("s_waitcnt lgkmcnt(0)\n\ts_barrier" ::: "memory");
        }
    }
    __syncthreads();
}

__device__ __forceinline__ void rwkv_post_unit(int tile, const bf16* PROJ, const float* YRAW, const float* C3, bf16* Y, const float* mu, const bf16* g2f, const float* ln_w, const float* ln_b, int lane, int wid) {
    asm volatile("" : "+s"(PROJ), "+s"(mu), "+s"(g2f), "+s"(YRAW));
    const int h = wid, r32 = lane & 31, hi = lane >> 5; const int tok0 = tile * 32; const bool first = (tok0 & (SEQ - 1)) == 0;
    bf16x8 afr[8];
    { const int tk = tok0 + r32; const bool hp = !(first && r32 == 0); v4u cwv[8], pwv[8];
      const __attribute__((address_space(1))) bf16* pg = (const __attribute__((address_space(1))) bf16*)(PROJ + (size_t)tk * EVEN_IN + 768 + 1664 + 8 * hi);
#pragma unroll
        for (int ks = 0; ks < 8; ++ks) { cwv[ks] = *(const __attribute__((address_space(1))) v4u*)(pg + 16 * ks); pwv[ks] = (v4u){0u, 0u, 0u, 0u};
            if (hp) pwv[ks] = *(const __attribute__((address_space(1))) v4u*)(pg - EVEN_IN + 16 * ks); }
#pragma unroll
        for (int ks = 0; ks < 8; ++ks) { float c[8], p[8]; unpack8(cwv[ks], c); unpack8(pwv[ks], p);
            const f32x4 m0 = *(const f32x4*)(mu + 1664 + 16 * ks + 8 * hi), m1 = *(const f32x4*)(mu + 1664 + 16 * ks + 8 * hi + 4);
#pragma unroll
            for (int i = 0; i < 8; ++i) c[i] = pg8::sigm(c[i] + (p[i] - c[i]) * (i < 4 ? m0[i] : m1[i - 4]));
            afr[ks] = pack8(c); } }
    f32x16 gt[2];
#pragma unroll
    for (int nb = 0; nb < 2; ++nb) { gt[nb] = f32x16{};
#pragma unroll
        for (int ks = 0; ks < 8; ++ks) { const bf16x8 bf = *(const bf16x8*)(g2f + ((size_t)((h * 2 + nb) * 8 + ks) * 64 + lane) * 8);
            gt[nb] = __builtin_amdgcn_mfma_f32_32x32x16_bf16(afr[ks], bf, gt[nb], 0, 0, 0); } }
    typedef const __attribute__((address_space(1))) float* gfp; typedef const __attribute__((address_space(1))) unsigned short* gup;
    const int ch0 = h * 64 + r32; const float lw0 = ln_w[ch0], lw1 = ln_w[ch0 + 32], lb0 = ln_b[ch0], lb1 = ln_b[ch0 + 32], mv0 = mu[1024 + ch0], mv1 = mu[1024 + ch0 + 32];
    float y0[16], y1[16], c3v[16]; unsigned vc[16], vp[16];
#pragma unroll
    for (int r = 0; r < 16; ++r) { const int tk = tok0 + crow(r, hi); gfp yp = (gfp)(YRAW + (size_t)tk * 512 + ch0); y0[r] = yp[0]; y1[r] = yp[32]; c3v[r] = ((gfp)C3)[(size_t)tk * 8 + h];
        gup vq = (gup)(PROJ + (size_t)tk * EVEN_IN + 768 + 1024 + ch0); vc[r] = (unsigned)vq[0] | ((unsigned)vq[32] << 16); vp[r] = 0u;
        if ((tk & (SEQ - 1)) != 0) vp[r] = (unsigned)vq[-EVEN_IN] | ((unsigned)vq[32 - EVEN_IN] << 16); }
#pragma unroll
    for (int r = 0; r < 16; ++r) { const int tk = tok0 + crow(r, hi);
        float s = y0[r] + y1[r]; s = red16(s); s += __shfl_xor(s, 16);
        const float mean = s * (1.f / 64.f), d0 = y0[r] - mean, d1 = y1[r] - mean; float q = d0 * d0 + d1 * d1; q = red16(q); q += __shfl_xor(q, 16);
        const float rstd = rsqrtf(q * (1.f / 64.f) + GN_EPS);
        const float cv0 = bflo(vc[r]), cv1 = bfhi(vc[r]), pv0 = bflo(vp[r]), pv1 = bfhi(vp[r]);
        const float v0 = cv0 + (pv0 - cv0) * mv0, v1 = cv1 + (pv1 - cv1) * mv1;
        const float o0 = (d0 * rstd * lw0 + lb0 + c3v[r] * v0) * gt[0][r], o1 = (d1 * rstd * lw1 + lb1 + c3v[r] * v1) * gt[1][r];
        bf16* op = Y + (size_t)tk * 1024 + 512 + ch0; op[0] = (bf16)(pk2(o0, 0.f) & 0xffffu); op[32] = (bf16)(pk2(o1, 0.f) & 0xffffu); }
}

__device__ __forceinline__ void fox_gate_pass(const bf16* XB, const bf16* Wf, const float* ssqv, const float* bfv, float* LF, int gw, int NGW, int lane) {
    typedef float f32x4g __attribute__((ext_vector_type(4)));
    const int fr = lane & 15, fq = lane >> 4;
    for (int t = gw; t < M / 16; t += NGW) {
        const bf16* ap = XB + (size_t)(t * 16 + fr) * D + 8 * fq; const bf16* bp = Wf + (size_t)fr * D + 8 * fq;
        f32x4g acc = {0.f, 0.f, 0.f, 0.f};
#pragma unroll 8
        for (int ks = 0; ks < D / 32; ++ks) acc = __builtin_amdgcn_mfma_f32_16x16x32_bf16(*(const bf16x8*)(ap + 32 * ks), *(const bf16x8*)(bp + 32 * ks), acc, 0, 0, 0);
        const float bn = bfv[fr];
#pragma unroll
        for (int j = 0; j < 4; ++j) { const int row = t * 16 + 4 * fq + j; const float z = fmaxf(acc[j] * pg8::rstd_of(ssqv, row) + bn, -80.f), e = __expf(-z);
            LF[(size_t)row * 16 + fr] = (e < 0.01f) ? -(e - 0.5f * e * e + e * e * e * (1.f / 3.f)) : -__logf(1.f + e); }
    }
}

__device__ __forceinline__ void fox_prefix(const float* LFbh, LAS float* cs, LAS float* wtot, int tid, int lane, int wid) {
    const float* lp = LFbh + (size_t)tid * 128;
    float s[8]; s[0] = lp[0]; s[1] = s[0] + lp[16]; s[2] = s[1] + lp[32]; s[3] = s[2] + lp[48]; s[4] = s[3] + lp[64]; s[5] = s[4] + lp[80]; s[6] = s[5] + lp[96]; s[7] = s[6] + lp[112];
    float incl = s[7];
#pragma unroll
    for (int o = 1; o < 64; o <<= 1) { const float t = __shfl_up(incl, o); if (lane >= o) incl += t; }
    if (lane == 63) wtot[wid] = incl;
    __syncthreads();
    float base = incl - s[7];
    for (int w = 0; w < wid; ++w) base += wtot[w];
#pragma unroll
    for (int i = 0; i < 8; ++i) { const float v = (base + s[i]) * LOG2E;
        const unsigned h1 = pk2(v, 0.f) & 0xffffu; const float r1 = v - __uint_as_float(h1 << 16); const unsigned h2 = pk2(r1, 0.f) & 0xffffu; const float r2 = r1 - __uint_as_float(h2 << 16); const unsigned h3 = pk2(r2, 0.f) & 0xffffu;
        ((LAS v2u*)cs)[8 * tid + i] = (v2u){h1 | (h2 << 16), h3}; }
    __syncthreads();
}
struct Args { const float* in[30]; float* out; unsigned char* ws; int ph_lo, ph_hi; };
#define AS4 __attribute__((address_space(4)))
#ifndef DUP_SWA
#define DUP_SWA 0
#endif
#ifndef DUP_SCAN
#define DUP_SCAN 0
#endif
#ifndef DUP_POST
#define DUP_POST 0
#endif
#ifndef DUP_GU
#define DUP_GU 0
#endif
#ifndef DUP_INPROJ
#define DUP_INPROJ 0
#endif
#ifndef DUP_P0
#define DUP_P0 0
#endif
#ifndef DUP_SYNC
#define DUP_SYNC 0
#endif
#define INP(i) (*(const float* const AS4*)(kp + 8 * (i)))
#define GSYNC() xcd_barrier(xbar)
#define FRESH() const AS4 char* kp = kp0; asm volatile("" : "+s"(kp)); unsigned char* ws = *(unsigned char* const AS4*)(kp + 248); float* X = *(float* const AS4*)(kp + 240); \
    int tid = threadIdx.x; asm volatile("" : "+v"(tid)); const int lane = tid & 63, wid = __builtin_amdgcn_readfirstlane(tid >> 6); \
    const int gw = bx * 8 + wid, NGW = G * 8; \
    float* ssq = (float*)(ws + WS_SSQP); float* C3 = (float*)(ws + WS_C3); float* LF = (float*)(ws + WS_LF); \
    bf16* XB = (bf16*)(ws + WS_XB); float* YRAW = (float*)(ws + WS_XB); bf16* Y = (bf16*)(ws + WS_Y); \
    bf16* H = (bf16*)(ws + WS_BIG); bf16* PROJ = (bf16*)(ws + WS_BIG); bf16* PP = (bf16*)(ws + WS_BIG); bf16* PB = (bf16*)(ws + WS_PB); \
    bf16* Qb = (bf16*)(ws + WS_BIG); bf16* Kb = Qb + (size_t)M * D; bf16* Vb = Kb + (size_t)M * D; \
    (void)X; (void)lane; (void)wid; (void)gw; (void)NGW; (void)ssq; (void)C3; (void)LF; (void)XB; (void)YRAW; (void)Y; (void)H; (void)PROJ; (void)PP; (void)PB; (void)Qb; (void)Kb; (void)Vb
__global__ void __launch_bounds__(512, 2) fwd_megakernel(Args a_unused) {
    extern __shared__ __attribute__((aligned(16))) unsigned char lds_raw[];
    cg::grid_group grid = cg::this_grid();
    LAS unsigned char* lds = (LAS unsigned char*)lds_raw;
    const int G = gridDim.x, bx = blockIdx.x;
    const AS4 char* kp0 = (const AS4 char*)__builtin_amdgcn_kernarg_segment_ptr();
    const int ph_lo = *(const int AS4*)(kp0 + 256), ph_hi = *(const int AS4*)(kp0 + 260);
    XcdBarrier xbar;
    { unsigned* barw = (unsigned*)(*(unsigned char* const AS4*)(kp0 + 248) + WS_BAR);
      if (bx == 0) for (int i = threadIdx.x; i < XCD_BAR_WORDS; i += 512) barw[i] = 0u;
      if (threadIdx.x < 4) ((LAS unsigned*)(lds + MISC_OFF))[threadIdx.x] = 0u;
      asm volatile("s_waitcnt vmcnt(0)" ::: "memory"); __syncthreads();
      grid.sync();
      __builtin_amdgcn_fence(__ATOMIC_ACQUIRE, "agent"); asm volatile("s_waitcnt vmcnt(0)" ::: "memory");
      xbar = xcd_barrier_post(barw, (volatile LAS unsigned*)(lds + MISC_OFF)); }

#ifdef NANFILL
    { FRESH(); v4u q = {0xffffffffu, 0xffffffffu, 0xffffffffu, 0xffffffffu};
      for (size_t i = (size_t)bx * 512 + tid; i < WS_END / 16; i += (size_t)G * 512) ((v4u*)ws)[i] = q;
      for (size_t i = (size_t)bx * 512 + tid; i < (size_t)M * D / 4; i += (size_t)G * 512) ((v4u*)X)[i] = q;
      for (int i = tid; i < LDS_BYTES / 4; i += 512) ((LAS unsigned*)lds)[i] = 0xffffffffu; }
    GSYNC();
#endif
    for (int dup = 0; dup < 1 + DUP_P0; ++dup)
    if (ph_lo == 0) {
        FRESH();
        LAS float* scr = (LAS float*)(lds + wid * 16384);
        constexpr int I_GU = (D / 64) * (2 * DFF / 32), I_D = (DFF / 64) * (D / 32), I_G = (D / 64) * (D / 32), I_P = (PLE / 64) * (D / 32), I_IN0 = (D / 64) * (EVEN_IN / 32), I_IN1 = (D / 64) * (FOX_INP / 32);
        constexpr int NITEMS = 4 * I_GU + 4 * I_D + 2 * I_G + 2 * I_P + I_IN0 + I_IN1 + 2 * I_G;
        for (int it = gw; it < NITEMS; it += NGW) {
            int r = it;
#define MAT(cnt, W_, K_, N_, NP_, WT_, G_, MODE_) if (r < (cnt)) { conv_item((W_), (K_), (N_), (NP_), (bf16*)(WT_), (G_), (MODE_), scr, r, lane); continue; } r -= (cnt);
            MAT(I_GU, INP(3), D, 2 * DFF, 2 * DFF, ws + WS_WGU, INP(2), 1)
            MAT(I_GU, INP(7), D, 2 * DFF, 2 * DFF, ws + WS_WGU + 11 * MiB, INP(6), 1)
            MAT(I_GU, INP(3) + (size_t)D * 2 * DFF, D, 2 * DFF, 2 * DFF, ws + WS_WGU + 22 * MiB, INP(2) + D, 1)
            MAT(I_GU, INP(7) + (size_t)D * 2 * DFF, D, 2 * DFF, 2 * DFF, ws + WS_WGU + 33 * MiB, INP(6) + D, 1)
            MAT(I_D, INP(4), DFF, D, D, ws + WS_WD, nullptr, 0)
            MAT(I_D, INP(8), DFF, D, D, ws + WS_WD + (size_t)D * DFF * 2, nullptr, 0)
            MAT(I_D, INP(4) + (size_t)D * DFF, DFF, D, D, ws + WS_WD + (size_t)D * DFF * 4, nullptr, 0)
            MAT(I_D, INP(8) + (size_t)D * DFF, DFF, D, D, ws + WS_WD + (size_t)D * DFF * 6, nullptr, 0)
            MAT(I_G, INP(10), D, D, D, ws + WS_WG, INP(9), 0)
            MAT(I_G, INP(10) + (size_t)D * D, D, D, D, ws + WS_WG + 2 * MiB, INP(9) + D, 0)
            MAT(I_P, INP(11), PLE, D, D, ws + WS_WP, nullptr, 0)
            MAT(I_P, INP(11) + (size_t)PLE * D, PLE, D, D, ws + WS_WP + (size_t)PLE * D * 2, nullptr, 0)
            MAT(I_IN0, INP(12), D, EVEN_IN, EVEN_IN, ws + WS_WIN0, INP(5), 0)
            MAT(I_IN1, INP(26), D, FOX_IN, FOX_INP, ws + WS_WIN1, INP(5) + D, 0)
            MAT(I_G, INP(13), D, D, D, ws + WS_WOUT0, nullptr, 0)
            MAT(I_G, INP(28), D, D, D, ws + WS_WOUT1, nullptr, 0)
#undef MAT
        }
        const float* x_in = INP(0);
        for (int m = gw; m < M; m += NGW) { const f32x4* xr = (const f32x4*)(x_in + (size_t)m * D) + lane; f32x4 v[4]; float s = 0.f;
#pragma unroll
            for (int j = 0; j < 4; ++j) { v[j] = xr[64 * j]; s += (v[j][0] * v[j][0] + v[j][1] * v[j][1]) + (v[j][2] * v[j][2] + v[j][3] * v[j][3]); }
            s = wave_sum(s); if (lane < 16) ssq[(size_t)m * 16 + lane] = (lane == 0) ? s : 0.f;
            v2u* o = (v2u*)(XB + (size_t)m * D) + lane;
#pragma unroll
            for (int j = 0; j < 4; ++j) { v2u w; w.x = pk2(v[j][0], v[j][1]); w.y = pk2(v[j][2], v[j][3]); o[64 * j] = w; } }
        const float* g2 = INP(20);
        for (int i = bx * 512 + tid; i < 8192; i += G * 512) { const int ln = i & 63, ks = (i >> 6) & 7, nb = (i >> 9) & 1, hh = i >> 10; float f[8];
#pragma unroll
            for (int j = 0; j < 8; ++j) f[j] = g2[(size_t)(16 * ks + 8 * (ln >> 5) + j) * 512 + hh * 64 + 32 * nb + (ln & 31)];
            ((bf16x8*)(ws + WS_G2F))[i] = pack8(f); }
    }
    if (ph_lo == 0 && ph_hi > 1) GSYNC();

#define GEMM(EpiT, Aptr, Bptr, Nn, Kk, Eobj) do { pg8::Gemm g_{(const pg8::bf16_t*)(Aptr), (const pg8::bf16_t*)(Bptr), M, (Nn), (Kk)}; pg8::StaticOrder S_; S_.init(M, (Nn), G, bx); \
        pg8::gemm_phase<EpiT, pg8::StaticOrder, true, true>(lds, g_, S_, (Eobj), tid); } while (0)
#pragma unroll 1
    for (int L = 0; L < 2; ++L) {
#pragma unroll 1
        for (int st = 0; st < 9; ++st) {
            const int ph = 1 + 9 * L + st; if (ph < ph_lo || ph >= ph_hi) continue;
            switch (st) {
            case 0: case 6: {
#if PHM & 1
                FRESH();
                for (int dup = 0; dup < 1 + DUP_GU; ++dup) {
                const int f = (st == 6); pg8::EpiGU E{H, ssq + (size_t)((f ? 2 : 0) & 1) * M * 16};
                GEMM(pg8::EpiGU, (L == 1 && st == 0) ? Y : XB, ws + WS_WGU + (size_t)(L * 2 + f) * 11 * MiB, 2 * DFF, D, E);
                __syncthreads(); }
#endif
            } break;
            case 1: case 5: case 7: {
#if PHM & 2
                FRESH();
                const bf16* A; const bf16* Bt; int K; float alpha; float* so;
                if (st == 5) { A = (L == 0) ? Y : Qb; Bt = (const bf16*)(ws + (L == 0 ? WS_WOUT0 : WS_WOUT1)); K = D; alpha = 1.f; so = ssq; }
                else { const int f = (st == 7); A = H; Bt = (const bf16*)(ws + WS_WD + (size_t)(L * 2 + f) * D * DFF * 2); K = DFF; alpha = 0.5f; so = ssq + (size_t)M * 16; }
                pg8::EpiRes E{(L == 0 && st == 1) ? INP(0) : (const float*)X, X, XB, so, alpha};
                GEMM(pg8::EpiRes, A, Bt, D, K, E);
                if (st == 7) {
                    const f32x4* ps = (const f32x4*)(INP(1) + (size_t)L * M * PLE);
                    for (int i = bx * 512 + tid; i < M * PLE / 8; i += G * 512) { const f32x4 u0 = ps[2 * i], u1 = ps[2 * i + 1]; v4u w; w.x = pk2(u0[0], u0[1]); w.y = pk2(u0[2], u0[3]); w.z = pk2(u1[0], u1[1]); w.w = pk2(u1[2], u1[3]); ((v4u*)PB)[i] = w; }
                }
#endif
            } break;
            case 2: {
#if PHM & 4
                FRESH();
                pg8::EpiStore E{Qb, L ? D : EVEN_IN, ssq + (size_t)M * 16, QSCALE, L ? 4 : 2, L ? 4 : 1000, (size_t)M * D, -1, LF, INP(27)};
                for (int dup = 0; dup < 1 + DUP_INPROJ; ++dup) { GEMM(pg8::EpiStore, XB, ws + (L ? WS_WIN1 : WS_WIN0), L ? 3 * D : EVEN_IN, D, E); __syncthreads(); }
                if (L == 1) fox_gate_pass(XB, (const bf16*)(ws + WS_WIN1) + (size_t)3 * D * D, ssq + (size_t)M * 16, INP(27), LF, gw, NGW, lane);
#endif
            } break;
            case 3: {
                if (L == 0) {
#if PHM & 8
                    { FRESH();
#pragma unroll 1
                    for (int dup = 0; dup < 1 + DUP_SWA; ++dup)
                    for (int u = bx; u < 256; u += G) swa_unit(u, PROJ, Y, INP(14), lds, tid, lane, wid); }
#endif
#if PHM & 16
                    { FRESH();
#pragma unroll 1
                    for (int dup = 0; dup < 1 + DUP_SCAN; ++dup)
                    for (int u = bx; u < 256; u += G) rwkv_scan_unit(u, PROJ, YRAW, C3, INP(15), INP(16), INP(17), INP(18), INP(19), INP(21), INP(22), INP(23), lds, lane, wid); }
#endif
                } else {
#if PHM & 32
                    FRESH();
                    const int vcu = (G % 8 == 0) ? (bx % 8) * (G / 8) + bx / 8 : bx;
#pragma unroll 1
                    for (int v = vcu; v < 256; v += G)
#pragma unroll 1
                        for (int i = 0; i < 4; ++i) { int tid2 = tid; asm volatile("" : "+v"(tid2)); const int lane2 = tid2 & 63, wid2 = __builtin_amdgcn_readfirstlane(tid2 >> 6); const int s = v & 3, bh = v >> 2, qb = (i == 0) ? s : (i == 1) ? 7 - s : (i == 2) ? 8 + s : 15 - s;
                            if (i == 0) fox_prefix(LF + (size_t)(bh >> 4) * SEQ * 16 + (bh & 15), (LAS float*)(lds + 98304), (LAS float*)(lds + 131072), tid2, lane2, wid2);
                            attn_body::attn_unit<60>(bh >> 4, bh & 15, qb, (const attn_body::bf16*)Qb, (const attn_body::bf16*)Kb, (const attn_body::bf16*)Vb, (attn_body::bf16*)Qb, (char*)lds_raw, (attn_body::lds_fptr)(lds + 98304), tid2); }
#endif
                }
            } break;
            case 4: {
#if PHM & 64
                if (L == 0) { FRESH();
#pragma unroll 1
                    for (int dup = 0; dup < 1 + DUP_POST; ++dup)
                    for (int t = bx; t < M / 32; t += G) rwkv_post_unit(t, PROJ, YRAW, C3, Y, INP(15), (const bf16*)(ws + WS_G2F), INP(24), INP(25), lane, wid); }
#endif
            } break;
            case 8: {
#if PHM & 128
                FRESH();
#pragma unroll 1
                for (int mode = 0; mode < 2; ++mode) {
                    pg8::EpiPle E{mode, X, (L == 0) ? Y : (bf16*)nullptr, PP, ssq + (size_t)M * 16, ssq};
                    GEMM(pg8::EpiPle, mode ? XB : PB, mode ? ws + WS_WG + (size_t)L * 2 * MiB : ws + WS_WP + (size_t)L * PLE * D * 2, D, mode ? D : PLE, E);
                    __syncthreads();
                }
#endif
            } break;
            }
            if (!(L == 1 && st == 4) && ph + 1 < ph_hi) { GSYNC(); for (int dup = 0; dup < DUP_SYNC; ++dup) GSYNC(); }
        }
    }
#undef GEMM
    if (ph_hi == 20) { FRESH(); const float* fg = INP(29); const float* s8 = ssq;
        for (int m = gw; m < M; m += NGW) { f32x4* xr = (f32x4*)(X + (size_t)m * D) + lane; const float rs = pg8::rstd_of(s8, m);
#pragma unroll
            for (int j = 0; j < 4; ++j) { const f32x4 gv = ((const f32x4*)fg)[lane + 64 * j]; xr[64 * j] = xr[64 * j] * rs * gv; } } }
}

extern "C" void kernel_launch(void* const* d_in, const int* in_sizes, int n_in, void* d_out, int out_size, void* d_ws, size_t ws_size, hipStream_t stream) {
    static int grid = 0;
    if (grid == 0) {
        if (n_in != 30 || out_size != M * D || ws_size < WS_END) { fprintf(stderr, "kernel_launch: unexpected shapes (n_in %d out %d ws %zu)\n", n_in, out_size, ws_size); grid = -1; return; }
        int dev = 0, cus = 0, per_cu = 0;
        if (hipGetDevice(&dev) != hipSuccess || hipDeviceGetAttribute(&cus, hipDeviceAttributeMultiprocessorCount, dev) != hipSuccess) { grid = -1; return; }
        if (hipFuncSetAttribute((const void*)fwd_megakernel, hipFuncAttributeMaxDynamicSharedMemorySize, LDS_BYTES) != hipSuccess) { fprintf(stderr, "kernel_launch: hipFuncSetAttribute failed\n"); grid = -1; return; }
        if (hipOccupancyMaxActiveBlocksPerMultiprocessor(&per_cu, (const void*)fwd_megakernel, 512, LDS_BYTES) != hipSuccess || per_cu < 1) { fprintf(stderr, "kernel_launch: occupancy query failed (%d)\n", per_cu); (void)hipGetLastError(); grid = -1; return; }
        grid = cus * per_cu;
        if (grid > 256) grid = 256;
    }
    if (grid < 0) return;
    Args a{};
    for (int i = 0; i < 30; ++i) a.in[i] = (const float*)d_in[i];
    a.out = (float*)d_out; a.ws = (unsigned char*)d_ws;
#ifndef N_LAUNCH_PER_PHASE
    a.ph_lo = 0; a.ph_hi = 20;
    { void* args[] = {&a};
      hipError_t e = hipLaunchCooperativeKernel((const void*)fwd_megakernel, dim3(grid), dim3(512), args, LDS_BYTES, stream);
      if (e != hipSuccess) fprintf(stderr, "cooperative launch failed: %s (grid %d)\n", hipGetErrorString(e), grid); }
#else
    for (int ph = 0; ph < 20; ++ph) { if (ph == 14) continue; a.ph_lo = ph; a.ph_hi = ph + 1; void* args[] = {&a};
      hipError_t e = hipLaunchCooperativeKernel((const void*)fwd_megakernel, dim3(grid), dim3(512), args, LDS_BYTES, stream);
      if (e != hipSuccess) { fprintf(stderr, "cooperative launch failed: %s (grid %d)\n", hipGetErrorString(e), grid); break; } }
#endif
}
```

```cpp
#include <hip/hip_runtime.h>
#include <hip/hip_cooperative_groups.h>
#include <hip/hip_bf16.h>
#include <cstdio>
#include <cstdint>
#include <cmath>
namespace cg = cooperative_groups;
#ifndef PHM
#define PHM 255
#endif
namespace pg8 {
#define PG8_LAS __attribute__((address_space(3)))
typedef unsigned short bf16_t;
typedef short bf16x8 __attribute__((ext_vector_type(8)));
typedef float f32x4 __attribute__((ext_vector_type(4)));
typedef unsigned u32x4 __attribute__((ext_vector_type(4)));
constexpr int BM = 256, BK = 64, HALF = 128, HTB = HALF * BK * 2  , STAGE_BYTES = 8 * HTB, NXCD = 8, WGM = 8;

__host__ __device__ __forceinline__ int lds_byte(int r, int c) { const int st = (r >> 4) * 2 + (c >> 5), rr = r & 15, cc = c & 31, ob = rr * 64 + cc * 2; return st * 1024 + (ob ^ (((ob >> 9) & 1) << 5)); }
__host__ __device__ __forceinline__ void stage_rc(int b, int& R, int& C) { const int st = b / 1024, sb = b % 1024, swz = sb ^ (((sb >> 9) & 1) << 5); R = (st >> 1) * 16 + swz / 64; C = (st & 1) * 32 + (swz % 64) / 2; }
__host__ __device__ __forceinline__ int perm32(int rho) { const int n = rho >> 4, i = rho & 15; return 8 * (i >> 2) + 4 * n + (i & 3); }

struct Unit { int pm, pn; };
struct Gemm { const bf16_t* A; const bf16_t* Bt; int M, N, K; };

struct StaticOrder {
    int nM, nN, nwg, G, c;
    __host__ __device__ void init(int M, int N, int G_, int c_) { nM = M / BM; nN = N / BM; nwg = nM * nN; G = G_; c = c_; }
    __host__ __device__ bool next(int i, Unit& u) const {
        const long L = (long)i * G + c; if (L >= nwg) return false;
        int wgid = (int)L; { const int q = nwg / NXCD, r = nwg % NXCD, xcd = wgid % NXCD, off = wgid / NXCD; wgid = (xcd < r ? xcd * (q + 1) : r * (q + 1) + (xcd - r) * q) + off; }
        const int nig = WGM * nN, gid = wgid / nig, fm = gid * WGM, gsz = (nM - fm) < WGM ? (nM - fm) : WGM;
        u.pm = fm + ((wgid % nig) % gsz); u.pn = (wgid % nig) / gsz; return true;
    }
    __device__ __forceinline__ void a_ready(const Unit&) const {}
    __device__ __forceinline__ void done(const Unit&) const {}
};

typedef float f32x2_c __attribute__((ext_vector_type(2))); typedef __bf16 bf16x2_c __attribute__((ext_vector_type(2)));
__device__ __forceinline__ unsigned cvt_pk_bf16(float lo, float hi) { f32x2_c v = {lo, hi}; bf16x2_c b = __builtin_convertvector(v, bf16x2_c); return __builtin_bit_cast(unsigned, b); }
typedef float f32x2 __attribute__((ext_vector_type(2)));
constexpr float NORM_EPS = 1e-6f;
__device__ __forceinline__ float ssq_sum(const float* ssq, int row) { const f32x4 a = *(const f32x4*)(ssq + (size_t)row * 4); return (a[0] + a[1]) + (a[2] + a[3]); }
__device__ __forceinline__ void ssq_combine(PG8_LAS float* red, float* ssq_out, const Unit& u, int wr, int wc, int lane) {
    asm volatile("s_waitcnt lgkmcnt(0)" ::: "memory"); __builtin_amdgcn_s_barrier(); asm volatile("" ::: "memory");
    if (wc == 0) {
#pragma unroll
        for (int q = 0; q < 2; ++q) { const int idx = lane + 64 * q; const PG8_LAS float* r = red + (wr * 4) * 128 + idx;
            const float sv = (r[0] + r[128]) + (r[256] + r[384]);
            const int row = u.pm * BM + (idx >> 6) * HALF + wr * 64 + ((idx >> 4) & 3) * 16 + (idx & 15);
            ssq_out[(size_t)row * 4 + u.pn] = sv; } }
    asm volatile("s_waitcnt lgkmcnt(0)" ::: "memory"); __builtin_amdgcn_s_barrier(); asm volatile("" ::: "memory");
}
__device__ __forceinline__ float rstd_of(const float* ssq, int row) { return rsqrtf(ssq_sum(ssq, row) * (1.0f / 1024.0f) + NORM_EPS); }
__device__ __forceinline__ void rstd8(const float* ssq, int row0, int fr, int fq, float (&rs)[2][4]) {
    const int i0 = 2 * fq, i1 = 2 * fq + 1;
    const float m0 = rstd_of(ssq, row0 + (i0 >> 2) * HALF + (i0 & 3) * 16), m1 = rstd_of(ssq, row0 + (i1 >> 2) * HALF + (i1 & 3) * 16);
#pragma unroll
    for (int ai = 0; ai < 2; ++ai)
#pragma unroll
        for (int m = 0; m < 4; ++m) { const int idx = ai * 4 + m; rs[ai][m] = __shfl((idx & 1) ? m1 : m0, (idx >> 1) * 16 + fr); }
}
__device__ __forceinline__ float sigm(float x) { return __builtin_amdgcn_rcpf(1.0f + __expf(-x)); }
struct EpiGU { static constexpr bool PERM = true, AFTER_DRAIN = false;
    bf16_t* H; const float* ssq;
    __device__ __forceinline__ void operator()(const f32x4 (&acc)[2][2][4][2], const Unit& u, int wr, int wc, int fr, int fq) const {
        int row0 = u.pm * BM + wr * 64 + fr; asm volatile("" : "+v"(row0)); const int col0 = u.pn * 128 + wc * 32 + 8 * fq; float rsv[2][4]; rstd8(ssq, row0, fr, fq, rsv);
#pragma unroll
        for (int ai = 0; ai < 2; ++ai)
#pragma unroll
            for (int m = 0; m < 4; ++m) { const int row = row0 + ai * HALF + m * 16; const float rs = rsv[ai][m];
                const float nk = -1.4426950408889634f * rs, rs2 = rs * rs; u32x4 w;
#pragma unroll
                for (int n = 0; n < 2; ++n) { const f32x4 ag = acc[ai][0][m][n], au = acc[ai][1][m][n]; const f32x4 t = ag * nk; f32x4 d;
                    d[0] = __builtin_amdgcn_exp2f(t[0]); d[1] = __builtin_amdgcn_exp2f(t[1]); d[2] = __builtin_amdgcn_exp2f(t[2]); d[3] = __builtin_amdgcn_exp2f(t[3]);
                    d = d + 1.0f; f32x4 r; r[0] = __builtin_amdgcn_rcpf(d[0]); r[1] = __builtin_amdgcn_rcpf(d[1]); r[2] = __builtin_amdgcn_rcpf(d[2]); r[3] = __builtin_amdgcn_rcpf(d[3]);
                    const f32x4 hv = (ag * au) * (r * rs2);
                    if (n == 0) { w.x = cvt_pk_bf16(hv[0], hv[1]); w.y = cvt_pk_bf16(hv[2], hv[3]); } else { w.z = cvt_pk_bf16(hv[0], hv[1]); w.w = cvt_pk_bf16(hv[2], hv[3]); } }
                *(u32x4*)(H + (size_t)row * 2816 + col0) = w; }
    }
};
struct EpiRes { static constexpr bool PERM = true, AFTER_DRAIN = false;
    const float* base; float* X; bf16_t* XB; float* ssq_out; float alpha; PG8_LAS float* red;
    __device__ __forceinline__ void operator()(const f32x4 (&acc)[2][2][4][2], const Unit& u, int wr, int wc, int fr, int fq) const {
        int row0 = u.pm * BM + wr * 64 + fr; asm volatile("" : "+v"(row0)); const int col0 = u.pn * BM + wc * 32 + 8 * fq;
#pragma unroll
        for (int ai = 0; ai < 2; ++ai) {
            f32x4 bb[4][2][2];
#pragma unroll
            for (int m = 0; m < 4; ++m)
#pragma unroll
                for (int bj = 0; bj < 2; ++bj) { const size_t off = (size_t)(row0 + ai * HALF + m * 16) * 1024 + col0 + bj * HALF; bb[m][bj][0] = *(const f32x4*)(base + off); bb[m][bj][1] = *(const f32x4*)(base + off + 4); }
#pragma unroll
            for (int m = 0; m < 4; ++m) { const int row = row0 + ai * HALF + m * 16; float part = 0.f;
#pragma unroll
                for (int bj = 0; bj < 2; ++bj) { const size_t off = (size_t)row * 1024 + col0 + bj * HALF;
                    const f32x4 v0 = bb[m][bj][0] + acc[ai][bj][m][0] * alpha, v1 = bb[m][bj][1] + acc[ai][bj][m][1] * alpha;
                    *(f32x4*)(X + off) = v0; *(f32x4*)(X + off + 4) = v1;
                    u32x4 w; w.x = cvt_pk_bf16(v0[0], v0[1]); w.y = cvt_pk_bf16(v0[2], v0[3]); w.z = cvt_pk_bf16(v1[0], v1[1]); w.w = cvt_pk_bf16(v1[2], v1[3]);
                    *(u32x4*)(XB + off) = w;
                    part += (v0[0] * v0[0] + v0[1] * v0[1]) + (v0[2] * v0[2] + v0[3] * v0[3]) + (v1[0] * v1[0] + v1[1] * v1[1]) + (v1[2] * v1[2] + v1[3] * v1[3]); }
                part += __shfl_xor(part, 16); part += __shfl_xor(part, 32);
                if (fq == 0) red[(wr * 4 + wc) * 128 + (ai * 4 + m) * 16 + fr] = part; } }
        ssq_combine(red, ssq_out, u, wr, wc, fq * 16 + fr);
    }
};
struct EpiPle { static constexpr bool PERM = true, AFTER_DRAIN = false;
    int mode; float* X; bf16_t* XB; bf16_t* PP; const float* ssq_in; float* ssq_out; PG8_LAS float* red;
    __device__ __forceinline__ void operator()(const f32x4 (&acc)[2][2][4][2], const Unit& u, int wr, int wc, int fr, int fq) const {
        int row0 = u.pm * BM + wr * 64 + fr; asm volatile("" : "+v"(row0)); const int col0 = u.pn * BM + wc * 32 + 8 * fq;
        if (mode == 0) {
#pragma unroll
            for (int ai = 0; ai < 2; ++ai)
#pragma unroll
                for (int m = 0; m < 4; ++m)
#pragma unroll
                    for (int bj = 0; bj < 2; ++bj) { const size_t off = (size_t)(row0 + ai * HALF + m * 16) * 1024 + col0 + bj * HALF; const f32x4 v0 = acc[ai][bj][m][0], v1 = acc[ai][bj][m][1];
                        u32x4 w; w.x = cvt_pk_bf16(v0[0], v0[1]); w.y = cvt_pk_bf16(v0[2], v0[3]); w.z = cvt_pk_bf16(v1[0], v1[1]); w.w = cvt_pk_bf16(v1[2], v1[3]);
                        *(u32x4*)(PP + off) = w; }
            return;
        }
        float rsv[2][4]; rstd8(ssq_in, row0, fr, fq, rsv);
#pragma unroll
        for (int ai = 0; ai < 2; ++ai)
#pragma unroll
            for (int mp = 0; mp < 2; ++mp) {
                u32x4 pw[2][2]; f32x4 xb[2][2][2];
#pragma unroll
                for (int mm = 0; mm < 2; ++mm)
#pragma unroll
                    for (int bj = 0; bj < 2; ++bj) { const size_t off = (size_t)(row0 + ai * HALF + (2 * mp + mm) * 16) * 1024 + col0 + bj * HALF;
                        pw[mm][bj] = *(const u32x4*)(PP + off); xb[mm][bj][0] = *(const f32x4*)(X + off); xb[mm][bj][1] = *(const f32x4*)(X + off + 4); }
#pragma unroll
                for (int mm = 0; mm < 2; ++mm) { const int m = 2 * mp + mm; const int row = row0 + ai * HALF + m * 16; float part = 0.f; const float rs = rsv[ai][m];
#pragma unroll
                    for (int bj = 0; bj < 2; ++bj) { const size_t off = (size_t)row * 1024 + col0 + bj * HALF; const u32x4 pq = pw[mm][bj];
                        const f32x4 p0 = {__uint_as_float(pq.x << 16), __uint_as_float(pq.x & 0xffff0000u), __uint_as_float(pq.y << 16), __uint_as_float(pq.y & 0xffff0000u)};
                        const f32x4 p1 = {__uint_as_float(pq.z << 16), __uint_as_float(pq.z & 0xffff0000u), __uint_as_float(pq.w << 16), __uint_as_float(pq.w & 0xffff0000u)};
                        const f32x4 a0 = acc[ai][bj][m][0] * rs, a1 = acc[ai][bj][m][1] * rs;
                        f32x4 v0, v1;
#pragma unroll
                        for (int j = 0; j < 4; ++j) { v0[j] = xb[mm][bj][0][j] + sigm(a0[j]) * p0[j]; v1[j] = xb[mm][bj][1][j] + sigm(a1[j]) * p1[j]; }
                        *(f32x4*)(X + off) = v0; *(f32x4*)(X + off + 4) = v1;
                        u32x4 w; w.x = cvt_pk_bf16(v0[0], v0[1]); w.y = cvt_pk_bf16(v0[2], v0[3]); w.z = cvt_pk_bf16(v1[0], v1[1]); w.w = cvt_pk_bf16(v1[2], v1[3]);
                        if (XB) *(u32x4*)(XB + off) = w;
                        part += (v0[0] * v0[0] + v0[1] * v0[1]) + (v0[2] * v0[2] + v0[3] * v0[3]) + (v1[0] * v1[0] + v1[1] * v1[1]) + (v1[2] * v1[2] + v1[3] * v1[3]); }
                    part += __shfl_xor(part, 16); part += __shfl_xor(part, 32); if (fq == 0) red[(wr * 4 + wc) * 128 + (ai * 4 + m) * 16 + fr] = part; } }
        ssq_combine(red, ssq_out, u, wr, wc, fq * 16 + fr);
    }
};
struct EpiStore { static constexpr bool PERM = true, AFTER_DRAIN = false;
    bf16_t* O; int ldc; const float* ssq; float scale0; int scale_tiles; int split_tiles; size_t split_stride; int lf_tile; float* LF; const float* bfv;
    __device__ __forceinline__ void operator()(const f32x4 (&acc)[2][2][4][2], const Unit& u, int wr, int wc, int fr, int fq) const {
        int row0 = u.pm * BM + wr * 64 + fr; asm volatile("" : "+v"(row0));
        if (u.pn == lf_tile) {
            if (wc == 0 && fq < 2) {
#pragma unroll
                for (int ai = 0; ai < 2; ++ai)
#pragma unroll
                    for (int m = 0; m < 4; ++m) { const int row = row0 + ai * HALF + m * 16; const float rs = rstd_of(ssq, row);
#pragma unroll
                        for (int n = 0; n < 2; ++n) { f32x4 o;
#pragma unroll
                            for (int j = 0; j < 4; ++j) { const float z = fmaxf(acc[ai][0][m][n][j] * rs + bfv[8 * fq + 4 * n + j], -80.f), e = __expf(-z);
                                o[j] = (e < 0.01f) ? -(e - 0.5f * e * e + e * e * e * (1.f / 3.f)) : -__logf(1.f + e); }
                            *(f32x4*)(LF + (size_t)row * 16 + 8 * fq + 4 * n) = o; } }
            }
            return;
        }
        const int t = u.pn / split_tiles, ct = u.pn - t * split_tiles;
        bf16_t* base = O + (size_t)t * split_stride; const float sc = (u.pn < scale_tiles) ? scale0 : 1.f;
        const int col0 = ct * BM + wc * 32 + 8 * fq; float rsv[2][4]; rstd8(ssq, row0, fr, fq, rsv);
#pragma unroll
        for (int ai = 0; ai < 2; ++ai)
#pragma unroll
            for (int m = 0; m < 4; ++m) { const int row = row0 + ai * HALF + m * 16; const float rs = rsv[ai][m] * sc;
#pragma unroll
                for (int bj = 0; bj < 2; ++bj) { const f32x4 v0 = acc[ai][bj][m][0] * rs, v1 = acc[ai][bj][m][1] * rs;
                    u32x4 w; w.x = cvt_pk_bf16(v0[0], v0[1]); w.y = cvt_pk_bf16(v0[2], v0[3]); w.z = cvt_pk_bf16(v1[0], v1[1]); w.w = cvt_pk_bf16(v1[2], v1[3]);
                    *(u32x4*)(base + (size_t)row * ldc + col0 + bj * HALF) = w; } }
    }
};

template <class Epi, class Sched, bool ALIGN_EPI = false, bool SP2 = false>
__device__ __forceinline__ void gemm_phase(PG8_LAS unsigned char* lds, const Gemm g, const Sched& S, const Epi& E, const int tid) {
    const int wid = __builtin_amdgcn_readfirstlane(tid >> 6), lane = tid & 63, wr = wid >> 2, wc = wid & 3, fr = lane & 15, fq = lane >> 4;
    const int K = g.K, nt = K / BK;
    unsigned voffA[2], voffB[2];
#pragma unroll
    for (int i = 0; i < 2; ++i) { int R, C; stage_rc(tid * 16 + i * 8192, R, C); const int Rb = Epi::PERM ? ((R & ~31) + perm32(R & 31)) : R;
        voffA[i] = (unsigned)(R * K + C) * 2u; voffB[i] = (unsigned)(Rb * K + C) * 2u; }
    const size_t kstep = (size_t)(BK * 2);
    const size_t hstep = (size_t)HALF * K * 2;
    const size_t tstep = 2 * hstep;
    const unsigned ldsw = (unsigned)wid * 1024u;
    const int aoff = lds_byte(wr * 64 + fr, fq * 8), boff = lds_byte(wc * 32 + fr, fq * 8);
#define PG8_SA(b, h) (((b) * 2 + (h)) * HTB)
#define PG8_SB(b, h) ((4 + (b) * 2 + (h)) * HTB)
#define PG8_STAGE(bufoff, gbase, voff) do { _Pragma("unroll") for (int _i = 0; _i < 2; ++_i) \
        __builtin_amdgcn_global_load_lds((const unsigned*)((const char*)(gbase) + (voff)[_i]), (PG8_LAS unsigned*)(lds + (bufoff) + ldsw + _i * 8192), 16, 0, 0); } while (0)
#define PG8_LDA(dst, b, h) do { _Pragma("unroll") for (int m = 0; m < 4; ++m) _Pragma("unroll") for (int k = 0; k < 2; ++k) dst[m][k] = *(const PG8_LAS bf16x8*)(lds + PG8_SA(b, h) + aoff + m * 2048 + k * 1024); } while (0)
#define PG8_LDB(dst, b, h) do { _Pragma("unroll") for (int n = 0; n < 2; ++n) _Pragma("unroll") for (int k = 0; k < 2; ++k) dst[n][k] = *(const PG8_LAS bf16x8*)(lds + PG8_SB(b, h) + boff + n * 2048 + k * 1024); } while (0)
#define PG8_MMA(ai, bj, At, Bt) do { __builtin_amdgcn_s_setprio(1); _Pragma("unroll") for (int m = 0; m < 4; ++m) _Pragma("unroll") for (int n = 0; n < 2; ++n) _Pragma("unroll") for (int k = 0; k < 2; ++k) \
        acc[ai][bj][m][n] = __builtin_amdgcn_mfma_f32_16x16x32_bf16(Bt[n][k], At[m][k], acc[ai][bj][m][n], 0, 0, 0); __builtin_amdgcn_s_setprio(0); } while (0)
#define PG8_WAIT_V(n) asm volatile("s_waitcnt vmcnt(" #n ")" ::: "memory")
#define PG8_WAIT_L(n) asm volatile("s_waitcnt lgkmcnt(" #n ")" ::: "memory")
#define PG8_BAR __builtin_amdgcn_s_barrier()
#define PG8_SCHED __builtin_amdgcn_sched_barrier(0)
    Unit cur, nxt; int ui = 0;
    if (!S.next(0, cur)) return;
    f32x4 acc[2][2][4][2];
#pragma unroll
    for (int a = 0; a < 2; ++a)
#pragma unroll
        for (int b = 0; b < 2; ++b)
#pragma unroll
            for (int m = 0; m < 4; ++m)
#pragma unroll
                for (int n = 0; n < 2; ++n) acc[a][b][m][n] = (f32x4){0.f, 0.f, 0.f, 0.f};
    bf16x8 At[4][2], B0[2][2], B1[2][2];
    const char* cA = (const char*)g.A + (size_t)cur.pm * tstep; const char* cB = (const char*)g.Bt + (size_t)cur.pn * tstep;
    S.a_ready(cur);
    if constexpr (SP2) {
        PG8_STAGE(PG8_SB(0, 0), cB, voffB); PG8_STAGE(PG8_SB(0, 1), cB + hstep, voffB); PG8_STAGE(PG8_SA(0, 0), cA, voffA); PG8_STAGE(PG8_SA(0, 1), cA + hstep, voffA);
        if (wr == 1) PG8_BAR;
        PG8_WAIT_V(2); PG8_BAR;
        PG8_STAGE(PG8_SB(1, 0), cB + kstep, voffB); PG8_STAGE(PG8_SA(1, 0), cA + kstep, voffA); PG8_STAGE(PG8_SB(1, 1), cB + hstep + kstep, voffB);
        PG8_WAIT_V(6); PG8_BAR;
    } else {
        PG8_STAGE(PG8_SB(0, 0), cB, voffB); PG8_STAGE(PG8_SA(0, 0), cA, voffA); PG8_STAGE(PG8_SB(0, 1), cB + hstep, voffB); PG8_STAGE(PG8_SA(0, 1), cA + hstep, voffA);
        if (wr == 1) PG8_BAR;
        PG8_WAIT_V(4); PG8_BAR;
        PG8_STAGE(PG8_SB(1, 0), cB + kstep, voffB); PG8_STAGE(PG8_SA(1, 0), cA + kstep, voffA); PG8_STAGE(PG8_SB(1, 1), cB + hstep + kstep, voffB);
        PG8_WAIT_V(6); PG8_BAR;
    }
    for (;;) {
        const bool has_next = S.next(ui + 1, nxt);
        const char* nA = has_next ? (const char*)g.A + (size_t)nxt.pm * tstep : cA; const char* nB = has_next ? (const char*)g.Bt + (size_t)nxt.pn * tstep : cB;
        for (int t = 0; t < nt; t += 2) {
            const bool last = (t == nt - 2);
            const char* a1 = cA + (size_t)(t + 1) * kstep;
            const char* a2 = last ? nA : cA + (size_t)(t + 2) * kstep; const char* b2 = last ? nB : cB + (size_t)(t + 2) * kstep;
            const char* a3 = a2 + kstep; const char* b3 = b2 + kstep;
            if (last && has_next) S.a_ready(nxt);
            if constexpr (SP2) {
            PG8_LDB(B0, 0, 0); PG8_LDB(B1, 0, 1); PG8_SCHED; PG8_LDA(At, 0, 0); PG8_STAGE(PG8_SA(1, 1), a1 + hstep, voffA);
            PG8_WAIT_V(8); PG8_WAIT_L(0); PG8_BAR; PG8_MMA(0, 0, At, B0); PG8_MMA(0, 1, At, B1); PG8_BAR; PG8_SCHED;
            PG8_LDA(At, 0, 1); PG8_STAGE(PG8_SB(0, 0), b2, voffB); PG8_STAGE(PG8_SB(0, 1), b2 + hstep, voffB); PG8_STAGE(PG8_SA(0, 0), a2, voffA);
            PG8_WAIT_V(8); PG8_WAIT_L(0); PG8_BAR; PG8_MMA(1, 0, At, B0); PG8_MMA(1, 1, At, B1); PG8_BAR; PG8_SCHED;
            PG8_LDB(B0, 1, 0); PG8_LDB(B1, 1, 1); PG8_SCHED; PG8_LDA(At, 1, 0); PG8_STAGE(PG8_SA(0, 1), a2 + hstep, voffA);
            PG8_WAIT_V(8); PG8_WAIT_L(0); PG8_BAR; PG8_MMA(0, 0, At, B0); PG8_MMA(0, 1, At, B1); PG8_BAR; PG8_SCHED;
            PG8_LDA(At, 1, 1); PG8_STAGE(PG8_SB(1, 0), b3, voffB); PG8_STAGE(PG8_SB(1, 1), b3 + hstep, voffB); PG8_STAGE(PG8_SA(1, 0), a3, voffA);
            PG8_WAIT_V(8); PG8_WAIT_L(0); PG8_BAR; PG8_MMA(1, 0, At, B0); PG8_MMA(1, 1, At, B1); PG8_BAR; PG8_SCHED;
            } else {
            PG8_LDB(B0, 0, 0); PG8_SCHED; PG8_LDA(At, 0, 0); PG8_STAGE(PG8_SA(1, 1), a1 + hstep, voffA);
            PG8_WAIT_L(8); PG8_BAR; PG8_WAIT_L(0); PG8_MMA(0, 0, At, B0); PG8_BAR; PG8_SCHED;
            PG8_LDB(B1, 0, 1); PG8_STAGE(PG8_SB(0, 0), b2, voffB);
            PG8_BAR; PG8_WAIT_L(0); PG8_MMA(0, 1, At, B1); PG8_BAR;
            PG8_LDA(At, 0, 1); PG8_STAGE(PG8_SA(0, 0), a2, voffA);
            PG8_BAR; PG8_WAIT_L(0); PG8_MMA(1, 0, At, B0); PG8_BAR; PG8_SCHED;
            PG8_STAGE(PG8_SB(0, 1), b2 + hstep, voffB);
            PG8_WAIT_V(6); PG8_BAR; PG8_MMA(1, 1, At, B1); PG8_BAR;
            PG8_LDB(B0, 1, 0); PG8_SCHED; PG8_LDA(At, 1, 0); PG8_STAGE(PG8_SA(0, 1), a2 + hstep, voffA);
            PG8_WAIT_L(8); PG8_BAR; PG8_WAIT_L(0); PG8_MMA(0, 0, At, B0); PG8_BAR; PG8_SCHED;
            PG8_LDB(B1, 1, 1); PG8_STAGE(PG8_SB(1, 0), b3, voffB);
            PG8_BAR; PG8_WAIT_L(0); PG8_MMA(0, 1, At, B1); PG8_BAR;
            PG8_LDA(At, 1, 1); PG8_STAGE(PG8_SA(1, 0), a3, voffA);
            PG8_BAR; PG8_WAIT_L(0); PG8_MMA(1, 0, At, B0); PG8_BAR; PG8_SCHED;
            PG8_STAGE(PG8_SB(1, 1), b3 + hstep, voffB);
            PG8_WAIT_V(6); PG8_BAR; PG8_MMA(1, 1, At, B1); PG8_BAR;
            }
        }
        if constexpr (ALIGN_EPI) { if (wr == 0) PG8_BAR; }
        if constexpr (!Epi::AFTER_DRAIN) { E(acc, cur, wr, wc, fr, fq); S.done(cur); }
        if (!has_next) break;
#pragma unroll
        for (int a = 0; a < 2; ++a)
#pragma unroll
            for (int b = 0; b < 2; ++b)
#pragma unroll
                for (int m = 0; m < 4; ++m)
#pragma unroll
                    for (int n = 0; n < 2; ++n) acc[a][b][m][n] = (f32x4){0.f, 0.f, 0.f, 0.f};
        cur = nxt; cA = nA; cB = nB; ++ui;
        if constexpr (ALIGN_EPI) { if (wr == 1) PG8_BAR; }
    }
    PG8_WAIT_V(0);
    if constexpr (!ALIGN_EPI) { if (wr == 0) PG8_BAR; }
    PG8_BAR;
    if constexpr (Epi::AFTER_DRAIN) { E.fused(acc, cur, wr, wc, fr, fq, lds, wid, lane); S.done(cur); }
#undef PG8_SA
#undef PG8_SB
#undef PG8_STAGE
#undef PG8_LDA
#undef PG8_LDB
#undef PG8_MMA
#undef PG8_WAIT_V
#undef PG8_WAIT_L
#undef PG8_BAR
#undef PG8_SCHED
}
}
#include <hip/hip_bf16.h>
#include <cmath>
namespace attn_body {
using bf16=__hip_bfloat16;
using bf16x8=__attribute__((ext_vector_type(8)))short;
using s16x4=__attribute__((ext_vector_type(4)))short;
using f32x16=__attribute__((ext_vector_type(16)))float;
using u32x4=__attribute__((ext_vector_type(4)))unsigned;
constexpr int BATCH=4,NHEAD=16,SEQ=4096,D=64,DM=NHEAD*D;
constexpr int NW=8,QBLK=32,QB=QBLK*NW,KVBLK=64,NQB=SEQ/QB;
constexpr int ATTN_PITCH=DM, ATTN_UNIT_ROWS=QB;
__device__ __forceinline__ int crow(int r,int hi){return (r&3)+8*(r>>2)+4*hi;}
#define SBAR() __builtin_amdgcn_sched_barrier(0)
__device__ __forceinline__ void cmask(f32x16&p0,f32x16&p1,int jb,int qrel,int hi){
  const float NEG=-INFINITY; int kb=64*jb+4*hi;
  #pragma unroll
  for(int r=0;r<16;++r){int kv=kb+(r&3)+8*(r>>2); if(kv>qrel)p0[r]=NEG; if(kv+32>qrel)p1[r]=NEG;}
}

constexpr int NSLOT=3, SLOTB=8192;
constexpr int LDS_K=0, LDS_V=NSLOT*SLOTB, LDS_WS=2*NSLOT*SLOTB, LDS_OST=LDS_WS+NW*64*4, LDS_BYTES=LDS_OST+NW*4096;
constexpr float C2=0.125f*1.4426950408889634f;
__device__ __forceinline__ void glds16(const void*gsrc,unsigned lds_dst){unsigned keep;
  asm volatile("s_mov_b32 %0, m0\n\ts_mov_b32 m0, %2\n\ts_nop 0\n\tglobal_load_lds_dwordx4 %1, off\n\ts_mov_b32 m0, %0":"=&s"(keep):"v"(gsrc),"s"(lds_dst):"memory");}
__device__ __forceinline__ float max3f(float a,float b,float c){float r;asm("v_max3_f32 %0, %1, %2, %3":"=v"(r):"v"(a),"v"(b),"v"(c));return r;}
__device__ __forceinline__ float max2f(float a,float b){float r;asm("v_max_f32_e32 %0, %1, %2":"=v"(r):"v"(a),"v"(b));return r;}
__device__ __forceinline__ float fadd_s(float a,float b){float r;asm("v_add_f32_e32 %0, %1, %2":"=v"(r):"v"(a),"v"(b));return r;}
__device__ __forceinline__ float fsub_s(float a,float b){float r;asm("v_sub_f32_e32 %0, %1, %2":"=v"(r):"v"(a),"v"(b));return r;}
typedef float f32x2_t __attribute__((ext_vector_type(2))); typedef __bf16 bf16x2_t __attribute__((ext_vector_type(2)));
__device__ __forceinline__ unsigned cvtpk_s(float lo,float hi){f32x2_t v={lo,hi};bf16x2_t b=__builtin_convertvector(v,bf16x2_t);return __builtin_bit_cast(unsigned,b);}
#define WAIT_BAR(N) asm volatile("s_waitcnt vmcnt(" #N ") lgkmcnt(0)\n\ts_barrier":::"memory")

__device__ __forceinline__ void qkt(f32x16&p0,f32x16&p1,const char*Kslot,const bf16x8*qr,int r32,int hi){
  const char*kb=Kslot+hi*1024+r32*16;
  #pragma unroll
  for(int d0=0;d0<4;++d0){
    const bf16x8 b0=*reinterpret_cast<const bf16x8*>(kb+d0*2048);
    const bf16x8 b1=*reinterpret_cast<const bf16x8*>(kb+d0*2048+512);
    {p0=__builtin_amdgcn_mfma_f32_32x32x16_bf16(b0,qr[d0],p0,0,0,0);p1=__builtin_amdgcn_mfma_f32_32x32x16_bf16(b1,qr[d0],p1,0,0,0);}}
}
typedef __attribute__((address_space(3))) const char* lds_cptr;
typedef short v4i16_t __attribute__((ext_vector_type(4)));
__device__ __forceinline__ void kload8(bf16x8*kf,lds_cptr kp){
  kf[0]=*(const __attribute__((address_space(3))) bf16x8*)(kp);      kf[1]=*(const __attribute__((address_space(3))) bf16x8*)(kp+512);
  kf[2]=*(const __attribute__((address_space(3))) bf16x8*)(kp+2048); kf[3]=*(const __attribute__((address_space(3))) bf16x8*)(kp+2560);
  kf[4]=*(const __attribute__((address_space(3))) bf16x8*)(kp+4096); kf[5]=*(const __attribute__((address_space(3))) bf16x8*)(kp+4608);
  kf[6]=*(const __attribute__((address_space(3))) bf16x8*)(kp+6144); kf[7]=*(const __attribute__((address_space(3))) bf16x8*)(kp+6656);
}
__device__ __forceinline__ void kload2(bf16x8*kf,lds_cptr kp,int j){ kf[2*j]=*(const __attribute__((address_space(3))) bf16x8*)(kp+j*2048); kf[2*j+1]=*(const __attribute__((address_space(3))) bf16x8*)(kp+j*2048+512); }
__device__ __forceinline__ s16x4 vtr(lds_cptr p){ return __builtin_bit_cast(s16x4,__builtin_amdgcn_ds_read_tr16_b64_v4i16((__attribute__((address_space(3))) v4i16_t*)p)); }
__device__ __forceinline__ float rowmax(const f32x16&p0,const f32x16&p1){
  float a=max3f(p0[0],p0[1],p1[0]),b=max3f(p0[2],p0[3],p1[1]);a=max3f(a,p1[2],p1[3]);
  #pragma unroll
  for(int r=4;r<16;r+=4){a=max3f(a,p0[r],p0[r+1]);b=max3f(b,p0[r+2],p0[r+3]);a=max3f(a,p1[r],p1[r+1]);b=max3f(b,p1[r+2],p1[r+3]);}
  const float m=max2f(a,b);
  auto rr=__builtin_amdgcn_permlane32_swap(__float_as_uint(m),__float_as_uint(m),false,false);
  return max2f(__uint_as_float(rr[0]),__uint_as_float(rr[1]));
}
__device__ __forceinline__ void pv(f32x16*o,int vb,bf16x8 pa0,bf16x8 pa1,bf16x8 pa2,bf16x8 pa3){
  #pragma unroll
  for(int d0=0;d0<2;++d0){s16x4 lo[4],hi[4];
    #pragma unroll
    for(int ks=0;ks<4;++ks){
      asm volatile("ds_read_b64_tr_b16 %0,%1 offset:%c2":"=&v"(lo[ks]):"v"(vb),"i"(d0*4096+ks*1024):"memory");
      asm volatile("ds_read_b64_tr_b16 %0,%1 offset:%c2":"=&v"(hi[ks]):"v"(vb),"i"(d0*4096+ks*1024+512):"memory");}
    asm volatile("s_waitcnt lgkmcnt(0)":::"memory");SBAR();
    #define PK(k) (bf16x8){lo[k][0],lo[k][1],lo[k][2],lo[k][3],hi[k][0],hi[k][1],hi[k][2],hi[k][3]}
    o[d0]=__builtin_amdgcn_mfma_f32_32x32x16_bf16(pa0,PK(0),o[d0],0,0,0);
    o[d0]=__builtin_amdgcn_mfma_f32_32x32x16_bf16(pa1,PK(1),o[d0],0,0,0);
    o[d0]=__builtin_amdgcn_mfma_f32_32x32x16_bf16(pa2,PK(2),o[d0],0,0,0);
    o[d0]=__builtin_amdgcn_mfma_f32_32x32x16_bf16(pa3,PK(3),o[d0],0,0,0);
    #undef PK
  }
}

#ifndef ATTN_STORE16
#define ATTN_STORE16(p,v) (*(u32x4*)(p)=(v))
#endif
typedef float f32x4b __attribute__((ext_vector_type(4)));
typedef __attribute__((address_space(3))) const float* lds_fptr;
typedef __attribute__((address_space(3))) const f32x4b* lds_f4ptr;
template<int THRL> __device__ __forceinline__ void attn_unit(int b,int h,int qb,const bf16*Q,const bf16*__restrict__ K,const bf16*__restrict__ V,bf16*O,char*shm,lds_fptr cs,const int tid){
  const int lane=tid&63,r32=lane&31,hi=lane>>5; const int wid=__builtin_amdgcn_readfirstlane(tid>>6);
  const long rowbase=(long)b*SEQ; const int q0=qb*QB;
  const bf16*Qw=Q+(rowbase+q0+wid*QBLK)*DM+h*D;
  const bf16*Kh=K+rowbase*DM+h*D,*Vh=V+rowbase*DM+h*D;
  const unsigned lds0=(unsigned)(uintptr_t)shm;
  float*wsf=(float*)(shm+LDS_WS)+wid*64;
  const bf16*ksrc=Kh+(long)lane*DM+wid*8;
  const bf16*vsrc=Vh+(long)(16*(wid&3)+(lane>>2))*DM+(wid>>2)*32+(lane&3)*8;
  const unsigned kdst=lds0+LDS_K+wid*1024, vdst=lds0+LDS_V+wid*1024;
  #define DMA_K(t,slot) glds16(ksrc+(long)(t)*KVBLK*DM,(unsigned)__builtin_amdgcn_readfirstlane(kdst+(slot)))
  #define DMA_V(t,slot) glds16(vsrc+(long)(t)*KVBLK*DM,(unsigned)__builtin_amdgcn_readfirstlane(vdst+(slot)))
  const int vb0=(int)(lds0+LDS_V)+((lane>>4)&1)*32+(lane&3)*8+(4*hi+((lane&15)>>2))*64;
  const char*Kbase=shm+LDS_K; bf16x8 kf[8];
  const lds_cptr shm3=(lds_cptr)shm; const lds_cptr kp0=shm3+LDS_K+hi*1024+r32*16; const lds_cptr vp0=shm3+LDS_V+((lane>>4)&1)*32+(lane&3)*8+(4*hi+((lane&15)>>2))*64;
  const int NT=(q0+QB)/KVBLK;
  DMA_K(0,0);DMA_V(0,0);DMA_K(1,SLOTB);
  bf16x8 qr[4];
  #pragma unroll
  for(int d0=0;d0<4;++d0)qr[d0]=*reinterpret_cast<const bf16x8*>(&Qw[(long)r32*DM+d0*16+hi*8]);
  const int qrel=wid*QBLK+r32;
  typedef __attribute__((address_space(3))) const unsigned long long* lds_u64p; typedef unsigned u32x2b __attribute__((ext_vector_type(2)));
  const lds_u64p ctr=(lds_u64p)cs;
  float ci2; { const unsigned long long w_=ctr[q0+qrel]; ci2=__uint_as_float((unsigned)w_<<16)+__uint_as_float((unsigned)w_&0xffff0000u)+__uint_as_float((unsigned)(w_>>32)<<16); }
  float mhat=0.f,l_reg=0.f;f32x16 o[2];o[0]=f32x16{};o[1]=f32x16{};float nm=ci2; bf16x8 bnm;
  #define MKBNM() do{ const unsigned h1_=cvtpk_s(nm,0.f)&0xffffu; const float r1_=nm-__uint_as_float(h1_<<16); const unsigned h2_=cvtpk_s(r1_,0.f)&0xffffu; const float r2_=r1_-__uint_as_float(h2_<<16); const unsigned h3_=cvtpk_s(r2_,0.f)&0xffffu; \
    u32x4 b_; b_.x=hi?0u:0xBF80BF80u; b_.y=hi?0u:(0xBF80u|(h1_<<16)); b_.z=hi?0u:(h2_|(h3_<<16)); b_.w=0u; bnm=__builtin_bit_cast(bf16x8,b_); }while(0)
  MKBNM();
  #define CINIT(P0,P1,t) do{ const unsigned long long w0_=ctr[64*(t)+r32], w1_=ctr[64*(t)+32+r32]; \
    u32x4 a0_; a0_.x=(unsigned)w0_; a0_.y=(unsigned)(w0_>>32)|0x3F800000u; a0_.z=0x3F803F80u; a0_.w=0u; u32x4 a1_; a1_.x=(unsigned)w1_; a1_.y=(unsigned)(w1_>>32)|0x3F800000u; a1_.z=0x3F803F80u; a1_.w=0u; \
    P0=__builtin_amdgcn_mfma_f32_32x32x16_bf16(__builtin_bit_cast(bf16x8,a0_),bnm,f32x16{},0,0,0); P1=__builtin_amdgcn_mfma_f32_32x32x16_bf16(__builtin_bit_cast(bf16x8,a1_),bnm,f32x16{},0,0,0); }while(0)
  #define CMASK(P0,P1,t) do{int jb_=(t)-(NT-4); if(jb_>=0)cmask(P0,P1,jb_,qrel,hi);}while(0)
  bool resc=false;
  #define START(P0,P1) do{ const float rm=rowmax(P0,P1); resc=false; \
    { const float dl=rm; mhat=fadd_s(mhat,dl); \
      _Pragma("unroll") for(int r=0;r<16;++r){P0[r]=fsub_s(P0[r],dl);P1[r]=fsub_s(P1[r],dl);} \
      nm=ci2-mhat; MKBNM(); } \
    _Pragma("unroll") for(int r=0;r<16;++r)P0[r]=__builtin_amdgcn_exp2f(P0[r]); }while(0)
  #define RESC() do{ if(resc){ asm volatile("s_waitcnt lgkmcnt(0)":::"memory"); \
      _Pragma("unroll") for(int d_=0;d_<2;++d_) _Pragma("unroll") for(int r=0;r<16;++r)o[d_][r]*=wsf[crow(r,hi)]; } }while(0)
  f32x16 pA0,pA1,pB0,pB1;
  int sl_prev=0,sl_cur=0,sl_next=SLOTB;
  #define ROT() do{sl_prev=sl_cur;sl_cur=sl_next;sl_next=(sl_next==(NSLOT-1)*SLOTB)?0:sl_next+SLOTB;}while(0)
  DMA_K(2,2*SLOTB);
  WAIT_BAR(3);
  CINIT(pA0,pA1,0);qkt(pA0,pA1,Kbase,qr,r32,hi);asm volatile("s_nop 15\n\ts_nop 7":"+v"(pA0),"+v"(pA1));CMASK(pA0,pA1,0);
  START(pA0,pA1);
  _Pragma("unroll") for(int r=0;r<16;++r)pA1[r]=__builtin_amdgcn_exp2f(pA1[r]);
  WAIT_BAR(0);
  DMA_K(3,0);DMA_V(1,SLOTB);
  ROT();
  kload8(kf,kp0+sl_cur);
  WAIT_BAR(2);
  s16x4 vlo[8],vhi[8]; u32x4 pw0,pw1,pw2,pw3;
  #define PKW(P,B) cvtpk_s(P[B],P[B+1])
  #define PAF(k) __builtin_bit_cast(bf16x8,pw##k)
  #define VFR(i) (bf16x8){vlo[i][0],vlo[i][1],vlo[i][2],vlo[i][3],vhi[i][0],vhi[i][1],vhi[i][2],vhi[i][3]}
  #define PIN(x) asm volatile("":"+v"(x))
  #define MX3(a,b,c) __builtin_fmaxf(__builtin_fmaxf((a),(b)),(c))
  #define GAPA(MF,A0,A1,A2,A3,W0,W1,PW) do{ MF; sacc+=A0; sacc+=A1; sacc+=A2; sacc+=A3; PIN(sacc); W0; W1; PIN(PW); SBAR(); }while(0)
  #define EX(v) __builtin_amdgcn_exp2f(v)
  #define GAPB(MF,X,B) do{ MF; X[B]=EX(X[B]); X[B+1]=EX(X[B+1]); X[B+2]=EX(X[B+2]); X[B+3]=EX(X[B+3]); PIN(X); SBAR(); }while(0)
  #define VRD(i) do{ vlo[i]=vtr(vp_+(((i)>>2)*4096+((i)&3)*1024)); vhi[i]=vtr(vp_+(((i)>>2)*4096+((i)&3)*1024+512)); }while(0)
  #define KRD(G,j) do{ if(G){ kload2(kf,kp0+sl_next,j); SBAR(); } }while(0)
  #define STEP(C0,C1,P0,P1,t,GK,GV,GL) do{ SBAR(); \
    const lds_cptr vp_=vp0+sl_prev; CINIT(C0,C1,t); SBAR(); \
    VRD(0); SBAR(); float sacc=(P0[0]+P0[1]); \
    GAPA(C0=__builtin_amdgcn_mfma_f32_32x32x16_bf16(kf[0],qr[0],C0,0,0,0), P0[2],P0[3],P0[4],P0[5],     pw0[0]=PKW(P0,0), pw0[1]=PKW(P0,2), pw0); \
    VRD(4); SBAR(); GAPA(C1=__builtin_amdgcn_mfma_f32_32x32x16_bf16(kf[1],qr[0],C1,0,0,0), P0[6],P0[7],P0[8],P0[9],     pw0[2]=PKW(P0,4), pw0[3]=PKW(P0,6), pw0); \
    VRD(1); SBAR(); GAPA(C0=__builtin_amdgcn_mfma_f32_32x32x16_bf16(kf[2],qr[1],C0,0,0,0),   P0[10],P0[11],P0[12],P0[13], pw1[0]=PKW(P0,8), pw1[1]=PKW(P0,10), pw1); \
    VRD(5); SBAR(); GAPA(C1=__builtin_amdgcn_mfma_f32_32x32x16_bf16(kf[3],qr[1],C1,0,0,0),   P0[14],P0[15],P1[0],P1[1],   pw1[2]=PKW(P0,12),pw1[3]=PKW(P0,14), pw1); \
    VRD(2); SBAR(); GAPA(C0=__builtin_amdgcn_mfma_f32_32x32x16_bf16(kf[4],qr[2],C0,0,0,0),   P1[2],P1[3],P1[4],P1[5],     pw2[0]=PKW(P1,0), pw2[1]=PKW(P1,2), pw2); \
    VRD(6); SBAR(); GAPA(C1=__builtin_amdgcn_mfma_f32_32x32x16_bf16(kf[5],qr[2],C1,0,0,0),   P1[6],P1[7],P1[8],P1[9],     pw2[2]=PKW(P1,4), pw2[3]=PKW(P1,6), pw2); \
    VRD(3); SBAR(); GAPA(C0=__builtin_amdgcn_mfma_f32_32x32x16_bf16(kf[6],qr[3],C0,0,0,0),   P1[10],P1[11],P1[12],P1[13], pw3[0]=PKW(P1,8), pw3[1]=PKW(P1,10), pw3); \
    VRD(7); SBAR(); GAPA(C1=__builtin_amdgcn_mfma_f32_32x32x16_bf16(kf[7],qr[3],C1,0,0,0),   P1[14],P1[15],0.f,0.f,       pw3[2]=PKW(P1,12),pw3[3]=PKW(P1,14), pw3); \
    l_reg+=sacc; \
    if(GK){DMA_K((t)+3,sl_cur);} if(GV){DMA_V((t)+1,sl_next);} \
    CMASK(C0,C1,t); \
    { float a=MX3(C0[0],C0[1],C1[0]),b=MX3(C0[2],C0[3],C1[1]); a=MX3(a,C1[2],C1[3]); \
      _Pragma("unroll") for(int r=4;r<16;r+=4){a=MX3(a,C0[r],C0[r+1]);b=MX3(b,C0[r+2],C0[r+3]);a=MX3(a,C1[r],C1[r+1]);b=MX3(b,C1[r+2],C1[r+3]);} \
      float rm=__builtin_fmaxf(a,b); { auto rr=__builtin_amdgcn_permlane32_swap(__float_as_uint(rm),__float_as_uint(rm),false,false); rm=__builtin_fmaxf(__uint_as_float(rr[0]),__uint_as_float(rr[1])); } \
      resc=false; \
      if(__builtin_expect(__any(rm>(float)THRL),0)){ const float dl=__builtin_fmaxf(rm,0.f); mhat+=dl; \
        _Pragma("unroll") for(int r=0;r<16;++r){C0[r]-=dl;C1[r]-=dl;} \
        nm=ci2-mhat; MKBNM(); \
        const float f=__builtin_amdgcn_exp2f(-dl); l_reg*=f; if(hi==0)wsf[r32]=f; resc=true; } } \
    SBAR(); \
    GAPB(o[0]=__builtin_amdgcn_mfma_f32_32x32x16_bf16(PAF(0),VFR(0),o[0],0,0,0), C0,0); \
    GAPB(o[1]=__builtin_amdgcn_mfma_f32_32x32x16_bf16(PAF(0),VFR(4),o[1],0,0,0), C0,4); \
    KRD(GL,0); GAPB(o[0]=__builtin_amdgcn_mfma_f32_32x32x16_bf16(PAF(1),VFR(1),o[0],0,0,0), C0,8); \
    KRD(GL,1); GAPB(o[1]=__builtin_amdgcn_mfma_f32_32x32x16_bf16(PAF(1),VFR(5),o[1],0,0,0), C0,12); \
    KRD(GL,2); GAPB(o[0]=__builtin_amdgcn_mfma_f32_32x32x16_bf16(PAF(2),VFR(2),o[0],0,0,0), C1,0); \
    KRD(GL,3); GAPB(o[1]=__builtin_amdgcn_mfma_f32_32x32x16_bf16(PAF(2),VFR(6),o[1],0,0,0), C1,4); \
    GAPB(o[0]=__builtin_amdgcn_mfma_f32_32x32x16_bf16(PAF(3),VFR(3),o[0],0,0,0), C1,8); \
    GAPB(o[1]=__builtin_amdgcn_mfma_f32_32x32x16_bf16(PAF(3),VFR(7),o[1],0,0,0), C1,12); \
    }while(0)
  int t=1;
  #undef CMASK
  #define CMASK(P0,P1,t) do{}while(0)
  for(;t+5<NT;t+=2){
    STEP(pB0,pB1,pA0,pA1,t,true,true,true);     WAIT_BAR(2); RESC(); ROT();
    STEP(pA0,pA1,pB0,pB1,t+1,true,true,true);   WAIT_BAR(2); RESC(); ROT();
  }
  #undef CMASK
  #define CMASK(P0,P1,t) do{int jb_=(t)-(NT-4); if(jb_>=0)cmask(P0,P1,jb_,qrel,hi);}while(0)
  #define ENDW(tt) do{ if((tt)+3<NT){WAIT_BAR(2);} else if((tt)+2<NT){WAIT_BAR(1);} else {WAIT_BAR(0);} }while(0)
  for(;t+1<NT;t+=2){
    STEP(pB0,pB1,pA0,pA1,t,(t+3<NT),(t+1<NT),(t+1<NT));       ENDW(t);   RESC(); ROT();
    STEP(pA0,pA1,pB0,pB1,t+1,(t+4<NT),(t+2<NT),(t+2<NT));     ENDW(t+1); RESC(); ROT();
  }
  STEP(pB0,pB1,pA0,pA1,NT-1,false,false,false); RESC();
  { float sacc=pB0[0]+pB0[1]; _Pragma("unroll") for(int r=2;r<16;++r)sacc+=pB0[r]; _Pragma("unroll") for(int r=0;r<16;++r)sacc+=pB1[r]; l_reg+=sacc;
    pw0=(u32x4){PKW(pB0,0),PKW(pB0,2),PKW(pB0,4),PKW(pB0,6)};pw1=(u32x4){PKW(pB0,8),PKW(pB0,10),PKW(pB0,12),PKW(pB0,14)};pw2=(u32x4){PKW(pB1,0),PKW(pB1,2),PKW(pB1,4),PKW(pB1,6)};pw3=(u32x4){PKW(pB1,8),PKW(pB1,10),PKW(pB1,12),PKW(pB1,14)};
    SBAR(); pv(o,vb0+sl_cur,PAF(0),PAF(1),PAF(2),PAF(3)); }
  #undef PKW
  #undef PAF
  #undef VFR
  #undef PIN
  #undef MX3
  #undef GAPA
  #undef GAPB
  #undef EX
  #undef VRD
  #undef KRD
  #undef STEP
  #undef ENDW
  {auto rr=__builtin_amdgcn_permlane32_swap(__float_as_uint(l_reg),__float_as_uint(l_reg),false,false);l_reg=__uint_as_float(rr[0])+__uint_as_float(rr[1]);}
  if(hi==0)wsf[32+r32]=l_reg;asm volatile("s_waitcnt lgkmcnt(0)":::"memory");
  float rli[16];
  #pragma unroll
  for(int r=0;r<16;++r)rli[r]=__builtin_amdgcn_rcpf(wsf[32+crow(r,hi)]);
  bf16*Ow=O+(rowbase+q0+wid*QBLK)*DM+h*D;
  { bf16*stg=(bf16*)(shm+LDS_OST)+wid*2048;
    #pragma unroll
    for(int r=0;r<16;++r){const int orow=crow(r,hi);
      #pragma unroll
      for(int d0=0;d0<2;++d0)stg[orow*64+d0*32+r32]=__float2bfloat16(o[d0][r]*rli[r]);}
    asm volatile("s_waitcnt lgkmcnt(0)":::"memory");
    #pragma unroll
    for(int i=0;i<4;++i){const int row=i*8+(lane>>3),ch=lane&7; const u32x4 v=*(const u32x4*)(stg+row*64+ch*8); ATTN_STORE16(Ow+(long)row*DM+ch*8,v);} }
  asm volatile("s_waitcnt lgkmcnt(0)\n\ts_barrier":::"memory");
  #undef DMA_K
  #undef DMA_V
  #undef CINIT
  #undef MKBNM
  #undef CMASK
  #undef START
  #undef RESC
  #undef ROT
}
constexpr int ATTN_LDS_BYTES=LDS_BYTES;
struct AttnTensors { const bf16* Q; const bf16* K; const bf16* V; bf16* O; };
struct AttnUnit { int bh; int qb; };
struct StaticOrder {
  int vcu;
  __device__ __forceinline__ explicit StaticOrder(int grid,int block):vcu((block%8)*(grid/8)+block/8){}
  __device__ __forceinline__ bool next(int i,AttnUnit&u)const{ if(i>=4)return false; const int s=vcu&3; u.bh=vcu>>2; u.qb=(i==0)?s:(i==1)?7-s:(i==2)?8+s:15-s; return true; }
  __device__ __forceinline__ void a_ready(const AttnUnit&)const{}
  __device__ __forceinline__ void done(const AttnUnit&)const{}
};
#undef SBAR
#undef WAIT_BAR
}
#define LAS __attribute__((address_space(3)))
typedef unsigned short bf16;
typedef unsigned v4u __attribute__((ext_vector_type(4)));
typedef unsigned v2u __attribute__((ext_vector_type(2)));
typedef float f32x4 __attribute__((ext_vector_type(4)));
typedef float f32x16 __attribute__((ext_vector_type(16)));
typedef short bf16x8 __attribute__((ext_vector_type(8)));
typedef float f32x2s __attribute__((ext_vector_type(2)));

constexpr int NBATCH = 4, SEQ = 4096, M = NBATCH * SEQ, D = 1024, DFF = 2816, PLE = 256;
constexpr int EVEN_IN = 2560, FOX_IN = 3088, FOX_INP = 3328;
constexpr float LOG2E = 1.4426950408889634f;
constexpr float QSCALE = 0.125f * LOG2E;
constexpr float GN_EPS = 64e-5f;
constexpr size_t MiB = 1u << 20;
constexpr size_t WS_SSQ = 0;
constexpr size_t WS_C3 = 1 * MiB;
constexpr size_t WS_LF = 2 * MiB;
constexpr size_t WS_G2F = 3 * MiB;
constexpr size_t WS_WGU = 4 * MiB;
constexpr size_t WS_WD = 48 * MiB;
constexpr size_t WS_WG = 70 * MiB;
constexpr size_t WS_WP = 74 * MiB;
constexpr size_t WS_WIN0 = 75 * MiB, WS_WOUT0 = 80 * MiB, WS_WIN1 = 82 * MiB, WS_WOUT1 = 89 * MiB;
constexpr size_t WS_XB = 91 * MiB;
constexpr size_t WS_Y = 123 * MiB;
constexpr size_t WS_BIG = 155 * MiB;
constexpr size_t WS_PB = 243 * MiB;
constexpr size_t WS_SSQP = 251 * MiB;
constexpr size_t WS_END = 253 * MiB;
constexpr size_t WS_BAR = 0;
constexpr int LDS_BYTES = 147456, MISC_OFF = 147456 - 64;

#define LDS_WAIT() asm volatile("s_waitcnt lgkmcnt(0)" ::: "memory")
__device__ __forceinline__ unsigned pk2(float lo, float hi) { return pg8::cvt_pk_bf16(lo, hi); }
__device__ __forceinline__ float bflo(unsigned w) { return __uint_as_float(w << 16); }
__device__ __forceinline__ float bfhi(unsigned w) { return __uint_as_float(w & 0xffff0000u); }
__device__ __forceinline__ float bf2f(bf16 h) { return __uint_as_float((unsigned)h << 16); }
__device__ __forceinline__ float wave_sum(float v) {
#pragma unroll
    for (int o = 1; o < 64; o <<= 1) v += __shfl_xor(v, o);
    return v;
}
__device__ __forceinline__ int crow(int r, int hi) { return (r & 3) + 8 * (r >> 2) + 4 * hi; }
template <int CTRL> __device__ __forceinline__ float dpp_f(float x) { return __int_as_float(__builtin_amdgcn_update_dpp(0, __float_as_int(x), CTRL, 0xf, 0xf, true)); }
__device__ __forceinline__ float red16(float x) { x += dpp_f<0xB1>(x); x += dpp_f<0x4E>(x); x += dpp_f<0x141>(x); x += dpp_f<0x140>(x); return x; }
__device__ __forceinline__ float red8(float x) { x += dpp_f<0xB1>(x); x += dpp_f<0x4E>(x); x += dpp_f<0x141>(x); return x; }
__device__ __forceinline__ void unpack8(const v4u w, float (&f)[8]) { f[0] = bflo(w.x); f[1] = bfhi(w.x); f[2] = bflo(w.y); f[3] = bfhi(w.y); f[4] = bflo(w.z); f[5] = bfhi(w.z); f[6] = bflo(w.w); f[7] = bfhi(w.w); }
__device__ __forceinline__ bf16x8 pack8(const float (&f)[8]) { v4u w; w.x = pk2(f[0], f[1]); w.y = pk2(f[2], f[3]); w.z = pk2(f[4], f[5]); w.w = pk2(f[6], f[7]); return __builtin_bit_cast(bf16x8, w); }

__device__ __forceinline__ void conv_item(const float* W, int K, int N, int NP, bf16* WT, const float* gain, int mode, LAS float* scr, int item, int lane) {
    const int nblk = NP / 32, kb = item / nblk, nb = item - kb * nblk, k0 = 64 * kb, n0 = 32 * nb;
    int orow0 = n0;
    if (mode == 1) orow0 = (n0 < DFF) ? (n0 / 128) * 256 + (n0 % 128) : ((n0 - DFF) / 128) * 256 + 128 + ((n0 - DFF) % 128);
    const int nq = 4 * (lane & 7); const bool inb = (n0 + nq) < N;
#pragma unroll
    for (int i = 0; i < 8; ++i) { const int kk = 8 * i + (lane >> 3); f32x4 v = {0.f, 0.f, 0.f, 0.f}; if (inb) v = *(const f32x4*)(W + (size_t)(k0 + kk) * N + n0 + nq);
        if (gain) v = v * gain[k0 + kk];
        LAS float* d = scr + kk * 33 + nq; d[0] = v[0]; d[1] = v[1]; d[2] = v[2]; d[3] = v[3]; }
    LDS_WAIT(); asm volatile("" ::: "memory");
    const int c = lane & 7;
#pragma unroll
    for (int j = 0; j < 4; ++j) { const int nn = (lane >> 3) + 8 * j; const LAS float* s = scr + (8 * c) * 33 + nn;
        v4u o; o.x = pk2(s[0 * 33], s[1 * 33]); o.y = pk2(s[2 * 33], s[3 * 33]); o.z = pk2(s[4 * 33], s[5 * 33]); o.w = pk2(s[6 * 33], s[7 * 33]);
        *(v4u*)(WT + (size_t)(orow0 + nn) * K + k0 + 8 * c) = o; }
    LDS_WAIT(); asm volatile("" ::: "memory");
}

constexpr int VTP = 264;
__device__ __forceinline__ void swa_unit(int unit, const bf16* PROJ, bf16* Y, const float* sinks, LAS unsigned char* lds, int tid, int lane, int wid) {
    const int b = unit >> 6, kvh = (unit >> 5) & 1, qblk = unit & 31, q0 = qblk * 128; const size_t rb = (size_t)b * SEQ;
    asm volatile("" : "+s"(PROJ), "+s"(Y));
    LAS bf16* VT = (LAS bf16*)lds;
    for (int c = tid; c < 2048; c += 512) { const int kvl = c >> 3, ch = c & 7, tok = q0 - 128 + kvl; v4u v = {0u, 0u, 0u, 0u};
        if (tok >= 0) v = *(const v4u*)(PROJ + (rb + tok) * EVEN_IN + 640 + kvh * 64 + ch * 8);
        LAS bf16* d = VT + (ch * 8) * VTP + kvl;
        d[0 * VTP] = (bf16)(v.x & 0xffffu); d[1 * VTP] = (bf16)(v.x >> 16); d[2 * VTP] = (bf16)(v.y & 0xffffu); d[3 * VTP] = (bf16)(v.y >> 16);
        d[4 * VTP] = (bf16)(v.z & 0xffffu); d[5 * VTP] = (bf16)(v.z >> 16); d[6 * VTP] = (bf16)(v.w & 0xffffu); d[7 * VTP] = (bf16)(v.w >> 16); }
    __syncthreads();
    const int g = wid >> 1, qh = wid & 1, hq = kvh * 4 + g;
    const float slope2 = exp2f(-(float)(hq + 1)) * LOG2E, sink2 = sinks[hq] * LOG2E;
#pragma unroll 1
    for (int sb = 0; sb < 2; ++sb) {
        int r32 = lane & 31, hi = lane >> 5; asm volatile("" : "+v"(r32), "+v"(hi));
        const int qs = q0 + 64 * qh + 32 * sb;
        bf16x8 qf[4];
#pragma unroll
        for (int ks = 0; ks < 4; ++ks) qf[ks] = *(const bf16x8*)(PROJ + (rb + qs + r32) * EVEN_IN + hq * 64 + 16 * ks + 8 * hi);
        f32x16 sc[5];
#pragma unroll
        for (int kt = 0; kt < 5; ++kt) { int tk = qs - 128 + 32 * kt + r32; tk = tk < 0 ? 0 : tk; sc[kt] = f32x16{};
#pragma unroll
            for (int ks = 0; ks < 4; ++ks) { const bf16x8 kf = *(const bf16x8*)(PROJ + (rb + tk) * EVEN_IN + 512 + kvh * 64 + 16 * ks + 8 * hi);
                sc[kt] = __builtin_amdgcn_mfma_f32_32x32x16_bf16(kf, qf[ks], sc[kt], 0, 0, 0); } }
        const int db = r32 + 128 - 4 * hi, kmin = 128 - qs - 4 * hi; const float ab = -slope2 * (float)db;
        float mx = sink2;
#pragma unroll
        for (int kt = 0; kt < 5; ++kt)
#pragma unroll
            for (int r = 0; r < 16; ++r) { const int kc = 32 * kt + (r & 3) + 8 * (r >> 2), dist = db - kc; const bool ok = ((unsigned)dist < 128u) && (kmin <= kc);
                const float s = ok ? fmaf(slope2, (float)kc, sc[kt][r] + ab) : -INFINITY; sc[kt][r] = s; mx = fmaxf(mx, s); }
        mx = fmaxf(mx, __shfl_xor(mx, 32));
        float l = 0.f;
#pragma unroll
        for (int kt = 0; kt < 5; ++kt)
#pragma unroll
            for (int r = 0; r < 16; ++r) { const float p = exp2f(sc[kt][r] - mx); sc[kt][r] = p; l += p; }
        l += __shfl_xor(l, 32); l += exp2f(sink2 - mx);
        const float rl = 1.0f / l;
        f32x16 o[2]; o[0] = f32x16{}; o[1] = f32x16{};
        const int kvl0 = 64 * qh + 32 * sb;
#pragma unroll
        for (int kt = 0; kt < 5; ++kt)
#pragma unroll
            for (int s2 = 0; s2 < 2; ++s2) { v4u pw; pw.x = pk2(sc[kt][8 * s2 + 0], sc[kt][8 * s2 + 1]); pw.y = pk2(sc[kt][8 * s2 + 2], sc[kt][8 * s2 + 3]); pw.z = pk2(sc[kt][8 * s2 + 4], sc[kt][8 * s2 + 5]); pw.w = pk2(sc[kt][8 * s2 + 6], sc[kt][8 * s2 + 7]);
                const bf16x8 pa = __builtin_bit_cast(bf16x8, pw);
#pragma unroll
                for (int db = 0; db < 2; ++db) { const LAS bf16* vp = VT + (32 * db + r32) * VTP + kvl0 + 32 * kt + 16 * s2 + 4 * hi;
                    const v2u lo = *(const LAS v2u*)vp, hh = *(const LAS v2u*)(vp + 8); v4u vw; vw.x = lo.x; vw.y = lo.y; vw.z = hh.x; vw.w = hh.y;
                    o[db] = __builtin_amdgcn_mfma_f32_32x32x16_bf16(pa, __builtin_bit_cast(bf16x8, vw), o[db], 0, 0, 0); } }
#pragma unroll
        for (int r = 0; r < 16; ++r) { const int qq = crow(r, hi); const float sc1 = __shfl(rl, qq);
            bf16* yp = Y + (rb + qs + qq) * 1024 + hq * 64 + r32;
            yp[0] = (bf16)(pk2(o[0][r] * sc1, 0.f) & 0xffffu); yp[32] = (bf16)(pk2(o[1][r] * sc1, 0.f) & 0xffffu); }
    }
    __syncthreads();
}
typedef unsigned v4u_unused_;
#define XB_TMO      128
#define XB_XCNT(j)  (256  + 64 * (j))
#define XB_XSUB(j)  (1280 + 64 * (j))
#define XB_XGEN(j)  (2304 + 64 * (j))
#define XB_TOP      3328
#define XB_TOPGEN   3392
#define XCD_BAR_WORDS 3456
#define XB_SPIN_CAP (1u << 18)

__device__ __forceinline__ unsigned xb_ld(unsigned* p)              { return __hip_atomic_load(p, __ATOMIC_RELAXED, __HIP_MEMORY_SCOPE_AGENT); }
__device__ __forceinline__ unsigned xb_add(unsigned* p, unsigned v) { return __hip_atomic_fetch_add(p, v, __ATOMIC_RELAXED, __HIP_MEMORY_SCOPE_AGENT); }
__device__ __forceinline__ unsigned xb_xcc_id() { return (unsigned)__builtin_amdgcn_s_getreg((3 << 11) | 20) & 0xFu; }
#define XB_SPIN(cond, bar) do { unsigned _sp = 0; while (cond) { __builtin_amdgcn_s_sleep(1); \
    if ((++_sp & 255u) == 0u) { if (xb_ld(&(bar)[XB_TMO])) break; if (_sp > XB_SPIN_CAP) { atomicAdd(&(bar)[XB_TMO], 1u); break; } } } } while (0)

struct XcdBarrier {
    unsigned* bar; unsigned x;
    volatile LAS unsigned* st;
};

__device__ __forceinline__ XcdBarrier xcd_barrier_post(unsigned* bar, volatile LAS unsigned* st) {
    XcdBarrier b; b.bar = bar; b.x = xb_xcc_id(); b.st = st;
    if (threadIdx.x == 0) (void)xb_add(&bar[XB_XCNT(b.x)], 1u);
    return b;
}
__device__ __forceinline__ void xcd_barrier_complete(unsigned* bar, unsigned x, unsigned& nloc, unsigned& nx) {
    const unsigned G = gridDim.x * gridDim.y * gridDim.z;
    unsigned sum, cnt, mine, sp = 0u;
    for (;;) {
        sum = 0u; cnt = 0u; mine = 0u;
#pragma unroll
        for (unsigned j = 0; j < 16; ++j) { const unsigned c = xb_ld(&bar[XB_XCNT(j)]); sum += c; cnt += (c > 0u) ? 1u : 0u; mine = (j == x) ? c : mine; }
        if (sum == G) break;
        __builtin_amdgcn_s_sleep(1);
        if ((++sp & 255u) == 0u) { if (xb_ld(&bar[XB_TMO])) break; if (sp > XB_SPIN_CAP) { atomicAdd(&bar[XB_TMO], 1u); break; } }
    }
    nloc = mine > 0u ? mine : 1u; nx = cnt > 0u ? cnt : 1u;
}

__device__ __forceinline__ void xcd_barrier(const XcdBarrier& b) {
    asm volatile("s_waitcnt vmcnt(0)" ::: "memory");
    __syncthreads();
    if (threadIdx.x == 0) {
        unsigned* bar = b.bar;
        __builtin_amdgcn_s_waitcnt(0);
        unsigned nloc = b.st[0], nx = b.st[1];
        if (nloc == 0u) { xcd_barrier_complete(bar, b.x, nloc, nx); b.st[0] = nloc; b.st[1] = nx; }
        const unsigned old = xb_add(&bar[XB_XSUB(b.x)], 1u);
        const unsigned gen = old / nloc;
        if (old + 1u == (gen + 1u) * nloc) {
            __builtin_amdgcn_fence(__ATOMIC_RELEASE, "agent");
            asm volatile("s_waitcnt vmcnt(0)" ::: "memory");
            const unsigned og = xb_add(&bar[XB_TOP], 1u);
            const unsigned tg = og / nx;
            if (og + 1u == (tg + 1u) * nx) xb_add(&bar[XB_TOPGEN], 1u);
            else XB_SPIN(xb_ld(&bar[XB_TOPGEN]) == tg, bar);
            __builtin_amdgcn_fence(__ATOMIC_ACQUIRE, "agent");
            xb_add(&bar[XB_XGEN(b.x)], 1u);
            asm volatile("s_waitcnt vmcnt(0)" ::: "memory");
        } else {
            XB_SPIN(xb_ld(&bar[XB_XGEN(b.x)]) == gen, bar);
            __builtin_amdgcn_fence(__ATOMIC_ACQUIRE, "agent");
            asm volatile("s_waitcnt vmcnt(0)" ::: "memory");
        }
    }
    __syncthreads();
}
constexpr int TC = 32, SBS = 340, LBS = 68;
constexpr int SBS_UNUSED_ = 336;
constexpr int RW_SBUF = 0, RW_SBUF_BYTES = TC * SBS * 4, RW_LW = 2 * RW_SBUF_BYTES, RW_LA = RW_LW + 2 * TC * LBS * 4, RW_EC = RW_LA + 2 * TC * LBS * 4, RW_BF = RW_EC + 2560;
__device__ __forceinline__ void rwkv_scan_unit(int unit, const bf16* PROJ, float* YRAW, float* C3, const float* mu, const float* w0, const float* w2, const float* a0, const float* a2,
                                               const float* k_k, const float* k_a, const float* r_k, LAS unsigned char* lds, const int lane, int wid) {
    const int role = (wid < 2) ? 0 : ((wid == 2 || wid == 3) ? 2 : 1), lw = wid - 2, ew = wid - 4;
    const int b = unit >> 6, h = (unit >> 3) & 7, rg = unit & 7; const size_t rb = (size_t)b * SEQ;
    const int r32 = lane & 31, hi = lane >> 5;
    constexpr int NCH = SEQ / TC;
    if (role == 2) {
        const int colx = 768 + ((lw == 0) ? 1536 : 1600); const float* Wl = (lw == 0) ? w2 : a2;
#pragma unroll
        for (int nb = 0; nb < 2; ++nb)
#pragma unroll
            for (int ks = 0; ks < 4; ++ks) { float f[8];
#pragma unroll
                for (int i = 0; i < 8; ++i) f[i] = Wl[(size_t)(16 * ks + 8 * hi + i) * 512 + h * 64 + 32 * nb + r32];
                *(LAS bf16x8*)(lds + RW_BF + (((lw * 2 + nb) * 4 + ks) * 64 + lane) * 16) = pack8(f); }
        ((LAS float*)(lds + RW_EC))[512 + lw * 64 + lane] = mu[colx - 768 + lane];
        v4u lcw[4], lpw[4];
#define LORA_LOAD(itn) do { const int tl_ = (itn) * TC + r32; const bf16* p_ = PROJ + (rb + tl_) * EVEN_IN + colx + 8 * hi; _Pragma("unroll") for (int ks = 0; ks < 4; ++ks) { lcw[ks] = *(const v4u*)(p_ + 16 * ks); \
            lpw[ks] = (v4u){0u, 0u, 0u, 0u}; if (tl_ > 0) lpw[ks] = *(const v4u*)(p_ - EVEN_IN + 16 * ks); } } while (0)
        LORA_LOAD(0);
#pragma unroll 1
        for (int it = 0; it < NCH + 2; ++it) {
            if (it < NCH) { bf16x8 afr[4];
#pragma unroll
                for (int ks = 0; ks < 4; ++ks) { float c[8], p[8]; unpack8(lcw[ks], c); unpack8(lpw[ks], p);
                    const LAS float* mq = (const LAS float*)(lds + RW_EC) + 512 + lw * 64 + 16 * ks + 8 * hi; const f32x4 m0 = *(const LAS f32x4*)mq, m1 = *(const LAS f32x4*)(mq + 4);
#pragma unroll
                    for (int i = 0; i < 8; ++i) { float x = c[i] + (p[i] - c[i]) * (i < 4 ? m0[i] : m1[i - 4]); if (lw == 0) x = 1.f - 2.f * __builtin_amdgcn_rcpf(1.f + __expf(2.f * x)); c[i] = x; }
                    afr[ks] = pack8(c); }
                if (it + 1 < NCH) LORA_LOAD(it + 1);
                LAS float* LB = (LAS float*)(lds + ((lw == 0) ? RW_LW : RW_LA)) + (it & 1) * (TC * LBS);
#pragma unroll
                for (int nb = 0; nb < 2; ++nb) { f32x16 acc = f32x16{};
#pragma unroll
                    for (int ks = 0; ks < 4; ++ks) acc = __builtin_amdgcn_mfma_f32_32x32x16_bf16(afr[ks], *(const LAS bf16x8*)(lds + RW_BF + (((lw * 2 + nb) * 4 + ks) * 64 + lane) * 16), acc, 0, 0, 0);
#pragma unroll
                    for (int r = 0; r < 16; ++r) LB[crow(r, hi) * LBS + 32 * nb + r32] = acc[r]; } }
            asm volatile("s_waitcnt lgkmcnt(0)\n\ts_barrier" ::: "memory");
        }
#undef LORA_LOAD
    } else if (role == 1) {
        const int el = ew * 64 + lane, s = el >> 3, g = el & 7;
        float ecc[8][8];
        { const int chn = h * 64 + 8 * g;
#pragma unroll
          for (int i = 0; i < 8; ++i) { ecc[0][i] = mu[chn + i]; ecc[1][i] = mu[512 + chn + i]; ecc[2][i] = mu[1024 + chn + i]; ecc[3][i] = w0[chn + i]; ecc[4][i] = a0[chn + i]; ecc[5][i] = k_k[chn + i]; ecc[6][i] = k_a[chn + i]; ecc[7][i] = r_k[chn + i]; } }
        v4u ecr, eck, ecv, epr, epk, epv;
#define ELEM_LOAD(cn) do { const int tl_ = (cn) * TC + s; const bf16* p_ = PROJ + (rb + tl_) * EVEN_IN + 768 + h * 64 + 8 * g; \
            ecr = *(const v4u*)p_; eck = *(const v4u*)(p_ + 512); ecv = *(const v4u*)(p_ + 1024); epr = (v4u){0u, 0u, 0u, 0u}; epk = epr; epv = epr; \
            if (tl_ > 0) { epr = *(const v4u*)(p_ - EVEN_IN); epk = *(const v4u*)(p_ - EVEN_IN + 512); epv = *(const v4u*)(p_ - EVEN_IN + 1024); } } while (0)
        ELEM_LOAD(0);
#pragma unroll 1
        for (int it = 0; it < NCH + 2; ++it) {
            const int c = it - 1;
            if (c >= 0 && c < NCH) { const size_t row = rb + c * TC + s;
                const LAS float* LW = (const LAS float*)(lds + RW_LW) + (c & 1) * (TC * LBS) + s * LBS + 8 * g; const LAS float* LA = (const LAS float*)(lds + RW_LA) + (c & 1) * (TC * LBS) + s * LBS + 8 * g;
                LAS float* sp = (LAS float*)(lds + RW_SBUF + (c & 1) * RW_SBUF_BYTES) + s * SBS;
                float ec[8];
#define LDEC(arr) do { _Pragma("unroll") for (int i_ = 0; i_ < 8; ++i_) ec[i_] = ecc[arr][i_]; } while (0)
                float r[8], k[8], v[8], t[8];
                unpack8(ecr, r); unpack8(epr, t); LDEC(0);
#pragma unroll
                for (int i = 0; i < 8; ++i) r[i] += (t[i] - r[i]) * ec[i];
                unpack8(eck, k); unpack8(epk, t); LDEC(1);
#pragma unroll
                for (int i = 0; i < 8; ++i) k[i] += (t[i] - k[i]) * ec[i];
                unpack8(ecv, v); unpack8(epv, t); LDEC(2);
#pragma unroll
                for (int i = 0; i < 8; ++i) v[i] += (t[i] - v[i]) * ec[i];
                if (c + 1 < NCH) ELEM_LOAD(c + 1);
                const f32x4 dw0 = *(const LAS f32x4*)LW, dw1 = *(const LAS f32x4*)(LW + 4), da0 = *(const LAS f32x4*)LA, da1 = *(const LAS f32x4*)(LA + 4);
                float w[8], a[8], kk[8], kp[8]; float n2 = 0.f;
#pragma unroll
                for (int i = 0; i < 8; ++i) w[i] = i < 4 ? dw0[i] : dw1[i - 4];
                LDEC(3);
#pragma unroll
                for (int i = 0; i < 8; ++i) w[i] = __expf(-0.60653065971f * pg8::sigm(ec[i] + w[i]));
                LDEC(4);
#pragma unroll
                for (int i = 0; i < 8; ++i) a[i] = pg8::sigm(ec[i] + (i < 4 ? da0[i] : da1[i - 4]));
                LDEC(5);
#pragma unroll
                for (int i = 0; i < 8; ++i) { kk[i] = k[i] * ec[i]; n2 += kk[i] * kk[i]; }
                LDEC(6);
#pragma unroll
                for (int i = 0; i < 8; ++i) kp[i] = k[i] * (1.f + (a[i] - 1.f) * ec[i]);
                LDEC(7);
                n2 = red8(n2); const float inv = __builtin_amdgcn_rsqf(fmaxf(n2, 1e-24f));
                float c1 = 0.f, c2 = 0.f, c3 = 0.f;
#pragma unroll
                for (int i = 0; i < 8; ++i) { kk[i] *= inv; t[i] = kk[i] * a[i]; c1 += t[i] * r[i]; c2 += kp[i] * r[i]; c3 += r[i] * kp[i] * ec[i]; }
#undef LDEC
                c1 = red8(c1); c2 = red8(c2); c3 = red8(c3);
                *(LAS f32x4*)(sp + 8 * g) = (f32x4){kk[0], kk[1], kk[2], kk[3]}; *(LAS f32x4*)(sp + 8 * g + 4) = (f32x4){kk[4], kk[5], kk[6], kk[7]};
                *(LAS f32x4*)(sp + 64 + 8 * g) = (f32x4){w[0] * r[0], w[1] * r[1], w[2] * r[2], w[3] * r[3]}; *(LAS f32x4*)(sp + 64 + 8 * g + 4) = (f32x4){w[4] * r[4], w[5] * r[5], w[6] * r[6], w[7] * r[7]};
                *(LAS f32x4*)(sp + 128 + 8 * g) = (f32x4){w[0], w[1], w[2], w[3]}; *(LAS f32x4*)(sp + 128 + 8 * g + 4) = (f32x4){w[4], w[5], w[6], w[7]};
                *(LAS f32x4*)(sp + 192 + 8 * g) = (f32x4){t[0], t[1], t[2], t[3]}; *(LAS f32x4*)(sp + 192 + 8 * g + 4) = (f32x4){t[4], t[5], t[6], t[7]};
                *(LAS f32x4*)(sp + 256 + 8 * g) = (f32x4){kp[0], kp[1], kp[2], kp[3]}; *(LAS f32x4*)(sp + 256 + 8 * g + 4) = (f32x4){kp[4], kp[5], kp[6], kp[7]};
                if (g == rg) { *(LAS f32x4*)(sp + 320) = (f32x4){v[0], v[1], v[2], v[3]}; *(LAS f32x4*)(sp + 324) = (f32x4){v[4], v[5], v[6], v[7]}; }
                if (g == 0) { sp[328] = c1; sp[329] = c2; if (rg == 0) C3[row * 8 + h] = c3; } }
            asm volatile("s_waitcnt lgkmcnt(0)\n\ts_barrier" ::: "memory");
        }
#undef ELEM_LOAD
    } else {
        const int rowl = 4 * (wid & 1) + (lane >> 4), cgp = lane & 15;
        f32x2s S01 = {0.f, 0.f}, S23 = {0.f, 0.f};
#pragma unroll 1
        for (int it = 0; it < NCH + 2; ++it) {
            const int c = it - 2;
            if (c >= 0) { const LAS float* SBF = (const LAS float*)(lds + RW_SBUF + (c & 1) * RW_SBUF_BYTES);
                float* yp = YRAW + (rb + (size_t)c * TC) * 512 + h * 64 + 8 * rg + rowl;
                __builtin_amdgcn_s_setprio(3);
                f32x4 kkA, wrA, wA, kaA, kpA, kkB, wrB, wB, kaB, kpB; float viA, viB; float pkeep = 0.f, qkeep = 0.f;
#define LDREC(X, s_) do { const LAS float* sp_ = SBF + (s_) * SBS; kk##X = *(const LAS f32x4*)(sp_ + 4 * cgp); wr##X = *(const LAS f32x4*)(sp_ + 64 + 4 * cgp); w##X = *(const LAS f32x4*)(sp_ + 128 + 4 * cgp); \
                    ka##X = *(const LAS f32x4*)(sp_ + 192 + 4 * cgp); kp##X = *(const LAS f32x4*)(sp_ + 256 + 4 * cgp); vi##X = sp_[320 + rowl]; } while (0)
#define LO2(v) __builtin_shufflevector(v, v, 0, 1)
#define HI2(v) __builtin_shufflevector(v, v, 2, 3)
#define STEPREC(X, s_) do { f32x2s pp = S01 * LO2(kk##X); pp = S23 * HI2(kk##X) + pp; f32x2s qq = S01 * LO2(wr##X); qq = S23 * HI2(wr##X) + qq; float p = pp[0] + pp[1], q = qq[0] + qq[1]; \
                    const f32x2s vv_ = {vi##X, vi##X}; const f32x2s u01_ = S01 * LO2(w##X) + LO2(kp##X) * vv_, u23_ = S23 * HI2(w##X) + HI2(kp##X) * vv_;     \
                    p += dpp_f<0xB1>(p); q += dpp_f<0xB1>(q); p += dpp_f<0x4E>(p); q += dpp_f<0x4E>(q); p += dpp_f<0x141>(p); q += dpp_f<0x141>(q); p += dpp_f<0x140>(p); q += dpp_f<0x140>(q); \
                    const f32x2s pv_ = {p, p}; \
                    S01 = u01_ - LO2(ka##X) * pv_; S23 = u23_ - HI2(ka##X) * pv_; \
                    pkeep = (((s_) & 15) == cgp) ? p : pkeep; qkeep = (((s_) & 15) == cgp) ? q : qkeep;     \
                    if (((s_) & 15) == 15) { const LAS float* sy_ = SBF + ((s_) - 15 + cgp) * SBS; const f32x2s cy_ = *(const LAS f32x2s*)(sy_ + 328); \
                        yp[(size_t)((s_) - 15 + cgp) * 512] = qkeep - pkeep * cy_[0] + sy_[320 + rowl] * cy_[1]; } } while (0)
                LDREC(A, 0);
#pragma unroll
                for (int s = 0; s < TC; s += 2) {
 LDREC(B, s + 1); STEPREC(A, s); LDREC(A, s + 2); STEPREC(B, s + 1); }
#undef LDREC
#undef STEPREC
#undef LO2
#undef HI2
                __builtin_amdgcn_s_setprio(0); }
            asm volatile("s_waitcnt lgkmcnt(0)\n\ts_barrier" ::: "memory");
        }
    }
    __syncthreads();
}

__device__ __forceinline__ void rwkv_post_unit(int tile, const bf16* PROJ, const float* YRAW, const float* C3, bf16* Y, const float* mu, const bf16* g2f, const float* ln_w, const float* ln_b, int lane, int wid) {
    asm volatile("" : "+s"(PROJ), "+s"(mu), "+s"(g2f), "+s"(YRAW));
    const int h = wid, r32 = lane & 31, hi = lane >> 5; const int tok0 = tile * 32; const bool first = (tok0 & (SEQ - 1)) == 0;
    bf16x8 afr[8];
    { const int tk = tok0 + r32; const bool hp = !(first && r32 == 0); v4u cwv[8], pwv[8];
      const __attribute__((address_space(1))) bf16* pg = (const __attribute__((address_space(1))) bf16*)(PROJ + (size_t)tk * EVEN_IN + 768 + 1664 + 8 * hi);
#pragma unroll
        for (int ks = 0; ks < 8; ++ks) { cwv[ks] = *(const __attribute__((address_space(1))) v4u*)(pg + 16 * ks); pwv[ks] = (v4u){0u, 0u, 0u, 0u};
            if (hp) pwv[ks] = *(const __attribute__((address_space(1))) v4u*)(pg - EVEN_IN + 16 * ks); }
#pragma unroll
        for (int ks = 0; ks < 8; ++ks) { float c[8], p[8]; unpack8(cwv[ks], c); unpack8(pwv[ks], p);
            const f32x4 m0 = *(const f32x4*)(mu + 1664 + 16 * ks + 8 * hi), m1 = *(const f32x4*)(mu + 1664 + 16 * ks + 8 * hi + 4);
#pragma unroll
            for (int i = 0; i < 8; ++i) c[i] = pg8::sigm(c[i] + (p[i] - c[i]) * (i < 4 ? m0[i] : m1[i - 4]));
            afr[ks] = pack8(c); } }
    f32x16 gt[2];
#pragma unroll
    for (int nb = 0; nb < 2; ++nb) { gt[nb] = f32x16{};
#pragma unroll
        for (int ks = 0; ks < 8; ++ks) { const bf16x8 bf = *(const bf16x8*)(g2f + ((size_t)((h * 2 + nb) * 8 + ks) * 64 + lane) * 8);
            gt[nb] = __builtin_amdgcn_mfma_f32_32x32x16_bf16(afr[ks], bf, gt[nb], 0, 0, 0); } }
    typedef const __attribute__((address_space(1))) float* gfp; typedef const __attribute__((address_space(1))) unsigned short* gup;
    const int ch0 = h * 64 + r32; const float lw0 = ln_w[ch0], lw1 = ln_w[ch0 + 32], lb0 = ln_b[ch0], lb1 = ln_b[ch0 + 32], mv0 = mu[1024 + ch0], mv1 = mu[1024 + ch0 + 32];
    float y0[16], y1[16], c3v[16]; unsigned vc[16], vp[16];
#pragma unroll
    for (int r = 0; r < 16; ++r) { const int tk = tok0 + crow(r, hi); gfp yp = (gfp)(YRAW + (size_t)tk * 512 + ch0); y0[r] = yp[0]; y1[r] = yp[32]; c3v[r] = ((gfp)C3)[(size_t)tk * 8 + h];
        gup vq = (gup)(PROJ + (size_t)tk * EVEN_IN + 768 + 1024 + ch0); vc[r] = (unsigned)vq[0] | ((unsigned)vq[32] << 16); vp[r] = 0u;
        if ((tk & (SEQ - 1)) != 0) vp[r] = (unsigned)vq[-EVEN_IN] | ((unsigned)vq[32 - EVEN_IN] << 16); }
#pragma unroll
    for (int r = 0; r < 16; ++r) { const int tk = tok0 + crow(r, hi);
        float s = y0[r] + y1[r]; s = red16(s); s += __shfl_xor(s, 16);
        const float mean = s * (1.f / 64.f), d0 = y0[r] - mean, d1 = y1[r] - mean; float q = d0 * d0 + d1 * d1; q = red16(q); q += __shfl_xor(q, 16);
        const float rstd = rsqrtf(q * (1.f / 64.f) + GN_EPS);
        const float cv0 = bflo(vc[r]), cv1 = bfhi(vc[r]), pv0 = bflo(vp[r]), pv1 = bfhi(vp[r]);
        const float v0 = cv0 + (pv0 - cv0) * mv0, v1 = cv1 + (pv1 - cv1) * mv1;
        const float o0 = (d0 * rstd * lw0 + lb0 + c3v[r] * v0) * gt[0][r], o1 = (d1 * rstd * lw1 + lb1 + c3v[r] * v1) * gt[1][r];
        bf16* op = Y + (size_t)tk * 1024 + 512 + ch0; op[0] = (bf16)(pk2(o0, 0.f) & 0xffffu); op[32] = (bf16)(pk2(o1, 0.f) & 0xffffu); }
}

__device__ __forceinline__ void fox_gate_pass(const bf16* XB, const bf16* Wf, const float* ssqv, const float* bfv, float* LF, int gw, int NGW, int lane) {
    typedef float f32x4g __attribute__((ext_vector_type(4)));
    const int fr = lane & 15, fq = lane >> 4;
    for (int t = gw; t < M / 16; t += NGW) {
        const bf16* ap = XB + (size_t)(t * 16 + fr) * D + 8 * fq; const bf16* bp = Wf + (size_t)fr * D + 8 * fq;
        f32x4g acc = {0.f, 0.f, 0.f, 0.f};
#pragma unroll 8
        for (int ks = 0; ks < D / 32; ++ks) acc = __builtin_amdgcn_mfma_f32_16x16x32_bf16(*(const bf16x8*)(ap + 32 * ks), *(const bf16x8*)(bp + 32 * ks), acc, 0, 0, 0);
        const float bn = bfv[fr];
#pragma unroll
        for (int j = 0; j < 4; ++j) { const int row = t * 16 + 4 * fq + j; const float z = fmaxf(acc[j] * pg8::rstd_of(ssqv, row) + bn, -80.f), e = __expf(-z);
            LF[(size_t)row * 16 + fr] = (e < 0.01f) ? -(e - 0.5f * e * e + e * e * e * (1.f / 3.f)) : -__logf(1.f + e); }
    }
}

__device__ __forceinline__ void fox_prefix(const float* LFbh, LAS float* cs, LAS float* wtot, int tid, int lane, int wid) {
    const float* lp = LFbh + (size_t)tid * 128;
    float s[8]; s[0] = lp[0]; s[1] = s[0] + lp[16]; s[2] = s[1] + lp[32]; s[3] = s[2] + lp[48]; s[4] = s[3] + lp[64]; s[5] = s[4] + lp[80]; s[6] = s[5] + lp[96]; s[7] = s[6] + lp[112];
    float incl = s[7];
#pragma unroll
    for (int o = 1; o < 64; o <<= 1) { const float t = __shfl_up(incl, o); if (lane >= o) incl += t; }
    if (lane == 63) wtot[wid] = incl;
    __syncthreads();
    float base = incl - s[7];
    for (int w = 0; w < wid; ++w) base += wtot[w];
#pragma unroll
    for (int i = 0; i < 8; ++i) { const float v = (base + s[i]) * LOG2E;
        const unsigned h1 = pk2(v, 0.f) & 0xffffu; const float r1 = v - __uint_as_float(h1 << 16); const unsigned h2 = pk2(r1, 0.f) & 0xffffu; const float r2 = r1 - __uint_as_float(h2 << 16); const unsigned h3 = pk2(r2, 0.f) & 0xffffu;
        ((LAS v2u*)cs)[8 * tid + i] = (v2u){h1 | (h2 << 16), h3}; }
    __syncthreads();
}
struct Args { const float* in[30]; float* out; unsigned char* ws; int ph_lo, ph_hi; };
#define AS4 __attribute__((address_space(4)))
#ifndef DUP_SWA
#define DUP_SWA 0
#endif
#ifndef DUP_SCAN
#define DUP_SCAN 0
#endif
#ifndef DUP_POST
#define DUP_POST 0
#endif
#ifndef DUP_GU
#define DUP_GU 0
#endif
#ifndef DUP_INPROJ
#define DUP_INPROJ 0
#endif
#ifndef DUP_P0
#define DUP_P0 0
#endif
#ifndef DUP_SYNC
#define DUP_SYNC 0
#endif
#define INP(i) (*(const float* const AS4*)(kp + 8 * (i)))
#define GSYNC() xcd_barrier(xbar)
#define FRESH() const AS4 char* kp = kp0; asm volatile("" : "+s"(kp)); unsigned char* ws = *(unsigned char* const AS4*)(kp + 248); float* X = *(float* const AS4*)(kp + 240); \
    int tid = threadIdx.x; asm volatile("" : "+v"(tid)); const int lane = tid & 63, wid = __builtin_amdgcn_readfirstlane(tid >> 6); \
    const int gw = bx * 8 + wid, NGW = G * 8; \
    float* ssq = (float*)(ws + WS_SSQP); float* C3 = (float*)(ws + WS_C3); float* LF = (float*)(ws + WS_LF); \
    bf16* XB = (bf16*)(ws + WS_XB); float* YRAW = (float*)(ws + WS_XB); bf16* Y = (bf16*)(ws + WS_Y); \
    bf16* H = (bf16*)(ws + WS_BIG); bf16* PROJ = (bf16*)(ws + WS_BIG); bf16* PP = (bf16*)(ws + WS_BIG); bf16* PB = (bf16*)(ws + WS_PB); \
    bf16* Qb = (bf16*)(ws + WS_BIG); bf16* Kb = Qb + (size_t)M * D; bf16* Vb = Kb + (size_t)M * D; \
    (void)X; (void)lane; (void)wid; (void)gw; (void)NGW; (void)ssq; (void)C3; (void)LF; (void)XB; (void)YRAW; (void)Y; (void)H; (void)PROJ; (void)PP; (void)PB; (void)Qb; (void)Kb; (void)Vb
__global__ void __launch_bounds__(512, 2) fwd_megakernel(Args a_unused) {
    extern __shared__ __attribute__((aligned(16))) unsigned char lds_raw[];
    cg::grid_group grid = cg::this_grid();
    LAS unsigned char* lds = (LAS unsigned char*)lds_raw;
    const int G = gridDim.x, bx = blockIdx.x;
    const AS4 char* kp0 = (const AS4 char*)__builtin_amdgcn_kernarg_segment_ptr();
    const int ph_lo = *(const int AS4*)(kp0 + 256), ph_hi = *(const int AS4*)(kp0 + 260);
    XcdBarrier xbar;
    { unsigned* barw = (unsigned*)(*(unsigned char* const AS4*)(kp0 + 248) + WS_BAR);
      if (bx == 0) for (int i = threadIdx.x; i < XCD_BAR_WORDS; i += 512) barw[i] = 0u;
      if (threadIdx.x < 4) ((LAS unsigned*)(lds + MISC_OFF))[threadIdx.x] = 0u;
      asm volatile("s_waitcnt vmcnt(0)" ::: "memory"); __syncthreads();
      grid.sync();
      __builtin_amdgcn_fence(__ATOMIC_ACQUIRE, "agent"); asm volatile("s_waitcnt vmcnt(0)" ::: "memory");
      xbar = xcd_barrier_post(barw, (volatile LAS unsigned*)(lds + MISC_OFF)); }

#ifdef NANFILL
    { FRESH(); v4u q = {0xffffffffu, 0xffffffffu, 0xffffffffu, 0xffffffffu};
      for (size_t i = (size_t)bx * 512 + tid; i < WS_END / 16; i += (size_t)G * 512) ((v4u*)ws)[i] = q;
      for (size_t i = (size_t)bx * 512 + tid; i < (size_t)M * D / 4; i += (size_t)G * 512) ((v4u*)X)[i] = q;
      for (int i = tid; i < LDS_BYTES / 4; i += 512) ((LAS unsigned*)lds)[i] = 0xffffffffu; }
    GSYNC();
#endif
    for (int dup = 0; dup < 1 + DUP_P0; ++dup)
    if (ph_lo == 0) {
        FRESH();
        LAS float* scr = (LAS float*)(lds + wid * 16384);
        constexpr int I_GU = (D / 64) * (2 * DFF / 32), I_D = (DFF / 64) * (D / 32), I_G = (D / 64) * (D / 32), I_P = (PLE / 64) * (D / 32), I_IN0 = (D / 64) * (EVEN_IN / 32), I_IN1 = (D / 64) * (FOX_INP / 32);
        constexpr int NITEMS = 4 * I_GU + 4 * I_D + 2 * I_G + 2 * I_P + I_IN0 + I_IN1 + 2 * I_G;
        for (int it = gw; it < NITEMS; it += NGW) {
            int r = it;
#define MAT(cnt, W_, K_, N_, NP_, WT_, G_, MODE_) if (r < (cnt)) { conv_item((W_), (K_), (N_), (NP_), (bf16*)(WT_), (G_), (MODE_), scr, r, lane); continue; } r -= (cnt);
            MAT(I_GU, INP(3), D, 2 * DFF, 2 * DFF, ws + WS_WGU, INP(2), 1)
            MAT(I_GU, INP(7), D, 2 * DFF, 2 * DFF, ws + WS_WGU + 11 * MiB, INP(6), 1)
            MAT(I_GU, INP(3) + (size_t)D * 2 * DFF, D, 2 * DFF, 2 * DFF, ws + WS_WGU + 22 * MiB, INP(2) + D, 1)
            MAT(I_GU, INP(7) + (size_t)D * 2 * DFF, D, 2 * DFF, 2 * DFF, ws + WS_WGU + 33 * MiB, INP(6) + D, 1)
            MAT(I_D, INP(4), DFF, D, D, ws + WS_WD, nullptr, 0)
            MAT(I_D, INP(8), DFF, D, D, ws + WS_WD + (size_t)D * DFF * 2, nullptr, 0)
            MAT(I_D, INP(4) + (size_t)D * DFF, DFF, D, D, ws + WS_WD + (size_t)D * DFF * 4, nullptr, 0)
            MAT(I_D, INP(8) + (size_t)D * DFF, DFF, D, D, ws + WS_WD + (size_t)D * DFF * 6, nullptr, 0)
            MAT(I_G, INP(10), D, D, D, ws + WS_WG, INP(9), 0)
            MAT(I_G, INP(10) + (size_t)D * D, D, D, D, ws + WS_WG + 2 * MiB, INP(9) + D, 0)
            MAT(I_P, INP(11), PLE, D, D, ws + WS_WP, nullptr, 0)
            MAT(I_P, INP(11) + (size_t)PLE * D, PLE, D, D, ws + WS_WP + (size_t)PLE * D * 2, nullptr, 0)
            MAT(I_IN0, INP(12), D, EVEN_IN, EVEN_IN, ws + WS_WIN0, INP(5), 0)
            MAT(I_IN1, INP(26), D, FOX_IN, FOX_INP, ws + WS_WIN1, INP(5) + D, 0)
            MAT(I_G, INP(13), D, D, D, ws + WS_WOUT0, nullptr, 0)
            MAT(I_G, INP(28), D, D, D, ws + WS_WOUT1, nullptr, 0)
#undef MAT
        }
        const float* x_in = INP(0);
        for (int m = gw; m < M; m += NGW) { const f32x4* xr = (const f32x4*)(x_in + (size_t)m * D) + lane; f32x4 v[4]; float s = 0.f;
#pragma unroll
            for (int j = 0; j < 4; ++j) { v[j] = xr[64 * j]; s += (v[j][0] * v[j][0] + v[j][1] * v[j][1]) + (v[j][2] * v[j][2] + v[j][3] * v[j][3]); }
            s = wave_sum(s); if (lane < 4) ssq[(size_t)m * 4 + lane] = (lane == 0) ? s : 0.f;
            v2u* o = (v2u*)(XB + (size_t)m * D) + lane;
#pragma unroll
            for (int j = 0; j < 4; ++j) { v2u w; w.x = pk2(v[j][0], v[j][1]); w.y = pk2(v[j][2], v[j][3]); o[64 * j] = w; } }
        const float* g2 = INP(20);
        for (int i = bx * 512 + tid; i < 8192; i += G * 512) { const int ln = i & 63, ks = (i >> 6) & 7, nb = (i >> 9) & 1, hh = i >> 10; float f[8];
#pragma unroll
            for (int j = 0; j < 8; ++j) f[j] = g2[(size_t)(16 * ks + 8 * (ln >> 5) + j) * 512 + hh * 64 + 32 * nb + (ln & 31)];
            ((bf16x8*)(ws + WS_G2F))[i] = pack8(f); }
    }
    if (ph_lo == 0 && ph_hi > 1) GSYNC();

#define GEMM(EpiT, Aptr, Bptr, Nn, Kk, Eobj) do { pg8::Gemm g_{(const pg8::bf16_t*)(Aptr), (const pg8::bf16_t*)(Bptr), M, (Nn), (Kk)}; pg8::StaticOrder S_; S_.init(M, (Nn), G, bx); \
        pg8::gemm_phase<EpiT, pg8::StaticOrder, true, true>(lds, g_, S_, (Eobj), tid); } while (0)
#pragma unroll 1
    for (int L = 0; L < 2; ++L) {
#pragma unroll 1
        for (int st = 0; st < 9; ++st) {
            const int ph = 1 + 9 * L + st; if (ph < ph_lo || ph >= ph_hi) continue;
            switch (st) {
            case 0: case 6: {
#if PHM & 1
                FRESH();
                for (int dup = 0; dup < 1 + DUP_GU; ++dup) {
                const int f = (st == 6); pg8::EpiGU E{H, ssq + (size_t)((f ? 2 : 0) & 1) * M * 4};
                GEMM(pg8::EpiGU, (L == 1 && st == 0) ? Y : XB, ws + WS_WGU + (size_t)(L * 2 + f) * 11 * MiB, 2 * DFF, D, E);
                __syncthreads(); }
#endif
            } break;
            case 1: case 5: case 7: {
#if PHM & 2
                FRESH();
                const bf16* A; const bf16* Bt; int K; float alpha; float* so;
                if (st == 5) { A = (L == 0) ? Y : Qb; Bt = (const bf16*)(ws + (L == 0 ? WS_WOUT0 : WS_WOUT1)); K = D; alpha = 1.f; so = ssq; }
                else { const int f = (st == 7); A = H; Bt = (const bf16*)(ws + WS_WD + (size_t)(L * 2 + f) * D * DFF * 2); K = DFF; alpha = 0.5f; so = ssq + (size_t)M * 4; }
                pg8::EpiRes E{(L == 0 && st == 1) ? INP(0) : (const float*)X, X, XB, so, alpha, (LAS float*)(lds + 131072)};
                GEMM(pg8::EpiRes, A, Bt, D, K, E);
                if (st == 7) {
                    const f32x4* ps = (const f32x4*)(INP(1) + (size_t)L * M * PLE);
                    for (int i = bx * 512 + tid; i < M * PLE / 8; i += G * 512) { const f32x4 u0 = ps[2 * i], u1 = ps[2 * i + 1]; v4u w; w.x = pk2(u0[0], u0[1]); w.y = pk2(u0[2], u0[3]); w.z = pk2(u1[0], u1[1]); w.w = pk2(u1[2], u1[3]); ((v4u*)PB)[i] = w; }
                }
#endif
            } break;
            case 2: {
#if PHM & 4
                FRESH();
                pg8::EpiStore E{Qb, L ? D : EVEN_IN, ssq + (size_t)M * 4, QSCALE, L ? 4 : 2, L ? 4 : 1000, (size_t)M * D, -1, LF, INP(27)};
                for (int dup = 0; dup < 1 + DUP_INPROJ; ++dup) { GEMM(pg8::EpiStore, XB, ws + (L ? WS_WIN1 : WS_WIN0), L ? 3 * D : EVEN_IN, D, E); __syncthreads(); }
                if (L == 1) fox_gate_pass(XB, (const bf16*)(ws + WS_WIN1) + (size_t)3 * D * D, ssq + (size_t)M * 4, INP(27), LF, gw, NGW, lane);
#endif
            } break;
            case 3: {
                if (L == 0) {
#if PHM & 8
                    { FRESH();
#pragma unroll 1
                    for (int dup = 0; dup < 1 + DUP_SWA; ++dup)
                    for (int u = bx; u < 256; u += G) swa_unit(u, PROJ, Y, INP(14), lds, tid, lane, wid); }
#endif
#if PHM & 16
                    { FRESH();
#pragma unroll 1
                    for (int dup = 0; dup < 1 + DUP_SCAN; ++dup)
                    for (int u = bx; u < 256; u += G) rwkv_scan_unit(u, PROJ, YRAW, C3, INP(15), INP(16), INP(17), INP(18), INP(19), INP(21), INP(22), INP(23), lds, lane, wid); }
#endif
                } else {
#if PHM & 32
                    FRESH();
                    const int vcu = (G % 8 == 0) ? (bx % 8) * (G / 8) + bx / 8 : bx;
#pragma unroll 1
                    for (int v = vcu; v < 256; v += G)
#pragma unroll 1
                        for (int i = 0; i < 4; ++i) { int tid2 = tid; asm volatile("" : "+v"(tid2)); const int lane2 = tid2 & 63, wid2 = __builtin_amdgcn_readfirstlane(tid2 >> 6); const int s = v & 3, bh = v >> 2, qb = (i == 0) ? s : (i == 1) ? 7 - s : (i == 2) ? 8 + s : 15 - s;
                            if (i == 0) fox_prefix(LF + (size_t)(bh >> 4) * SEQ * 16 + (bh & 15), (LAS float*)(lds + 98304), (LAS float*)(lds + 131072), tid2, lane2, wid2);
                            attn_body::attn_unit<60>(bh >> 4, bh & 15, qb, (const attn_body::bf16*)Qb, (const attn_body::bf16*)Kb, (const attn_body::bf16*)Vb, (attn_body::bf16*)Qb, (char*)lds_raw, (attn_body::lds_fptr)(lds + 98304), tid2); }
#endif
                }
            } break;
            case 4: {
#if PHM & 64
                if (L == 0) { FRESH();
#pragma unroll 1
                    for (int dup = 0; dup < 1 + DUP_POST; ++dup)
                    for (int t = bx; t < M / 32; t += G) rwkv_post_unit(t, PROJ, YRAW, C3, Y, INP(15), (const bf16*)(ws + WS_G2F), INP(24), INP(25), lane, wid); }
#endif
            } break;
            case 8: {
#if PHM & 128
                FRESH();
#pragma unroll 1
                for (int mode = 0; mode < 2; ++mode) {
                    pg8::EpiPle E{mode, X, (L == 0) ? Y : (bf16*)nullptr, PP, ssq + (size_t)M * 4, ssq, (LAS float*)(lds + 131072)};
                    GEMM(pg8::EpiPle, mode ? XB : PB, mode ? ws + WS_WG + (size_t)L * 2 * MiB : ws + WS_WP + (size_t)L * PLE * D * 2, D, mode ? D : PLE, E);
                    __syncthreads();
                }
#endif
            } break;
            }
            if (!(L == 1 && st == 4) && ph + 1 < ph_hi) { GSYNC(); for (int dup = 0; dup < DUP_SYNC; ++dup) GSYNC(); }
        }
    }
#undef GEMM
    if (ph_hi == 20) { FRESH(); const float* fg = INP(29); const float* s8 = ssq;
        for (int m = gw; m < M; m += NGW) { f32x4* xr = (f32x4*)(X + (size_t)m * D) + lane; const float rs = pg8::rstd_of(s8, m);
#pragma unroll
            for (int j = 0; j < 4; ++j) { const f32x4 gv = ((const f32x4*)fg)[lane + 64 * j]; xr[64 * j] = xr[64 * j] * rs * gv; } } }
}

extern "C" void kernel_launch(void* const* d_in, const int* in_sizes, int n_in, void* d_out, int out_size, void* d_ws, size_t ws_size, hipStream_t stream) {
    static int grid = 0;
    if (grid == 0) {
        if (n_in != 30 || out_size != M * D || ws_size < WS_END) { fprintf(stderr, "kernel_launch: unexpected shapes (n_in %d out %d ws %zu)\n", n_in, out_size, ws_size); grid = -1; return; }
        int dev = 0, cus = 0, per_cu = 0;
        if (hipGetDevice(&dev) != hipSuccess || hipDeviceGetAttribute(&cus, hipDeviceAttributeMultiprocessorCount, dev) != hipSuccess) { grid = -1; return; }
        if (hipFuncSetAttribute((const void*)fwd_megakernel, hipFuncAttributeMaxDynamicSharedMemorySize, LDS_BYTES) != hipSuccess) { fprintf(stderr, "kernel_launch: hipFuncSetAttribute failed\n"); grid = -1; return; }
        if (hipOccupancyMaxActiveBlocksPerMultiprocessor(&per_cu, (const void*)fwd_megakernel, 512, LDS_BYTES) != hipSuccess || per_cu < 1) { fprintf(stderr, "kernel_launch: occupancy query failed (%d)\n", per_cu); (void)hipGetLastError(); grid = -1; return; }
        grid = cus * per_cu;
        if (grid > 256) grid = 256;
    }
    if (grid < 0) return;
    Args a{};
    for (int i = 0; i < 30; ++i) a.in[i] = (const float*)d_in[i];
    a.out = (float*)d_out; a.ws = (unsigned char*)d_ws;
#ifndef N_LAUNCH_PER_PHASE
    a.ph_lo = 0; a.ph_hi = 20;
    { void* args[] = {&a};
      hipError_t e = hipLaunchCooperativeKernel((const void*)fwd_megakernel, dim3(grid), dim3(512), args, LDS_BYTES, stream);
      if (e != hipSuccess) fprintf(stderr, "cooperative launch failed: %s (grid %d)\n", hipGetErrorString(e), grid); }
#else
    for (int ph = 0; ph < 20; ++ph) { if (ph == 14) continue; a.ph_lo = ph; a.ph_hi = ph + 1; void* args[] = {&a};
      hipError_t e = hipLaunchCooperativeKernel((const void*)fwd_megakernel, dim3(grid), dim3(512), args, LDS_BYTES, stream);
      if (e != hipSuccess) { fprintf(stderr, "cooperative launch failed: %s (grid %d)\n", hipGetErrorString(e), grid); break; } }
#endif
}
```
